# Optimizing an MI355X kernel written in HIP

```python
import jax, jax.numpy as jnp
from jax import lax
import numpy as np

D_MODEL = 1024
BATCH = 8
SEQ = 2048
DEPTH = 4

GRID_W = 64
CTX_LEN = 256
N_MIXERS = 2
EXPAND = 2
D_BRANCH = EXPAND * D_MODEL
FNET_GROUPS = 8
FNET_GROUP_DIM = D_BRANCH // FNET_GROUPS
RET_QK_DIM = 256
RET_HEADS = D_MODEL // RET_QK_DIM
RET_V_DIM = D_BRANCH // RET_HEADS
RET_CHUNK = 128
RET_IN_DIM = 2 * RET_HEADS * RET_QK_DIM + 2 * D_BRANCH
ROPE_BASE = 10000.0
EPS = 1e-6
N_FNET_LAYERS = (DEPTH + 1) // 2
N_RET_LAYERS = DEPTH // 2

kernel_name = 'hybrid_fnet_retention_dit_trunk'


def rmsnorm(x, g):
    xf = x.astype(jnp.float32)
    y = xf * lax.rsqrt(jnp.mean(xf * xf, axis=-1, keepdims=True) + EPS) * g.astype(jnp.float32)
    return y.astype(x.dtype)


def ada_params(cond, w, b):
    m = jax.nn.silu(cond) @ w + b
    return jnp.split(m, 3, axis=-1)


def fourier_mixer(h, w_in, w_out):
    b, l, _ = h.shape
    u, z = jnp.split(h @ w_in, 2, axis=-1)
    ug = u.astype(jnp.float32).reshape(b, l, FNET_GROUPS, FNET_GROUP_DIM)
    y = jnp.fft.fft2(ug, axes=(1, 3), norm='ortho').real
    y = y.reshape(b, l, D_BRANCH).astype(h.dtype)
    return (y * jax.nn.silu(z)) @ w_out


def axial_rope(t, row, col):
    half = t.shape[-1] // 2
    nf = half // 2
    freqs = ROPE_BASE ** (-jnp.arange(nf, dtype=jnp.float32) / nf)

    def rot(xp, pos):
        ang = pos[:, None] * freqs[None, :]
        cos = jnp.cos(ang)[None, :, None, :]
        sin = jnp.sin(ang)[None, :, None, :]
        x1, x2 = xp[..., :nf], xp[..., nf:]
        return jnp.concatenate([x1 * cos - x2 * sin, x1 * sin + x2 * cos], axis=-1)

    return jnp.concatenate([rot(t[..., :half], row), rot(t[..., half:], col)], axis=-1)


def ret_projections(h, w_in):
    b, l, _ = h.shape
    hq = RET_HEADS * RET_QK_DIM
    p = h @ w_in
    q, k, v, z = jnp.split(p, [hq, 2 * hq, 2 * hq + D_BRANCH], axis=-1)
    q = q.astype(jnp.float32).reshape(b, l, RET_HEADS, RET_QK_DIM)
    k = k.astype(jnp.float32).reshape(b, l, RET_HEADS, RET_QK_DIM) * (RET_QK_DIM ** -0.5)
    v = v.astype(jnp.float32).reshape(b, l, RET_HEADS, RET_V_DIM)
    return q, k, v, z


def chunk_retention(q, k, v, log_g, r0):
    b, h, l, _ = q.shape
    dv = v.shape[-1]
    n = l // RET_CHUNK
    idx = jnp.arange(RET_CHUNK, dtype=jnp.float32)
    diff = idx[:, None] - idx[None, :]
    dec_intra = jnp.where(diff[None] >= 0.0,
                          jnp.exp(jnp.maximum(diff, 0.0)[None] * log_g[:, None, None]), 0.0)
    dec_cross = jnp.exp((idx + 1.0)[None, :] * log_g[:, None])
    dec_state = jnp.exp((RET_CHUNK - 1.0 - idx)[None, :] * log_g[:, None])
    dec_chunk = jnp.exp(RET_CHUNK * log_g)[:, None, None]

    def to_chunks(t):
        return jnp.moveaxis(t.reshape(b, h, n, RET_CHUNK, t.shape[-1]), 2, 0)

    def step(r, qkv):
        qc, kc, vc = qkv
        s = jnp.einsum('bhjd,bhmd->bhjm', qc, kc) * dec_intra
        o = (jnp.einsum('bhjm,bhme->bhje', s, vc)
             + jnp.einsum('bhjd,bhde->bhje', qc, r) * dec_cross[..., None])
        r = dec_chunk * r + jnp.einsum('bhmd,bhme->bhde', kc * dec_state[..., None], vc)
        return r, o

    r, o = lax.scan(step, r0, (to_chunks(q), to_chunks(k), to_chunks(v)))
    o = jnp.moveaxis(o, 0, 2).reshape(b, h, l, dv)
    return o, r


def bi_retention(q, k, v, log_g_f, log_g_b, r0_f, r0_b):
    o_f, r_f = chunk_retention(q, k, v, log_g_f, r0_f)
    flip = lambda t: jnp.flip(t, axis=2)
    o_b, r_b = chunk_retention(flip(q), flip(k), flip(v), log_g_b, r0_b)
    return o_f + flip(o_b), r_f, r_b


def ret_output(o, z, w_out):
    b, h, l, dv = o.shape
    o = o * lax.rsqrt(jnp.mean(o * o, axis=-1, keepdims=True) + EPS)
    o = jnp.transpose(o, (0, 2, 1, 3)).reshape(b, l, h * dv).astype(z.dtype)
    return (o * jax.nn.silu(z)) @ w_out


def retention_mixer(h_lat, h_ctx, w_in, w_out, decay, row, col, need_ctx_out):
    log_g = jnp.log1p(-jnp.exp2(decay.astype(jnp.float32)))
    ql, kl, vl, zl = ret_projections(h_lat, w_in)
    qc, kc, vc, zc = ret_projections(h_ctx, w_in)
    ql = axial_rope(ql, row, col)
    kl = axial_rope(kl, row, col)
    tr = lambda t: jnp.transpose(t, (0, 2, 1, 3))
    b = h_lat.shape[0]
    zeros = jnp.zeros((b, RET_HEADS, RET_QK_DIM, RET_V_DIM), jnp.float32)
    oc, r_f, r_b = bi_retention(tr(qc), tr(kc), tr(vc), log_g[0], log_g[1], zeros, zeros)
    ol, _, _ = bi_retention(tr(ql), tr(kl), tr(vl), log_g[0], log_g[1], r_f, r_b)
    out_lat = ret_output(ol, zl, w_out)
    out_ctx = ret_output(oc, zc, w_out) if need_ctx_out else None
    return out_lat, out_ctx


def setup_inputs(seed: int = 0) -> dict:
    key = jax.random.key(seed)
    ks = jax.random.split(key, 16)
    f32 = jnp.float32
    nrm = lambda k, s: jax.random.normal(k, s, f32)
    return {
        'x': nrm(ks[0], (BATCH, SEQ, D_MODEL)),
        'c': nrm(ks[1], (BATCH, D_MODEL)),
        'ctx': nrm(ks[2], (BATCH, CTX_LEN, D_MODEL)),
        'c_ctx': nrm(ks[3], (D_MODEL,)),
        'norm_g': 1.0 + 0.02 * nrm(ks[4], (DEPTH, D_MODEL)),
        'ada_w': nrm(ks[5], (DEPTH, D_MODEL, 3 * D_MODEL)) * (0.5 * D_MODEL ** -0.5),
        'ada_b': 0.01 * nrm(ks[6], (DEPTH, 3 * D_MODEL)),
        'fnet_w_in': nrm(ks[7], (N_FNET_LAYERS, D_MODEL, 2 * D_BRANCH)) * D_MODEL ** -0.5,
        'fnet_w_out': nrm(ks[8], (N_FNET_LAYERS, D_BRANCH, D_MODEL)) * D_BRANCH ** -0.5,
        'ret_w_in': nrm(ks[9], (N_RET_LAYERS, D_MODEL, RET_IN_DIM)) * D_MODEL ** -0.5,
        'ret_w_out': nrm(ks[10], (N_RET_LAYERS, D_BRANCH, D_MODEL)) * D_BRANCH ** -0.5,
        'ret_decay': (-5.0 - jnp.arange(RET_HEADS, dtype=f32))[None, None, :]
                     + 0.1 * nrm(ks[11], (N_RET_LAYERS, 2, RET_HEADS)),
        'final_g': 1.0 + 0.02 * nrm(ks[12], (D_MODEL,)),
    }


def reference(x, c, ctx, c_ctx, norm_g, ada_w, ada_b, fnet_w_in, fnet_w_out,
              ret_w_in, ret_w_out, ret_decay, final_g):
    n_lat = x.shape[1]
    rows = n_lat // GRID_W
    pos = jnp.arange(rows * GRID_W)
    row = (pos // GRID_W).astype(jnp.float32)
    col = (pos % GRID_W).astype(jnp.float32)
    for i in range(DEPTH):
        last = i == DEPTH - 1
        sh_l, sc_l, gt_l = ada_params(c, ada_w[i], ada_b[i])
        sh_c, sc_c, gt_c = ada_params(c_ctx, ada_w[i], ada_b[i])
        hl = rmsnorm(x, norm_g[i]) * (1.0 + sc_l[:, None, :]) + sh_l[:, None, :]
        hc = rmsnorm(ctx, norm_g[i]) * (1.0 + sc_c) + sh_c
        j = i // N_MIXERS
        if i % N_MIXERS == 0:
            ol = fourier_mixer(hl, fnet_w_in[j], fnet_w_out[j])
            oc = None if last else fourier_mixer(hc, fnet_w_in[j], fnet_w_out[j])
        else:
            ol, oc = retention_mixer(hl, hc, ret_w_in[j], ret_w_out[j], ret_decay[j],
                                     row, col, not last)
        x = x + gt_l[:, None, :] * ol
        if not last:
            ctx = ctx + gt_c * oc
    return rmsnorm(x, final_g)
```

```cpp
#include <hip/hip_runtime.h>
#include <cstdio>
#include <cstdint>

#ifndef MK_PER_PHASE_LAUNCH
#define MK_PER_PHASE_LAUNCH 1
#endif

#define LAS __attribute__((address_space(3)))
#define GAS __attribute__((address_space(1)))
typedef unsigned short bf16_t;
typedef short bf16x8 __attribute__((ext_vector_type(8)));
typedef float f32x4 __attribute__((ext_vector_type(4)));
typedef float f32x16 __attribute__((ext_vector_type(16)));
typedef unsigned u32x4 __attribute__((ext_vector_type(4)));
typedef unsigned u32x2 __attribute__((ext_vector_type(2)));

constexpr int DM = 1024, NB = 8, SEQ = 2048, CTXL = 256, DBR = 2048, NLAYER = 4;
constexpr int NLAT = NB * SEQ, NCTX = NB * CTXL, NTOK = NLAT + NCTX;
constexpr float EPS = 1e-6f;

constexpr size_t MiB = 1u << 20;
constexpr size_t WS_CTL = 0, CTL_ZERO_BYTES = 1 * MiB;
constexpr size_t WS_ADA = 1 * MiB;
constexpr size_t WS_TC = 2 * MiB;
constexpr size_t WS_ROPE = 2 * MiB + 256 * 1024;
constexpr size_t WS_CS256 = 2 * MiB + 512 * 1024;
constexpr size_t WS_RINV = 3 * MiB;
constexpr size_t WS_XCTX = 4 * MiB;
constexpr size_t WS_W = 12 * MiB;
constexpr size_t WS_R = 28 * MiB;
constexpr size_t WS_H = WS_R;
constexpr size_t WS_Z = WS_R + 36 * MiB;
constexpr size_t WS_UTL = WS_R + 108 * MiB;
constexpr size_t WS_UTC = WS_R + 172 * MiB;
constexpr size_t WS_CS = WS_R + 180 * MiB;
constexpr size_t WS_Q = WS_R;
constexpr size_t WS_K = WS_R + 36 * MiB;
constexpr size_t WS_V = WS_R + 72 * MiB;
constexpr size_t WS_OF = WS_R + 144 * MiB;
constexpr size_t WS_SSP = WS_R + 216 * MiB;
constexpr size_t WS_END = 256 * MiB;
static_assert(WS_SSP + (size_t)NTOK * 32 * 4 <= WS_END && WS_CS + 16 * MiB + 0 <= WS_END, "ws map");

constexpr int LDS_BYTES = 147456;
constexpr int RING_BYTES = 131072;
constexpr int SCAN_RG = 34816;
constexpr int SCAN_SS_OFF = 4 * SCAN_RG;
constexpr int MISC_OFF = 145408;
static_assert(SCAN_SS_OFF + 2048 <= MISC_OFF && MISC_OFF + 512 <= LDS_BYTES, "lds map");

__device__ __forceinline__ unsigned f2bf(float f) { unsigned u = __builtin_bit_cast(unsigned, f); return (u + 0x7fffu + ((u >> 16) & 1u)) >> 16; }
__device__ __forceinline__ unsigned pk2(float lo, float hi) { return f2bf(lo) | (f2bf(hi) << 16); }
__device__ __forceinline__ float bflo(unsigned w) { return __builtin_bit_cast(float, w << 16); }
__device__ __forceinline__ float bfhi(unsigned w) { return __builtin_bit_cast(float, w & 0xffff0000u); }
__device__ __forceinline__ float bf1(bf16_t h) { return __builtin_bit_cast(float, (unsigned)h << 16); }
__device__ __forceinline__ float silu_f(float x) { return x * __builtin_amdgcn_rcpf(1.f + __expf(-x)); }
__device__ __forceinline__ float shx(float v, int o, int lane) { return __builtin_bit_cast(float, __builtin_amdgcn_ds_bpermute((lane ^ o) << 2, __builtin_bit_cast(int, v))); }
__device__ __forceinline__ float wave_sum(float v, int lane) {
#pragma unroll
    for (int o = 1; o < 64; o <<= 1) v += shx(v, o, lane);
    return v;
}

namespace pg8 {
constexpr int BM = 256, BK = 64, HALF = 128, HTB = HALF * BK * 2, STAGE_BYTES = 8 * HTB, NXCD = 8, WGM = 8;
__host__ __device__ __forceinline__ int lds_byte(int r, int c) { const int st = (r >> 4) * 2 + (c >> 5), rr = r & 15, cc = c & 31, ob = rr * 64 + cc * 2; return st * 1024 + (ob ^ (((ob >> 9) & 1) << 5)); }
__host__ __device__ __forceinline__ void stage_rc(int b, int& R, int& C) { const int st = b / 1024, sb = b % 1024, swz = sb ^ (((sb >> 9) & 1) << 5); R = (st >> 1) * 16 + swz / 64; C = (st & 1) * 32 + (swz % 64) / 2; }
__host__ __device__ __forceinline__ int perm32(int rho) { const int n = rho >> 4, i = rho & 15; return 8 * (i >> 2) + 4 * n + (i & 3); }
struct Unit { int pm, pn; };
struct Gemm { const bf16_t* A; const bf16_t* Bt; int lda, ldb, K; };
struct TileOrder {
    int nM, nN, nwg, G, c;
    __device__ void init(int nM_, int nN_, int G_, int c_) { nM = nM_; nN = nN_; nwg = nM * nN; G = G_; c = c_; }
    __device__ bool next(int i, Unit& u) const {
        const long L = (long)i * G + c; if (L >= nwg) return false;
        int wgid = (int)L; { const int q = nwg / NXCD, r = nwg % NXCD, xcd = wgid % NXCD, off = wgid / NXCD; wgid = (xcd < r ? xcd * (q + 1) : r * (q + 1) + (xcd - r) * q) + off; }
        const int nig = WGM * nN, gid = wgid / nig, fm = gid * WGM, gsz = (nM - fm) < WGM ? (nM - fm) : WGM;
        u.pm = fm + ((wgid % nig) % gsz); u.pn = (wgid % nig) / gsz; return true;
    }
};
__device__ __forceinline__ unsigned cvt_pk_bf16(float lo, float hi) { unsigned r; asm volatile("v_cvt_pk_bf16_f32 %0, %1, %2" : "=v"(r) : "v"(lo), "v"(hi)); return r; }

template <class Epi, bool ALIGN_EPI = true, bool SP2 = true>
__device__ __forceinline__ void gemm_phase(LAS unsigned char* lds, int wv, const Gemm g, const TileOrder& S, const Epi& E) {
    int tid; { int l_; asm volatile("v_mbcnt_lo_u32_b32 %0, -1, 0\n\tv_mbcnt_hi_u32_b32 %0, -1, %0" : "=v"(l_)); tid = wv * 64 + l_; }
    const int wid = __builtin_amdgcn_readfirstlane(tid >> 6), lane = tid & 63, wr = wid >> 2, wc = wid & 3, fr = lane & 15, fq = lane >> 4;
    const int K = g.K, nt = K / BK;
    unsigned voffA[2], voffB[2];
#pragma unroll
    for (int i = 0; i < 2; ++i) { int R, C; stage_rc(tid * 16 + i * 8192, R, C); const int Rb = Epi::PERM ? ((R & ~31) + perm32(R & 31)) : R;
        voffA[i] = (unsigned)(R * g.lda + C) * 2u; voffB[i] = (unsigned)(Rb * g.ldb + C) * 2u; }
    const size_t kstep = (size_t)(BK * 2);
    const size_t hstepA = (size_t)HALF * g.lda * 2, hstepB = (size_t)HALF * g.ldb * 2;
    const size_t tstepA = 2 * hstepA, tstepB = 2 * hstepB;
    const unsigned ldsw = (unsigned)wid * 1024u;
    const int aoff = lds_byte(wr * 64 + fr, fq * 8), boff = lds_byte(wc * 32 + fr, fq * 8);
#define PG8_SA(b, h) (((b) * 2 + (h)) * HTB)
#define PG8_SB(b, h) ((4 + (b) * 2 + (h)) * HTB)
#define PG8_STAGE(bufoff, gbase, voff) do { _Pragma("unroll") for (int _i = 0; _i < 2; ++_i) \
        __builtin_amdgcn_global_load_lds((const unsigned*)((const char*)(gbase) + (voff)[_i]), (LAS unsigned*)(lds + (bufoff) + ldsw + _i * 8192), 16, 0, 0); } while (0)
#define PG8_LDA(dst, b, h) do { _Pragma("unroll") for (int m = 0; m < 4; ++m) _Pragma("unroll") for (int k = 0; k < 2; ++k) dst[m][k] = *(const LAS bf16x8*)(lds + PG8_SA(b, h) + aoff + m * 2048 + k * 1024); } while (0)
#define PG8_LDB(dst, b, h) do { _Pragma("unroll") for (int n = 0; n < 2; ++n) _Pragma("unroll") for (int k = 0; k < 2; ++k) dst[n][k] = *(const LAS bf16x8*)(lds + PG8_SB(b, h) + boff + n * 2048 + k * 1024); } while (0)
#define PG8_MMA(ai, bj, At, Bt) do { __builtin_amdgcn_s_setprio(1); _Pragma("unroll") for (int m = 0; m < 4; ++m) _Pragma("unroll") for (int n = 0; n < 2; ++n) _Pragma("unroll") for (int k = 0; k < 2; ++k) \
        acc[ai][bj][m][n] = __builtin_amdgcn_mfma_f32_16x16x32_bf16(Bt[n][k], At[m][k], acc[ai][bj][m][n], 0, 0, 0); __builtin_amdgcn_s_setprio(0); } while (0)
#define PG8_WAIT_V(n) asm volatile("s_waitcnt vmcnt(" #n ")" ::: "memory")
#define PG8_WAIT_L(n) asm volatile("s_waitcnt lgkmcnt(" #n ")" ::: "memory")
#define PG8_BAR __builtin_amdgcn_s_barrier()
#define PG8_SCHED __builtin_amdgcn_sched_barrier(0)
    Unit cur, nxt; int ui = 0;
    if (!S.next(0, cur)) return;
    f32x4 acc[2][2][4][2];
#pragma unroll
    for (int a = 0; a < 2; ++a)
#pragma unroll
        for (int b = 0; b < 2; ++b)
#pragma unroll
            for (int m = 0; m < 4; ++m)
#pragma unroll
                for (int n = 0; n < 2; ++n) acc[a][b][m][n] = (f32x4){0.f, 0.f, 0.f, 0.f};
    bf16x8 At[4][2], B0[2][2], B1[2][2];
    const char* cA = (const char*)g.A + (size_t)cur.pm * tstepA; const char* cB = (const char*)g.Bt + (size_t)cur.pn * tstepB;
    if constexpr (SP2) {
        PG8_STAGE(PG8_SB(0, 0), cB, voffB); PG8_STAGE(PG8_SB(0, 1), cB + hstepB, voffB); PG8_STAGE(PG8_SA(0, 0), cA, voffA); PG8_STAGE(PG8_SA(0, 1), cA + hstepA, voffA);
        if (wr == 1) PG8_BAR;
        PG8_WAIT_V(2); PG8_BAR;
        PG8_STAGE(PG8_SB(1, 0), cB + kstep, voffB); PG8_STAGE(PG8_SA(1, 0), cA + kstep, voffA); PG8_STAGE(PG8_SB(1, 1), cB + hstepB + kstep, voffB);
        PG8_WAIT_V(6); PG8_BAR;
    } else {
        PG8_STAGE(PG8_SB(0, 0), cB, voffB); PG8_STAGE(PG8_SA(0, 0), cA, voffA); PG8_STAGE(PG8_SB(0, 1), cB + hstepB, voffB); PG8_STAGE(PG8_SA(0, 1), cA + hstepA, voffA);
        if (wr == 1) PG8_BAR;
        PG8_WAIT_V(4); PG8_BAR;
        PG8_STAGE(PG8_SB(1, 0), cB + kstep, voffB); PG8_STAGE(PG8_SA(1, 0), cA + kstep, voffA); PG8_STAGE(PG8_SB(1, 1), cB + hstepB + kstep, voffB);
        PG8_WAIT_V(6); PG8_BAR;
    }
    for (;;) {
        const bool has_next = S.next(ui + 1, nxt);
        const char* nA = has_next ? (const char*)g.A + (size_t)nxt.pm * tstepA : cA; const char* nB = has_next ? (const char*)g.Bt + (size_t)nxt.pn * tstepB : cB;
        for (int t = 0; t < nt; t += 2) {
            const bool last = (t == nt - 2);
            const char* a1 = cA + (size_t)(t + 1) * kstep;
            const char* a2 = last ? nA : cA + (size_t)(t + 2) * kstep; const char* b2 = last ? nB : cB + (size_t)(t + 2) * kstep;
            const char* a3 = a2 + kstep; const char* b3 = b2 + kstep;
            if constexpr (SP2) {
            PG8_LDB(B0, 0, 0); PG8_LDB(B1, 0, 1); PG8_SCHED; PG8_LDA(At, 0, 0); PG8_STAGE(PG8_SA(1, 1), a1 + hstepA, voffA);
            PG8_WAIT_V(8); PG8_WAIT_L(0); PG8_BAR; PG8_MMA(0, 0, At, B0); PG8_MMA(0, 1, At, B1); PG8_BAR; PG8_SCHED;
            PG8_LDA(At, 0, 1); PG8_STAGE(PG8_SB(0, 0), b2, voffB); PG8_STAGE(PG8_SB(0, 1), b2 + hstepB, voffB); PG8_STAGE(PG8_SA(0, 0), a2, voffA);
            PG8_WAIT_V(8); PG8_WAIT_L(0); PG8_BAR; PG8_MMA(1, 0, At, B0); PG8_MMA(1, 1, At, B1); PG8_BAR; PG8_SCHED;
            PG8_LDB(B0, 1, 0); PG8_LDB(B1, 1, 1); PG8_SCHED; PG8_LDA(At, 1, 0); PG8_STAGE(PG8_SA(0, 1), a2 + hstepA, voffA);
            PG8_WAIT_V(8); PG8_WAIT_L(0); PG8_BAR; PG8_MMA(0, 0, At, B0); PG8_MMA(0, 1, At, B1); PG8_BAR; PG8_SCHED;
            PG8_LDA(At, 1, 1); PG8_STAGE(PG8_SB(1, 0), b3, voffB); PG8_STAGE(PG8_SB(1, 1), b3 + hstepB, voffB); PG8_STAGE(PG8_SA(1, 0), a3, voffA);
            PG8_WAIT_V(8); PG8_WAIT_L(0); PG8_BAR; PG8_MMA(1, 0, At, B0); PG8_MMA(1, 1, At, B1); PG8_BAR; PG8_SCHED;
            } else {
            PG8_LDB(B0, 0, 0); PG8_SCHED; PG8_LDA(At, 0, 0); PG8_STAGE(PG8_SA(1, 1), a1 + hstepA, voffA);
            PG8_WAIT_L(8); PG8_BAR; PG8_WAIT_L(0); PG8_MMA(0, 0, At, B0); PG8_BAR; PG8_SCHED;
            PG8_LDB(B1, 0, 1); PG8_STAGE(PG8_SB(0, 0), b2, voffB);
            PG8_BAR; PG8_WAIT_L(0); PG8_MMA(0, 1, At, B1); PG8_BAR;
            PG8_LDA(At, 0, 1); PG8_STAGE(PG8_SA(0, 0), a2, voffA);
            PG8_BAR; PG8_WAIT_L(0); PG8_MMA(1, 0, At, B0); PG8_BAR; PG8_SCHED;
            PG8_STAGE(PG8_SB(0, 1), b2 + hstepB, voffB);
            PG8_WAIT_V(6); PG8_BAR; PG8_MMA(1, 1, At, B1); PG8_BAR;
            PG8_LDB(B0, 1, 0); PG8_SCHED; PG8_LDA(At, 1, 0); PG8_STAGE(PG8_SA(0, 1), a2 + hstepA, voffA);
            PG8_WAIT_L(8); PG8_BAR; PG8_WAIT_L(0); PG8_MMA(0, 0, At, B0); PG8_BAR; PG8_SCHED;
            PG8_LDB(B1, 1, 1); PG8_STAGE(PG8_SB(1, 0), b3, voffB);
            PG8_BAR; PG8_WAIT_L(0); PG8_MMA(0, 1, At, B1); PG8_BAR;
            PG8_LDA(At, 1, 1); PG8_STAGE(PG8_SA(1, 0), a3, voffA);
            PG8_BAR; PG8_WAIT_L(0); PG8_MMA(1, 0, At, B0); PG8_BAR; PG8_SCHED;
            PG8_STAGE(PG8_SB(1, 1), b3 + hstepB, voffB);
            PG8_WAIT_V(6); PG8_BAR; PG8_MMA(1, 1, At, B1); PG8_BAR;
            }
        }
        if constexpr (ALIGN_EPI) { if (wr == 0) PG8_BAR; }
        E(acc, cur, wr, wc, fr, fq);
        if (!has_next) break;
#pragma unroll
        for (int a = 0; a < 2; ++a)
#pragma unroll
            for (int b = 0; b < 2; ++b)
#pragma unroll
                for (int m = 0; m < 4; ++m)
#pragma unroll
                    for (int n = 0; n < 2; ++n) acc[a][b][m][n] = (f32x4){0.f, 0.f, 0.f, 0.f};
        cur = nxt; cA = nA; cB = nB; ++ui;
        if constexpr (ALIGN_EPI) { if (wr == 1) PG8_BAR; }
    }
    PG8_WAIT_V(0);
    if constexpr (!ALIGN_EPI) { if (wr == 0) PG8_BAR; }
    PG8_BAR;
#undef PG8_SA
#undef PG8_SB
#undef PG8_STAGE
#undef PG8_LDA
#undef PG8_LDB
#undef PG8_MMA
#undef PG8_WAIT_V
#undef PG8_WAIT_L
#undef PG8_BAR
#undef PG8_SCHED
}
}
using pg8::cvt_pk_bf16;
typedef const f32x4 (&AccRef)[2][2][4][2];

struct EpiSilu {
    static constexpr bool PERM = true;
    bf16_t* O; int ldc;
    __device__ __forceinline__ void operator()(AccRef acc, const pg8::Unit& u, int wr, int wc, int fr, int fq) const {
        const int row0 = u.pm * 256 + wr * 64 + fr, col0 = u.pn * 256 + wc * 32 + 8 * fq;
#pragma unroll
        for (int ai = 0; ai < 2; ++ai)
#pragma unroll
            for (int m = 0; m < 4; ++m) { bf16_t* rowp = O + (size_t)(row0 + ai * 128 + m * 16) * ldc + col0;
#pragma unroll
                for (int bj = 0; bj < 2; ++bj) { const f32x4 v0 = acc[ai][bj][m][0], v1 = acc[ai][bj][m][1]; u32x4 w;
                    w.x = cvt_pk_bf16(silu_f(v0[0]), silu_f(v0[1])); w.y = cvt_pk_bf16(silu_f(v0[2]), silu_f(v0[3]));
                    w.z = cvt_pk_bf16(silu_f(v1[0]), silu_f(v1[1])); w.w = cvt_pk_bf16(silu_f(v1[2]), silu_f(v1[3]));
                    *(u32x4*)(rowp + bj * 128) = w; } }
    }
};
struct EpiUT {
    static constexpr bool PERM = true;
    bf16_t* UTl; bf16_t* UTc;
    __device__ __forceinline__ void operator()(AccRef acc, const pg8::Unit& u, int wr, int wc, int fr, int fq) const {
        const int feat0 = u.pm * 256 + wr * 64 + fr; bf16_t* base; int L;
        if (u.pn < 64) { const int b = u.pn >> 3, l0 = (u.pn & 7) * 256; base = UTl + (size_t)b * 2048 * 2048 + l0; L = 2048; }
        else { const int b = u.pn - 64; base = UTc + (size_t)b * 2048 * 256; L = 256; }
        const int col0 = wc * 32 + 8 * fq;
#pragma unroll
        for (int ai = 0; ai < 2; ++ai)
#pragma unroll
            for (int m = 0; m < 4; ++m) { bf16_t* rowp = base + (size_t)(feat0 + ai * 128 + m * 16) * L + col0;
#pragma unroll
                for (int bj = 0; bj < 2; ++bj) { const f32x4 v0 = acc[ai][bj][m][0], v1 = acc[ai][bj][m][1]; u32x4 w;
                    w.x = cvt_pk_bf16(v0[0], v0[1]); w.y = cvt_pk_bf16(v0[2], v0[3]); w.z = cvt_pk_bf16(v1[0], v1[1]); w.w = cvt_pk_bf16(v1[2], v1[3]);
                    *(u32x4*)(rowp + bj * 128) = w; } }
    }
};
struct EpiDft {
    static constexpr bool PERM = true;
    bf16_t* Z; int L; int tok_base;
    __device__ __forceinline__ void operator()(AccRef acc, const pg8::Unit& u, int wr, int wc, int fr, int fq) const {
        const int b = u.pn >> 3, g = u.pn & 7, k0 = u.pm * 128 + wr * 64 + fr, mi0 = wc * 32 + 8 * fq;
#pragma unroll
        for (int m = 0; m < 4; ++m) {
            const int k = k0 + 16 * m; bf16_t* zrow = Z + (size_t)(tok_base + b * L + k) * 2048 + g * 256;
#pragma unroll
            for (int n = 0; n < 2; ++n) {
                const int mi = mi0 + 4 * n; const f32x4 P = acc[0][0][m][n], Q = acc[1][1][m][n];
                const u32x2 s = *(const u32x2*)(zrow + mi);
                float y0 = (mi == 0) ? P[0] : (P[0] - Q[0]);
                u32x2 o; o.x = cvt_pk_bf16(y0 * bflo(s.x), (P[1] - Q[1]) * bfhi(s.x)); o.y = cvt_pk_bf16((P[2] - Q[2]) * bflo(s.y), (P[3] - Q[3]) * bfhi(s.y));
                *(u32x2*)(zrow + mi) = o;
#pragma unroll
                for (int e = 0; e < 4; ++e) if (mi + e >= 1) { const int c = 256 - (mi + e); zrow[c] = (bf16_t)f2bf((P[e] + Q[e]) * bf1(zrow[c])); }
            }
            if (wc == 0 && fq == 0) zrow[128] = (bf16_t)f2bf(acc[0][1][m][0][0] * bf1(zrow[128]));
        }
    }
};
struct EpiResid {
    static constexpr bool PERM = false;
    const float* xin_lat; const float* xin_ctx; float* xout_lat; float* xout_ctx; const float* gate;
    __device__ __forceinline__ void operator()(AccRef acc, const pg8::Unit& u, int wr, int wc, int fr, int fq) const {
        const int row0 = u.pm * 256 + wr * 64 + fr, col0 = u.pn * 256 + wc * 32 + 4 * fq;
        const bool lat = u.pm < 64; const int r = lat ? (u.pm >> 3) : 8;
        const float* xi = lat ? xin_lat : xin_ctx - (size_t)NLAT * DM; float* xo = lat ? xout_lat : xout_ctx - (size_t)NLAT * DM;
        const float* gp = gate + r * 3072 + col0;
        f32x4 gv[2][2];
#pragma unroll
        for (int bj = 0; bj < 2; ++bj)
#pragma unroll
            for (int n = 0; n < 2; ++n) gv[bj][n] = *(const f32x4*)(gp + bj * 128 + n * 16);
#pragma unroll
        for (int ai = 0; ai < 2; ++ai)
#pragma unroll
            for (int m = 0; m < 4; ++m) { const size_t off = (size_t)(row0 + ai * 128 + m * 16) * DM + col0;
#pragma unroll
                for (int bj = 0; bj < 2; ++bj)
#pragma unroll
                    for (int n = 0; n < 2; ++n) { const f32x4 xv = *(const f32x4*)(xi + off + bj * 128 + n * 16);
                        *(f32x4*)(xo + off + bj * 128 + n * 16) = xv + gv[bj][n] * acc[ai][bj][m][n]; }
                asm volatile("" ::: "memory"); }
    }
};
struct EpiQKV {
    static constexpr bool PERM = true;
    bf16_t* Q; bf16_t* K; bf16_t* V; const float* rcos; const float* rsin;
    __device__ __forceinline__ void operator()(AccRef acc, const pg8::Unit& u, int wr, int wc, int fr, int fq) const {
        const int row0 = u.pm * 256 + wr * 64 + fr, c0 = wc * 32 + 8 * fq;
        if (u.pn >= 8) {
#pragma unroll
            for (int ai = 0; ai < 2; ++ai)
#pragma unroll
                for (int m = 0; m < 4; ++m) { bf16_t* rowp = V + (size_t)(row0 + ai * 128 + m * 16) * 2048 + (u.pn - 8) * 256 + c0;
#pragma unroll
                    for (int bj = 0; bj < 2; ++bj) { const f32x4 v0 = acc[ai][bj][m][0], v1 = acc[ai][bj][m][1]; u32x4 w;
                        w.x = cvt_pk_bf16(v0[0], v0[1]); w.y = cvt_pk_bf16(v0[2], v0[3]); w.z = cvt_pk_bf16(v1[0], v1[1]); w.w = cvt_pk_bf16(v1[2], v1[3]);
                        *(u32x4*)(rowp + bj * 128) = w; } }
            return;
        }
        const bool isk = u.pn >= 4, lat = u.pm < 64; const int h = u.pn & 3; bf16_t* dst = isk ? K : Q; const float sc = isk ? 0.0625f : 1.0f;
        const int i0 = 16 * wc + 4 * fq;
#pragma unroll
        for (int ai = 0; ai < 2; ++ai)
#pragma unroll
            for (int m = 0; m < 4; ++m) { const int row = row0 + ai * 128 + m * 16, l = row & 2047; bf16_t* rowp = dst + (size_t)row * 1024 + h * 256 + c0;
#pragma unroll
                for (int bj = 0; bj < 2; ++bj) { f32x4 x1 = acc[ai][bj][m][0], x2 = acc[ai][bj][m][1];
                    if (lat) { const int pos = bj == 0 ? (l >> 6) : (l & 63); const f32x4 cv = *(const f32x4*)(rcos + pos * 64 + i0), sv = *(const f32x4*)(rsin + pos * 64 + i0);
                        const f32x4 o1 = x1 * cv - x2 * sv, o2 = x1 * sv + x2 * cv; x1 = o1; x2 = o2; }
                    x1 = x1 * sc; x2 = x2 * sc; u32x4 w;
                    w.x = cvt_pk_bf16(x1[0], x1[1]); w.y = cvt_pk_bf16(x1[2], x1[3]); w.z = cvt_pk_bf16(x2[0], x2[1]); w.w = cvt_pk_bf16(x2[2], x2[3]);
                    *(u32x4*)(rowp + bj * 128) = w; } }
    }
};
struct EpiZGate {
    static constexpr bool PERM = true;
    const bf16_t* O; const float* rinv; bf16_t* AO;
    __device__ __forceinline__ void operator()(AccRef acc, const pg8::Unit& u, int wr, int wc, int fr, int fq) const {
        const int row0 = u.pm * 256 + wr * 64 + fr, col0 = u.pn * 256 + wc * 32 + 8 * fq, head = u.pn >> 1;
#pragma unroll
        for (int ai = 0; ai < 2; ++ai)
#pragma unroll
            for (int m = 0; m < 4; ++m) { const int row = row0 + ai * 128 + m * 16; const float rv = rinv[row * 4 + head];
#pragma unroll
                for (int bj = 0; bj < 2; ++bj) { const size_t off = (size_t)row * 2048 + col0 + bj * 128; const u32x4 o = *(const u32x4*)(O + off);
                    const f32x4 v0 = acc[ai][bj][m][0], v1 = acc[ai][bj][m][1]; u32x4 w;
                    w.x = cvt_pk_bf16(bflo(o.x) * rv * silu_f(v0[0]), bfhi(o.x) * rv * silu_f(v0[1])); w.y = cvt_pk_bf16(bflo(o.y) * rv * silu_f(v0[2]), bfhi(o.y) * rv * silu_f(v0[3]));
                    w.z = cvt_pk_bf16(bflo(o.z) * rv * silu_f(v1[0]), bfhi(o.z) * rv * silu_f(v1[1])); w.w = cvt_pk_bf16(bflo(o.w) * rv * silu_f(v1[2]), bfhi(o.w) * rv * silu_f(v1[3]));
                    *(u32x4*)(AO + off) = w; } }
    }
};

#define XB_TMO      128
#define XB_XCNT(j)  (256  + 64 * (j))
#define XB_XSUB(j)  (1280 + 64 * (j))
#define XB_XGEN(j)  (2304 + 64 * (j))
#define XB_TOP      3328
#define XB_TOPGEN   3392
#define XCD_BAR_WORDS 3456
#define XB_SPIN_CAP (1u << 18)
__device__ __forceinline__ unsigned xb_ld(unsigned* p)              { return __hip_atomic_load(p, __ATOMIC_RELAXED, __HIP_MEMORY_SCOPE_AGENT); }
__device__ __forceinline__ unsigned xb_add(unsigned* p, unsigned v) { return __hip_atomic_fetch_add(p, v, __ATOMIC_RELAXED, __HIP_MEMORY_SCOPE_AGENT); }
__device__ __forceinline__ unsigned xb_xcc_id() { return (unsigned)__builtin_amdgcn_s_getreg((3 << 11) | 20) & 0xFu; }
#define XB_SPIN(cond, bar) do { unsigned _sp = 0; while (cond) { __builtin_amdgcn_s_sleep(1); \
    if ((++_sp & 255u) == 0u) { if (xb_ld(&(bar)[XB_TMO])) break; if (_sp > XB_SPIN_CAP) { atomicAdd(&(bar)[XB_TMO], 1u); break; } } } } while (0)
struct XcdBarrier { unsigned* bar; unsigned x; volatile LAS unsigned* st; };
__device__ __forceinline__ XcdBarrier xcd_barrier_post(unsigned* bar, volatile LAS unsigned* st) {
    XcdBarrier b; b.bar = bar; b.x = xb_xcc_id(); b.st = st;
    if (threadIdx.x == 0) (void)xb_add(&bar[XB_XCNT(b.x)], 1u);
    return b;
}
__device__ __forceinline__ void xcd_barrier_complete(unsigned* bar, unsigned x, unsigned& nloc, unsigned& nx) {
    const unsigned G = gridDim.x * gridDim.y * gridDim.z;
    unsigned sum, cnt, mine, sp = 0u;
    for (;;) {
        sum = 0u; cnt = 0u; mine = 0u;
#pragma unroll
        for (unsigned j = 0; j < 16; ++j) { const unsigned c = xb_ld(&bar[XB_XCNT(j)]); sum += c; cnt += (c > 0u) ? 1u : 0u; mine = (j == x) ? c : mine; }
        if (sum == G) break;
        __builtin_amdgcn_s_sleep(1);
        if ((++sp & 255u) == 0u) { if (xb_ld(&bar[XB_TMO])) break; if (sp > XB_SPIN_CAP) { atomicAdd(&bar[XB_TMO], 1u); break; } }
    }
    nloc = mine > 0u ? mine : 1u; nx = cnt > 0u ? cnt : 1u;
}
__device__ __forceinline__ void xcd_barrier(const XcdBarrier& b) {
    asm volatile("s_waitcnt vmcnt(0)" ::: "memory");
    __syncthreads();
    if (threadIdx.x == 0) {
        unsigned* bar = b.bar;
        __builtin_amdgcn_s_waitcnt(0);
        unsigned nloc = b.st[0], nx = b.st[1];
        if (nloc == 0u) { xcd_barrier_complete(bar, b.x, nloc, nx); b.st[0] = nloc; b.st[1] = nx; }
        const unsigned old = xb_add(&bar[XB_XSUB(b.x)], 1u);
        const unsigned gen = old / nloc;
        if (old + 1u == (gen + 1u) * nloc) {
            __builtin_amdgcn_fence(__ATOMIC_RELEASE, "agent");
            asm volatile("s_waitcnt vmcnt(0)" ::: "memory");
            const unsigned og = xb_add(&bar[XB_TOP], 1u);
            const unsigned tg = og / nx;
            if (og + 1u == (tg + 1u) * nx) xb_add(&bar[XB_TOPGEN], 1u);
            else XB_SPIN(xb_ld(&bar[XB_TOPGEN]) == tg, bar);
            __builtin_amdgcn_fence(__ATOMIC_ACQUIRE, "agent");
            xb_add(&bar[XB_XGEN(b.x)], 1u);
            asm volatile("s_waitcnt vmcnt(0)" ::: "memory");
        } else {
            XB_SPIN(xb_ld(&bar[XB_XGEN(b.x)]) == gen, bar);
            __builtin_amdgcn_fence(__ATOMIC_ACQUIRE, "agent");
            asm volatile("s_waitcnt vmcnt(0)" ::: "memory");
        }
    }
    __syncthreads();
}

struct Args { const float* in[13]; float* out; unsigned char* ws; int ph_lo, ph_hi, pad0, pad1; };
struct Frame {
    LAS unsigned char* lds;
    int vcu, G, wv;
    unsigned char* ws;
};
__device__ __forceinline__ int lane_id() { int l; asm volatile("v_mbcnt_lo_u32_b32 %0, -1, 0\n\tv_mbcnt_hi_u32_b32 %0, -1, %0" : "=v"(l)); return l; }
__device__ __forceinline__ unsigned char* launder_ptr(unsigned char* p) {
    unsigned lo = (unsigned)(unsigned long long)p, hi = (unsigned)((unsigned long long)p >> 32);
    asm volatile("" : "+s"(lo), "+s"(hi));
    return (unsigned char*)(((unsigned long long)hi << 32) | lo);
}
#define PHASE_IDS() int tid = F.wv * 64 + lane_id(); asm volatile("" : "+v"(tid)); const int lane = tid & 63, wave = __builtin_amdgcn_readfirstlane(tid >> 6); (void)lane; (void)wave; \
    unsigned char* ws = launder_ptr(F.ws); (void)ws
#define LDS_WAIT() asm volatile("s_waitcnt lgkmcnt(0)" ::: "memory")

__device__ __forceinline__ int qk_pos(int d) { const int half = d >> 7, n = (d >> 6) & 1, i = d & 63; return 128 * half + 8 * (i >> 2) + 4 * n + (i & 3); }
template <int MODE>
__device__ __forceinline__ void transpose_item(const float* W, int K, int N, int n_begin, bf16_t* WT, LAS float* scr, int item, int nblk, int lane) {
    const int kb = item / nblk, nb = item % nblk, k0 = 64 * kb, n0 = n_begin + 32 * nb;
#pragma unroll 8
    for (int i = 0; i < 32; ++i) { const int kk = 2 * i + (lane >> 5); scr[kk * 33 + (lane & 31)] = W[(size_t)(k0 + kk) * N + n0 + (lane & 31)]; }
    LDS_WAIT(); asm volatile("" ::: "memory");
    const int c = lane & 7;
#pragma unroll
    for (int j = 0; j < 4; ++j) { const int n = (lane >> 3) + 8 * j; const LAS float* s = scr + (8 * c) * 33 + n;
        u32x4 o; o.x = pk2(s[0 * 33], s[1 * 33]); o.y = pk2(s[2 * 33], s[3 * 33]); o.z = pk2(s[4 * 33], s[5 * 33]); o.w = pk2(s[6 * 33], s[7 * 33]);
        int nn = n0 + n - n_begin;
        if (MODE == 1) { const int na = n0 + n; nn = (na < 2048) ? ((na & ~255) + qk_pos(na & 255)) : na; }
        *(u32x4*)(WT + (size_t)nn * K + k0 + 8 * c) = o; }
    LDS_WAIT(); asm volatile("" ::: "memory");
}
__device__ __forceinline__ void fold_task(const float* Win  , const float* TC, bf16_t* WfT, int t, int lane) {
    const int g = t >> 8, p0 = ((t >> 5) & 7) * 32, kk0 = (t & 31) * 32, s = lane >> 5, li = lane & 31;
    f32x16 acc;
#pragma unroll
    for (int i = 0; i < 16; ++i) acc[i] = 0.f;
    const float* wrow = Win + (size_t)(kk0 + li) * 4096 + g * 256 + 4 * s;
    const float* tcol = TC + p0 + li;
#pragma unroll 4
    for (int tp = 0; tp < 32; ++tp) {
        const f32x4 wv = *(const f32x4*)(wrow + 8 * tp);
#pragma unroll
        for (int uu = 0; uu < 4; ++uu) { const float a = tcol[(8 * tp + 4 * s + uu) * 256]; acc = __builtin_amdgcn_mfma_f32_32x32x2f32(a, wv[uu], acc, 0, 0, 0); }
    }
#pragma unroll
    for (int i = 0; i < 16; ++i) { const int row = (i & 3) + 8 * (i >> 2) + 4 * s; WfT[(size_t)(g * 256 + p0 + row) * 1024 + kk0 + li] = (bf16_t)f2bf(acc[i]); }
}

__device__ __forceinline__ void p0_phase(Frame& F, const Args& a) {
    PHASE_IDS();
    float* ADA = (float*)(ws + WS_ADA);
    const float* c = a.in[1]; const float* cctx = a.in[3]; const float* ada_w = a.in[5]; const float* ada_b = a.in[6];
    LAS float* sl = (LAS float*)F.lds;
    LAS float* part = (LAS float*)(F.lds + 36864);
    bool loaded = false;
#ifndef DBG_P0
#define DBG_P0 3
#endif
    if (DBG_P0 & 1)
    for (int u = F.vcu; u < 192; u += F.G) {
        if (!loaded) { for (int idx = tid; idx < 9 * 1024; idx += 512) { const int r = idx >> 10, k = idx & 1023; const float x = r < 8 ? c[r * 1024 + k] : cctx[k]; sl[idx] = x / (1.f + expf(-x)); } loaded = true; }
        __syncthreads();
        const int i = u / 48, n0 = (u % 48) * 64;
        float acc[9];
#pragma unroll
        for (int r = 0; r < 9; ++r) acc[r] = 0.f;
        const float* wp = ada_w + ((size_t)i * 1024 + wave * 128) * 3072 + n0 + lane;
#pragma unroll 8
        for (int kk = 0; kk < 128; ++kk) { const float wv = wp[(size_t)kk * 3072]; const int k = wave * 128 + kk;
#pragma unroll
            for (int r = 0; r < 9; ++r) acc[r] += sl[r * 1024 + k] * wv; }
#pragma unroll
        for (int r = 0; r < 9; ++r) part[(wave * 9 + r) * 64 + lane] = acc[r];
        __syncthreads();
        for (int idx = tid; idx < 576; idx += 512) { const int r = idx >> 6, l = idx & 63; float s = 0.f;
#pragma unroll
            for (int w = 0; w < 8; ++w) s += part[(w * 9 + r) * 64 + l];
            ADA[(i * 9 + r) * 3072 + n0 + l] = s + ada_b[i * 3072 + n0 + l]; }
    }
    if (!(DBG_P0 & 2)) return;
    const int gt = F.vcu * 512 + tid, NT = F.G * 512;
    float* TC = (float*)(ws + WS_TC);
    for (int idx = gt; idx < 65536; idx += NT) { const int cc = idx >> 8, p = idx & 255; float v;
        if (p < 128) v = cospif((float)((p * cc) & 255) * (1.f / 128.f));
        else if (p == 128) v = (cc & 1) ? -1.f : 1.f;
        else v = sinpif((float)(((p - 128) * cc) & 255) * (1.f / 128.f));
        TC[idx] = v * 0.0625f; }
    float* RC = (float*)(ws + WS_ROPE); float* RS = RC + 4096;
    for (int idx = gt; idx < 4096; idx += NT) { const int pos = idx >> 6, i = idx & 63; const float freq = powf(10000.0f, -(float)i / 64.0f); const float ang = (float)pos * freq;
        RC[idx] = cosf(ang); RS[idx] = sinf(ang); }
    bf16_t* CS256 = (bf16_t*)(ws + WS_CS256);
    for (int idx = gt; idx < 512 * 256; idx += NT) { const int row = idx >> 8, l = idx & 255, kt = row >> 8, hf = (row >> 7) & 1, k = kt * 128 + (row & 127);
        const float x = (float)((k * l) & 255) * (1.f / 128.f); const float v = (hf ? sinpif(x) : cospif(x)) * 0.0625f; CS256[idx] = (bf16_t)f2bf(v); }
}

__device__ __forceinline__ void norm_row(const float* xrow, const float* ng, const float* adar  , bf16_t* orow, int lane) {
    const f32x4* xr = (const f32x4*)xrow + lane;
    f32x4 v[4]; float s = 0.f;
#pragma unroll
    for (int j = 0; j < 4; ++j) { v[j] = xr[64 * j]; s += (v[j].x * v[j].x + v[j].y * v[j].y) + (v[j].z * v[j].z + v[j].w * v[j].w); }
    const float rinv = rsqrtf(wave_sum(s, lane) * (1.f / DM) + EPS);
    unsigned long long* o8 = (unsigned long long*)orow + lane;
#pragma unroll
    for (int j = 0; j < 4; ++j) { const int col = 4 * lane + 256 * j; const f32x4 g = *(const f32x4*)(ng + col), sh = *(const f32x4*)(adar + col), sc = *(const f32x4*)(adar + 1024 + col);
        const f32x4 y = v[j] * rinv * g * (sc + 1.0f) + sh;
        o8[64 * j] = (unsigned long long)pk2(y.x, y.y) | ((unsigned long long)pk2(y.z, y.w) << 32); }
}
__device__ __forceinline__ void norm_rows(Frame& F, const Args& a, int layer, bf16_t* H) {
    PHASE_IDS();
    const float* xl = layer == 0 ? a.in[0] : a.out; const float* xc = layer == 0 ? a.in[2] : (const float*)(ws + WS_XCTX);
    const float* ng = a.in[4] + layer * DM; const float* ADA = (const float*)(ws + WS_ADA) + layer * 9 * 3072;
    const int gw = F.vcu * 8 + wave, NGW = F.G * 8;
    for (int m = gw; m < NTOK; m += NGW) {
        const bool lat = m < NLAT; const int r = lat ? (m >> 11) : 8;
        const float* xrow = lat ? xl + (size_t)m * DM : xc + (size_t)(m - NLAT) * DM;
        norm_row(xrow, ng, ADA + r * 3072, H + (size_t)m * DM, lane);
    }
}
__device__ __forceinline__ void n_phase(Frame& F, const Args& a, int layer) {
    PHASE_IDS();
    const bool fourier = (layer & 1) == 0; const int j = layer >> 1;
    norm_rows(F, a, layer, (bf16_t*)(ws + (fourier ? WS_H : WS_OF)));
    LAS float* scr = (LAS float*)(F.lds + wave * 16384);
    const int gw = F.vcu * 8 + wave, NGW = F.G * 8;
    bf16_t* W1 = (bf16_t*)(ws + WS_W);
    if (fourier) {
        const float* win = a.in[7] + (size_t)j * 1024 * 4096; const float* wout = a.in[8] + (size_t)j * 2048 * 1024;
        bf16_t* WfoT = W1 + (size_t)4096 * 1024;
        for (int t = gw; t < 2048; t += NGW) fold_task(win, (const float*)(ws + WS_TC), W1, t, lane);
        for (int it = gw; it < 16 * 64; it += NGW) transpose_item<0>(win, 1024, 4096, 2048, W1 + (size_t)2048 * 1024, scr, it, 64, lane);
        for (int it = gw; it < 32 * 32; it += NGW) transpose_item<0>(wout, 2048, 1024, 0, WfoT, scr, it, 32, lane);
        bf16_t* CS = (bf16_t*)(ws + WS_CS);
        const int gt = F.vcu * 512 + tid, NT = F.G * 512;
        for (int ch = gt; ch < 4096 * 256; ch += NT) { const int row = ch >> 8, l0 = (ch & 255) * 8, kt = row >> 8, hf = (row >> 7) & 1, k = kt * 128 + (row & 127);
            unsigned w[4];
#pragma unroll
            for (int e = 0; e < 4; ++e) { float v[2];
#pragma unroll
                for (int q = 0; q < 2; ++q) { const int l = l0 + 2 * e + q; const float x = (float)((k * l) & 2047) * (1.f / 1024.f); v[q] = (hf ? sinpif(x) : cospif(x)) * 0.022097087f; }
                w[e] = pk2(v[0], v[1]); }
            *(u32x4*)(CS + (size_t)row * 2048 + l0) = (u32x4){w[0], w[1], w[2], w[3]}; }
    } else {
        const float* win = a.in[9] + (size_t)j * 1024 * 6144; const float* wout = a.in[10] + (size_t)j * 2048 * 1024;
        bf16_t* WroT = W1 + (size_t)6144 * 1024;
        for (int it = gw; it < 16 * 192; it += NGW) transpose_item<1>(win, 1024, 6144, 0, W1, scr, it, 192, lane);
        for (int it = gw; it < 32 * 32; it += NGW) transpose_item<0>(wout, 2048, 1024, 0, WroT, scr, it, 32, lane);
    }
}

typedef short bf16x4 __attribute__((ext_vector_type(4)));
__device__ __forceinline__ void scan_unit(Frame& F, int tid, int b, int h, int sl, int dir, float lg,
                                          const bf16_t* Qg, const bf16_t* Kg, const bf16_t* Vg, bf16_t* OF, float* SSP) {
    LAS unsigned char* B0 = F.lds; LAS unsigned char* B1 = F.lds + SCAN_RG; LAS unsigned char* B2 = F.lds + 2 * SCAN_RG; LAS unsigned char* B3 = F.lds + 3 * SCAN_RG;
    LAS float* ssl = (LAS float*)(F.lds + SCAN_SS_OFF);
    const int lane = tid & 63, w = __builtin_amdgcn_readfirstlane(tid >> 6), r = lane & 15, q = lane >> 4, half = w >> 2, eg = w & 3;
    const float g128 = __expf(128.f * lg);
    float wm[2], rsc[4];
#pragma unroll
    for (int i = 0; i < 2; ++i) { const int m = (tid >> 3) + 64 * i; wm[i] = __expf(lg * (float)(dir == 0 ? 127 - m : m)); }
#pragma unroll
    for (int jb = 0; jb < 4; ++jb) { const int jj = 64 * half + 16 * jb + r; rsc[jb] = __expf(lg * (float)(dir == 0 ? jj - 127 : -jj)); }
    f32x4 Rb[8];
#pragma unroll
    for (int i = 0; i < 8; ++i) Rb[i] = (f32x4){0.f, 0.f, 0.f, 0.f};
    for (int s = 0; s < 18; ++s) {
        int t0;
        if (dir == 0) t0 = (s < 2) ? (NLAT + b * CTXL + s * 128) : (b * SEQ + (s - 2) * 128);
        else t0 = (s < 2) ? (NLAT + b * CTXL + (1 - s) * 128) : (b * SEQ + (17 - s) * 128);
        {
            u32x4 qv[8], kv[8];
#pragma unroll
            for (int i = 0; i < 8; ++i) { const int id = tid + 512 * i, row = id >> 5, d0 = (id & 31) * 8; const size_t go = (size_t)(t0 + row) * 1024 + h * 256 + d0;
                qv[i] = *(const u32x4*)(Qg + go); kv[i] = *(const u32x4*)(Kg + go); }
#pragma unroll
            for (int i = 0; i < 8; ++i) { const int id = tid + 512 * i, row = id >> 5, d0 = (id & 31) * 8; const int off = row * 272 + (d0 & 127) * 2;
                *(LAS u32x4*)(((d0 >> 7) ? B2 : B0) + off) = qv[i]; *(LAS u32x4*)(((d0 >> 7) ? B3 : B1) + off) = kv[i]; }
        }
        __syncthreads();
        f32x4 S[8];
#pragma unroll
        for (int mb = 0; mb < 8; ++mb) { f32x4 c = (f32x4){0.f, 0.f, 0.f, 0.f};
#pragma unroll
            for (int ks = 0; ks < 8; ++ks) { const int co = ((32 * ks + 8 * q) & 127) * 2;
                const bf16x8 av = *(const LAS bf16x8*)((ks < 4 ? B1 : B3) + (16 * mb + r) * 272 + co);
                const bf16x8 bv = *(const LAS bf16x8*)((ks < 4 ? B0 : B2) + (16 * w + r) * 272 + co);
                c = __builtin_amdgcn_mfma_f32_16x16x32_bf16(av, bv, c, 0, 0, 0); }
            S[mb] = c; }
        __syncthreads();
        {
            const int jl = 16 * w + r;
#pragma unroll
            for (int mb = 0; mb < 8; ++mb) { float v[4];
#pragma unroll
                for (int e = 0; e < 4; ++e) { const int ml = 16 * mb + 4 * q + e; const bool keep = dir == 0 ? (ml <= jl) : (ml >= jl); v[e] = keep ? S[mb][e] : 0.f; }
                u32x2 o; o.x = cvt_pk_bf16(v[0], v[1]); o.y = cvt_pk_bf16(v[2], v[3]);
                *(LAS u32x2*)(B1 + jl * 272 + (16 * mb + 4 * q) * 2) = o; }
#pragma unroll
            for (int i = 0; i < 2; ++i) { const int id = tid + 512 * i, m = id >> 3, e0 = (id & 7) * 8;
                const u32x4 vv = *(const u32x4*)(Vg + (size_t)(t0 + m) * 2048 + h * 512 + sl * 64 + e0);
                const unsigned ww[4] = {vv.x, vv.y, vv.z, vv.w};
#pragma unroll
                for (int e = 0; e < 4; ++e) { *(LAS bf16_t*)(B3 + (e0 + 2 * e) * 272 + m * 2) = (bf16_t)f2bf(bflo(ww[e]) * wm[i]); *(LAS bf16_t*)(B3 + (e0 + 2 * e + 1) * 272 + m * 2) = (bf16_t)f2bf(bfhi(ww[e]) * wm[i]); } }
        }
        __syncthreads();
        f32x4 O[4];
#pragma unroll
        for (int jb = 0; jb < 4; ++jb) { f32x4 c = (f32x4){0.f, 0.f, 0.f, 0.f};
#pragma unroll
            for (int ks = 0; ks < 4; ++ks) { const int co = (32 * ks + 8 * q) * 2;
                const bf16x8 av = *(const LAS bf16x8*)(B3 + (16 * eg + r) * 272 + co);
                const bf16x8 bv = *(const LAS bf16x8*)(B1 + (64 * half + 16 * jb + r) * 272 + co);
                c = __builtin_amdgcn_mfma_f32_16x16x32_bf16(av, bv, c, 0, 0, 0); }
            O[jb] = c; }
        __syncthreads();
#pragma unroll
        for (int db = 0; db < 8; ++db) { u32x2 o; o.x = cvt_pk_bf16(Rb[db][0], Rb[db][1]); o.y = cvt_pk_bf16(Rb[db][2], Rb[db][3]);
            *(LAS u32x2*)(B1 + (16 * eg + r) * 528 + (128 * half + 16 * db + 4 * q) * 2) = o; }
        __syncthreads();
#pragma unroll
        for (int jb = 0; jb < 4; ++jb) { f32x4 c = O[jb];
#pragma unroll
            for (int ks = 0; ks < 8; ++ks) {
                const bf16x8 av = *(const LAS bf16x8*)(B1 + (16 * eg + r) * 528 + (32 * ks + 8 * q) * 2);
                const bf16x8 bv = *(const LAS bf16x8*)((ks < 4 ? B0 : B2) + (64 * half + 16 * jb + r) * 272 + ((32 * ks + 8 * q) & 127) * 2);
                c = __builtin_amdgcn_mfma_f32_16x16x32_bf16(av, bv, c, 0, 0, 0); }
            O[jb] = c; }
#pragma unroll
        for (int jb = 0; jb < 4; ++jb) { const int jl = 64 * half + 16 * jb + r; bf16_t* op = OF + (size_t)(t0 + jl) * 2048 + h * 512 + sl * 64 + 16 * eg + 4 * q;
            f32x4 v = O[jb] * rsc[jb];
            if (dir == 1) { const u32x2 p = *(const u32x2*)op; v[0] += bflo(p.x); v[1] += bfhi(p.x); v[2] += bflo(p.y); v[3] += bfhi(p.y);
                float ss = (v[0] * v[0] + v[1] * v[1]) + (v[2] * v[2] + v[3] * v[3]); ss += shx(ss, 16, lane); ss += shx(ss, 32, lane);
                if (q == 0) ssl[eg * 128 + jl] = ss; }
            u32x2 o; o.x = cvt_pk_bf16(v[0], v[1]); o.y = cvt_pk_bf16(v[2], v[3]); *(u32x2*)op = o; }
        __syncthreads();
        if (dir == 1 && tid < 128) SSP[(size_t)(t0 + tid) * 32 + h * 8 + sl] = (ssl[tid] + ssl[128 + tid]) + (ssl[256 + tid] + ssl[384 + tid]);
        {
            u32x4 kv[8];
#pragma unroll
            for (int i = 0; i < 8; ++i) { const int id = tid + 512 * i, row = id >> 5, d0 = (id & 31) * 8; kv[i] = *(const u32x4*)(Kg + (size_t)(t0 + row) * 1024 + h * 256 + d0); }
#pragma unroll
            for (int i = 0; i < 8; ++i) { const int id = tid + 512 * i, m = id >> 5, d0 = (id & 31) * 8; LAS unsigned char* dst = ((d0 >> 7) ? B2 : B0) + (d0 & 127) * 272 + m * 2;
                const unsigned ww[4] = {kv[i].x, kv[i].y, kv[i].z, kv[i].w};
#pragma unroll
                for (int e = 0; e < 4; ++e) { *(LAS bf16_t*)(dst + (2 * e) * 272) = (bf16_t)(ww[e] & 0xffffu); *(LAS bf16_t*)(dst + (2 * e + 1) * 272) = (bf16_t)(ww[e] >> 16); } }
        }
        __syncthreads();
#pragma unroll
        for (int db = 0; db < 8; ++db) { f32x4 c = Rb[db];
#pragma unroll
            for (int ks = 0; ks < 4; ++ks) { const int co = (32 * ks + 8 * q) * 2;
                const bf16x8 av = *(const LAS bf16x8*)((half ? B2 : B0) + (16 * db + r) * 272 + co);
                const bf16x8 bv = *(const LAS bf16x8*)(B3 + (16 * eg + r) * 272 + co);
                c = __builtin_amdgcn_mfma_f32_16x16x32_bf16(av, bv, c, 0, 0, 0); }
            Rb[db] = c * g128; }
        __syncthreads();
    }
}
__device__ __forceinline__ void scan_phase(Frame& F, const Args& a, int layer, int dir) {
    PHASE_IDS();
    const int j = layer >> 1; const float* dec = a.in[11] + j * 8 + dir * 4;
    for (int u = F.vcu; u < 256; u += F.G) {
        const int b = u >> 5, h = (u >> 3) & 3, sl = u & 7;
        const float lg = log1pf(-exp2f(dec[h]));
        scan_unit(F, tid, b, h, sl, dir, lg, (const bf16_t*)(ws + WS_Q), (const bf16_t*)(ws + WS_K), (const bf16_t*)(ws + WS_V), (bf16_t*)(ws + WS_OF), (float*)(ws + WS_SSP));
    }
}
__device__ __forceinline__ void n2_phase(Frame& F, const Args& a, int layer) {
    PHASE_IDS();
    norm_rows(F, a, layer, (bf16_t*)(ws + WS_Q));
    const float* SSP = (const float*)(ws + WS_SSP); float* RINV = (float*)(ws + WS_RINV);
    const int gt = F.vcu * 512 + tid, NT = F.G * 512;
    for (int idx = gt; idx < NTOK * 4; idx += NT) { const f32x4 p0 = *(const f32x4*)(SSP + (size_t)idx * 8), p1 = *(const f32x4*)(SSP + (size_t)idx * 8 + 4);
        const float ss = ((p0.x + p0.y) + (p0.z + p0.w)) + ((p1.x + p1.y) + (p1.z + p1.w)); RINV[idx] = rsqrtf(ss * (1.f / 512.f) + EPS); }
}
__device__ __forceinline__ void final_phase(Frame& F, const Args& a) {
    PHASE_IDS();
    const float* fg = a.in[12]; const int gw = F.vcu * 8 + wave, NGW = F.G * 8;
    for (int m = gw; m < NLAT; m += NGW) {
        f32x4* xr = (f32x4*)(a.out + (size_t)m * DM) + lane;
        f32x4 v[4]; float s = 0.f;
#pragma unroll
        for (int jj = 0; jj < 4; ++jj) { v[jj] = xr[64 * jj]; s += (v[jj].x * v[jj].x + v[jj].y * v[jj].y) + (v[jj].z * v[jj].z + v[jj].w * v[jj].w); }
        const float rinv = rsqrtf(wave_sum(s, lane) * (1.f / DM) + EPS);
#pragma unroll
        for (int jj = 0; jj < 4; ++jj) { const f32x4 g = *(const f32x4*)(fg + 4 * lane + 256 * jj); xr[64 * jj] = v[jj] * rinv * g; }
    }
}

constexpr int N_PHASES = 34;
__global__ void __launch_bounds__(512, 2) trunk_fwd(Args args) {
    extern __shared__ __attribute__((aligned(16))) unsigned char lds_raw[];
    Frame F;
    F.lds = (LAS unsigned char*)lds_raw;
    F.G = gridDim.x; F.wv = __builtin_amdgcn_readfirstlane((int)threadIdx.x >> 6); { const int bx = blockIdx.x; F.vcu = (F.G % 8 == 0) ? (bx % 8) * (F.G / 8) + bx / 8 : bx; }
    F.ws = args.ws;
    volatile LAS unsigned* MISC = (volatile LAS unsigned*)(F.lds + MISC_OFF);
    for (int u = threadIdx.x; u < 128; u += 512) MISC[u] = 0u;
    __syncthreads();
    const int lo = args.ph_lo, hi = args.ph_hi;
    XcdBarrier bar; bar.bar = (unsigned*)(args.ws + WS_CTL) + 4096; bar.x = 0; bar.st = nullptr;
    const bool multi = (hi - lo) > 1;
    if (multi) bar = xcd_barrier_post((unsigned*)(args.ws + WS_CTL) + 4096, MISC + 8);
#ifndef KINDS
#define KINDS 0xFFFF
#endif
#define KON(b) (((KINDS) >> (b)) & 1)
#define IN(k) (lo <= (k) && (k) < hi)
#define SEAM(k) do { if (multi && (k) + 1 < hi) xcd_barrier(bar); } while (0)
    const int bx = (int)blockIdx.x, G = F.G;
    if (KON(0) && IN(0)) { p0_phase(F, args); SEAM(0); }
    for (int layer = 0; layer < NLAYER; ++layer) {
        const int pb = 1 + 8 * layer; const bool fourier = (layer & 1) == 0;
        unsigned char* ws = launder_ptr(args.ws);
        const float* ADAg = (const float*)(ws + WS_ADA) + layer * 9 * 3072 + 2048;
        const float* xin_lat = layer == 0 ? args.in[0] : args.out; const float* xin_ctx = layer == 0 ? args.in[2] : (const float*)(ws + WS_XCTX);
        const EpiResid ER{xin_lat, xin_ctx, args.out, (float*)(ws + WS_XCTX), ADAg};
        if (KON(1) && IN(pb)) { n_phase(F, args, layer); SEAM(pb); }
        if (fourier) {
            bf16_t* W1 = (bf16_t*)(ws + WS_W);
            if (KON(2) && IN(pb + 1)) {
                { pg8::Gemm g{(const bf16_t*)(ws + WS_H), W1 + (size_t)2048 * 1024, 1024, 1024, 1024}; pg8::TileOrder S; S.init(72, 8, G, bx);
                  EpiSilu E{(bf16_t*)(ws + WS_Z), 2048}; pg8::gemm_phase(F.lds, F.wv, g, S, E); }
                { pg8::Gemm g{W1, (const bf16_t*)(ws + WS_H), 1024, 1024, 1024}; pg8::TileOrder S; S.init(8, 72, G, (bx + 64) % G);
                  EpiUT E{(bf16_t*)(ws + WS_UTL), (bf16_t*)(ws + WS_UTC)}; pg8::gemm_phase(F.lds, F.wv, g, S, E); }
                SEAM(pb + 1);
            }
            if (KON(3) && IN(pb + 2)) {
                { pg8::Gemm g{(const bf16_t*)(ws + WS_CS), (const bf16_t*)(ws + WS_UTL), 2048, 2048, 2048}; pg8::TileOrder S; S.init(16, 64, G, bx);
                  EpiDft E{(bf16_t*)(ws + WS_Z), 2048, 0}; pg8::gemm_phase(F.lds, F.wv, g, S, E); }
                { pg8::Gemm g{(const bf16_t*)(ws + WS_CS256), (const bf16_t*)(ws + WS_UTC), 256, 256, 256}; pg8::TileOrder S; S.init(2, 64, G, bx);
                  EpiDft E{(bf16_t*)(ws + WS_Z), 256, NLAT}; pg8::gemm_phase(F.lds, F.wv, g, S, E); }
                SEAM(pb + 2);
            }
            if (KON(4) && IN(pb + 3)) {
                pg8::Gemm g{(const bf16_t*)(ws + WS_Z), W1 + (size_t)4096 * 1024, 2048, 2048, 2048}; pg8::TileOrder S; S.init(72, 4, G, bx);
                pg8::gemm_phase(F.lds, F.wv, g, S, ER);
                SEAM(pb + 3);
            }
        } else {
            bf16_t* W1 = (bf16_t*)(ws + WS_W);
            if (KON(5) && IN(pb + 1)) {
                pg8::Gemm g{(const bf16_t*)(ws + WS_OF), W1, 1024, 1024, 1024}; pg8::TileOrder S; S.init(72, 16, G, bx);
                EpiQKV E{(bf16_t*)(ws + WS_Q), (bf16_t*)(ws + WS_K), (bf16_t*)(ws + WS_V), (const float*)(ws + WS_ROPE), (const float*)(ws + WS_ROPE) + 4096};
                pg8::gemm_phase(F.lds, F.wv, g, S, E);
                SEAM(pb + 1);
            }
            if (KON(6) && IN(pb + 2)) { scan_phase(F, args, layer, 0); SEAM(pb + 2); }
            if (KON(6) && IN(pb + 3)) { scan_phase(F, args, layer, 1); SEAM(pb + 3); }
            if (KON(7) && IN(pb + 4)) { n2_phase(F, args, layer); SEAM(pb + 4); }
            if (KON(8) && IN(pb + 5)) {
                pg8::Gemm g{(const bf16_t*)(ws + WS_Q), W1 + (size_t)4096 * 1024, 1024, 1024, 1024}; pg8::TileOrder S; S.init(72, 8, G, bx);
                EpiZGate E{(const bf16_t*)(ws + WS_OF), (const float*)(ws + WS_RINV), (bf16_t*)(ws + WS_V)};
                pg8::gemm_phase(F.lds, F.wv, g, S, E);
                SEAM(pb + 5);
            }
            if (KON(9) && IN(pb + 6)) {
                pg8::Gemm g{(const bf16_t*)(ws + WS_V), W1 + (size_t)6144 * 1024, 2048, 2048, 2048}; pg8::TileOrder S; S.init(72, 4, G, bx);
                pg8::gemm_phase(F.lds, F.wv, g, S, ER);
                SEAM(pb + 6);
            }
        }
    }
    if (KON(10) && IN(33)) final_phase(F, args);
#undef IN
#undef SEAM
}

static bool phase_used(int p) {
    if (p == 0 || p == 33) return true;
    const int layer = (p - 1) / 8, k = (p - 1) % 8;
    return (layer & 1) == 0 ? (k <= 3) : (k <= 6);
}
extern "C" void kernel_launch(void* const* d_in, const int* in_sizes, int n_in, void* d_out, int out_size, void* d_ws, size_t ws_size, hipStream_t stream) {
    static int grid = 0;
    if (grid == 0) {
        if (n_in != 13 || out_size != NLAT * DM || ws_size < WS_END) { fprintf(stderr, "kernel_launch: unexpected problem (n_in %d, out %d, ws %zu)\n", n_in, out_size, ws_size); grid = -1; return; }
        int dev = 0, cus = 0;
        if (hipGetDevice(&dev) != hipSuccess || hipDeviceGetAttribute(&cus, hipDeviceAttributeMultiprocessorCount, dev) != hipSuccess) { grid = -1; return; }
        if (hipFuncSetAttribute((const void*)trunk_fwd, hipFuncAttributeMaxDynamicSharedMemorySize, LDS_BYTES) != hipSuccess) { fprintf(stderr, "kernel_launch: hipFuncSetAttribute failed\n"); grid = -1; return; }
        (void)hipGetLastError();
        grid = cus;
    }
    if (grid < 0) return;
    if (hipMemsetAsync((char*)d_ws + WS_CTL, 0, CTL_ZERO_BYTES, stream) != hipSuccess) return;
    Args a{};
    for (int i = 0; i < 13; ++i) a.in[i] = (const float*)d_in[i];
    a.out = (float*)d_out; a.ws = (unsigned char*)d_ws;
#if MK_PER_PHASE_LAUNCH
#ifndef DBG_MAXPH
#define DBG_MAXPH 99
#endif
    for (int p = 0; p < N_PHASES; ++p) { if (!phase_used(p)) continue; if (p > DBG_MAXPH && p != 33) continue; a.ph_lo = p; a.ph_hi = p + 1; hipLaunchKernelGGL(trunk_fwd, dim3(grid), dim3(512), LDS_BYTES, stream, a); }
#else
    a.ph_lo = 0; a.ph_hi = N_PHASES;
    hipLaunchKernelGGL(trunk_fwd, dim3(grid), dim3(512), LDS_BYTES, stream, a);
#endif
}
```

```cpp
#include <hip/hip_runtime.h>
#include <cstdio>
#include <cstdint>

#ifndef MK_PER_PHASE_LAUNCH
#define MK_PER_PHASE_LAUNCH 0
#endif

#define LAS __attribute__((address_space(3)))
#define GAS __attribute__((address_space(1)))
typedef unsigned short bf16_t;
typedef short bf16x8 __attribute__((ext_vector_type(8)));
typedef float f32x4 __attribute__((ext_vector_type(4)));
typedef float f32x16 __attribute__((ext_vector_type(16)));
typedef unsigned u32x4 __attribute__((ext_vector_type(4)));
typedef unsigned u32x2 __attribute__((ext_vector_type(2)));

constexpr int DM = 1024, NB = 8, SEQ = 2048, CTXL = 256, DBR = 2048, NLAYER = 4;
constexpr int NLAT = NB * SEQ, NCTX = NB * CTXL, NTOK = NLAT + NCTX;
constexpr float EPS = 1e-6f;

constexpr size_t MiB = 1u << 20;
constexpr size_t WS_CTL = 0, CTL_ZERO_BYTES = 1 * MiB;
constexpr size_t WS_ADA = 1 * MiB;
constexpr size_t WS_TC = 2 * MiB;
constexpr size_t WS_ROPE = 2 * MiB + 256 * 1024;
constexpr size_t WS_CS256 = 2 * MiB + 512 * 1024;
constexpr size_t WS_RINV = 3 * MiB;
constexpr size_t WS_XCTX = 4 * MiB;
constexpr size_t WS_W = 12 * MiB;
constexpr size_t WS_R = 28 * MiB;
constexpr size_t WS_H = WS_R;
constexpr size_t WS_Z = WS_R + 36 * MiB;
constexpr size_t WS_UTL = WS_R + 108 * MiB;
constexpr size_t WS_UTC = WS_R + 172 * MiB;
constexpr size_t WS_CS = WS_R + 180 * MiB;
constexpr size_t WS_Q = WS_R;
constexpr size_t WS_K = WS_R + 36 * MiB;
constexpr size_t WS_V = WS_R + 72 * MiB;
constexpr size_t WS_OF = WS_R + 144 * MiB;
constexpr size_t WS_SSP = WS_R + 216 * MiB;
constexpr size_t WS_END = 256 * MiB;
static_assert(WS_SSP + (size_t)NTOK * 32 * 4 <= WS_END && WS_CS + 16 * MiB + 0 <= WS_END, "ws map");

constexpr int LDS_BYTES = 147456;
constexpr int RING_BYTES = 131072;
constexpr int SCAN_RG = 34816;
constexpr int SCAN_SS_OFF = 4 * SCAN_RG;
constexpr int MISC_OFF = 145408;
static_assert(SCAN_SS_OFF + 2048 <= MISC_OFF && MISC_OFF + 512 <= LDS_BYTES, "lds map");

__device__ __forceinline__ unsigned f2bf(float f) { unsigned u = __builtin_bit_cast(unsigned, f); return (u + 0x7fffu + ((u >> 16) & 1u)) >> 16; }
__device__ __forceinline__ unsigned pk2(float lo, float hi) { return f2bf(lo) | (f2bf(hi) << 16); }
__device__ __forceinline__ float bflo(unsigned w) { return __builtin_bit_cast(float, w << 16); }
__device__ __forceinline__ float bfhi(unsigned w) { return __builtin_bit_cast(float, w & 0xffff0000u); }
__device__ __forceinline__ float bf1(bf16_t h) { return __builtin_bit_cast(float, (unsigned)h << 16); }
__device__ __forceinline__ float silu_f(float x) { return x * __builtin_amdgcn_rcpf(1.f + __expf(-x)); }
__device__ __forceinline__ float shx(float v, int o, int lane) { return __builtin_bit_cast(float, __builtin_amdgcn_ds_bpermute((lane ^ o) << 2, __builtin_bit_cast(int, v))); }
__device__ __forceinline__ float wave_sum(float v, int lane) {
#pragma unroll
    for (int o = 1; o < 64; o <<= 1) v += shx(v, o, lane);
    return v;
}

namespace pg8 {
constexpr int BM = 256, BK = 64, HALF = 128, HTB = HALF * BK * 2, STAGE_BYTES = 8 * HTB, NXCD = 8, WGM = 8;
__host__ __device__ __forceinline__ int lds_byte(int r, int c) { const int st = (r >> 4) * 2 + (c >> 5), rr = r & 15, cc = c & 31, ob = rr * 64 + cc * 2; return st * 1024 + (ob ^ (((ob >> 9) & 1) << 5)); }
__host__ __device__ __forceinline__ void stage_rc(int b, int& R, int& C) { const int st = b / 1024, sb = b % 1024, swz = sb ^ (((sb >> 9) & 1) << 5); R = (st >> 1) * 16 + swz / 64; C = (st & 1) * 32 + (swz % 64) / 2; }
__host__ __device__ __forceinline__ int perm32(int rho) { const int n = rho >> 4, i = rho & 15; return 8 * (i >> 2) + 4 * n + (i & 3); }
struct Unit { int pm, pn; };
struct Gemm { const bf16_t* A; const bf16_t* Bt; int lda, ldb, K; };
struct TileOrder {
    int nM, nN, nwg, G, c;
    __device__ void init(int nM_, int nN_, int G_, int c_) { nM = nM_; nN = nN_; nwg = nM * nN; G = G_; c = c_; }
    __device__ bool next(int i, Unit& u) const {
        const long L = (long)i * G + c; if (L >= nwg) return false;
        int wgid = (int)L; { const int q = nwg / NXCD, r = nwg % NXCD, xcd = wgid % NXCD, off = wgid / NXCD; wgid = (xcd < r ? xcd * (q + 1) : r * (q + 1) + (xcd - r) * q) + off; }
        const int nig = WGM * nN, gid = wgid / nig, fm = gid * WGM, gsz = (nM - fm) < WGM ? (nM - fm) : WGM;
        u.pm = fm + ((wgid % nig) % gsz); u.pn = (wgid % nig) / gsz; return true;
    }
};
__device__ __forceinline__ unsigned cvt_pk_bf16(float lo, float hi) { unsigned r; asm volatile("v_cvt_pk_bf16_f32 %0, %1, %2" : "=v"(r) : "v"(lo), "v"(hi)); return r; }

template <class Epi, bool ALIGN_EPI = true, bool SP2 = true>
__device__ __forceinline__ void gemm_phase(LAS unsigned char* lds, int wv, const Gemm g, const TileOrder& S, const Epi& E) {
    int tid; { int l_; asm volatile("v_mbcnt_lo_u32_b32 %0, -1, 0\n\tv_mbcnt_hi_u32_b32 %0, -1, %0" : "=v"(l_)); tid = wv * 64 + l_; }
    const int wid = __builtin_amdgcn_readfirstlane(tid >> 6), lane = tid & 63, wr = wid >> 2, wc = wid & 3, fr = lane & 15, fq = lane >> 4;
    const int K = g.K, nt = K / BK;
    unsigned voffA[2], voffB[2];
#pragma unroll
    for (int i = 0; i < 2; ++i) { int R, C; stage_rc(tid * 16 + i * 8192, R, C); const int Rb = Epi::PERM ? ((R & ~31) + perm32(R & 31)) : R;
        voffA[i] = (unsigned)(R * g.lda + C) * 2u; voffB[i] = (unsigned)(Rb * g.ldb + C) * 2u; }
    const size_t kstep = (size_t)(BK * 2);
    const size_t hstepA = (size_t)HALF * g.lda * 2, hstepB = (size_t)HALF * g.ldb * 2;
    const size_t tstepA = 2 * hstepA, tstepB = 2 * hstepB;
    const unsigned ldsw = (unsigned)wid * 1024u;
    const int aoff = lds_byte(wr * 64 + fr, fq * 8), boff = lds_byte(wc * 32 + fr, fq * 8);
#define PG8_SA(b, h) (((b) * 2 + (h)) * HTB)
#define PG8_SB(b, h) ((4 + (b) * 2 + (h)) * HTB)
#define PG8_STAGE(bufoff, gbase, voff) do { _Pragma("unroll") for (int _i = 0; _i < 2; ++_i) \
        __builtin_amdgcn_global_load_lds((const unsigned*)((const char*)(gbase) + (voff)[_i]), (LAS unsigned*)(lds + (bufoff) + ldsw + _i * 8192), 16, 0, 0); } while (0)
#define PG8_LDA(dst, b, h) do { _Pragma("unroll") for (int m = 0; m < 4; ++m) _Pragma("unroll") for (int k = 0; k < 2; ++k) dst[m][k] = *(const LAS bf16x8*)(lds + PG8_SA(b, h) + aoff + m * 2048 + k * 1024); } while (0)
#define PG8_LDB(dst, b, h) do { _Pragma("unroll") for (int n = 0; n < 2; ++n) _Pragma("unroll") for (int k = 0; k < 2; ++k) dst[n][k] = *(const LAS bf16x8*)(lds + PG8_SB(b, h) + boff + n * 2048 + k * 1024); } while (0)
#define PG8_MMA(ai, bj, At, Bt) do { __builtin_amdgcn_s_setprio(1); _Pragma("unroll") for (int m = 0; m < 4; ++m) _Pragma("unroll") for (int n = 0; n < 2; ++n) _Pragma("unroll") for (int k = 0; k < 2; ++k) \
        acc[ai][bj][m][n] = __builtin_amdgcn_mfma_f32_16x16x32_bf16(Bt[n][k], At[m][k], acc[ai][bj][m][n], 0, 0, 0); __builtin_amdgcn_s_setprio(0); } while (0)
#define PG8_WAIT_V(n) asm volatile("s_waitcnt vmcnt(" #n ")" ::: "memory")
#define PG8_WAIT_L(n) asm volatile("s_waitcnt lgkmcnt(" #n ")" ::: "memory")
#define PG8_BAR __builtin_amdgcn_s_barrier()
#define PG8_SCHED __builtin_amdgcn_sched_barrier(0)
    Unit cur, nxt; int ui = 0;
    if (!S.next(0, cur)) return;
    f32x4 acc[2][2][4][2];
#pragma unroll
    for (int a = 0; a < 2; ++a)
#pragma unroll
        for (int b = 0; b < 2; ++b)
#pragma unroll
            for (int m = 0; m < 4; ++m)
#pragma unroll
                for (int n = 0; n < 2; ++n) acc[a][b][m][n] = (f32x4){0.f, 0.f, 0.f, 0.f};
    bf16x8 At[4][2], B0[2][2], B1[2][2];
    const char* cA = (const char*)g.A + (size_t)cur.pm * tstepA; const char* cB = (const char*)g.Bt + (size_t)cur.pn * tstepB;
    if constexpr (SP2) {
        PG8_STAGE(PG8_SB(0, 0), cB, voffB); PG8_STAGE(PG8_SB(0, 1), cB + hstepB, voffB); PG8_STAGE(PG8_SA(0, 0), cA, voffA); PG8_STAGE(PG8_SA(0, 1), cA + hstepA, voffA);
        if (wr == 1) PG8_BAR;
        PG8_WAIT_V(2); PG8_BAR;
        PG8_STAGE(PG8_SB(1, 0), cB + kstep, voffB); PG8_STAGE(PG8_SA(1, 0), cA + kstep, voffA); PG8_STAGE(PG8_SB(1, 1), cB + hstepB + kstep, voffB);
        PG8_WAIT_V(6); PG8_BAR;
    } else {
        PG8_STAGE(PG8_SB(0, 0), cB, voffB); PG8_STAGE(PG8_SA(0, 0), cA, voffA); PG8_STAGE(PG8_SB(0, 1), cB + hstepB, voffB); PG8_STAGE(PG8_SA(0, 1), cA + hstepA, voffA);
        if (wr == 1) PG8_BAR;
        PG8_WAIT_V(4); PG8_BAR;
        PG8_STAGE(PG8_SB(1, 0), cB + kstep, voffB); PG8_STAGE(PG8_SA(1, 0), cA + kstep, voffA); PG8_STAGE(PG8_SB(1, 1), cB + hstepB + kstep, voffB);
        PG8_WAIT_V(6); PG8_BAR;
    }
    for (;;) {
        const bool has_next = S.next(ui + 1, nxt);
        const char* nA = has_next ? (const char*)g.A + (size_t)nxt.pm * tstepA : cA; const char* nB = has_next ? (const char*)g.Bt + (size_t)nxt.pn * tstepB : cB;
        for (int t = 0; t < nt; t += 2) {
            const bool last = (t == nt - 2);
            const char* a1 = cA + (size_t)(t + 1) * kstep;
            const char* a2 = last ? nA : cA + (size_t)(t + 2) * kstep; const char* b2 = last ? nB : cB + (size_t)(t + 2) * kstep;
            const char* a3 = a2 + kstep; const char* b3 = b2 + kstep;
            if constexpr (SP2) {
            PG8_LDB(B0, 0, 0); PG8_LDB(B1, 0, 1); PG8_SCHED; PG8_LDA(At, 0, 0); PG8_STAGE(PG8_SA(1, 1), a1 + hstepA, voffA);
            PG8_WAIT_V(8); PG8_WAIT_L(0); PG8_BAR; PG8_MMA(0, 0, At, B0); PG8_MMA(0, 1, At, B1); PG8_BAR; PG8_SCHED;
            PG8_LDA(At, 0, 1); PG8_STAGE(PG8_SB(0, 0), b2, voffB); PG8_STAGE(PG8_SB(0, 1), b2 + hstepB, voffB); PG8_STAGE(PG8_SA(0, 0), a2, voffA);
            PG8_WAIT_V(8); PG8_WAIT_L(0); PG8_BAR; PG8_MMA(1, 0, At, B0); PG8_MMA(1, 1, At, B1); PG8_BAR; PG8_SCHED;
            PG8_LDB(B0, 1, 0); PG8_LDB(B1, 1, 1); PG8_SCHED; PG8_LDA(At, 1, 0); PG8_STAGE(PG8_SA(0, 1), a2 + hstepA, voffA);
            PG8_WAIT_V(8); PG8_WAIT_L(0); PG8_BAR; PG8_MMA(0, 0, At, B0); PG8_MMA(0, 1, At, B1); PG8_BAR; PG8_SCHED;
            PG8_LDA(At, 1, 1); PG8_STAGE(PG8_SB(1, 0), b3, voffB); PG8_STAGE(PG8_SB(1, 1), b3 + hstepB, voffB); PG8_STAGE(PG8_SA(1, 0), a3, voffA);
            PG8_WAIT_V(8); PG8_WAIT_L(0); PG8_BAR; PG8_MMA(1, 0, At, B0); PG8_MMA(1, 1, At, B1); PG8_BAR; PG8_SCHED;
            } else {
            PG8_LDB(B0, 0, 0); PG8_SCHED; PG8_LDA(At, 0, 0); PG8_STAGE(PG8_SA(1, 1), a1 + hstepA, voffA);
            PG8_WAIT_L(8); PG8_BAR; PG8_WAIT_L(0); PG8_MMA(0, 0, At, B0); PG8_BAR; PG8_SCHED;
            PG8_LDB(B1, 0, 1); PG8_STAGE(PG8_SB(0, 0), b2, voffB);
            PG8_BAR; PG8_WAIT_L(0); PG8_MMA(0, 1, At, B1); PG8_BAR;
            PG8_LDA(At, 0, 1); PG8_STAGE(PG8_SA(0, 0), a2, voffA);
            PG8_BAR; PG8_WAIT_L(0); PG8_MMA(1, 0, At, B0); PG8_BAR; PG8_SCHED;
            PG8_STAGE(PG8_SB(0, 1), b2 + hstepB, voffB);
            PG8_WAIT_V(6); PG8_BAR; PG8_MMA(1, 1, At, B1); PG8_BAR;
            PG8_LDB(B0, 1, 0); PG8_SCHED; PG8_LDA(At, 1, 0); PG8_STAGE(PG8_SA(0, 1), a2 + hstepA, voffA);
            PG8_WAIT_L(8); PG8_BAR; PG8_WAIT_L(0); PG8_MMA(0, 0, At, B0); PG8_BAR; PG8_SCHED;
            PG8_LDB(B1, 1, 1); PG8_STAGE(PG8_SB(1, 0), b3, voffB);
            PG8_BAR; PG8_WAIT_L(0); PG8_MMA(0, 1, At, B1); PG8_BAR;
            PG8_LDA(At, 1, 1); PG8_STAGE(PG8_SA(1, 0), a3, voffA);
            PG8_BAR; PG8_WAIT_L(0); PG8_MMA(1, 0, At, B0); PG8_BAR; PG8_SCHED;
            PG8_STAGE(PG8_SB(1, 1), b3 + hstepB, voffB);
            PG8_WAIT_V(6); PG8_BAR; PG8_MMA(1, 1, At, B1); PG8_BAR;
            }
        }
        if constexpr (ALIGN_EPI) { if (wr == 0) PG8_BAR; }
        E(acc, cur, wr, wc, fr, fq);
        if (!has_next) break;
#pragma unroll
        for (int a = 0; a < 2; ++a)
#pragma unroll
            for (int b = 0; b < 2; ++b)
#pragma unroll
                for (int m = 0; m < 4; ++m)
#pragma unroll
                    for (int n = 0; n < 2; ++n) acc[a][b][m][n] = (f32x4){0.f, 0.f, 0.f, 0.f};
        cur = nxt; cA = nA; cB = nB; ++ui;
        if constexpr (ALIGN_EPI) { if (wr == 1) PG8_BAR; }
    }
    PG8_WAIT_V(0);
    if constexpr (!ALIGN_EPI) { if (wr == 0) PG8_BAR; }
    PG8_BAR;
#undef PG8_SA
#undef PG8_SB
#undef PG8_STAGE
#undef PG8_LDA
#undef PG8_LDB
#undef PG8_MMA
#undef PG8_WAIT_V
#undef PG8_WAIT_L
#undef PG8_BAR
#undef PG8_SCHED
}
}
using pg8::cvt_pk_bf16;
typedef const f32x4 (&AccRef)[2][2][4][2];

struct EpiSilu {
    static constexpr bool PERM = true;
    bf16_t* O; int ldc;
    __device__ __forceinline__ void operator()(AccRef acc, const pg8::Unit& u, int wr, int wc, int fr, int fq) const {
        const int row0 = u.pm * 256 + wr * 64 + fr, col0 = u.pn * 256 + wc * 32 + 8 * fq;
#pragma unroll
        for (int ai = 0; ai < 2; ++ai)
#pragma unroll
            for (int m = 0; m < 4; ++m) { bf16_t* rowp = O + (size_t)(row0 + ai * 128 + m * 16) * ldc + col0;
#pragma unroll
                for (int bj = 0; bj < 2; ++bj) { const f32x4 v0 = acc[ai][bj][m][0], v1 = acc[ai][bj][m][1]; u32x4 w;
                    w.x = cvt_pk_bf16(silu_f(v0[0]), silu_f(v0[1])); w.y = cvt_pk_bf16(silu_f(v0[2]), silu_f(v0[3]));
                    w.z = cvt_pk_bf16(silu_f(v1[0]), silu_f(v1[1])); w.w = cvt_pk_bf16(silu_f(v1[2]), silu_f(v1[3]));
                    *(u32x4*)(rowp + bj * 128) = w; } }
    }
};
struct EpiUT {
    static constexpr bool PERM = true;
    bf16_t* UTl; bf16_t* UTc;
    __device__ __forceinline__ void operator()(AccRef acc, const pg8::Unit& u, int wr, int wc, int fr, int fq) const {
        const int feat0 = u.pm * 256 + wr * 64 + fr; bf16_t* base; int L;
        if (u.pn < 64) { const int b = u.pn >> 3, l0 = (u.pn & 7) * 256; base = UTl + (size_t)b * 2048 * 2048 + l0; L = 2048; }
        else { const int b = u.pn - 64; base = UTc + (size_t)b * 2048 * 256; L = 256; }
        const int col0 = wc * 32 + 8 * fq;
#pragma unroll
        for (int ai = 0; ai < 2; ++ai)
#pragma unroll
            for (int m = 0; m < 4; ++m) { bf16_t* rowp = base + (size_t)(feat0 + ai * 128 + m * 16) * L + col0;
#pragma unroll
                for (int bj = 0; bj < 2; ++bj) { const f32x4 v0 = acc[ai][bj][m][0], v1 = acc[ai][bj][m][1]; u32x4 w;
                    w.x = cvt_pk_bf16(v0[0], v0[1]); w.y = cvt_pk_bf16(v0[2], v0[3]); w.z = cvt_pk_bf16(v1[0], v1[1]); w.w = cvt_pk_bf16(v1[2], v1[3]);
                    *(u32x4*)(rowp + bj * 128) = w; } }
    }
};
struct EpiDft {
    static constexpr bool PERM = true;
    bf16_t* Z; int L; int tok_base;
    __device__ __forceinline__ void operator()(AccRef acc, const pg8::Unit& u, int wr, int wc, int fr, int fq) const {
        const int b = u.pn >> 3, g = u.pn & 7, k0 = u.pm * 128 + wr * 64 + fr, mi0 = wc * 32 + 8 * fq;
#pragma unroll
        for (int m = 0; m < 4; ++m) {
            const int k = k0 + 16 * m; bf16_t* zrow = Z + (size_t)(tok_base + b * L + k) * 2048 + g * 256;
#pragma unroll
            for (int n = 0; n < 2; ++n) {
                const int mi = mi0 + 4 * n; const f32x4 P = acc[0][0][m][n], Q = acc[1][1][m][n];
                const u32x2 s = *(const u32x2*)(zrow + mi);
                float y0 = (mi == 0) ? P[0] : (P[0] - Q[0]);
                u32x2 o; o.x = cvt_pk_bf16(y0 * bflo(s.x), (P[1] - Q[1]) * bfhi(s.x)); o.y = cvt_pk_bf16((P[2] - Q[2]) * bflo(s.y), (P[3] - Q[3]) * bfhi(s.y));
                *(u32x2*)(zrow + mi) = o;
#pragma unroll
                for (int e = 0; e < 4; ++e) if (mi + e >= 1) { const int c = 256 - (mi + e); zrow[c] = (bf16_t)f2bf((P[e] + Q[e]) * bf1(zrow[c])); }
            }
            if (wc == 0 && fq == 0) zrow[128] = (bf16_t)f2bf(acc[0][1][m][0][0] * bf1(zrow[128]));
        }
    }
};
struct EpiResid {
    static constexpr bool PERM = false;
    const float* xin_lat; const float* xin_ctx; float* xout_lat; float* xout_ctx; const float* gate;
    __device__ __forceinline__ void operator()(AccRef acc, const pg8::Unit& u, int wr, int wc, int fr, int fq) const {
        const int row0 = u.pm * 256 + wr * 64 + fr, col0 = u.pn * 256 + wc * 32 + 4 * fq;
        const bool lat = u.pm < 64; const int r = lat ? (u.pm >> 3) : 8;
        const float* xi = lat ? xin_lat : xin_ctx - (size_t)NLAT * DM; float* xo = lat ? xout_lat : xout_ctx - (size_t)NLAT * DM;
        const float* gp = gate + r * 3072 + col0;
        f32x4 gv[2][2];
#pragma unroll
        for (int bj = 0; bj < 2; ++bj)
#pragma unroll
            for (int n = 0; n < 2; ++n) gv[bj][n] = *(const f32x4*)(gp + bj * 128 + n * 16);
#pragma unroll
        for (int ai = 0; ai < 2; ++ai)
#pragma unroll
            for (int m = 0; m < 4; ++m) { const size_t off = (size_t)(row0 + ai * 128 + m * 16) * DM + col0;
#pragma unroll
                for (int bj = 0; bj < 2; ++bj)
#pragma unroll
                    for (int n = 0; n < 2; ++n) { const f32x4 xv = *(const f32x4*)(xi + off + bj * 128 + n * 16);
                        *(f32x4*)(xo + off + bj * 128 + n * 16) = xv + gv[bj][n] * acc[ai][bj][m][n]; }
                asm volatile("" ::: "memory"); }
    }
};
struct EpiQKV {
    static constexpr bool PERM = true;
    bf16_t* Q; bf16_t* K; bf16_t* V; const float* rcos; const float* rsin;
    __device__ __forceinline__ void operator()(AccRef acc, const pg8::Unit& u, int wr, int wc, int fr, int fq) const {
        const int row0 = u.pm * 256 + wr * 64 + fr, c0 = wc * 32 + 8 * fq;
        if (u.pn >= 8) {
#pragma unroll
            for (int ai = 0; ai < 2; ++ai)
#pragma unroll
                for (int m = 0; m < 4; ++m) { bf16_t* rowp = V + (size_t)(row0 + ai * 128 + m * 16) * 2048 + (u.pn - 8) * 256 + c0;
#pragma unroll
                    for (int bj = 0; bj < 2; ++bj) { const f32x4 v0 = acc[ai][bj][m][0], v1 = acc[ai][bj][m][1]; u32x4 w;
                        w.x = cvt_pk_bf16(v0[0], v0[1]); w.y = cvt_pk_bf16(v0[2], v0[3]); w.z = cvt_pk_bf16(v1[0], v1[1]); w.w = cvt_pk_bf16(v1[2], v1[3]);
                        *(u32x4*)(rowp + bj * 128) = w; } }
            return;
        }
        const bool isk = u.pn >= 4, lat = u.pm < 64; const int h = u.pn & 3; bf16_t* dst = isk ? K : Q; const float sc = isk ? 0.0625f : 1.0f;
        const int i0 = 16 * wc + 4 * fq;
#pragma unroll
        for (int ai = 0; ai < 2; ++ai)
#pragma unroll
            for (int m = 0; m < 4; ++m) { const int row = row0 + ai * 128 + m * 16, l = row & 2047; bf16_t* rowp = dst + (size_t)row * 1024 + h * 256 + c0;
#pragma unroll
                for (int bj = 0; bj < 2; ++bj) { f32x4 x1 = acc[ai][bj][m][0], x2 = acc[ai][bj][m][1];
                    if (lat) { const int pos = bj == 0 ? (l >> 6) : (l & 63); const f32x4 cv = *(const f32x4*)(rcos + pos * 64 + i0), sv = *(const f32x4*)(rsin + pos * 64 + i0);
                        const f32x4 o1 = x1 * cv - x2 * sv, o2 = x1 * sv + x2 * cv; x1 = o1; x2 = o2; }
                    x1 = x1 * sc; x2 = x2 * sc; u32x4 w;
                    w.x = cvt_pk_bf16(x1[0], x1[1]); w.y = cvt_pk_bf16(x1[2], x1[3]); w.z = cvt_pk_bf16(x2[0], x2[1]); w.w = cvt_pk_bf16(x2[2], x2[3]);
                    *(u32x4*)(rowp + bj * 128) = w; } }
    }
};
struct EpiZGate {
    static constexpr bool PERM = true;
    const bf16_t* O; const float* rinv; bf16_t* AO;
    __device__ __forceinline__ void operator()(AccRef acc, const pg8::Unit& u, int wr, int wc, int fr, int fq) const {
        const int row0 = u.pm * 256 + wr * 64 + fr, col0 = u.pn * 256 + wc * 32 + 8 * fq, head = u.pn >> 1;
#pragma unroll
        for (int ai = 0; ai < 2; ++ai)
#pragma unroll
            for (int m = 0; m < 4; ++m) { const int row = row0 + ai * 128 + m * 16; const float rv = rinv[row * 4 + head];
#pragma unroll
                for (int bj = 0; bj < 2; ++bj) { const size_t off = (size_t)row * 2048 + col0 + bj * 128; const u32x4 o = *(const u32x4*)(O + off);
                    const f32x4 v0 = acc[ai][bj][m][0], v1 = acc[ai][bj][m][1]; u32x4 w;
                    w.x = cvt_pk_bf16(bflo(o.x) * rv * silu_f(v0[0]), bfhi(o.x) * rv * silu_f(v0[1])); w.y = cvt_pk_bf16(bflo(o.y) * rv * silu_f(v0[2]), bfhi(o.y) * rv * silu_f(v0[3]));
                    w.z = cvt_pk_bf16(bflo(o.z) * rv * silu_f(v1[0]), bfhi(o.z) * rv * silu_f(v1[1])); w.w = cvt_pk_bf16(bflo(o.w) * rv * silu_f(v1[2]), bfhi(o.w) * rv * silu_f(v1[3]));
                    *(u32x4*)(AO + off) = w; } }
    }
};

#define XB_TMO      128
#define XB_XCNT(j)  (256  + 64 * (j))
#define XB_XSUB(j)  (1280 + 64 * (j))
#define XB_XGEN(j)  (2304 + 64 * (j))
#define XB_TOP      3328
#define XB_TOPGEN   3392
#define XCD_BAR_WORDS 3456
#define XB_SPIN_CAP (1u << 18)
__device__ __forceinline__ unsigned xb_ld(unsigned* p)              { return __hip_atomic_load(p, __ATOMIC_RELAXED, __HIP_MEMORY_SCOPE_AGENT); }
__device__ __forceinline__ unsigned xb_add(unsigned* p, unsigned v) { return __hip_atomic_fetch_add(p, v, __ATOMIC_RELAXED, __HIP_MEMORY_SCOPE_AGENT); }
__device__ __forceinline__ unsigned xb_xcc_id() { return (unsigned)__builtin_amdgcn_s_getreg((3 << 11) | 20) & 0xFu; }
#define XB_SPIN(cond, bar) do { unsigned _sp = 0; while (cond) { __builtin_amdgcn_s_sleep(1); \
    if ((++_sp & 255u) == 0u) { if (xb_ld(&(bar)[XB_TMO])) break; if (_sp > XB_SPIN_CAP) { atomicAdd(&(bar)[XB_TMO], 1u); break; } } } } while (0)
struct XcdBarrier { unsigned* bar; unsigned x; volatile LAS unsigned* st; };
__device__ __forceinline__ XcdBarrier xcd_barrier_post(unsigned* bar, volatile LAS unsigned* st) {
    XcdBarrier b; b.bar = bar; b.x = xb_xcc_id(); b.st = st;
    if (threadIdx.x == 0) (void)xb_add(&bar[XB_XCNT(b.x)], 1u);
    return b;
}
__device__ __forceinline__ void xcd_barrier_complete(unsigned* bar, unsigned x, unsigned& nloc, unsigned& nx) {
    const unsigned G = gridDim.x * gridDim.y * gridDim.z;
    unsigned sum, cnt, mine, sp = 0u;
    for (;;) {
        sum = 0u; cnt = 0u; mine = 0u;
#pragma unroll
        for (unsigned j = 0; j < 16; ++j) { const unsigned c = xb_ld(&bar[XB_XCNT(j)]); sum += c; cnt += (c > 0u) ? 1u : 0u; mine = (j == x) ? c : mine; }
        if (sum == G) break;
        __builtin_amdgcn_s_sleep(1);
        if ((++sp & 255u) == 0u) { if (xb_ld(&bar[XB_TMO])) break; if (sp > XB_SPIN_CAP) { atomicAdd(&bar[XB_TMO], 1u); break; } }
    }
    nloc = mine > 0u ? mine : 1u; nx = cnt > 0u ? cnt : 1u;
}
__device__ __forceinline__ void xcd_barrier(const XcdBarrier& b) {
    asm volatile("s_waitcnt vmcnt(0)" ::: "memory");
    __syncthreads();
    if (threadIdx.x == 0) {
        unsigned* bar = b.bar;
        __builtin_amdgcn_s_waitcnt(0);
        unsigned nloc = b.st[0], nx = b.st[1];
        if (nloc == 0u) { xcd_barrier_complete(bar, b.x, nloc, nx); b.st[0] = nloc; b.st[1] = nx; }
        const unsigned old = xb_add(&bar[XB_XSUB(b.x)], 1u);
        const unsigned gen = old / nloc;
        if (old + 1u == (gen + 1u) * nloc) {
            __builtin_amdgcn_fence(__ATOMIC_RELEASE, "agent");
            asm volatile("s_waitcnt vmcnt(0)" ::: "memory");
            const unsigned og = xb_add(&bar[XB_TOP], 1u);
            const unsigned tg = og / nx;
            if (og + 1u == (tg + 1u) * nx) xb_add(&bar[XB_TOPGEN], 1u);
            else XB_SPIN(xb_ld(&bar[XB_TOPGEN]) == tg, bar);
            __builtin_amdgcn_fence(__ATOMIC_ACQUIRE, "agent");
            xb_add(&bar[XB_XGEN(b.x)], 1u);
            asm volatile("s_waitcnt vmcnt(0)" ::: "memory");
        } else {
            XB_SPIN(xb_ld(&bar[XB_XGEN(b.x)]) == gen, bar);
            __builtin_amdgcn_fence(__ATOMIC_ACQUIRE, "agent");
            asm volatile("s_waitcnt vmcnt(0)" ::: "memory");
        }
    }
    __syncthreads();
}

struct Args { const float* in[13]; float* out; unsigned char* ws; int ph_lo, ph_hi, pad0, pad1; };
struct Frame {
    LAS unsigned char* lds;
    int vcu, G, wv;
    unsigned char* ws;
};
__device__ __forceinline__ int lane_id() { int l; asm volatile("v_mbcnt_lo_u32_b32 %0, -1, 0\n\tv_mbcnt_hi_u32_b32 %0, -1, %0" : "=v"(l)); return l; }
__device__ __forceinline__ unsigned char* launder_ptr(unsigned char* p) {
    unsigned lo = (unsigned)(unsigned long long)p, hi = (unsigned)((unsigned long long)p >> 32);
    asm volatile("" : "+s"(lo), "+s"(hi));
    return (unsigned char*)(((unsigned long long)hi << 32) | lo);
}
#define PHASE_IDS() int tid = F.wv * 64 + lane_id(); asm volatile("" : "+v"(tid)); const int lane = tid & 63, wave = __builtin_amdgcn_readfirstlane(tid >> 6); (void)lane; (void)wave; \
    unsigned char* ws = launder_ptr(F.ws); (void)ws
#define LDS_WAIT() asm volatile("s_waitcnt lgkmcnt(0)" ::: "memory")

__device__ __forceinline__ int qk_pos(int d) { const int half = d >> 7, n = (d >> 6) & 1, i = d & 63; return 128 * half + 8 * (i >> 2) + 4 * n + (i & 3); }
template <int MODE>
__device__ __forceinline__ void transpose_item(const float* W, int K, int N, int n_begin, bf16_t* WT, LAS float* scr, int item, int nblk, int lane) {
    const int kb = item / nblk, nb = item % nblk, k0 = 64 * kb, n0 = n_begin + 32 * nb;
#pragma unroll 8
    for (int i = 0; i < 32; ++i) { const int kk = 2 * i + (lane >> 5); scr[kk * 33 + (lane & 31)] = W[(size_t)(k0 + kk) * N + n0 + (lane & 31)]; }
    LDS_WAIT(); asm volatile("" ::: "memory");
    const int c = lane & 7;
#pragma unroll
    for (int j = 0; j < 4; ++j) { const int n = (lane >> 3) + 8 * j; const LAS float* s = scr + (8 * c) * 33 + n;
        u32x4 o; o.x = pk2(s[0 * 33], s[1 * 33]); o.y = pk2(s[2 * 33], s[3 * 33]); o.z = pk2(s[4 * 33], s[5 * 33]); o.w = pk2(s[6 * 33], s[7 * 33]);
        int nn = n0 + n - n_begin;
        if (MODE == 1) { const int na = n0 + n; nn = (na < 2048) ? ((na & ~255) + qk_pos(na & 255)) : na; }
        *(u32x4*)(WT + (size_t)nn * K + k0 + 8 * c) = o; }
    LDS_WAIT(); asm volatile("" ::: "memory");
}
__device__ __forceinline__ void fold_task(const float* Win  , const float* TC, bf16_t* WfT, int t, int lane) {
    const int g = t >> 8, p0 = ((t >> 5) & 7) * 32, kk0 = (t & 31) * 32, s = lane >> 5, li = lane & 31;
    f32x16 acc;
#pragma unroll
    for (int i = 0; i < 16; ++i) acc[i] = 0.f;
    const float* wrow = Win + (size_t)(kk0 + li) * 4096 + g * 256 + 4 * s;
    const float* tcol = TC + p0 + li;
#pragma unroll 4
    for (int tp = 0; tp < 32; ++tp) {
        const f32x4 wv = *(const f32x4*)(wrow + 8 * tp);
#pragma unroll
        for (int uu = 0; uu < 4; ++uu) { const float a = tcol[(8 * tp + 4 * s + uu) * 256]; acc = __builtin_amdgcn_mfma_f32_32x32x2f32(a, wv[uu], acc, 0, 0, 0); }
    }
#pragma unroll
    for (int i = 0; i < 16; ++i) { const int row = (i & 3) + 8 * (i >> 2) + 4 * s; WfT[(size_t)(g * 256 + p0 + row) * 1024 + kk0 + li] = (bf16_t)f2bf(acc[i]); }
}

__device__ __forceinline__ void p0_phase(Frame& F, const Args& a) {
    PHASE_IDS();
    float* ADA = (float*)(ws + WS_ADA);
    const float* c = a.in[1]; const float* cctx = a.in[3]; const float* ada_w = a.in[5]; const float* ada_b = a.in[6];
    LAS float* sl = (LAS float*)F.lds;
    LAS float* part = (LAS float*)(F.lds + 36864);
    bool loaded = false;
#ifndef DBG_P0
#define DBG_P0 3
#endif
    if (DBG_P0 & 1)
    for (int u = F.vcu; u < 192; u += F.G) {
        if (!loaded) { for (int idx = tid; idx < 9 * 1024; idx += 512) { const int r = idx >> 10, k = idx & 1023; const float x = r < 8 ? c[r * 1024 + k] : cctx[k]; sl[idx] = x / (1.f + expf(-x)); } loaded = true; }
        __syncthreads();
        const int i = u / 48, n0 = (u % 48) * 64;
        float acc[9];
#pragma unroll
        for (int r = 0; r < 9; ++r) acc[r] = 0.f;
        const float* wp = ada_w + ((size_t)i * 1024 + wave * 128) * 3072 + n0 + lane;
#pragma unroll 8
        for (int kk = 0; kk < 128; ++kk) { const float wv = wp[(size_t)kk * 3072]; const int k = wave * 128 + kk;
#pragma unroll
            for (int r = 0; r < 9; ++r) acc[r] += sl[r * 1024 + k] * wv; }
#pragma unroll
        for (int r = 0; r < 9; ++r) part[(wave * 9 + r) * 64 + lane] = acc[r];
        __syncthreads();
        for (int idx = tid; idx < 576; idx += 512) { const int r = idx >> 6, l = idx & 63; float s = 0.f;
#pragma unroll
            for (int w = 0; w < 8; ++w) s += part[(w * 9 + r) * 64 + l];
            ADA[(i * 9 + r) * 3072 + n0 + l] = s + ada_b[i * 3072 + n0 + l]; }
    }
    if (!(DBG_P0 & 2)) return;
    const int gt = F.vcu * 512 + tid, NT = F.G * 512;
    float* TC = (float*)(ws + WS_TC);
    for (int idx = gt; idx < 65536; idx += NT) { const int cc = idx >> 8, p = idx & 255; float v;
        if (p < 128) v = cospif((float)((p * cc) & 255) * (1.f / 128.f));
        else if (p == 128) v = (cc & 1) ? -1.f : 1.f;
        else v = sinpif((float)(((p - 128) * cc) & 255) * (1.f / 128.f));
        TC[idx] = v * 0.0625f; }
    float* RC = (float*)(ws + WS_ROPE); float* RS = RC + 4096;
    for (int idx = gt; idx < 4096; idx += NT) { const int pos = idx >> 6, i = idx & 63; const float freq = powf(10000.0f, -(float)i / 64.0f); const float ang = (float)pos * freq;
        RC[idx] = cosf(ang); RS[idx] = sinf(ang); }
    bf16_t* CS256 = (bf16_t*)(ws + WS_CS256);
    for (int idx = gt; idx < 512 * 256; idx += NT) { const int row = idx >> 8, l = idx & 255, kt = row >> 8, hf = (row >> 7) & 1, k = kt * 128 + (row & 127);
        const float x = (float)((k * l) & 255) * (1.f / 128.f); const float v = (hf ? sinpif(x) : cospif(x)) * 0.0625f; CS256[idx] = (bf16_t)f2bf(v); }
}

__device__ __forceinline__ void norm_row(const float* xrow, const float* ng, const float* adar  , bf16_t* orow, int lane) {
    const f32x4* xr = (const f32x4*)xrow + lane;
    f32x4 v[4]; float s = 0.f;
#pragma unroll
    for (int j = 0; j < 4; ++j) { v[j] = xr[64 * j]; s += (v[j].x * v[j].x + v[j].y * v[j].y) + (v[j].z * v[j].z + v[j].w * v[j].w); }
    const float rinv = rsqrtf(wave_sum(s, lane) * (1.f / DM) + EPS);
    unsigned long long* o8 = (unsigned long long*)orow + lane;
#pragma unroll
    for (int j = 0; j < 4; ++j) { const int col = 4 * lane + 256 * j; const f32x4 g = *(const f32x4*)(ng + col), sh = *(const f32x4*)(adar + col), sc = *(const f32x4*)(adar + 1024 + col);
        const f32x4 y = v[j] * rinv * g * (sc + 1.0f) + sh;
        o8[64 * j] = (unsigned long long)pk2(y.x, y.y) | ((unsigned long long)pk2(y.z, y.w) << 32); }
}
__device__ __forceinline__ void norm_rows(Frame& F, const Args& a, int layer, bf16_t* H) {
    PHASE_IDS();
    const float* xl = layer == 0 ? a.in[0] : a.out; const float* xc = layer == 0 ? a.in[2] : (const float*)(ws + WS_XCTX);
    const float* ng = a.in[4] + layer * DM; const float* ADA = (const float*)(ws + WS_ADA) + layer * 9 * 3072;
    const int gw = F.vcu * 8 + wave, NGW = F.G * 8;
    for (int m = gw; m < NTOK; m += NGW) {
        const bool lat = m < NLAT; const int r = lat ? (m >> 11) : 8;
        const float* xrow = lat ? xl + (size_t)m * DM : xc + (size_t)(m - NLAT) * DM;
        norm_row(xrow, ng, ADA + r * 3072, H + (size_t)m * DM, lane);
    }
}
__device__ __forceinline__ void n_phase(Frame& F, const Args& a, int layer) {
    PHASE_IDS();
    const bool fourier = (layer & 1) == 0; const int j = layer >> 1;
    norm_rows(F, a, layer, (bf16_t*)(ws + (fourier ? WS_H : WS_OF)));
    LAS float* scr = (LAS float*)(F.lds + wave * 16384);
    const int gw = F.vcu * 8 + wave, NGW = F.G * 8;
    bf16_t* W1 = (bf16_t*)(ws + WS_W);
    if (fourier) {
        const float* win = a.in[7] + (size_t)j * 1024 * 4096; const float* wout = a.in[8] + (size_t)j * 2048 * 1024;
        bf16_t* WfoT = W1 + (size_t)4096 * 1024;
        for (int t = gw; t < 2048; t += NGW) fold_task(win, (const float*)(ws + WS_TC), W1, t, lane);
        for (int it = gw; it < 16 * 64; it += NGW) transpose_item<0>(win, 1024, 4096, 2048, W1 + (size_t)2048 * 1024, scr, it, 64, lane);
        for (int it = gw; it < 32 * 32; it += NGW) transpose_item<0>(wout, 2048, 1024, 0, WfoT, scr, it, 32, lane);
        bf16_t* CS = (bf16_t*)(ws + WS_CS);
        const int gt = F.vcu * 512 + tid, NT = F.G * 512;
        for (int ch = gt; ch < 4096 * 256; ch += NT) { const int row = ch >> 8, l0 = (ch & 255) * 8, kt = row >> 8, hf = (row >> 7) & 1, k = kt * 128 + (row & 127);
            unsigned w[4];
#pragma unroll
            for (int e = 0; e < 4; ++e) { float v[2];
#pragma unroll
                for (int q = 0; q < 2; ++q) { const int l = l0 + 2 * e + q; const float x = (float)((k * l) & 2047) * (1.f / 1024.f); v[q] = (hf ? sinpif(x) : cospif(x)) * 0.022097087f; }
                w[e] = pk2(v[0], v[1]); }
            *(u32x4*)(CS + (size_t)row * 2048 + l0) = (u32x4){w[0], w[1], w[2], w[3]}; }
    } else {
        const float* win = a.in[9] + (size_t)j * 1024 * 6144; const float* wout = a.in[10] + (size_t)j * 2048 * 1024;
        bf16_t* WroT = W1 + (size_t)6144 * 1024;
        for (int it = gw; it < 16 * 192; it += NGW) transpose_item<1>(win, 1024, 6144, 0, W1, scr, it, 192, lane);
        for (int it = gw; it < 32 * 32; it += NGW) transpose_item<0>(wout, 2048, 1024, 0, WroT, scr, it, 32, lane);
    }
}

typedef short bf16x4 __attribute__((ext_vector_type(4)));
__device__ __forceinline__ void scan_unit(Frame& F, int tid, int b, int h, int sl, int dir, float lg,
                                          const bf16_t* Qg, const bf16_t* Kg, const bf16_t* Vg, bf16_t* OF, float* SSP) {
    LAS unsigned char* B0 = F.lds; LAS unsigned char* B1 = F.lds + SCAN_RG; LAS unsigned char* B2 = F.lds + 2 * SCAN_RG; LAS unsigned char* B3 = F.lds + 3 * SCAN_RG;
    LAS float* ssl = (LAS float*)(F.lds + SCAN_SS_OFF);
    const int lane = tid & 63, w = __builtin_amdgcn_readfirstlane(tid >> 6), r = lane & 15, q = lane >> 4, half = w >> 2, eg = w & 3;
    const float g128 = __expf(128.f * lg);
    float wm[2], rsc[4];
#pragma unroll
    for (int i = 0; i < 2; ++i) { const int m = (tid >> 3) + 64 * i; wm[i] = __expf(lg * (float)(dir == 0 ? 127 - m : m)); }
#pragma unroll
    for (int jb = 0; jb < 4; ++jb) { const int jj = 64 * half + 16 * jb + r; rsc[jb] = __expf(lg * (float)(dir == 0 ? jj - 127 : -jj)); }
    f32x4 Rb[8];
#pragma unroll
    for (int i = 0; i < 8; ++i) Rb[i] = (f32x4){0.f, 0.f, 0.f, 0.f};
    for (int s = 0; s < 18; ++s) {
        int t0;
        if (dir == 0) t0 = (s < 2) ? (NLAT + b * CTXL + s * 128) : (b * SEQ + (s - 2) * 128);
        else t0 = (s < 2) ? (NLAT + b * CTXL + (1 - s) * 128) : (b * SEQ + (17 - s) * 128);
        {
            u32x4 qv[8], kv[8];
#pragma unroll
            for (int i = 0; i < 8; ++i) { const int id = tid + 512 * i, row = id >> 5, d0 = (id & 31) * 8; const size_t go = (size_t)(t0 + row) * 1024 + h * 256 + d0;
                qv[i] = *(const u32x4*)(Qg + go); kv[i] = *(const u32x4*)(Kg + go); }
#pragma unroll
            for (int i = 0; i < 8; ++i) { const int id = tid + 512 * i, row = id >> 5, d0 = (id & 31) * 8; const int off = row * 272 + (d0 & 127) * 2;
                *(LAS u32x4*)(((d0 >> 7) ? B2 : B0) + off) = qv[i]; *(LAS u32x4*)(((d0 >> 7) ? B3 : B1) + off) = kv[i]; }
        }
        __syncthreads();
        f32x4 S[8];
#pragma unroll
        for (int mb = 0; mb < 8; ++mb) { f32x4 c = (f32x4){0.f, 0.f, 0.f, 0.f};
#pragma unroll
            for (int ks = 0; ks < 8; ++ks) { const int co = ((32 * ks + 8 * q) & 127) * 2;
                const bf16x8 av = *(const LAS bf16x8*)((ks < 4 ? B1 : B3) + (16 * mb + r) * 272 + co);
                const bf16x8 bv = *(const LAS bf16x8*)((ks < 4 ? B0 : B2) + (16 * w + r) * 272 + co);
                c = __builtin_amdgcn_mfma_f32_16x16x32_bf16(av, bv, c, 0, 0, 0); }
            S[mb] = c; }
        __syncthreads();
        {
            const int jl = 16 * w + r;
#pragma unroll
            for (int mb = 0; mb < 8; ++mb) { float v[4];
#pragma unroll
                for (int e = 0; e < 4; ++e) { const int ml = 16 * mb + 4 * q + e; const bool keep = dir == 0 ? (ml <= jl) : (ml >= jl); v[e] = keep ? S[mb][e] : 0.f; }
                u32x2 o; o.x = cvt_pk_bf16(v[0], v[1]); o.y = cvt_pk_bf16(v[2], v[3]);
                *(LAS u32x2*)(B1 + jl * 272 + (16 * mb + 4 * q) * 2) = o; }
#pragma unroll
            for (int i = 0; i < 2; ++i) { const int id = tid + 512 * i, m = id >> 3, e0 = (id & 7) * 8;
                const u32x4 vv = *(const u32x4*)(Vg + (size_t)(t0 + m) * 2048 + h * 512 + sl * 64 + e0);
                const unsigned ww[4] = {vv.x, vv.y, vv.z, vv.w};
#pragma unroll
                for (int e = 0; e < 4; ++e) { *(LAS bf16_t*)(B3 + (e0 + 2 * e) * 272 + m * 2) = (bf16_t)f2bf(bflo(ww[e]) * wm[i]); *(LAS bf16_t*)(B3 + (e0 + 2 * e + 1) * 272 + m * 2) = (bf16_t)f2bf(bfhi(ww[e]) * wm[i]); } }
        }
        __syncthreads();
        f32x4 O[4];
#pragma unroll
        for (int jb = 0; jb < 4; ++jb) { f32x4 c = (f32x4){0.f, 0.f, 0.f, 0.f};
#pragma unroll
            for (int ks = 0; ks < 4; ++ks) { const int co = (32 * ks + 8 * q) * 2;
                const bf16x8 av = *(const LAS bf16x8*)(B3 + (16 * eg + r) * 272 + co);
                const bf16x8 bv = *(const LAS bf16x8*)(B1 + (64 * half + 16 * jb + r) * 272 + co);
                c = __builtin_amdgcn_mfma_f32_16x16x32_bf16(av, bv, c, 0, 0, 0); }
            O[jb] = c; }
        __syncthreads();
#pragma unroll
        for (int db = 0; db < 8; ++db) { u32x2 o; o.x = cvt_pk_bf16(Rb[db][0], Rb[db][1]); o.y = cvt_pk_bf16(Rb[db][2], Rb[db][3]);
            *(LAS u32x2*)(B1 + (16 * eg + r) * 528 + (128 * half + 16 * db + 4 * q) * 2) = o; }
        __syncthreads();
#pragma unroll
        for (int jb = 0; jb < 4; ++jb) { f32x4 c = O[jb];
#pragma unroll
            for (int ks = 0; ks < 8; ++ks) {
                const bf16x8 av = *(const LAS bf16x8*)(B1 + (16 * eg + r) * 528 + (32 * ks + 8 * q) * 2);
                const bf16x8 bv = *(const LAS bf16x8*)((ks < 4 ? B0 : B2) + (64 * half + 16 * jb + r) * 272 + ((32 * ks + 8 * q) & 127) * 2);
                c = __builtin_amdgcn_mfma_f32_16x16x32_bf16(av, bv, c, 0, 0, 0); }
            O[jb] = c; }
#pragma unroll
        for (int jb = 0; jb < 4; ++jb) { const int jl = 64 * half + 16 * jb + r; bf16_t* op = OF + (size_t)(t0 + jl) * 2048 + h * 512 + sl * 64 + 16 * eg + 4 * q;
            f32x4 v = O[jb] * rsc[jb];
            if (dir == 1) { const u32x2 p = *(const u32x2*)op; v[0] += bflo(p.x); v[1] += bfhi(p.x); v[2] += bflo(p.y); v[3] += bfhi(p.y);
                float ss = (v[0] * v[0] + v[1] * v[1]) + (v[2] * v[2] + v[3] * v[3]); ss += shx(ss, 16, lane); ss += shx(ss, 32, lane);
                if (q == 0) ssl[eg * 128 + jl] = ss; }
            u32x2 o; o.x = cvt_pk_bf16(v[0], v[1]); o.y = cvt_pk_bf16(v[2], v[3]); *(u32x2*)op = o; }
        __syncthreads();
        if (dir == 1 && tid < 128) SSP[(size_t)(t0 + tid) * 32 + h * 8 + sl] = (ssl[tid] + ssl[128 + tid]) + (ssl[256 + tid] + ssl[384 + tid]);
        {
            u32x4 kv[8];
#pragma unroll
            for (int i = 0; i < 8; ++i) { const int id = tid + 512 * i, row = id >> 5, d0 = (id & 31) * 8; kv[i] = *(const u32x4*)(Kg + (size_t)(t0 + row) * 1024 + h * 256 + d0); }
#pragma unroll
            for (int i = 0; i < 8; ++i) { const int id = tid + 512 * i, m = id >> 5, d0 = (id & 31) * 8; LAS unsigned char* dst = ((d0 >> 7) ? B2 : B0) + (d0 & 127) * 272 + m * 2;
                const unsigned ww[4] = {kv[i].x, kv[i].y, kv[i].z, kv[i].w};
#pragma unroll
                for (int e = 0; e < 4; ++e) { *(LAS bf16_t*)(dst + (2 * e) * 272) = (bf16_t)(ww[e] & 0xffffu); *(LAS bf16_t*)(dst + (2 * e + 1) * 272) = (bf16_t)(ww[e] >> 16); } }
        }
        __syncthreads();
#pragma unroll
        for (int db = 0; db < 8; ++db) { f32x4 c = Rb[db];
#pragma unroll
            for (int ks = 0; ks < 4; ++ks) { const int co = (32 * ks + 8 * q) * 2;
                const bf16x8 av = *(const LAS bf16x8*)((half ? B2 : B0) + (16 * db + r) * 272 + co);
                const bf16x8 bv = *(const LAS bf16x8*)(B3 + (16 * eg + r) * 272 + co);
                c = __builtin_amdgcn_mfma_f32_16x16x32_bf16(av, bv, c, 0, 0, 0); }
            Rb[db] = c * g128; }
        __syncthreads();
    }
}
__device__ __forceinline__ void scan_phase(Frame& F, const Args& a, int layer, int dir) {
    PHASE_IDS();
    const int j = layer >> 1; const float* dec = a.in[11] + j * 8 + dir * 4;
    for (int u = F.vcu; u < 256; u += F.G) {
        const int b = u >> 5, h = (u >> 3) & 3, sl = u & 7;
        const float lg = log1pf(-exp2f(dec[h]));
        scan_unit(F, tid, b, h, sl, dir, lg, (const bf16_t*)(ws + WS_Q), (const bf16_t*)(ws + WS_K), (const bf16_t*)(ws + WS_V), (bf16_t*)(ws + WS_OF), (float*)(ws + WS_SSP));
    }
}
__device__ __forceinline__ void n2_phase(Frame& F, const Args& a, int layer) {
    PHASE_IDS();
    norm_rows(F, a, layer, (bf16_t*)(ws + WS_Q));
    const float* SSP = (const float*)(ws + WS_SSP); float* RINV = (float*)(ws + WS_RINV);
    const int gt = F.vcu * 512 + tid, NT = F.G * 512;
    for (int idx = gt; idx < NTOK * 4; idx += NT) { const f32x4 p0 = *(const f32x4*)(SSP + (size_t)idx * 8), p1 = *(const f32x4*)(SSP + (size_t)idx * 8 + 4);
        const float ss = ((p0.x + p0.y) + (p0.z + p0.w)) + ((p1.x + p1.y) + (p1.z + p1.w)); RINV[idx] = rsqrtf(ss * (1.f / 512.f) + EPS); }
}
__device__ __forceinline__ void final_phase(Frame& F, const Args& a) {
    PHASE_IDS();
    const float* fg = a.in[12]; const int gw = F.vcu * 8 + wave, NGW = F.G * 8;
    for (int m = gw; m < NLAT; m += NGW) {
        f32x4* xr = (f32x4*)(a.out + (size_t)m * DM) + lane;
        f32x4 v[4]; float s = 0.f;
#pragma unroll
        for (int jj = 0; jj < 4; ++jj) { v[jj] = xr[64 * jj]; s += (v[jj].x * v[jj].x + v[jj].y * v[jj].y) + (v[jj].z * v[jj].z + v[jj].w * v[jj].w); }
        const float rinv = rsqrtf(wave_sum(s, lane) * (1.f / DM) + EPS);
#pragma unroll
        for (int jj = 0; jj < 4; ++jj) { const f32x4 g = *(const f32x4*)(fg + 4 * lane + 256 * jj); xr[64 * jj] = v[jj] * rinv * g; }
    }
}

constexpr int N_PHASES = 34;
__global__ void __launch_bounds__(512, 2) trunk_fwd(Args args) {
    extern __shared__ __attribute__((aligned(16))) unsigned char lds_raw[];
    Frame F;
    F.lds = (LAS unsigned char*)lds_raw;
    F.G = gridDim.x; F.wv = __builtin_amdgcn_readfirstlane((int)threadIdx.x >> 6); { const int bx = blockIdx.x; F.vcu = (F.G % 8 == 0) ? (bx % 8) * (F.G / 8) + bx / 8 : bx; }
    F.ws = args.ws;
    volatile LAS unsigned* MISC = (volatile LAS unsigned*)(F.lds + MISC_OFF);
    for (int u = threadIdx.x; u < 128; u += 512) MISC[u] = 0u;
    __syncthreads();
    const int lo = args.ph_lo, hi = args.ph_hi;
    XcdBarrier bar; bar.bar = (unsigned*)(args.ws + WS_CTL) + 4096; bar.x = 0; bar.st = nullptr;
    const bool multi = (hi - lo) > 1;
    if (multi) bar = xcd_barrier_post((unsigned*)(args.ws + WS_CTL) + 4096, MISC + 8);
#ifndef KINDS
#define KINDS 0xFFFF
#endif
#define KON(b) (((KINDS) >> (b)) & 1)
#define IN(k) (lo <= (k) && (k) < hi)
#define SEAM(k) do { if (multi && (k) + 1 < hi) xcd_barrier(bar); } while (0)
    const int bx = (int)blockIdx.x, G = F.G;
    if (KON(0) && IN(0)) { p0_phase(F, args); SEAM(0); }
    for (int layer = 0; layer < NLAYER; ++layer) {
        const int pb = 1 + 8 * layer; const bool fourier = (layer & 1) == 0;
        unsigned char* ws = launder_ptr(args.ws);
        const float* ADAg = (const float*)(ws + WS_ADA) + layer * 9 * 3072 + 2048;
        const float* xin_lat = layer == 0 ? args.in[0] : args.out; const float* xin_ctx = layer == 0 ? args.in[2] : (const float*)(ws + WS_XCTX);
        const EpiResid ER{xin_lat, xin_ctx, args.out, (float*)(ws + WS_XCTX), ADAg};
        if (KON(1) && IN(pb)) { n_phase(F, args, layer); SEAM(pb); }
        if (fourier) {
            bf16_t* W1 = (bf16_t*)(ws + WS_W);
            if (KON(2) && IN(pb + 1)) {
                { pg8::Gemm g{(const bf16_t*)(ws + WS_H), W1 + (size_t)2048 * 1024, 1024, 1024, 1024}; pg8::TileOrder S; S.init(72, 8, G, bx);
                  EpiSilu E{(bf16_t*)(ws + WS_Z), 2048}; pg8::gemm_phase(F.lds, F.wv, g, S, E); }
                { pg8::Gemm g{W1, (const bf16_t*)(ws + WS_H), 1024, 1024, 1024}; pg8::TileOrder S; S.init(8, 72, G, (bx + 64) % G);
                  EpiUT E{(bf16_t*)(ws + WS_UTL), (bf16_t*)(ws + WS_UTC)}; pg8::gemm_phase(F.lds, F.wv, g, S, E); }
                SEAM(pb + 1);
            }
            if (KON(3) && IN(pb + 2)) {
                { pg8::Gemm g{(const bf16_t*)(ws + WS_CS), (const bf16_t*)(ws + WS_UTL), 2048, 2048, 2048}; pg8::TileOrder S; S.init(16, 64, G, bx);
                  EpiDft E{(bf16_t*)(ws + WS_Z), 2048, 0}; pg8::gemm_phase(F.lds, F.wv, g, S, E); }
                { pg8::Gemm g{(const bf16_t*)(ws + WS_CS256), (const bf16_t*)(ws + WS_UTC), 256, 256, 256}; pg8::TileOrder S; S.init(2, 64, G, bx);
                  EpiDft E{(bf16_t*)(ws + WS_Z), 256, NLAT}; pg8::gemm_phase(F.lds, F.wv, g, S, E); }
                SEAM(pb + 2);
            }
            if (KON(4) && IN(pb + 3)) {
                pg8::Gemm g{(const bf16_t*)(ws + WS_Z), W1 + (size_t)4096 * 1024, 2048, 2048, 2048}; pg8::TileOrder S; S.init(72, 4, G, bx);
                pg8::gemm_phase(F.lds, F.wv, g, S, ER);
                SEAM(pb + 3);
            }
        } else {
            bf16_t* W1 = (bf16_t*)(ws + WS_W);
            if (KON(5) && IN(pb + 1)) {
                pg8::Gemm g{(const bf16_t*)(ws + WS_OF), W1, 1024, 1024, 1024}; pg8::TileOrder S; S.init(72, 16, G, bx);
                EpiQKV E{(bf16_t*)(ws + WS_Q), (bf16_t*)(ws + WS_K), (bf16_t*)(ws + WS_V), (const float*)(ws + WS_ROPE), (const float*)(ws + WS_ROPE) + 4096};
                pg8::gemm_phase(F.lds, F.wv, g, S, E);
                SEAM(pb + 1);
            }
            if (KON(6) && IN(pb + 2)) { scan_phase(F, args, layer, 0); SEAM(pb + 2); }
            if (KON(6) && IN(pb + 3)) { scan_phase(F, args, layer, 1); SEAM(pb + 3); }
            if (KON(7) && IN(pb + 4)) { n2_phase(F, args, layer); SEAM(pb + 4); }
            if (KON(8) && IN(pb + 5)) {
                pg8::Gemm g{(const bf16_t*)(ws + WS_Q), W1 + (size_t)4096 * 1024, 1024, 1024, 1024}; pg8::TileOrder S; S.init(72, 8, G, bx);
                EpiZGate E{(const bf16_t*)(ws + WS_OF), (const float*)(ws + WS_RINV), (bf16_t*)(ws + WS_V)};
                pg8::gemm_phase(F.lds, F.wv, g, S, E);
                SEAM(pb + 5);
            }
            if (KON(9) && IN(pb + 6)) {
                pg8::Gemm g{(const bf16_t*)(ws + WS_V), W1 + (size_t)6144 * 1024, 2048, 2048, 2048}; pg8::TileOrder S; S.init(72, 4, G, bx);
                pg8::gemm_phase(F.lds, F.wv, g, S, ER);
                SEAM(pb + 6);
            }
        }
    }
    if (KON(10) && IN(33)) final_phase(F, args);
#undef IN
#undef SEAM
}

static bool phase_used(int p) {
    if (p == 0 || p == 33) return true;
    const int layer = (p - 1) / 8, k = (p - 1) % 8;
    return (layer & 1) == 0 ? (k <= 3) : (k <= 6);
}
extern "C" void kernel_launch(void* const* d_in, const int* in_sizes, int n_in, void* d_out, int out_size, void* d_ws, size_t ws_size, hipStream_t stream) {
    static int grid = 0;
    if (grid == 0) {
        if (n_in != 13 || out_size != NLAT * DM || ws_size < WS_END) { fprintf(stderr, "kernel_launch: unexpected problem (n_in %d, out %d, ws %zu)\n", n_in, out_size, ws_size); grid = -1; return; }
        int dev = 0, cus = 0;
        if (hipGetDevice(&dev) != hipSuccess || hipDeviceGetAttribute(&cus, hipDeviceAttributeMultiprocessorCount, dev) != hipSuccess) { grid = -1; return; }
        if (hipFuncSetAttribute((const void*)trunk_fwd, hipFuncAttributeMaxDynamicSharedMemorySize, LDS_BYTES) != hipSuccess) { fprintf(stderr, "kernel_launch: hipFuncSetAttribute failed\n"); grid = -1; return; }
        (void)hipGetLastError();
        grid = cus;
    }
    if (grid < 0) return;
    if (hipMemsetAsync((char*)d_ws + WS_CTL, 0, CTL_ZERO_BYTES, stream) != hipSuccess) return;
    Args a{};
    for (int i = 0; i < 13; ++i) a.in[i] = (const float*)d_in[i];
    a.out = (float*)d_out; a.ws = (unsigned char*)d_ws;
#if MK_PER_PHASE_LAUNCH
#ifndef DBG_MAXPH
#define DBG_MAXPH 99
#endif
    for (int p = 0; p < N_PHASES; ++p) { if (!phase_used(p)) continue; if (p > DBG_MAXPH && p != 33) continue; a.ph_lo = p; a.ph_hi = p + 1; hipLaunchKernelGGL(trunk_fwd, dim3(grid), dim3(512), LDS_BYTES, stream, a); }
#else
    a.ph_lo = 0; a.ph_hi = N_PHASES;
    hipLaunchKernelGGL(trunk_fwd, dim3(grid), dim3(512), LDS_BYTES, stream, a);
#endif
}
```

```cpp
#include <hip/hip_runtime.h>
#include <cstdio>
#include <cstdint>

#ifndef MK_PER_PHASE_LAUNCH
#define MK_PER_PHASE_LAUNCH 0
#endif

#define LAS __attribute__((address_space(3)))
#define GAS __attribute__((address_space(1)))
typedef unsigned short bf16_t;
typedef short bf16x8 __attribute__((ext_vector_type(8)));
typedef float f32x4 __attribute__((ext_vector_type(4)));
typedef float f32x16 __attribute__((ext_vector_type(16)));
typedef unsigned u32x4 __attribute__((ext_vector_type(4)));
typedef unsigned u32x2 __attribute__((ext_vector_type(2)));

constexpr int DM = 1024, NB = 8, SEQ = 2048, CTXL = 256, DBR = 2048, NLAYER = 4;
constexpr int NLAT = NB * SEQ, NCTX = NB * CTXL, NTOK = NLAT + NCTX;
constexpr float EPS = 1e-6f;

constexpr size_t MiB = 1u << 20;
constexpr size_t KiB = 1024;
constexpr size_t WS_CTL = 0, CTL_ZERO_BYTES = 64 * KiB;
constexpr size_t WS_ADA = 256 * KiB;
constexpr size_t WS_TC = 768 * KiB;
constexpr size_t WS_ROPE = 1024 * KiB;
constexpr size_t WS_CS256 = 1088 * KiB;
constexpr size_t WS_RINV = 1344 * KiB;
constexpr size_t WS_XCTX = 2 * MiB;
constexpr size_t WS_W = 10 * MiB;
constexpr size_t WS_R = 26 * MiB;
constexpr size_t WS_H = WS_R;
constexpr size_t WS_Z = WS_R + 36 * MiB;
constexpr size_t WS_UTL = WS_R + 108 * MiB;
constexpr size_t WS_UTC = WS_R + 172 * MiB;
constexpr size_t WS_CS = WS_R + 180 * MiB;
constexpr size_t WS_Q = WS_R;
constexpr size_t WS_K = WS_R + 36 * MiB;
constexpr size_t WS_V = WS_R + 72 * MiB;
constexpr size_t WS_OF = WS_R + 144 * MiB;
constexpr size_t WS_SSP = WS_R + 216 * MiB;
constexpr size_t WS_SA = WS_W;
constexpr size_t WS_SB = WS_R + 219 * MiB;
constexpr size_t WS_END = 256 * MiB;
static_assert(WS_SSP + (size_t)NTOK * 32 * 4 <= WS_SB && WS_SB + 10 * MiB <= WS_END && WS_CS + 16 * MiB <= WS_END && WS_RINV + 288 * KiB <= WS_XCTX, "ws map");

constexpr int LDS_BYTES = 147456;
constexpr int RING_BYTES = 131072;
constexpr int SC_V_OFF = 0;
constexpr int SC_RT_OFF = 16384;
constexpr int SC_K_OFF = 16384 + 33792;
constexpr int MISC_OFF = 145408;
static_assert(SC_K_OFF + 65536 <= MISC_OFF && MISC_OFF + 512 <= LDS_BYTES, "lds map");

__device__ __forceinline__ unsigned f2bf(float f) { unsigned u = __builtin_bit_cast(unsigned, f); return (u + 0x7fffu + ((u >> 16) & 1u)) >> 16; }
__device__ __forceinline__ unsigned pk2(float lo, float hi) { return f2bf(lo) | (f2bf(hi) << 16); }
__device__ __forceinline__ float bflo(unsigned w) { return __builtin_bit_cast(float, w << 16); }
__device__ __forceinline__ float bfhi(unsigned w) { return __builtin_bit_cast(float, w & 0xffff0000u); }
__device__ __forceinline__ float bf1(bf16_t h) { return __builtin_bit_cast(float, (unsigned)h << 16); }
__device__ __forceinline__ float silu_f(float x) { return x * __builtin_amdgcn_rcpf(1.f + __expf(-x)); }
__device__ __forceinline__ float shx(float v, int o, int lane) { return __builtin_bit_cast(float, __builtin_amdgcn_ds_bpermute((lane ^ o) << 2, __builtin_bit_cast(int, v))); }
__device__ __forceinline__ float wave_sum(float v, int lane) {
#pragma unroll
    for (int o = 1; o < 64; o <<= 1) v += shx(v, o, lane);
    return v;
}

namespace pg8 {
constexpr int BM = 256, BK = 64, HALF = 128, HTB = HALF * BK * 2, STAGE_BYTES = 8 * HTB, NXCD = 8, WGM = 8;
__host__ __device__ __forceinline__ int lds_byte(int r, int c) { const int st = (r >> 4) * 2 + (c >> 5), rr = r & 15, cc = c & 31, ob = rr * 64 + cc * 2; return st * 1024 + (ob ^ (((ob >> 9) & 1) << 5)); }
__host__ __device__ __forceinline__ void stage_rc(int b, int& R, int& C) { const int st = b / 1024, sb = b % 1024, swz = sb ^ (((sb >> 9) & 1) << 5); R = (st >> 1) * 16 + swz / 64; C = (st & 1) * 32 + (swz % 64) / 2; }
__host__ __device__ __forceinline__ int perm32(int rho) { const int n = rho >> 4, i = rho & 15; return 8 * (i >> 2) + 4 * n + (i & 3); }
struct Unit { int pm, pn; };
struct Gemm { const bf16_t* A; const bf16_t* Bt; int lda, ldb, K; };
struct TileOrder {
    int nM, nN, nwg, G, c;
    __device__ void init(int nM_, int nN_, int G_, int c_) { nM = nM_; nN = nN_; nwg = nM * nN; G = G_; c = c_; }
    __device__ bool next(int i, Unit& u) const {
        const long L = (long)i * G + c; if (L >= nwg) return false;
        int wgid = (int)L; { const int q = nwg / NXCD, r = nwg % NXCD, xcd = wgid % NXCD, off = wgid / NXCD; wgid = (xcd < r ? xcd * (q + 1) : r * (q + 1) + (xcd - r) * q) + off; }
        const int nig = WGM * nN, gid = wgid / nig, fm = gid * WGM, gsz = (nM - fm) < WGM ? (nM - fm) : WGM;
        u.pm = fm + ((wgid % nig) % gsz); u.pn = (wgid % nig) / gsz; return true;
    }
};
__device__ __forceinline__ unsigned cvt_pk_bf16(float lo, float hi) { unsigned r; asm volatile("v_cvt_pk_bf16_f32 %0, %1, %2" : "=v"(r) : "v"(lo), "v"(hi)); return r; }

template <class Epi, class Sched, bool ALIGN_EPI = true, bool SP2 = true>
__device__ __forceinline__ void gemm_phase(LAS unsigned char* lds, int wv, const Gemm g, const Sched& S, const Epi& E) {
    int tid; { int l_; asm volatile("v_mbcnt_lo_u32_b32 %0, -1, 0\n\tv_mbcnt_hi_u32_b32 %0, -1, %0" : "=v"(l_)); tid = wv * 64 + l_; }
    const int wid = __builtin_amdgcn_readfirstlane(tid >> 6), lane = tid & 63, wr = wid >> 2, wc = wid & 3, fr = lane & 15, fq = lane >> 4;
    const int K = g.K, nt = K / BK;
    unsigned voffA[2], voffB[2];
#pragma unroll
    for (int i = 0; i < 2; ++i) { int R, C; stage_rc(tid * 16 + i * 8192, R, C); const int Rb = Epi::PERM ? ((R & ~31) + perm32(R & 31)) : R;
        voffA[i] = (unsigned)(R * g.lda + C) * 2u; voffB[i] = (unsigned)(Rb * g.ldb + C) * 2u; }
    const size_t kstep = (size_t)(BK * 2);
    const size_t hstepA = (size_t)HALF * g.lda * 2, hstepB = (size_t)HALF * g.ldb * 2;
    const size_t tstepA = 2 * hstepA, tstepB = 2 * hstepB;
    const unsigned ldsw = (unsigned)wid * 1024u;
    const int aoff = lds_byte(wr * 64 + fr, fq * 8), boff = lds_byte(wc * 32 + fr, fq * 8);
#define PG8_SA(b, h) (((b) * 2 + (h)) * HTB)
#define PG8_SB(b, h) ((4 + (b) * 2 + (h)) * HTB)
#define PG8_STAGE(bufoff, gbase, voff) do { _Pragma("unroll") for (int _i = 0; _i < 2; ++_i) \
        __builtin_amdgcn_global_load_lds((const unsigned*)((const char*)(gbase) + (voff)[_i]), (LAS unsigned*)(lds + (bufoff) + ldsw + _i * 8192), 16, 0, 0); } while (0)
#define PG8_LDA(dst, b, h) do { _Pragma("unroll") for (int m = 0; m < 4; ++m) _Pragma("unroll") for (int k = 0; k < 2; ++k) dst[m][k] = *(const LAS bf16x8*)(lds + PG8_SA(b, h) + aoff + m * 2048 + k * 1024); } while (0)
#define PG8_LDB(dst, b, h) do { _Pragma("unroll") for (int n = 0; n < 2; ++n) _Pragma("unroll") for (int k = 0; k < 2; ++k) dst[n][k] = *(const LAS bf16x8*)(lds + PG8_SB(b, h) + boff + n * 2048 + k * 1024); } while (0)
#define PG8_MMA(ai, bj, At, Bt) do { __builtin_amdgcn_s_setprio(1); _Pragma("unroll") for (int m = 0; m < 4; ++m) _Pragma("unroll") for (int n = 0; n < 2; ++n) _Pragma("unroll") for (int k = 0; k < 2; ++k) \
        acc[ai][bj][m][n] = __builtin_amdgcn_mfma_f32_16x16x32_bf16(Bt[n][k], At[m][k], acc[ai][bj][m][n], 0, 0, 0); __builtin_amdgcn_s_setprio(0); } while (0)
#define PG8_WAIT_V(n) asm volatile("s_waitcnt vmcnt(" #n ")" ::: "memory")
#define PG8_WAIT_L(n) asm volatile("s_waitcnt lgkmcnt(" #n ")" ::: "memory")
#define PG8_BAR __builtin_amdgcn_s_barrier()
#define PG8_SCHED __builtin_amdgcn_sched_barrier(0)
    Unit cur, nxt; int ui = 0;
    if (!S.next(0, cur)) return;
    f32x4 acc[2][2][4][2];
#pragma unroll
    for (int a = 0; a < 2; ++a)
#pragma unroll
        for (int b = 0; b < 2; ++b)
#pragma unroll
            for (int m = 0; m < 4; ++m)
#pragma unroll
                for (int n = 0; n < 2; ++n) acc[a][b][m][n] = (f32x4){0.f, 0.f, 0.f, 0.f};
    bf16x8 At[4][2], B0[2][2], B1[2][2];
    const char* cA = (const char*)g.A + (size_t)cur.pm * tstepA; const char* cB = (const char*)g.Bt + (size_t)cur.pn * tstepB;
    if constexpr (SP2) {
        PG8_STAGE(PG8_SB(0, 0), cB, voffB); PG8_STAGE(PG8_SB(0, 1), cB + hstepB, voffB); PG8_STAGE(PG8_SA(0, 0), cA, voffA); PG8_STAGE(PG8_SA(0, 1), cA + hstepA, voffA);
        if (wr == 1) PG8_BAR;
        PG8_WAIT_V(2); PG8_BAR;
        PG8_STAGE(PG8_SB(1, 0), cB + kstep, voffB); PG8_STAGE(PG8_SA(1, 0), cA + kstep, voffA); PG8_STAGE(PG8_SB(1, 1), cB + hstepB + kstep, voffB);
        PG8_WAIT_V(6); PG8_BAR;
    } else {
        PG8_STAGE(PG8_SB(0, 0), cB, voffB); PG8_STAGE(PG8_SA(0, 0), cA, voffA); PG8_STAGE(PG8_SB(0, 1), cB + hstepB, voffB); PG8_STAGE(PG8_SA(0, 1), cA + hstepA, voffA);
        if (wr == 1) PG8_BAR;
        PG8_WAIT_V(4); PG8_BAR;
        PG8_STAGE(PG8_SB(1, 0), cB + kstep, voffB); PG8_STAGE(PG8_SA(1, 0), cA + kstep, voffA); PG8_STAGE(PG8_SB(1, 1), cB + hstepB + kstep, voffB);
        PG8_WAIT_V(6); PG8_BAR;
    }
    for (;;) {
        const bool has_next = S.next(ui + 1, nxt);
        const char* nA = has_next ? (const char*)g.A + (size_t)nxt.pm * tstepA : cA; const char* nB = has_next ? (const char*)g.Bt + (size_t)nxt.pn * tstepB : cB;
        for (int t = 0; t < nt; t += 2) {
            const bool last = (t == nt - 2);
            const char* a1 = cA + (size_t)(t + 1) * kstep;
            const char* a2 = last ? nA : cA + (size_t)(t + 2) * kstep; const char* b2 = last ? nB : cB + (size_t)(t + 2) * kstep;
            const char* a3 = a2 + kstep; const char* b3 = b2 + kstep;
            if constexpr (SP2) {
            PG8_LDB(B0, 0, 0); PG8_LDB(B1, 0, 1); PG8_SCHED; PG8_LDA(At, 0, 0); PG8_STAGE(PG8_SA(1, 1), a1 + hstepA, voffA);
            PG8_WAIT_V(8); PG8_WAIT_L(0); PG8_BAR; PG8_MMA(0, 0, At, B0); PG8_MMA(0, 1, At, B1); PG8_BAR; PG8_SCHED;
            PG8_LDA(At, 0, 1); PG8_STAGE(PG8_SB(0, 0), b2, voffB); PG8_STAGE(PG8_SB(0, 1), b2 + hstepB, voffB); PG8_STAGE(PG8_SA(0, 0), a2, voffA);
            PG8_WAIT_V(8); PG8_WAIT_L(0); PG8_BAR; PG8_MMA(1, 0, At, B0); PG8_MMA(1, 1, At, B1); PG8_BAR; PG8_SCHED;
            PG8_LDB(B0, 1, 0); PG8_LDB(B1, 1, 1); PG8_SCHED; PG8_LDA(At, 1, 0); PG8_STAGE(PG8_SA(0, 1), a2 + hstepA, voffA);
            PG8_WAIT_V(8); PG8_WAIT_L(0); PG8_BAR; PG8_MMA(0, 0, At, B0); PG8_MMA(0, 1, At, B1); PG8_BAR; PG8_SCHED;
            PG8_LDA(At, 1, 1); PG8_STAGE(PG8_SB(1, 0), b3, voffB); PG8_STAGE(PG8_SB(1, 1), b3 + hstepB, voffB); PG8_STAGE(PG8_SA(1, 0), a3, voffA);
            PG8_WAIT_V(8); PG8_WAIT_L(0); PG8_BAR; PG8_MMA(1, 0, At, B0); PG8_MMA(1, 1, At, B1); PG8_BAR; PG8_SCHED;
            } else {
            PG8_LDB(B0, 0, 0); PG8_SCHED; PG8_LDA(At, 0, 0); PG8_STAGE(PG8_SA(1, 1), a1 + hstepA, voffA);
            PG8_WAIT_L(8); PG8_BAR; PG8_WAIT_L(0); PG8_MMA(0, 0, At, B0); PG8_BAR; PG8_SCHED;
            PG8_LDB(B1, 0, 1); PG8_STAGE(PG8_SB(0, 0), b2, voffB);
            PG8_BAR; PG8_WAIT_L(0); PG8_MMA(0, 1, At, B1); PG8_BAR;
            PG8_LDA(At, 0, 1); PG8_STAGE(PG8_SA(0, 0), a2, voffA);
            PG8_BAR; PG8_WAIT_L(0); PG8_MMA(1, 0, At, B0); PG8_BAR; PG8_SCHED;
            PG8_STAGE(PG8_SB(0, 1), b2 + hstepB, voffB);
            PG8_WAIT_V(6); PG8_BAR; PG8_MMA(1, 1, At, B1); PG8_BAR;
            PG8_LDB(B0, 1, 0); PG8_SCHED; PG8_LDA(At, 1, 0); PG8_STAGE(PG8_SA(0, 1), a2 + hstepA, voffA);
            PG8_WAIT_L(8); PG8_BAR; PG8_WAIT_L(0); PG8_MMA(0, 0, At, B0); PG8_BAR; PG8_SCHED;
            PG8_LDB(B1, 1, 1); PG8_STAGE(PG8_SB(1, 0), b3, voffB);
            PG8_BAR; PG8_WAIT_L(0); PG8_MMA(0, 1, At, B1); PG8_BAR;
            PG8_LDA(At, 1, 1); PG8_STAGE(PG8_SA(1, 0), a3, voffA);
            PG8_BAR; PG8_WAIT_L(0); PG8_MMA(1, 0, At, B0); PG8_BAR; PG8_SCHED;
            PG8_STAGE(PG8_SB(1, 1), b3 + hstepB, voffB);
            PG8_WAIT_V(6); PG8_BAR; PG8_MMA(1, 1, At, B1); PG8_BAR;
            }
        }
        if constexpr (ALIGN_EPI) { if (wr == 0) PG8_BAR; }
        E(acc, cur, wr, wc, fr, fq);
        if (!has_next) break;
#pragma unroll
        for (int a = 0; a < 2; ++a)
#pragma unroll
            for (int b = 0; b < 2; ++b)
#pragma unroll
                for (int m = 0; m < 4; ++m)
#pragma unroll
                    for (int n = 0; n < 2; ++n) acc[a][b][m][n] = (f32x4){0.f, 0.f, 0.f, 0.f};
        cur = nxt; cA = nA; cB = nB; ++ui;
        if constexpr (ALIGN_EPI) { if (wr == 1) PG8_BAR; }
    }
    PG8_WAIT_V(0);
    if constexpr (!ALIGN_EPI) { if (wr == 0) PG8_BAR; }
    PG8_BAR;
#undef PG8_SA
#undef PG8_SB
#undef PG8_STAGE
#undef PG8_LDA
#undef PG8_LDB
#undef PG8_MMA
#undef PG8_WAIT_V
#undef PG8_WAIT_L
#undef PG8_BAR
#undef PG8_SCHED
}
}
using pg8::cvt_pk_bf16;
typedef const f32x4 (&AccRef)[2][2][4][2];

struct EpiSilu {
    static constexpr bool PERM = true;
    bf16_t* O; int ldc;
    __device__ __forceinline__ void operator()(AccRef acc, const pg8::Unit& u, int wr, int wc, int fr, int fq) const {
        const int row0 = u.pm * 256 + wr * 64 + fr, col0 = u.pn * 256 + wc * 32 + 8 * fq;
#pragma unroll
        for (int ai = 0; ai < 2; ++ai)
#pragma unroll
            for (int m = 0; m < 4; ++m) { bf16_t* rowp = O + (size_t)(row0 + ai * 128 + m * 16) * ldc + col0;
#pragma unroll
                for (int bj = 0; bj < 2; ++bj) { const f32x4 v0 = acc[ai][bj][m][0], v1 = acc[ai][bj][m][1]; u32x4 w;
                    w.x = cvt_pk_bf16(silu_f(v0[0]), silu_f(v0[1])); w.y = cvt_pk_bf16(silu_f(v0[2]), silu_f(v0[3]));
                    w.z = cvt_pk_bf16(silu_f(v1[0]), silu_f(v1[1])); w.w = cvt_pk_bf16(silu_f(v1[2]), silu_f(v1[3]));
                    *(u32x4*)(rowp + bj * 128) = w; } }
    }
};
struct EpiUT {
    static constexpr bool PERM = true;
    bf16_t* UTl; bf16_t* UTc;
    __device__ __forceinline__ void operator()(AccRef acc, const pg8::Unit& u, int wr, int wc, int fr, int fq) const {
        const int feat0 = u.pm * 256 + wr * 64 + fr; bf16_t* base; int L;
        if (u.pn < 64) { const int b = u.pn >> 3, l0 = (u.pn & 7) * 256; base = UTl + (size_t)b * 2048 * 2048 + l0; L = 2048; }
        else { const int b = u.pn - 64; base = UTc + (size_t)b * 2048 * 256; L = 256; }
        const int col0 = wc * 32 + 8 * fq;
#pragma unroll
        for (int ai = 0; ai < 2; ++ai)
#pragma unroll
            for (int m = 0; m < 4; ++m) { bf16_t* rowp = base + (size_t)(feat0 + ai * 128 + m * 16) * L + col0;
#pragma unroll
                for (int bj = 0; bj < 2; ++bj) { const f32x4 v0 = acc[ai][bj][m][0], v1 = acc[ai][bj][m][1]; u32x4 w;
                    w.x = cvt_pk_bf16(v0[0], v0[1]); w.y = cvt_pk_bf16(v0[2], v0[3]); w.z = cvt_pk_bf16(v1[0], v1[1]); w.w = cvt_pk_bf16(v1[2], v1[3]);
                    *(u32x4*)(rowp + bj * 128) = w; } }
    }
};
struct EpiDft {
    static constexpr bool PERM = true;
    bf16_t* Z; int L; int tok_base;
    __device__ __forceinline__ void operator()(AccRef acc, const pg8::Unit& u, int wr, int wc, int fr, int fq) const {
        const int b = u.pn >> 3, g = u.pn & 7, k0 = u.pm * 128 + wr * 64 + fr, mi0 = wc * 32 + 8 * fq;
#pragma unroll
        for (int m = 0; m < 4; ++m) {
            const int k = k0 + 16 * m; bf16_t* zrow = Z + (size_t)(tok_base + b * L + k) * 2048 + g * 256;
#pragma unroll
            for (int n = 0; n < 2; ++n) {
                const int mi = mi0 + 4 * n; const f32x4 P = acc[0][0][m][n], Q = acc[1][1][m][n];
                const u32x2 s = *(const u32x2*)(zrow + mi);
                float y0 = (mi == 0) ? P[0] : (P[0] - Q[0]);
                u32x2 o; o.x = cvt_pk_bf16(y0 * bflo(s.x), (P[1] - Q[1]) * bfhi(s.x)); o.y = cvt_pk_bf16((P[2] - Q[2]) * bflo(s.y), (P[3] - Q[3]) * bfhi(s.y));
                *(u32x2*)(zrow + mi) = o;
#pragma unroll
                for (int e = 0; e < 4; ++e) if (mi + e >= 1) { const int c = 256 - (mi + e); zrow[c] = (bf16_t)f2bf((P[e] + Q[e]) * bf1(zrow[c])); }
            }
            if (wc == 0 && fq == 0) zrow[128] = (bf16_t)f2bf(acc[0][1][m][0][0] * bf1(zrow[128]));
        }
    }
};
struct EpiResid {
    static constexpr bool PERM = false;
    const float* xin_lat; const float* xin_ctx; float* xout_lat; float* xout_ctx; const float* gate;
    __device__ __forceinline__ void operator()(AccRef acc, const pg8::Unit& u, int wr, int wc, int fr, int fq) const {
        const int row0 = u.pm * 256 + wr * 64 + fr, col0 = u.pn * 256 + wc * 32 + 4 * fq;
        const bool lat = u.pm < 64; const int r = lat ? (u.pm >> 3) : 8;
        const float* xi = lat ? xin_lat : xin_ctx - (size_t)NLAT * DM; float* xo = lat ? xout_lat : xout_ctx - (size_t)NLAT * DM;
        const float* gp = gate + r * 3072 + col0;
        f32x4 gv[2][2];
#pragma unroll
        for (int bj = 0; bj < 2; ++bj)
#pragma unroll
            for (int n = 0; n < 2; ++n) gv[bj][n] = *(const f32x4*)(gp + bj * 128 + n * 16);
#pragma unroll
        for (int ai = 0; ai < 2; ++ai)
#pragma unroll
            for (int m = 0; m < 4; ++m) { const size_t off = (size_t)(row0 + ai * 128 + m * 16) * DM + col0;
#pragma unroll
                for (int bj = 0; bj < 2; ++bj)
#pragma unroll
                    for (int n = 0; n < 2; ++n) { const f32x4 xv = *(const f32x4*)(xi + off + bj * 128 + n * 16);
                        *(f32x4*)(xo + off + bj * 128 + n * 16) = xv + gv[bj][n] * acc[ai][bj][m][n]; }
                asm volatile("" ::: "memory"); }
    }
};
struct EpiQKV {
    static constexpr bool PERM = true;
    bf16_t* Q; bf16_t* K; bf16_t* V; const float* rcos; const float* rsin;
    __device__ __forceinline__ void operator()(AccRef acc, const pg8::Unit& u, int wr, int wc, int fr, int fq) const {
        const int row0 = u.pm * 256 + wr * 64 + fr, c0 = wc * 32 + 8 * fq;
        if (u.pn >= 8) {
#pragma unroll
            for (int ai = 0; ai < 2; ++ai)
#pragma unroll
                for (int m = 0; m < 4; ++m) { bf16_t* rowp = V + (size_t)(row0 + ai * 128 + m * 16) * 2048 + (u.pn - 8) * 256 + c0;
#pragma unroll
                    for (int bj = 0; bj < 2; ++bj) { const f32x4 v0 = acc[ai][bj][m][0], v1 = acc[ai][bj][m][1]; u32x4 w;
                        w.x = cvt_pk_bf16(v0[0], v0[1]); w.y = cvt_pk_bf16(v0[2], v0[3]); w.z = cvt_pk_bf16(v1[0], v1[1]); w.w = cvt_pk_bf16(v1[2], v1[3]);
                        *(u32x4*)(rowp + bj * 128) = w; } }
            return;
        }
        const bool isk = u.pn >= 4, lat = u.pm < 64; const int h = u.pn & 3; bf16_t* dst = isk ? K : Q; const float sc = isk ? 0.0625f : 1.0f;
        const int i0 = 16 * wc + 4 * fq;
#pragma unroll
        for (int ai = 0; ai < 2; ++ai)
#pragma unroll
            for (int m = 0; m < 4; ++m) { const int row = row0 + ai * 128 + m * 16, l = row & 2047; bf16_t* rowp = dst + (size_t)row * 1024 + h * 256 + c0;
#pragma unroll
                for (int bj = 0; bj < 2; ++bj) { f32x4 x1 = acc[ai][bj][m][0], x2 = acc[ai][bj][m][1];
                    if (lat) { const int pos = bj == 0 ? (l >> 6) : (l & 63); const f32x4 cv = *(const f32x4*)(rcos + pos * 64 + i0), sv = *(const f32x4*)(rsin + pos * 64 + i0);
                        const f32x4 o1 = x1 * cv - x2 * sv, o2 = x1 * sv + x2 * cv; x1 = o1; x2 = o2; }
                    x1 = x1 * sc; x2 = x2 * sc; u32x4 w;
                    w.x = cvt_pk_bf16(x1[0], x1[1]); w.y = cvt_pk_bf16(x1[2], x1[3]); w.z = cvt_pk_bf16(x2[0], x2[1]); w.w = cvt_pk_bf16(x2[2], x2[3]);
                    *(u32x4*)(rowp + bj * 128) = w; } }
    }
};
struct EpiZGate {
    static constexpr bool PERM = true;
    const bf16_t* O; const float* rinv; bf16_t* AO;
    __device__ __forceinline__ void operator()(AccRef acc, const pg8::Unit& u, int wr, int wc, int fr, int fq) const {
        const int row0 = u.pm * 256 + wr * 64 + fr, col0 = u.pn * 256 + wc * 32 + 8 * fq, head = u.pn >> 1;
#pragma unroll
        for (int ai = 0; ai < 2; ++ai)
#pragma unroll
            for (int m = 0; m < 4; ++m) { const int row = row0 + ai * 128 + m * 16; const float rv = rinv[row * 4 + head];
#pragma unroll
                for (int bj = 0; bj < 2; ++bj) { const size_t off = (size_t)row * 2048 + col0 + bj * 128; const u32x4 o = *(const u32x4*)(O + off);
                    const f32x4 v0 = acc[ai][bj][m][0], v1 = acc[ai][bj][m][1]; u32x4 w;
                    w.x = cvt_pk_bf16(bflo(o.x) * rv * silu_f(v0[0]), bfhi(o.x) * rv * silu_f(v0[1])); w.y = cvt_pk_bf16(bflo(o.y) * rv * silu_f(v0[2]), bfhi(o.y) * rv * silu_f(v0[3]));
                    w.z = cvt_pk_bf16(bflo(o.z) * rv * silu_f(v1[0]), bfhi(o.z) * rv * silu_f(v1[1])); w.w = cvt_pk_bf16(bflo(o.w) * rv * silu_f(v1[2]), bfhi(o.w) * rv * silu_f(v1[3]));
                    *(u32x4*)(AO + off) = w; } }
    }
};

#define XB_TMO      128
#define XB_XCNT(j)  (256  + 64 * (j))
#define XB_XSUB(j)  (1280 + 64 * (j))
#define XB_XGEN(j)  (2304 + 64 * (j))
#define XB_TOP      3328
#define XB_TOPGEN   3392
#define XCD_BAR_WORDS 3456
#define XB_SPIN_CAP (1u << 18)
__device__ __forceinline__ unsigned xb_ld(unsigned* p)              { return __hip_atomic_load(p, __ATOMIC_RELAXED, __HIP_MEMORY_SCOPE_AGENT); }
__device__ __forceinline__ unsigned xb_add(unsigned* p, unsigned v) { return __hip_atomic_fetch_add(p, v, __ATOMIC_RELAXED, __HIP_MEMORY_SCOPE_AGENT); }
__device__ __forceinline__ unsigned xb_xcc_id() { return (unsigned)__builtin_amdgcn_s_getreg((3 << 11) | 20) & 0xFu; }
#define XB_SPIN(cond, bar) do { unsigned _sp = 0; while (cond) { __builtin_amdgcn_s_sleep(1); \
    if ((++_sp & 255u) == 0u) { if (xb_ld(&(bar)[XB_TMO])) break; if (_sp > XB_SPIN_CAP) { atomicAdd(&(bar)[XB_TMO], 1u); break; } } } } while (0)
struct XcdBarrier { unsigned* bar; unsigned x; volatile LAS unsigned* st; };
__device__ __forceinline__ XcdBarrier xcd_barrier_post(unsigned* bar, volatile LAS unsigned* st) {
    XcdBarrier b; b.bar = bar; b.x = xb_xcc_id(); b.st = st;
    if (threadIdx.x == 0) (void)xb_add(&bar[XB_XCNT(b.x)], 1u);
    return b;
}
__device__ __forceinline__ void xcd_barrier_complete(unsigned* bar, unsigned x, unsigned& nloc, unsigned& nx) {
    const unsigned G = gridDim.x * gridDim.y * gridDim.z;
    unsigned sum, cnt, mine, sp = 0u;
    for (;;) {
        sum = 0u; cnt = 0u; mine = 0u;
#pragma unroll
        for (unsigned j = 0; j < 16; ++j) { const unsigned c = xb_ld(&bar[XB_XCNT(j)]); sum += c; cnt += (c > 0u) ? 1u : 0u; mine = (j == x) ? c : mine; }
        if (sum == G) break;
        __builtin_amdgcn_s_sleep(1);
        if ((++sp & 255u) == 0u) { if (xb_ld(&bar[XB_TMO])) break; if (sp > XB_SPIN_CAP) { atomicAdd(&bar[XB_TMO], 1u); break; } }
    }
    nloc = mine > 0u ? mine : 1u; nx = cnt > 0u ? cnt : 1u;
}
__device__ __forceinline__ void xcd_barrier(const XcdBarrier& b) {
    asm volatile("s_waitcnt vmcnt(0)" ::: "memory");
    __syncthreads();
    if (threadIdx.x == 0) {
        unsigned* bar = b.bar;
        __builtin_amdgcn_s_waitcnt(0);
        unsigned nloc = b.st[0], nx = b.st[1];
        if (nloc == 0u) { xcd_barrier_complete(bar, b.x, nloc, nx); b.st[0] = nloc; b.st[1] = nx; }
        const unsigned old = xb_add(&bar[XB_XSUB(b.x)], 1u);
        const unsigned gen = old / nloc;
        if (old + 1u == (gen + 1u) * nloc) {
            __builtin_amdgcn_fence(__ATOMIC_RELEASE, "agent");
            asm volatile("s_waitcnt vmcnt(0)" ::: "memory");
            const unsigned og = xb_add(&bar[XB_TOP], 1u);
            const unsigned tg = og / nx;
            if (og + 1u == (tg + 1u) * nx) xb_add(&bar[XB_TOPGEN], 1u);
            else XB_SPIN(xb_ld(&bar[XB_TOPGEN]) == tg, bar);
            __builtin_amdgcn_fence(__ATOMIC_ACQUIRE, "agent");
            xb_add(&bar[XB_XGEN(b.x)], 1u);
            asm volatile("s_waitcnt vmcnt(0)" ::: "memory");
        } else {
            XB_SPIN(xb_ld(&bar[XB_XGEN(b.x)]) == gen, bar);
            __builtin_amdgcn_fence(__ATOMIC_ACQUIRE, "agent");
            asm volatile("s_waitcnt vmcnt(0)" ::: "memory");
        }
    }
    __syncthreads();
}

struct Args { const float* in[13]; float* out; unsigned char* ws; int ph_lo, ph_hi, pad0, pad1; };
struct Frame {
    LAS unsigned char* lds;
    int vcu, G, wv;
    unsigned char* ws;
};
__device__ __forceinline__ int lane_id() { int l; asm volatile("v_mbcnt_lo_u32_b32 %0, -1, 0\n\tv_mbcnt_hi_u32_b32 %0, -1, %0" : "=v"(l)); return l; }
__device__ __forceinline__ unsigned char* launder_ptr(unsigned char* p) {
    unsigned lo = (unsigned)(unsigned long long)p, hi = (unsigned)((unsigned long long)p >> 32);
    asm volatile("" : "+s"(lo), "+s"(hi));
    return (unsigned char*)(((unsigned long long)hi << 32) | lo);
}
#define PHASE_IDS() int tid = F.wv * 64 + lane_id(); asm volatile("" : "+v"(tid)); const int lane = tid & 63, wave = __builtin_amdgcn_readfirstlane(tid >> 6); (void)lane; (void)wave; \
    unsigned char* ws = launder_ptr(F.ws); (void)ws
#define LDS_WAIT() asm volatile("s_waitcnt lgkmcnt(0)" ::: "memory")

__device__ __forceinline__ int qk_pos(int d) { const int half = d >> 7, n = (d >> 6) & 1, i = d & 63; return 128 * half + 8 * (i >> 2) + 4 * n + (i & 3); }
template <int MODE>
__device__ __forceinline__ void transpose_item(const float* W, int K, int N, int n_begin, bf16_t* WT, LAS float* scr, int item, int nblk, int lane) {
    const int kb = item / nblk, nb = item % nblk, k0 = 64 * kb, n0 = n_begin + 32 * nb;
#pragma unroll 8
    for (int i = 0; i < 32; ++i) { const int kk = 2 * i + (lane >> 5); scr[kk * 33 + (lane & 31)] = W[(size_t)(k0 + kk) * N + n0 + (lane & 31)]; }
    LDS_WAIT(); asm volatile("" ::: "memory");
    const int c = lane & 7;
#pragma unroll
    for (int j = 0; j < 4; ++j) { const int n = (lane >> 3) + 8 * j; const LAS float* s = scr + (8 * c) * 33 + n;
        u32x4 o; o.x = pk2(s[0 * 33], s[1 * 33]); o.y = pk2(s[2 * 33], s[3 * 33]); o.z = pk2(s[4 * 33], s[5 * 33]); o.w = pk2(s[6 * 33], s[7 * 33]);
        int nn = n0 + n - n_begin;
        if (MODE == 1) { const int na = n0 + n; nn = (na < 2048) ? ((na & ~255) + qk_pos(na & 255)) : na; }
        *(u32x4*)(WT + (size_t)nn * K + k0 + 8 * c) = o; }
    LDS_WAIT(); asm volatile("" ::: "memory");
}
__device__ __forceinline__ void fold_task(const float* Win  , const float* TC, bf16_t* WfT, int t, int lane) {
    const int g = t >> 8, p0 = ((t >> 5) & 7) * 32, kk0 = (t & 31) * 32, s = lane >> 5, li = lane & 31;
    f32x16 acc;
#pragma unroll
    for (int i = 0; i < 16; ++i) acc[i] = 0.f;
    const float* wrow = Win + (size_t)(kk0 + li) * 4096 + g * 256 + 4 * s;
    const float* tcol = TC + p0 + li;
#pragma unroll 4
    for (int tp = 0; tp < 32; ++tp) {
        const f32x4 wv = *(const f32x4*)(wrow + 8 * tp);
#pragma unroll
        for (int uu = 0; uu < 4; ++uu) { const float a = tcol[(8 * tp + 4 * s + uu) * 256]; acc = __builtin_amdgcn_mfma_f32_32x32x2f32(a, wv[uu], acc, 0, 0, 0); }
    }
#pragma unroll
    for (int i = 0; i < 16; ++i) { const int row = (i & 3) + 8 * (i >> 2) + 4 * s; WfT[(size_t)(g * 256 + p0 + row) * 1024 + kk0 + li] = (bf16_t)f2bf(acc[i]); }
}

__device__ __forceinline__ void p0_phase(Frame& F, const Args& a) {
    PHASE_IDS();
    float* ADA = (float*)(ws + WS_ADA);
    const float* c = a.in[1]; const float* cctx = a.in[3]; const float* ada_w = a.in[5]; const float* ada_b = a.in[6];
    LAS float* sl = (LAS float*)F.lds;
    LAS float* part = (LAS float*)(F.lds + 36864);
    bool loaded = false;
#ifndef DBG_P0
#define DBG_P0 3
#endif
    if (DBG_P0 & 1)
    for (int u = F.vcu; u < 192; u += F.G) {
        if (!loaded) { for (int idx = tid; idx < 9 * 1024; idx += 512) { const int r = idx >> 10, k = idx & 1023; const float x = r < 8 ? c[r * 1024 + k] : cctx[k]; sl[idx] = x / (1.f + expf(-x)); } loaded = true; }
        __syncthreads();
        const int i = u / 48, n0 = (u % 48) * 64;
        float acc[9];
#pragma unroll
        for (int r = 0; r < 9; ++r) acc[r] = 0.f;
        const float* wp = ada_w + ((size_t)i * 1024 + wave * 128) * 3072 + n0 + lane;
#pragma unroll 8
        for (int kk = 0; kk < 128; ++kk) { const float wv = wp[(size_t)kk * 3072]; const int k = wave * 128 + kk;
#pragma unroll
            for (int r = 0; r < 9; ++r) acc[r] += sl[r * 1024 + k] * wv; }
#pragma unroll
        for (int r = 0; r < 9; ++r) part[(wave * 9 + r) * 64 + lane] = acc[r];
        __syncthreads();
        for (int idx = tid; idx < 576; idx += 512) { const int r = idx >> 6, l = idx & 63; float s = 0.f;
#pragma unroll
            for (int w = 0; w < 8; ++w) s += part[(w * 9 + r) * 64 + l];
            ADA[(i * 9 + r) * 3072 + n0 + l] = s + ada_b[i * 3072 + n0 + l]; }
    }
    if (!(DBG_P0 & 2)) return;
    const int gt = F.vcu * 512 + tid, NT = F.G * 512;
    float* TC = (float*)(ws + WS_TC);
    for (int idx = gt; idx < 65536; idx += NT) { const int cc = idx >> 8, p = idx & 255; float v;
        if (p < 128) v = cospif((float)((p * cc) & 255) * (1.f / 128.f));
        else if (p == 128) v = (cc & 1) ? -1.f : 1.f;
        else v = sinpif((float)(((p - 128) * cc) & 255) * (1.f / 128.f));
        TC[idx] = v * 0.0625f; }
    float* RC = (float*)(ws + WS_ROPE); float* RS = RC + 4096;
    for (int idx = gt; idx < 4096; idx += NT) { const int pos = idx >> 6, i = idx & 63; const float freq = powf(10000.0f, -(float)i / 64.0f); const float ang = (float)pos * freq;
        RC[idx] = cosf(ang); RS[idx] = sinf(ang); }
    bf16_t* CS256 = (bf16_t*)(ws + WS_CS256);
    for (int idx = gt; idx < 512 * 256; idx += NT) { const int row = idx >> 8, l = idx & 255, kt = row >> 8, hf = (row >> 7) & 1, k = kt * 128 + (row & 127);
        const float x = (float)((k * l) & 255) * (1.f / 128.f); const float v = (hf ? sinpif(x) : cospif(x)) * 0.0625f; CS256[idx] = (bf16_t)f2bf(v); }
}

__device__ __forceinline__ void norm_row(const float* xrow, const float* ng, const float* adar  , bf16_t* orow, int lane) {
    const f32x4* xr = (const f32x4*)xrow + lane;
    f32x4 v[4]; float s = 0.f;
#pragma unroll
    for (int j = 0; j < 4; ++j) { v[j] = xr[64 * j]; s += (v[j].x * v[j].x + v[j].y * v[j].y) + (v[j].z * v[j].z + v[j].w * v[j].w); }
    const float rinv = rsqrtf(wave_sum(s, lane) * (1.f / DM) + EPS);
    unsigned long long* o8 = (unsigned long long*)orow + lane;
#pragma unroll
    for (int j = 0; j < 4; ++j) { const int col = 4 * lane + 256 * j; const f32x4 g = *(const f32x4*)(ng + col), sh = *(const f32x4*)(adar + col), sc = *(const f32x4*)(adar + 1024 + col);
        const f32x4 y = v[j] * rinv * g * (sc + 1.0f) + sh;
        o8[64 * j] = (unsigned long long)pk2(y.x, y.y) | ((unsigned long long)pk2(y.z, y.w) << 32); }
}
__device__ __forceinline__ void norm_rows(Frame& F, const Args& a, int layer, bf16_t* H) {
    PHASE_IDS();
    const float* xl = layer == 0 ? a.in[0] : a.out; const float* xc = layer == 0 ? a.in[2] : (const float*)(ws + WS_XCTX);
    const float* ng = a.in[4] + layer * DM; const float* ADA = (const float*)(ws + WS_ADA) + layer * 9 * 3072;
    const int gw = F.vcu * 8 + wave, NGW = F.G * 8;
    for (int m = gw; m < NTOK; m += NGW) {
        const bool lat = m < NLAT; const int r = lat ? (m >> 11) : 8;
        const float* xrow = lat ? xl + (size_t)m * DM : xc + (size_t)(m - NLAT) * DM;
        norm_row(xrow, ng, ADA + r * 3072, H + (size_t)m * DM, lane);
    }
}
__device__ __forceinline__ void n_phase(Frame& F, const Args& a, int layer) {
    PHASE_IDS();
    const bool fourier = (layer & 1) == 0; const int j = layer >> 1;
    norm_rows(F, a, layer, (bf16_t*)(ws + (fourier ? WS_H : WS_OF)));
    LAS float* scr = (LAS float*)(F.lds + wave * 16384);
    const int gw = F.vcu * 8 + wave, NGW = F.G * 8;
    bf16_t* W1 = (bf16_t*)(ws + WS_W);
    if (fourier) {
        const float* win = a.in[7] + (size_t)j * 1024 * 4096; const float* wout = a.in[8] + (size_t)j * 2048 * 1024;
        bf16_t* WfoT = W1 + (size_t)4096 * 1024;
        for (int t = gw; t < 2048; t += NGW) fold_task(win, (const float*)(ws + WS_TC), W1, t, lane);
        for (int it = gw; it < 16 * 64; it += NGW) transpose_item<0>(win, 1024, 4096, 2048, W1 + (size_t)2048 * 1024, scr, it, 64, lane);
        for (int it = gw; it < 32 * 32; it += NGW) transpose_item<0>(wout, 2048, 1024, 0, WfoT, scr, it, 32, lane);
        bf16_t* CS = (bf16_t*)(ws + WS_CS);
        const int gt = F.vcu * 512 + tid, NT = F.G * 512;
        for (int ch = gt; ch < 4096 * 256; ch += NT) { const int row = ch >> 8, l0 = (ch & 255) * 8, kt = row >> 8, hf = (row >> 7) & 1, k = kt * 128 + (row & 127);
            unsigned w[4];
#pragma unroll
            for (int e = 0; e < 4; ++e) { float v[2];
#pragma unroll
                for (int q = 0; q < 2; ++q) { const int l = l0 + 2 * e + q; const float x = (float)((k * l) & 2047) * (1.f / 1024.f); v[q] = (hf ? sinpif(x) : cospif(x)) * 0.022097087f; }
                w[e] = pk2(v[0], v[1]); }
            *(u32x4*)(CS + (size_t)row * 2048 + l0) = (u32x4){w[0], w[1], w[2], w[3]}; }
    } else {
        const float* win = a.in[9] + (size_t)j * 1024 * 6144; const float* wout = a.in[10] + (size_t)j * 2048 * 1024;
        bf16_t* WroT = W1 + (size_t)6144 * 1024;
        for (int it = gw; it < 16 * 192; it += NGW) transpose_item<1>(win, 1024, 6144, 0, W1, scr, it, 192, lane);
        for (int it = gw; it < 32 * 32; it += NGW) transpose_item<0>(wout, 2048, 1024, 0, WroT, scr, it, 32, lane);
    }
}

__device__ __forceinline__ bf16_t* s_chunk(unsigned char* ws, int h, int rc) {
    return rc < 64 ? (bf16_t*)(ws + WS_SA) + ((size_t)(h * 64 + rc) << 14) : (bf16_t*)(ws + WS_SB) + ((size_t)(h * 80 + rc - 64) << 14);
}
struct DiagOrder { int G, c; __device__ bool next(int i, pg8::Unit& u) const { const int L = i * G + c; if (L >= 72) return false; u.pm = L; u.pn = L; return true; } };
struct EpiS {
    static constexpr bool PERM = true;
    unsigned char* ws; int h;
    __device__ __forceinline__ void operator()(AccRef acc, const pg8::Unit& u, int wr, int wc, int fr, int fq) const {
#pragma unroll
        for (int ai = 0; ai < 2; ++ai) { bf16_t* sp = s_chunk(ws, h, 2 * u.pm + ai);
#pragma unroll
            for (int m = 0; m < 4; ++m) { const f32x4 v0 = acc[ai][ai][m][0], v1 = acc[ai][ai][m][1]; u32x4 w;
                w.x = cvt_pk_bf16(v0[0], v0[1]); w.y = cvt_pk_bf16(v0[2], v0[3]); w.z = cvt_pk_bf16(v1[0], v1[1]); w.w = cvt_pk_bf16(v1[2], v1[3]);
                *(u32x4*)(sp + (wr * 64 + m * 16 + fr) * 128 + wc * 32 + 8 * fq) = w; } }
    }
};
typedef short bf16x4 __attribute__((ext_vector_type(4)));
typedef short v4i16_t __attribute__((ext_vector_type(4)));
__device__ __forceinline__ bf16x8 ldtr2(const LAS unsigned char* p0, const LAS unsigned char* p1) {
    const bf16x4 lo = __builtin_bit_cast(bf16x4, __builtin_amdgcn_ds_read_tr16_b64_v4i16((LAS v4i16_t*)p0));
    const bf16x4 hi = __builtin_bit_cast(bf16x4, __builtin_amdgcn_ds_read_tr16_b64_v4i16((LAS v4i16_t*)p1));
    return __builtin_shufflevector(lo, hi, 0, 1, 2, 3, 4, 5, 6, 7);
}
__device__ __forceinline__ int blk_perm(int rb) { return (rb & ~3) | ((rb >> 1) & 1) | ((rb & 1) << 1); }
__device__ __forceinline__ int scan_t0(int dir, int b, int s) {
    return dir == 0 ? ((s < 2) ? (NLAT + b * CTXL + s * 128) : (b * SEQ + (s - 2) * 128)) : ((s < 2) ? (NLAT + b * CTXL + (1 - s) * 128) : (b * SEQ + (17 - s) * 128));
}
__device__ __forceinline__ int scan_rc(int dir, int b, int s) {
    return dir == 0 ? ((s < 2) ? (128 + b * 2 + s) : (b * 16 + (s - 2))) : ((s < 2) ? (128 + b * 2 + (1 - s)) : (b * 16 + (17 - s)));
}
__device__ __forceinline__ u32x4 ldg16(const void* ub, unsigned voff) { return *(const GAS u32x4*)((const GAS unsigned char*)ub + voff); }
__device__ __forceinline__ void scan_load_s(u32x4 (&sf)[4], unsigned char* ws, int h, int rc, int w, int r, int q) {
    const bf16_t* ub = s_chunk(ws, h, rc) + 16 * w * 128; const unsigned vo = (unsigned)(r * 128 + 8 * q) * 2u;
#pragma unroll
    for (int ks = 0; ks < 4; ++ks) sf[ks] = ldg16(ub, vo + 64u * ks);
}
__device__ __forceinline__ void scan_load_q(u32x4 (&qf)[8], const bf16_t* Qg, int h, int t0, int w, int r, int q) {
    const bf16_t* ub = Qg + (size_t)(t0 + 16 * w) * 1024 + h * 256; const unsigned vo = (unsigned)(r * 1024 + 8 * q) * 2u;
#pragma unroll
    for (int ks = 0; ks < 8; ++ks) qf[ks] = ldg16(ub, vo + 64u * ks);
}
__device__ __forceinline__ void scan_load_kv(u32x4 (&kr)[8], u32x4 (&vr)[2], const bf16_t* Kg, const bf16_t* Vg, int h, int sl, int t0, int w, int lane, int tid) {
    const bf16_t* kb = Kg + (size_t)t0 * 1024 + h * 256 + 32 * w; const unsigned ko = (unsigned)((lane >> 2) * 1024 + 8 * (lane & 3)) * 2u;
#pragma unroll
    for (int it = 0; it < 8; ++it) kr[it] = ldg16(kb + (size_t)it * 16 * 1024, ko);
    const bf16_t* vb = Vg + (size_t)t0 * 2048 + h * 512 + sl * 64; const unsigned vo = (unsigned)((tid >> 3) * 2048 + 8 * (tid & 7)) * 2u;
#pragma unroll
    for (int i = 0; i < 2; ++i) vr[i] = ldg16(vb + (size_t)i * 64 * 2048, vo);
}
template <int DIR>
__device__ __forceinline__ void scan_step(LAS unsigned char* lds, u32x4 (&sf)[4], u32x4 (&qf)[8], u32x4 (&kr)[8], u32x4 (&vr)[2], f32x4 (&Rb)[2][4], const float (&wm)[2], float rsc, float g128,
                                          int t0, int t0n, int rcn, unsigned char* ws, int h, int sl, int w, int lane, int tid, const bf16_t* Qg, const bf16_t* Kg, const bf16_t* Vg, bf16_t* OF, float* SSP) {
    const int r = lane & 15, q = lane >> 4;
    LAS unsigned char* VI = lds + SC_V_OFF; LAS unsigned char* RT = lds + SC_RT_OFF; LAS unsigned char* KI = lds + SC_K_OFF + w * 8192;
#pragma unroll
    for (int i = 0; i < 2; ++i) { const int m = (tid >> 3) + 64 * i, e0 = 8 * (tid & 7); const float sc = wm[i]; const u32x4 v = vr[i]; u32x4 o;
        o.x = cvt_pk_bf16(bflo(v.x) * sc, bfhi(v.x) * sc); o.y = cvt_pk_bf16(bflo(v.y) * sc, bfhi(v.y) * sc); o.z = cvt_pk_bf16(bflo(v.z) * sc, bfhi(v.z) * sc); o.w = cvt_pk_bf16(bflo(v.w) * sc, bfhi(v.w) * sc);
        *(LAS u32x4*)(VI + 128 * ((e0 >> 4) * 32 + blk_perm(m >> 2)) + (m & 3) * 32 + (e0 & 15) * 2) = o; }
#pragma unroll
    for (int it = 0; it < 8; ++it) { const int m = it * 16 + (lane >> 2), dc = lane & 3;
        *(LAS u32x4*)(KI + 128 * ((dc >> 1) * 32 + blk_perm(m >> 2)) + (m & 3) * 32 + (dc & 1) * 16) = kr[it]; }
    __syncthreads();
    scan_load_kv(kr, vr, Kg, Vg, h, sl, t0n, w, lane, tid);
    const int jl = 16 * w + r;
    f32x4 O[4];
#pragma unroll
    for (int eb = 0; eb < 4; ++eb) O[eb] = (f32x4){0.f, 0.f, 0.f, 0.f};
    const LAS unsigned char* rtb = RT + r * 528 + q * 16;
#pragma unroll
    for (int ks = 0; ks < 8; ++ks) { const bf16x8 qv = __builtin_bit_cast(bf16x8, qf[ks]);
#pragma unroll
        for (int eb = 0; eb < 4; ++eb) { const bf16x8 av = *(const LAS bf16x8*)(rtb + (16 * eb * 528 + 64 * ks));
            O[eb] = __builtin_amdgcn_mfma_f32_16x16x32_bf16(av, qv, O[eb], 0, 0, 0); } }
    scan_load_q(qf, Qg, h, t0n, w, r, q);
    const int lofs = 128 * (4 * (q >> 1) + (q & 1)) + 8 * r;
    const LAS unsigned char* vtb = VI + lofs; const LAS unsigned char* ktb = KI + lofs;
#pragma unroll
    for (int ks = 0; ks < 4; ++ks) {
        bf16x8 vb[4], ka[2];
#pragma unroll
        for (int eb = 0; eb < 4; ++eb) vb[eb] = ldtr2(vtb + 128 * (eb * 32 + 8 * ks), vtb + 128 * (eb * 32 + 8 * ks + 2));
#pragma unroll
        for (int db = 0; db < 2; ++db) ka[db] = ldtr2(ktb + 128 * (db * 32 + 8 * ks), ktb + 128 * (db * 32 + 8 * ks + 2));
        bf16x8 sfm;
        { unsigned wd[4] = {sf[ks].x, sf[ks].y, sf[ks].z, sf[ks].w};
#pragma unroll
          for (int i = 0; i < 4; ++i) { const int m0 = 32 * ks + 8 * q + 2 * i; const bool k0 = DIR == 0 ? (m0 <= jl) : (m0 >= jl), k1 = DIR == 0 ? (m0 + 1 <= jl) : (m0 + 1 >= jl);
              wd[i] &= (k0 ? 0xffffu : 0u) | (k1 ? 0xffff0000u : 0u); }
          sfm = __builtin_bit_cast(bf16x8, (u32x4){wd[0], wd[1], wd[2], wd[3]}); }
#pragma unroll
        for (int eb = 0; eb < 4; ++eb) O[eb] = __builtin_amdgcn_mfma_f32_16x16x32_bf16(vb[eb], sfm, O[eb], 0, 0, 0);
#pragma unroll
        for (int db = 0; db < 2; ++db)
#pragma unroll
            for (int eb = 0; eb < 4; ++eb) Rb[db][eb] = __builtin_amdgcn_mfma_f32_16x16x32_bf16(ka[db], vb[eb], Rb[db][eb], 0, 0, 0);
    }
    scan_load_s(sf, ws, h, rcn, w, r, q);
    {
        GAS unsigned char* ob = (GAS unsigned char*)(OF + (size_t)(t0 + 16 * w) * 2048 + h * 512 + sl * 64); const unsigned oo = (unsigned)(r * 2048 + 4 * q) * 2u; float ss = 0.f;
#pragma unroll
        for (int eb = 0; eb < 4; ++eb) { f32x4 v = O[eb] * rsc; GAS bf16_t* op = (GAS bf16_t*)(ob + oo) ;
            if (DIR == 1) { const u32x2 pv = *(const GAS u32x2*)(op + 16 * eb); v[0] += bflo(pv.x); v[1] += bfhi(pv.x); v[2] += bflo(pv.y); v[3] += bfhi(pv.y);
                ss += (v[0] * v[0] + v[1] * v[1]) + (v[2] * v[2] + v[3] * v[3]); }
            u32x2 o; o.x = cvt_pk_bf16(v[0], v[1]); o.y = cvt_pk_bf16(v[2], v[3]); *(GAS u32x2*)(op + 16 * eb) = o; }
        if (DIR == 1) { ss += shx(ss, 16, lane); ss += shx(ss, 32, lane); if (q == 0) *(GAS float*)((GAS unsigned char*)(SSP + (size_t)(t0 + 16 * w) * 32 + h * 8 + sl) + (unsigned)r * 128u) = ss; }
    }
#pragma unroll
    for (int db = 0; db < 2; ++db)
#pragma unroll
        for (int eb = 0; eb < 4; ++eb) Rb[db][eb] = Rb[db][eb] * g128;
    __syncthreads();
#pragma unroll
    for (int db = 0; db < 2; ++db)
#pragma unroll
        for (int eb = 0; eb < 4; ++eb) { u32x2 o; o.x = cvt_pk_bf16(Rb[db][eb][0], Rb[db][eb][1]); o.y = cvt_pk_bf16(Rb[db][eb][2], Rb[db][eb][3]);
            *(LAS u32x2*)(RT + (16 * eb + r) * 528 + (32 * w + 16 * db + 4 * q) * 2) = o; }
}
template <int DIR>
__device__ __forceinline__ void scan_unit(Frame& F, int tid, unsigned char* ws, int b, int h, int sl, float lg, const bf16_t* Qg, const bf16_t* Kg, const bf16_t* Vg, bf16_t* OF, float* SSP) {
    const int lane = tid & 63, w = __builtin_amdgcn_readfirstlane(tid >> 6), r = lane & 15, q = lane >> 4;
    const float g128 = __expf(128.f * lg);
    float wm[2];
#pragma unroll
    for (int i = 0; i < 2; ++i) { const int m = (tid >> 3) + 64 * i; wm[i] = __expf(lg * (float)(DIR == 0 ? 127 - m : m)); }
    const int jl = 16 * w + r; const float rsc = __expf(lg * (float)(DIR == 0 ? jl - 127 : -jl));
    f32x4 Rb[2][4];
#pragma unroll
    for (int db = 0; db < 2; ++db)
#pragma unroll
        for (int eb = 0; eb < 4; ++eb) Rb[db][eb] = (f32x4){0.f, 0.f, 0.f, 0.f};
    {
        LAS unsigned char* RT = F.lds + SC_RT_OFF;
#pragma unroll
        for (int db = 0; db < 2; ++db)
#pragma unroll
            for (int eb = 0; eb < 4; ++eb) *(LAS u32x2*)(RT + (16 * eb + r) * 528 + (32 * w + 16 * db + 4 * q) * 2) = (u32x2){0u, 0u};
    }
    u32x4 sf[4], qf[8], kr[8], vr[2];
    scan_load_s(sf, ws, h, scan_rc(DIR, b, 0), w, r, q);
    scan_load_q(qf, Qg, h, scan_t0(DIR, b, 0), w, r, q);
    scan_load_kv(kr, vr, Kg, Vg, h, sl, scan_t0(DIR, b, 0), w, lane, tid);
    for (int s = 0; s < 18; ++s) {
        const int sn = (s + 1 < 18) ? s + 1 : 17;
        scan_step<DIR>(F.lds, sf, qf, kr, vr, Rb, wm, rsc, g128, scan_t0(DIR, b, s), scan_t0(DIR, b, sn), scan_rc(DIR, b, sn), ws, h, sl, w, lane, tid, Qg, Kg, Vg, OF, SSP);
    }
    __syncthreads();
}
__device__ __forceinline__ void scan_phase(Frame& F, const Args& a, int layer, int dir) {
    PHASE_IDS();
    const int j = layer >> 1; const float* dec = a.in[11] + j * 8 + dir * 4;
    for (int u = F.vcu; u < 256; u += F.G) {
        const int b = u >> 5, h = (u >> 3) & 3, sl = u & 7;
        const float lg = log1pf(-exp2f(dec[h]));
        if (dir == 0) scan_unit<0>(F, tid, ws, b, h, sl, lg, (const bf16_t*)(ws + WS_Q), (const bf16_t*)(ws + WS_K), (const bf16_t*)(ws + WS_V), (bf16_t*)(ws + WS_OF), (float*)(ws + WS_SSP));
        else scan_unit<1>(F, tid, ws, b, h, sl, lg, (const bf16_t*)(ws + WS_Q), (const bf16_t*)(ws + WS_K), (const bf16_t*)(ws + WS_V), (bf16_t*)(ws + WS_OF), (float*)(ws + WS_SSP));
    }
}
__device__ __forceinline__ void n2_phase(Frame& F, const Args& a, int layer) {
    PHASE_IDS();
    norm_rows(F, a, layer, (bf16_t*)(ws + WS_Q));
    const float* SSP = (const float*)(ws + WS_SSP); float* RINV = (float*)(ws + WS_RINV);
    const int gt = F.vcu * 512 + tid, NT = F.G * 512;
    for (int idx = gt; idx < NTOK * 4; idx += NT) { const f32x4 p0 = *(const f32x4*)(SSP + (size_t)idx * 8), p1 = *(const f32x4*)(SSP + (size_t)idx * 8 + 4);
        const float ss = ((p0.x + p0.y) + (p0.z + p0.w)) + ((p1.x + p1.y) + (p1.z + p1.w)); RINV[idx] = rsqrtf(ss * (1.f / 512.f) + EPS); }
}
__device__ __forceinline__ void final_phase(Frame& F, const Args& a) {
    PHASE_IDS();
    const float* fg = a.in[12]; const int gw = F.vcu * 8 + wave, NGW = F.G * 8;
    for (int m = gw; m < NLAT; m += NGW) {
        f32x4* xr = (f32x4*)(a.out + (size_t)m * DM) + lane;
        f32x4 v[4]; float s = 0.f;
#pragma unroll
        for (int jj = 0; jj < 4; ++jj) { v[jj] = xr[64 * jj]; s += (v[jj].x * v[jj].x + v[jj].y * v[jj].y) + (v[jj].z * v[jj].z + v[jj].w * v[jj].w); }
        const float rinv = rsqrtf(wave_sum(s, lane) * (1.f / DM) + EPS);
#pragma unroll
        for (int jj = 0; jj < 4; ++jj) { const f32x4 g = *(const f32x4*)(fg + 4 * lane + 256 * jj); xr[64 * jj] = v[jj] * rinv * g; }
    }
}

constexpr int N_PHASES = 34;
__global__ void __launch_bounds__(512, 2) trunk_fwd(Args args) {
    extern __shared__ __attribute__((aligned(16))) unsigned char lds_raw[];
    Frame F;
    F.lds = (LAS unsigned char*)lds_raw;
    F.G = gridDim.x; F.wv = __builtin_amdgcn_readfirstlane((int)threadIdx.x >> 6); { const int bx = blockIdx.x; F.vcu = (F.G % 8 == 0) ? (bx % 8) * (F.G / 8) + bx / 8 : bx; }
    F.ws = args.ws;
    volatile LAS unsigned* MISC = (volatile LAS unsigned*)(F.lds + MISC_OFF);
    for (int u = threadIdx.x; u < 128; u += 512) MISC[u] = 0u;
    __syncthreads();
    const int lo = args.ph_lo, hi = args.ph_hi;
    XcdBarrier bar; bar.bar = (unsigned*)(args.ws + WS_CTL) + 4096; bar.x = 0; bar.st = nullptr;
    const bool multi = (hi - lo) > 1;
    if (multi) bar = xcd_barrier_post((unsigned*)(args.ws + WS_CTL) + 4096, MISC + 8);
#ifndef KINDS
#define KINDS 0xFFFF
#endif
#define KON(b) (((KINDS) >> (b)) & 1)
#ifndef REPK
#define REPK 0
#endif
#define NREP(b) ((((REPK) >> (b)) & 1) ? 2 : 1)
#define IN(k) (lo <= (k) && (k) < hi)
#define SEAM(k) do { if (multi && (k) + 1 < hi) xcd_barrier(bar); } while (0)
    const int bx = (int)blockIdx.x, G = F.G;
    if (KON(0) && IN(0)) { p0_phase(F, args); SEAM(0); }
    for (int layer = 0; layer < NLAYER; ++layer) {
        const int pb = 1 + 8 * layer; const bool fourier = (layer & 1) == 0;
        unsigned char* ws = launder_ptr(args.ws);
        const float* ADAg = (const float*)(ws + WS_ADA) + layer * 9 * 3072 + 2048;
        const float* xin_lat = layer == 0 ? args.in[0] : args.out; const float* xin_ctx = layer == 0 ? args.in[2] : (const float*)(ws + WS_XCTX);
        const EpiResid ER{xin_lat, xin_ctx, args.out, (float*)(ws + WS_XCTX), ADAg};
        if (KON(1) && IN(pb)) { for (int rep = 0; rep < NREP(1); ++rep) { n_phase(F, args, layer); SEAM(pb); } }
        if (fourier) {
            bf16_t* W1 = (bf16_t*)(ws + WS_W);
            if (KON(2) && IN(pb + 1)) for (int rep = 0; rep < NREP(2); ++rep) {
                { pg8::Gemm g{(const bf16_t*)(ws + WS_H), W1 + (size_t)2048 * 1024, 1024, 1024, 1024}; pg8::TileOrder S; S.init(72, 8, G, bx);
                  EpiSilu E{(bf16_t*)(ws + WS_Z), 2048}; pg8::gemm_phase(F.lds, F.wv, g, S, E); }
                { pg8::Gemm g{W1, (const bf16_t*)(ws + WS_H), 1024, 1024, 1024}; pg8::TileOrder S; S.init(8, 72, G, (bx + 64) % G);
                  EpiUT E{(bf16_t*)(ws + WS_UTL), (bf16_t*)(ws + WS_UTC)}; pg8::gemm_phase(F.lds, F.wv, g, S, E); }
                SEAM(pb + 1);
            }
            if (KON(3) && IN(pb + 2)) {
                { pg8::Gemm g{(const bf16_t*)(ws + WS_CS), (const bf16_t*)(ws + WS_UTL), 2048, 2048, 2048}; pg8::TileOrder S; S.init(16, 64, G, bx);
                  EpiDft E{(bf16_t*)(ws + WS_Z), 2048, 0}; pg8::gemm_phase(F.lds, F.wv, g, S, E); }
                { pg8::Gemm g{(const bf16_t*)(ws + WS_CS256), (const bf16_t*)(ws + WS_UTC), 256, 256, 256}; pg8::TileOrder S; S.init(2, 64, G, bx);
                  EpiDft E{(bf16_t*)(ws + WS_Z), 256, NLAT}; pg8::gemm_phase(F.lds, F.wv, g, S, E); }
                SEAM(pb + 2);
            }
            if (KON(4) && IN(pb + 3)) {
                pg8::Gemm g{(const bf16_t*)(ws + WS_Z), W1 + (size_t)4096 * 1024, 2048, 2048, 2048}; pg8::TileOrder S; S.init(72, 4, G, bx);
                pg8::gemm_phase(F.lds, F.wv, g, S, ER);
                SEAM(pb + 3);
            }
        } else {
            bf16_t* W1 = (bf16_t*)(ws + WS_W);
            if (KON(5) && IN(pb + 1)) for (int rep = 0; rep < NREP(5); ++rep) {
                pg8::Gemm g{(const bf16_t*)(ws + WS_OF), W1, 1024, 1024, 1024}; pg8::TileOrder S; S.init(72, 16, G, bx);
                EpiQKV E{(bf16_t*)(ws + WS_Q), (bf16_t*)(ws + WS_K), (bf16_t*)(ws + WS_V), (const float*)(ws + WS_ROPE), (const float*)(ws + WS_ROPE) + 4096};
                pg8::gemm_phase(F.lds, F.wv, g, S, E);
                SEAM(pb + 1);
            }
            if (KON(6) && IN(pb + 2)) {
                for (int h = 0; h < 4; ++h) { pg8::Gemm g{(const bf16_t*)(ws + WS_Q) + h * 256, (const bf16_t*)(ws + WS_K) + h * 256, 1024, 1024, 256}; DiagOrder S{G, (bx + 64 * h) % G};
                    EpiS E{ws, h}; pg8::gemm_phase(F.lds, F.wv, g, S, E); }
                if (multi) xcd_barrier(bar);
                for (int rep = 0; rep < NREP(6); ++rep) { scan_phase(F, args, layer, 0); SEAM(pb + 2); }
            }
            if (KON(6) && IN(pb + 3)) { scan_phase(F, args, layer, 1); SEAM(pb + 3); }
            if (KON(7) && IN(pb + 4)) for (int rep = 0; rep < NREP(7); ++rep) { n2_phase(F, args, layer); SEAM(pb + 4); }
            if (KON(8) && IN(pb + 5)) for (int rep = 0; rep < NREP(8); ++rep) {
                pg8::Gemm g{(const bf16_t*)(ws + WS_Q), W1 + (size_t)4096 * 1024, 1024, 1024, 1024}; pg8::TileOrder S; S.init(72, 8, G, bx);
                EpiZGate E{(const bf16_t*)(ws + WS_OF), (const float*)(ws + WS_RINV), (bf16_t*)(ws + WS_V)};
                pg8::gemm_phase(F.lds, F.wv, g, S, E);
                SEAM(pb + 5);
            }
            if (KON(9) && IN(pb + 6)) {
                pg8::Gemm g{(const bf16_t*)(ws + WS_V), W1 + (size_t)6144 * 1024, 2048, 2048, 2048}; pg8::TileOrder S; S.init(72, 4, G, bx);
                pg8::gemm_phase(F.lds, F.wv, g, S, ER);
                SEAM(pb + 6);
            }
        }
    }
    if (KON(10) && IN(33)) final_phase(F, args);
#undef IN
#undef SEAM
}

static bool phase_used(int p) {
    if (p == 0 || p == 33) return true;
    const int layer = (p - 1) / 8, k = (p - 1) % 8;
    return (layer & 1) == 0 ? (k <= 3) : (k <= 6);
}
extern "C" void kernel_launch(void* const* d_in, const int* in_sizes, int n_in, void* d_out, int out_size, void* d_ws, size_t ws_size, hipStream_t stream) {
    static int grid = 0;
    if (grid == 0) {
        if (n_in != 13 || out_size != NLAT * DM || ws_size < WS_END) { fprintf(stderr, "kernel_launch: unexpected problem (n_in %d, out %d, ws %zu)\n", n_in, out_size, ws_size); grid = -1; return; }
        int dev = 0, cus = 0;
        if (hipGetDevice(&dev) != hipSuccess || hipDeviceGetAttribute(&cus, hipDeviceAttributeMultiprocessorCount, dev) != hipSuccess) { grid = -1; return; }
        if (hipFuncSetAttribute((const void*)trunk_fwd, hipFuncAttributeMaxDynamicSharedMemorySize, LDS_BYTES) != hipSuccess) { fprintf(stderr, "kernel_launch: hipFuncSetAttribute failed\n"); grid = -1; return; }
        (void)hipGetLastError();
        grid = cus;
    }
    if (grid < 0) return;
    if (hipMemsetAsync((char*)d_ws + WS_CTL, 0, CTL_ZERO_BYTES, stream) != hipSuccess) return;
    Args a{};
    for (int i = 0; i < 13; ++i) a.in[i] = (const float*)d_in[i];
    a.out = (float*)d_out; a.ws = (unsigned char*)d_ws;
#if MK_PER_PHASE_LAUNCH
#ifndef DBG_MAXPH
#define DBG_MAXPH 99
#endif
    for (int p = 0; p < N_PHASES; ++p) { if (!phase_used(p)) continue; if (p > DBG_MAXPH && p != 33) continue; a.ph_lo = p; a.ph_hi = p + 1; hipLaunchKernelGGL(trunk_fwd, dim3(grid), dim3(512), LDS_BYTES, stream, a); }
#else
    a.ph_lo = 0; a.ph_hi = N_PHASES;
    hipLaunchKernelGGL(trunk_fwd, dim3(grid), dim3(512), LDS_BYTES, stream, a);
#endif
}
```

```cpp
#include <hip/hip_runtime.h>
#include <cstdio>
#include <cstdint>

#ifndef MK_PER_PHASE_LAUNCH
#define MK_PER_PHASE_LAUNCH 0
#endif

#define LAS __attribute__((address_space(3)))
#define GAS __attribute__((address_space(1)))
typedef unsigned short bf16_t;
typedef short bf16x8 __attribute__((ext_vector_type(8)));
typedef float f32x4 __attribute__((ext_vector_type(4)));
typedef float f32x16 __attribute__((ext_vector_type(16)));
typedef unsigned u32x4 __attribute__((ext_vector_type(4)));
typedef unsigned u32x2 __attribute__((ext_vector_type(2)));

constexpr int DM = 1024, NB = 8, SEQ = 2048, CTXL = 256, DBR = 2048, NLAYER = 4;
constexpr int NLAT = NB * SEQ, NCTX = NB * CTXL, NTOK = NLAT + NCTX;
constexpr float EPS = 1e-6f;

constexpr size_t MiB = 1u << 20;
constexpr size_t KiB = 1024;
constexpr size_t WS_CTL = 0, CTL_ZERO_BYTES = 64 * KiB;
constexpr size_t WS_ADA = 256 * KiB;
constexpr size_t WS_TC = 768 * KiB;
constexpr size_t WS_ROPE = 1024 * KiB;
constexpr size_t WS_CS256 = 1088 * KiB;
constexpr size_t WS_RINV = 1344 * KiB;
constexpr size_t WS_XCTX = 2 * MiB;
constexpr size_t WS_W = 10 * MiB;
constexpr size_t WS_R = 26 * MiB;
constexpr size_t WS_H = WS_R;
constexpr size_t WS_Z = WS_R + 36 * MiB;
constexpr size_t WS_UTL = WS_R + 108 * MiB;
constexpr size_t WS_UTC = WS_R + 172 * MiB;
constexpr size_t WS_CS = WS_R + 180 * MiB;
constexpr size_t WS_Q = WS_R;
constexpr size_t WS_K = WS_R + 36 * MiB;
constexpr size_t WS_V = WS_R + 72 * MiB;
constexpr size_t WS_OF = WS_R + 144 * MiB;
constexpr size_t WS_SSP = WS_R + 216 * MiB;
constexpr size_t WS_SA = WS_W;
constexpr size_t WS_SB = WS_R + 219 * MiB;
constexpr size_t WS_END = 256 * MiB;
static_assert(WS_SSP + (size_t)NTOK * 32 * 4 <= WS_SB && WS_SB + 10 * MiB <= WS_END && WS_CS + 16 * MiB <= WS_END && WS_RINV + 288 * KiB <= WS_XCTX, "ws map");

constexpr int LDS_BYTES = 147456;
constexpr int RING_BYTES = 131072;
constexpr int SC_V_OFF = 0;
constexpr int SC_RT_OFF = 16384;
constexpr int SC_K_OFF = 16384 + 33792;
constexpr int MISC_OFF = 145408;
static_assert(SC_K_OFF + 65536 <= MISC_OFF && MISC_OFF + 512 <= LDS_BYTES, "lds map");

__device__ __forceinline__ unsigned f2bf(float f) { unsigned u = __builtin_bit_cast(unsigned, f); return (u + 0x7fffu + ((u >> 16) & 1u)) >> 16; }
__device__ __forceinline__ unsigned pk2(float lo, float hi) { return f2bf(lo) | (f2bf(hi) << 16); }
__device__ __forceinline__ float bflo(unsigned w) { return __builtin_bit_cast(float, w << 16); }
__device__ __forceinline__ float bfhi(unsigned w) { return __builtin_bit_cast(float, w & 0xffff0000u); }
__device__ __forceinline__ float bf1(bf16_t h) { return __builtin_bit_cast(float, (unsigned)h << 16); }
__device__ __forceinline__ float silu_f(float x) { return x * __builtin_amdgcn_rcpf(1.f + __expf(-x)); }
__device__ __forceinline__ float shx(float v, int o, int lane) { return __builtin_bit_cast(float, __builtin_amdgcn_ds_bpermute((lane ^ o) << 2, __builtin_bit_cast(int, v))); }
__device__ __forceinline__ float wave_sum(float v, int lane) {
#pragma unroll
    for (int o = 1; o < 64; o <<= 1) v += shx(v, o, lane);
    return v;
}

namespace pg8 {
constexpr int BM = 256, BK = 64, HALF = 128, HTB = HALF * BK * 2, STAGE_BYTES = 8 * HTB, NXCD = 8, WGM = 8;
__host__ __device__ __forceinline__ int lds_byte(int r, int c) { const int st = (r >> 4) * 2 + (c >> 5), rr = r & 15, cc = c & 31, ob = rr * 64 + cc * 2; return st * 1024 + (ob ^ (((ob >> 9) & 1) << 5)); }
__host__ __device__ __forceinline__ void stage_rc(int b, int& R, int& C) { const int st = b / 1024, sb = b % 1024, swz = sb ^ (((sb >> 9) & 1) << 5); R = (st >> 1) * 16 + swz / 64; C = (st & 1) * 32 + (swz % 64) / 2; }
__host__ __device__ __forceinline__ int perm32(int rho) { const int n = rho >> 4, i = rho & 15; return 8 * (i >> 2) + 4 * n + (i & 3); }
struct Unit { int pm, pn; };
struct Gemm { const bf16_t* A; const bf16_t* Bt; int lda, ldb, K; };
struct TileOrder {
    int nM, nN, nwg, G, c;
    __device__ void init(int nM_, int nN_, int G_, int c_) { nM = nM_; nN = nN_; nwg = nM * nN; G = G_; c = c_; }
    __device__ bool next(int i, Unit& u) const {
        const long L = (long)i * G + c; if (L >= nwg) return false;
        int wgid = (int)L; { const int q = nwg / NXCD, r = nwg % NXCD, xcd = wgid % NXCD, off = wgid / NXCD; wgid = (xcd < r ? xcd * (q + 1) : r * (q + 1) + (xcd - r) * q) + off; }
        const int nig = WGM * nN, gid = wgid / nig, fm = gid * WGM, gsz = (nM - fm) < WGM ? (nM - fm) : WGM;
        u.pm = fm + ((wgid % nig) % gsz); u.pn = (wgid % nig) / gsz; return true;
    }
};
__device__ __forceinline__ unsigned cvt_pk_bf16(float lo, float hi) { unsigned r; asm volatile("v_cvt_pk_bf16_f32 %0, %1, %2" : "=v"(r) : "v"(lo), "v"(hi)); return r; }

template <class Epi, class Sched, bool ALIGN_EPI = true, bool SP2 = true>
__device__ __forceinline__ void gemm_phase(LAS unsigned char* lds, int wv, const Gemm g, const Sched& S, const Epi& E) {
    int tid; { int l_; asm volatile("v_mbcnt_lo_u32_b32 %0, -1, 0\n\tv_mbcnt_hi_u32_b32 %0, -1, %0" : "=v"(l_)); tid = wv * 64 + l_; }
    const int wid = __builtin_amdgcn_readfirstlane(tid >> 6), lane = tid & 63, wr = wid >> 2, wc = wid & 3, fr = lane & 15, fq = lane >> 4;
    const int K = g.K, nt = K / BK;
    unsigned voffA[2], voffB[2];
#pragma unroll
    for (int i = 0; i < 2; ++i) { int R, C; stage_rc(tid * 16 + i * 8192, R, C); const int Rb = Epi::PERM ? ((R & ~31) + perm32(R & 31)) : R;
        voffA[i] = (unsigned)(R * g.lda + C) * 2u; voffB[i] = (unsigned)(Rb * g.ldb + C) * 2u; }
    const size_t kstep = (size_t)(BK * 2);
    const size_t hstepA = (size_t)HALF * g.lda * 2, hstepB = (size_t)HALF * g.ldb * 2;
    const size_t tstepA = 2 * hstepA, tstepB = 2 * hstepB;
    const unsigned ldsw = (unsigned)wid * 1024u;
    const int aoff = lds_byte(wr * 64 + fr, fq * 8), boff = lds_byte(wc * 32 + fr, fq * 8);
#define PG8_SA(b, h) (((b) * 2 + (h)) * HTB)
#define PG8_SB(b, h) ((4 + (b) * 2 + (h)) * HTB)
#define PG8_STAGE(bufoff, gbase, voff) do { _Pragma("unroll") for (int _i = 0; _i < 2; ++_i) \
        __builtin_amdgcn_global_load_lds((const unsigned*)((const char*)(gbase) + (voff)[_i]), (LAS unsigned*)(lds + (bufoff) + ldsw + _i * 8192), 16, 0, 0); } while (0)
#define PG8_LDA(dst, b, h) do { _Pragma("unroll") for (int m = 0; m < 4; ++m) _Pragma("unroll") for (int k = 0; k < 2; ++k) dst[m][k] = *(const LAS bf16x8*)(lds + PG8_SA(b, h) + aoff + m * 2048 + k * 1024); } while (0)
#define PG8_LDB(dst, b, h) do { _Pragma("unroll") for (int n = 0; n < 2; ++n) _Pragma("unroll") for (int k = 0; k < 2; ++k) dst[n][k] = *(const LAS bf16x8*)(lds + PG8_SB(b, h) + boff + n * 2048 + k * 1024); } while (0)
#define PG8_MMA(ai, bj, At, Bt) do { __builtin_amdgcn_s_setprio(1); _Pragma("unroll") for (int m = 0; m < 4; ++m) _Pragma("unroll") for (int n = 0; n < 2; ++n) _Pragma("unroll") for (int k = 0; k < 2; ++k) \
        acc[ai][bj][m][n] = __builtin_amdgcn_mfma_f32_16x16x32_bf16(Bt[n][k], At[m][k], acc[ai][bj][m][n], 0, 0, 0); __builtin_amdgcn_s_setprio(0); } while (0)
#define PG8_WAIT_V(n) asm volatile("s_waitcnt vmcnt(" #n ")" ::: "memory")
#define PG8_WAIT_L(n) asm volatile("s_waitcnt lgkmcnt(" #n ")" ::: "memory")
#define PG8_BAR __builtin_amdgcn_s_barrier()
#define PG8_SCHED __builtin_amdgcn_sched_barrier(0)
    Unit cur, nxt; int ui = 0;
    if (!S.next(0, cur)) return;
    f32x4 acc[2][2][4][2];
#pragma unroll
    for (int a = 0; a < 2; ++a)
#pragma unroll
        for (int b = 0; b < 2; ++b)
#pragma unroll
            for (int m = 0; m < 4; ++m)
#pragma unroll
                for (int n = 0; n < 2; ++n) acc[a][b][m][n] = (f32x4){0.f, 0.f, 0.f, 0.f};
    bf16x8 At[4][2], B0[2][2], B1[2][2];
    const char* cA = (const char*)g.A + (size_t)cur.pm * tstepA; const char* cB = (const char*)g.Bt + (size_t)cur.pn * tstepB;
    if constexpr (SP2) {
        PG8_STAGE(PG8_SB(0, 0), cB, voffB); PG8_STAGE(PG8_SB(0, 1), cB + hstepB, voffB); PG8_STAGE(PG8_SA(0, 0), cA, voffA); PG8_STAGE(PG8_SA(0, 1), cA + hstepA, voffA);
        if (wr == 1) PG8_BAR;
        PG8_WAIT_V(2); PG8_BAR;
        PG8_STAGE(PG8_SB(1, 0), cB + kstep, voffB); PG8_STAGE(PG8_SA(1, 0), cA + kstep, voffA); PG8_STAGE(PG8_SB(1, 1), cB + hstepB + kstep, voffB);
        PG8_WAIT_V(6); PG8_BAR;
    } else {
        PG8_STAGE(PG8_SB(0, 0), cB, voffB); PG8_STAGE(PG8_SA(0, 0), cA, voffA); PG8_STAGE(PG8_SB(0, 1), cB + hstepB, voffB); PG8_STAGE(PG8_SA(0, 1), cA + hstepA, voffA);
        if (wr == 1) PG8_BAR;
        PG8_WAIT_V(4); PG8_BAR;
        PG8_STAGE(PG8_SB(1, 0), cB + kstep, voffB); PG8_STAGE(PG8_SA(1, 0), cA + kstep, voffA); PG8_STAGE(PG8_SB(1, 1), cB + hstepB + kstep, voffB);
        PG8_WAIT_V(6); PG8_BAR;
    }
    for (;;) {
        const bool has_next = S.next(ui + 1, nxt);
        const char* nA = has_next ? (const char*)g.A + (size_t)nxt.pm * tstepA : cA; const char* nB = has_next ? (const char*)g.Bt + (size_t)nxt.pn * tstepB : cB;
        for (int t = 0; t < nt; t += 2) {
            const bool last = (t == nt - 2);
            const char* a1 = cA + (size_t)(t + 1) * kstep;
            const char* a2 = last ? nA : cA + (size_t)(t + 2) * kstep; const char* b2 = last ? nB : cB + (size_t)(t + 2) * kstep;
            const char* a3 = a2 + kstep; const char* b3 = b2 + kstep;
            if constexpr (SP2) {
            PG8_LDB(B0, 0, 0); PG8_LDB(B1, 0, 1); PG8_SCHED; PG8_LDA(At, 0, 0); PG8_STAGE(PG8_SA(1, 1), a1 + hstepA, voffA);
            PG8_WAIT_V(8); PG8_WAIT_L(0); PG8_BAR; PG8_MMA(0, 0, At, B0); PG8_MMA(0, 1, At, B1); PG8_BAR; PG8_SCHED;
            PG8_LDA(At, 0, 1); PG8_STAGE(PG8_SB(0, 0), b2, voffB); PG8_STAGE(PG8_SB(0, 1), b2 + hstepB, voffB); PG8_STAGE(PG8_SA(0, 0), a2, voffA);
            PG8_WAIT_V(8); PG8_WAIT_L(0); PG8_BAR; PG8_MMA(1, 0, At, B0); PG8_MMA(1, 1, At, B1); PG8_BAR; PG8_SCHED;
            PG8_LDB(B0, 1, 0); PG8_LDB(B1, 1, 1); PG8_SCHED; PG8_LDA(At, 1, 0); PG8_STAGE(PG8_SA(0, 1), a2 + hstepA, voffA);
            PG8_WAIT_V(8); PG8_WAIT_L(0); PG8_BAR; PG8_MMA(0, 0, At, B0); PG8_MMA(0, 1, At, B1); PG8_BAR; PG8_SCHED;
            PG8_LDA(At, 1, 1); PG8_STAGE(PG8_SB(1, 0), b3, voffB); PG8_STAGE(PG8_SB(1, 1), b3 + hstepB, voffB); PG8_STAGE(PG8_SA(1, 0), a3, voffA);
            PG8_WAIT_V(8); PG8_WAIT_L(0); PG8_BAR; PG8_MMA(1, 0, At, B0); PG8_MMA(1, 1, At, B1); PG8_BAR; PG8_SCHED;
            } else {
            PG8_LDB(B0, 0, 0); PG8_SCHED; PG8_LDA(At, 0, 0); PG8_STAGE(PG8_SA(1, 1), a1 + hstepA, voffA);
            PG8_WAIT_L(8); PG8_BAR; PG8_WAIT_L(0); PG8_MMA(0, 0, At, B0); PG8_BAR; PG8_SCHED;
            PG8_LDB(B1, 0, 1); PG8_STAGE(PG8_SB(0, 0), b2, voffB);
            PG8_BAR; PG8_WAIT_L(0); PG8_MMA(0, 1, At, B1); PG8_BAR;
            PG8_LDA(At, 0, 1); PG8_STAGE(PG8_SA(0, 0), a2, voffA);
            PG8_BAR; PG8_WAIT_L(0); PG8_MMA(1, 0, At, B0); PG8_BAR; PG8_SCHED;
            PG8_STAGE(PG8_SB(0, 1), b2 + hstepB, voffB);
            PG8_WAIT_V(6); PG8_BAR; PG8_MMA(1, 1, At, B1); PG8_BAR;
            PG8_LDB(B0, 1, 0); PG8_SCHED; PG8_LDA(At, 1, 0); PG8_STAGE(PG8_SA(0, 1), a2 + hstepA, voffA);
            PG8_WAIT_L(8); PG8_BAR; PG8_WAIT_L(0); PG8_MMA(0, 0, At, B0); PG8_BAR; PG8_SCHED;
            PG8_LDB(B1, 1, 1); PG8_STAGE(PG8_SB(1, 0), b3, voffB);
            PG8_BAR; PG8_WAIT_L(0); PG8_MMA(0, 1, At, B1); PG8_BAR;
            PG8_LDA(At, 1, 1); PG8_STAGE(PG8_SA(1, 0), a3, voffA);
            PG8_BAR; PG8_WAIT_L(0); PG8_MMA(1, 0, At, B0); PG8_BAR; PG8_SCHED;
            PG8_STAGE(PG8_SB(1, 1), b3 + hstepB, voffB);
            PG8_WAIT_V(6); PG8_BAR; PG8_MMA(1, 1, At, B1); PG8_BAR;
            }
        }
        if constexpr (ALIGN_EPI) { if (wr == 0) PG8_BAR; }
        E(acc, cur, wr, wc, fr, fq);
        if (!has_next) break;
#pragma unroll
        for (int a = 0; a < 2; ++a)
#pragma unroll
            for (int b = 0; b < 2; ++b)
#pragma unroll
                for (int m = 0; m < 4; ++m)
#pragma unroll
                    for (int n = 0; n < 2; ++n) acc[a][b][m][n] = (f32x4){0.f, 0.f, 0.f, 0.f};
        cur = nxt; cA = nA; cB = nB; ++ui;
        if constexpr (ALIGN_EPI) { if (wr == 1) PG8_BAR; }
    }
    PG8_WAIT_V(0);
    if constexpr (!ALIGN_EPI) { if (wr == 0) PG8_BAR; }
    PG8_BAR;
#undef PG8_SA
#undef PG8_SB
#undef PG8_STAGE
#undef PG8_LDA
#undef PG8_LDB
#undef PG8_MMA
#undef PG8_WAIT_V
#undef PG8_WAIT_L
#undef PG8_BAR
#undef PG8_SCHED
}
}
using pg8::cvt_pk_bf16;
typedef const f32x4 (&AccRef)[2][2][4][2];

struct EpiSilu {
    static constexpr bool PERM = true;
    bf16_t* O; int ldc;
    __device__ __forceinline__ void operator()(AccRef acc, const pg8::Unit& u, int wr, int wc, int fr, int fq) const {
        const int row0 = u.pm * 256 + wr * 64 + fr, col0 = u.pn * 256 + wc * 32 + 8 * fq;
#pragma unroll
        for (int ai = 0; ai < 2; ++ai)
#pragma unroll
            for (int m = 0; m < 4; ++m) { bf16_t* rowp = O + (size_t)(row0 + ai * 128 + m * 16) * ldc + col0;
#pragma unroll
                for (int bj = 0; bj < 2; ++bj) { const f32x4 v0 = acc[ai][bj][m][0], v1 = acc[ai][bj][m][1]; u32x4 w;
                    w.x = cvt_pk_bf16(silu_f(v0[0]), silu_f(v0[1])); w.y = cvt_pk_bf16(silu_f(v0[2]), silu_f(v0[3]));
                    w.z = cvt_pk_bf16(silu_f(v1[0]), silu_f(v1[1])); w.w = cvt_pk_bf16(silu_f(v1[2]), silu_f(v1[3]));
                    *(u32x4*)(rowp + bj * 128) = w; } }
    }
};
struct EpiUT {
    static constexpr bool PERM = true;
    bf16_t* UTl; bf16_t* UTc;
    __device__ __forceinline__ void operator()(AccRef acc, const pg8::Unit& u, int wr, int wc, int fr, int fq) const {
        const int feat0 = u.pm * 256 + wr * 64 + fr; bf16_t* base; int L;
        if (u.pn < 64) { const int b = u.pn >> 3, l0 = (u.pn & 7) * 256; base = UTl + (size_t)b * 2048 * 2048 + l0; L = 2048; }
        else { const int b = u.pn - 64; base = UTc + (size_t)b * 2048 * 256; L = 256; }
        const int col0 = wc * 32 + 8 * fq;
#pragma unroll
        for (int ai = 0; ai < 2; ++ai)
#pragma unroll
            for (int m = 0; m < 4; ++m) { bf16_t* rowp = base + (size_t)(feat0 + ai * 128 + m * 16) * L + col0;
#pragma unroll
                for (int bj = 0; bj < 2; ++bj) { const f32x4 v0 = acc[ai][bj][m][0], v1 = acc[ai][bj][m][1]; u32x4 w;
                    w.x = cvt_pk_bf16(v0[0], v0[1]); w.y = cvt_pk_bf16(v0[2], v0[3]); w.z = cvt_pk_bf16(v1[0], v1[1]); w.w = cvt_pk_bf16(v1[2], v1[3]);
                    *(u32x4*)(rowp + bj * 128) = w; } }
    }
};
__device__ __forceinline__ void dft_row_out(bf16_t* zrow, int mi0, const float (&d)[8], const float (&mr)[8]) {
    const u32x4 zd = *(const u32x4*)(zrow + mi0); const u32x4 zm = *(const u32x4*)(zrow + 248 - mi0);
    u32x4 o; o.x = cvt_pk_bf16(d[0] * bflo(zd.x), d[1] * bfhi(zd.x)); o.y = cvt_pk_bf16(d[2] * bflo(zd.y), d[3] * bfhi(zd.y));
    o.z = cvt_pk_bf16(d[4] * bflo(zd.z), d[5] * bfhi(zd.z)); o.w = cvt_pk_bf16(d[6] * bflo(zd.w), d[7] * bfhi(zd.w));
    *(u32x4*)(zrow + mi0) = o;
    bf16_t* mp = zrow + 248 - mi0;
    mp[1] = (bf16_t)f2bf(mr[7] * bfhi(zm.x));
    *(unsigned*)(mp + 2) = cvt_pk_bf16(mr[6] * bflo(zm.y), mr[5] * bfhi(zm.y));
    u32x2 w; w.x = cvt_pk_bf16(mr[4] * bflo(zm.z), mr[3] * bfhi(zm.z)); w.y = cvt_pk_bf16(mr[2] * bflo(zm.w), mr[1] * bfhi(zm.w));
    *(u32x2*)(mp + 4) = w;
    if (mi0 >= 8) mp[8] = (bf16_t)f2bf(mr[0] * bf1(mp[8]));
}
template <bool FOLD> struct EpiDft {
    static constexpr bool PERM = true;
    bf16_t* Z; int L; int tok_base; const float* AH;
    __device__ __forceinline__ void operator()(AccRef acc, const pg8::Unit& u, int wr, int wc, int fr, int fq) const {
        const int b = u.pn >> 3, g = u.pn & 7, k0 = u.pm * 128 + wr * 64 + fr, mi0 = wc * 32 + 8 * fq;
        f32x4 ah[2] = {(f32x4){0.f, 0.f, 0.f, 0.f}, (f32x4){0.f, 0.f, 0.f, 0.f}}; float ahn = 0.f;
        if (FOLD) { const float* ap = AH + (size_t)b * 2048 + g * 256; ah[0] = *(const f32x4*)(ap + mi0) * 0.022097087f; ah[1] = *(const f32x4*)(ap + mi0 + 4) * 0.022097087f; ahn = ap[128] * 0.022097087f; }
#pragma unroll
        for (int m = 0; m < 4; ++m) {
            const int k = k0 + 16 * m; bf16_t* zrow = Z + (size_t)(tok_base + b * L + k) * 2048 + g * 256;
            bf16_t* zmir = Z + (size_t)(tok_base + b * L + (L - k)) * 2048 + g * 256;
            const float sg = (k & 1) ? -1.f : 1.f;
            float dm[8], sm[8];
#pragma unroll
            for (int n = 0; n < 2; ++n) { f32x4 P = acc[0][0][m][n]; const f32x4 Q = acc[1][1][m][n]; if (FOLD) P = P + ah[n] * sg;
#pragma unroll
                for (int e = 0; e < 4; ++e) { dm[4 * n + e] = P[e] - Q[e]; sm[4 * n + e] = P[e] + Q[e]; }
                if (n == 0 && mi0 == 0) { dm[0] = P[0]; sm[0] = P[0]; } }
            dft_row_out(zrow, mi0, dm, sm);
            if (FOLD && k >= 1) dft_row_out(zmir, mi0, sm, dm);
            if (wc == 0 && fq == 0) { const float yn = acc[0][1][m][0][0] + (FOLD ? ahn * sg : 0.f);
                zrow[128] = (bf16_t)f2bf(yn * bf1(zrow[128]));
                if (FOLD && k >= 1) zmir[128] = (bf16_t)f2bf(yn * bf1(zmir[128])); }
            asm volatile("" ::: "memory");
        }
    }
};
struct EpiResid {
    static constexpr bool PERM = false;
    const float* xin_lat; const float* xin_ctx; float* xout_lat; float* xout_ctx; const float* gate;
    __device__ __forceinline__ void operator()(AccRef acc, const pg8::Unit& u, int wr, int wc, int fr, int fq) const {
        const int row0 = u.pm * 256 + wr * 64 + fr, col0 = u.pn * 256 + wc * 32 + 4 * fq;
        const bool lat = u.pm < 64; const int r = lat ? (u.pm >> 3) : 8;
        const float* xi = lat ? xin_lat : xin_ctx - (size_t)NLAT * DM; float* xo = lat ? xout_lat : xout_ctx - (size_t)NLAT * DM;
        const float* gp = gate + r * 3072 + col0;
        f32x4 gv[2][2];
#pragma unroll
        for (int bj = 0; bj < 2; ++bj)
#pragma unroll
            for (int n = 0; n < 2; ++n) gv[bj][n] = *(const f32x4*)(gp + bj * 128 + n * 16);
#pragma unroll
        for (int ai = 0; ai < 2; ++ai)
#pragma unroll
            for (int m = 0; m < 4; ++m) { const size_t off = (size_t)(row0 + ai * 128 + m * 16) * DM + col0;
#pragma unroll
                for (int bj = 0; bj < 2; ++bj)
#pragma unroll
                    for (int n = 0; n < 2; ++n) { const f32x4 xv = *(const f32x4*)(xi + off + bj * 128 + n * 16);
                        *(f32x4*)(xo + off + bj * 128 + n * 16) = xv + gv[bj][n] * acc[ai][bj][m][n]; }
                asm volatile("" ::: "memory"); }
    }
};
struct EpiQKV {
    static constexpr bool PERM = true;
    bf16_t* Q; bf16_t* K; bf16_t* V; const float* rcos; const float* rsin;
    __device__ __forceinline__ void operator()(AccRef acc, const pg8::Unit& u, int wr, int wc, int fr, int fq) const {
        const int row0 = u.pm * 256 + wr * 64 + fr, c0 = wc * 32 + 8 * fq;
        if (u.pn >= 8) {
#pragma unroll
            for (int ai = 0; ai < 2; ++ai)
#pragma unroll
                for (int m = 0; m < 4; ++m) { bf16_t* rowp = V + (size_t)(row0 + ai * 128 + m * 16) * 2048 + (u.pn - 8) * 256 + c0;
#pragma unroll
                    for (int bj = 0; bj < 2; ++bj) { const f32x4 v0 = acc[ai][bj][m][0], v1 = acc[ai][bj][m][1]; u32x4 w;
                        w.x = cvt_pk_bf16(v0[0], v0[1]); w.y = cvt_pk_bf16(v0[2], v0[3]); w.z = cvt_pk_bf16(v1[0], v1[1]); w.w = cvt_pk_bf16(v1[2], v1[3]);
                        *(u32x4*)(rowp + bj * 128) = w; } }
            return;
        }
        const bool isk = u.pn >= 4, lat = u.pm < 64; const int h = u.pn & 3; bf16_t* dst = isk ? K : Q; const float sc = isk ? 0.0625f : 1.0f;
        const int i0 = 16 * wc + 4 * fq;
#pragma unroll
        for (int ai = 0; ai < 2; ++ai)
#pragma unroll
            for (int m = 0; m < 4; ++m) { const int row = row0 + ai * 128 + m * 16, l = row & 2047; bf16_t* rowp = dst + (size_t)row * 1024 + h * 256 + c0;
#pragma unroll
                for (int bj = 0; bj < 2; ++bj) { f32x4 x1 = acc[ai][bj][m][0], x2 = acc[ai][bj][m][1];
                    if (lat) { const int pos = bj == 0 ? (l >> 6) : (l & 63); const f32x4 cv = *(const f32x4*)(rcos + pos * 64 + i0), sv = *(const f32x4*)(rsin + pos * 64 + i0);
                        const f32x4 o1 = x1 * cv - x2 * sv, o2 = x1 * sv + x2 * cv; x1 = o1; x2 = o2; }
                    x1 = x1 * sc; x2 = x2 * sc; u32x4 w;
                    w.x = cvt_pk_bf16(x1[0], x1[1]); w.y = cvt_pk_bf16(x1[2], x1[3]); w.z = cvt_pk_bf16(x2[0], x2[1]); w.w = cvt_pk_bf16(x2[2], x2[3]);
                    *(u32x4*)(rowp + bj * 128) = w; } }
    }
};
struct EpiZGate {
    static constexpr bool PERM = true;
    const bf16_t* O; const float* rinv; bf16_t* AO;
    __device__ __forceinline__ void operator()(AccRef acc, const pg8::Unit& u, int wr, int wc, int fr, int fq) const {
        const int row0 = u.pm * 256 + wr * 64 + fr, col0 = u.pn * 256 + wc * 32 + 8 * fq, head = u.pn >> 1;
#pragma unroll
        for (int ai = 0; ai < 2; ++ai)
#pragma unroll
            for (int m = 0; m < 4; ++m) { const int row = row0 + ai * 128 + m * 16; const float rv = rinv[row * 4 + head];
#pragma unroll
                for (int bj = 0; bj < 2; ++bj) { const size_t off = (size_t)row * 2048 + col0 + bj * 128; const u32x4 o = *(const u32x4*)(O + off);
                    const f32x4 v0 = acc[ai][bj][m][0], v1 = acc[ai][bj][m][1]; u32x4 w;
                    w.x = cvt_pk_bf16(bflo(o.x) * rv * silu_f(v0[0]), bfhi(o.x) * rv * silu_f(v0[1])); w.y = cvt_pk_bf16(bflo(o.y) * rv * silu_f(v0[2]), bfhi(o.y) * rv * silu_f(v0[3]));
                    w.z = cvt_pk_bf16(bflo(o.z) * rv * silu_f(v1[0]), bfhi(o.z) * rv * silu_f(v1[1])); w.w = cvt_pk_bf16(bflo(o.w) * rv * silu_f(v1[2]), bfhi(o.w) * rv * silu_f(v1[3]));
                    *(u32x4*)(AO + off) = w; } }
    }
};

#define XB_TMO      128
#define XB_XCNT(j)  (256  + 64 * (j))
#define XB_XSUB(j)  (1280 + 64 * (j))
#define XB_XGEN(j)  (2304 + 64 * (j))
#define XB_TOP      3328
#define XB_TOPGEN   3392
#define XCD_BAR_WORDS 3456
#define XB_SPIN_CAP (1u << 18)
__device__ __forceinline__ unsigned xb_ld(unsigned* p)              { return __hip_atomic_load(p, __ATOMIC_RELAXED, __HIP_MEMORY_SCOPE_AGENT); }
__device__ __forceinline__ unsigned xb_add(unsigned* p, unsigned v) { return __hip_atomic_fetch_add(p, v, __ATOMIC_RELAXED, __HIP_MEMORY_SCOPE_AGENT); }
__device__ __forceinline__ unsigned xb_xcc_id() { return (unsigned)__builtin_amdgcn_s_getreg((3 << 11) | 20) & 0xFu; }
#define XB_SPIN(cond, bar) do { unsigned _sp = 0; while (cond) { __builtin_amdgcn_s_sleep(1); \
    if ((++_sp & 255u) == 0u) { if (xb_ld(&(bar)[XB_TMO])) break; if (_sp > XB_SPIN_CAP) { atomicAdd(&(bar)[XB_TMO], 1u); break; } } } } while (0)
struct XcdBarrier { unsigned* bar; unsigned x; volatile LAS unsigned* st; };
__device__ __forceinline__ XcdBarrier xcd_barrier_post(unsigned* bar, volatile LAS unsigned* st) {
    XcdBarrier b; b.bar = bar; b.x = xb_xcc_id(); b.st = st;
    if (threadIdx.x == 0) (void)xb_add(&bar[XB_XCNT(b.x)], 1u);
    return b;
}
__device__ __forceinline__ void xcd_barrier_complete(unsigned* bar, unsigned x, unsigned& nloc, unsigned& nx) {
    const unsigned G = gridDim.x * gridDim.y * gridDim.z;
    unsigned sum, cnt, mine, sp = 0u;
    for (;;) {
        sum = 0u; cnt = 0u; mine = 0u;
#pragma unroll
        for (unsigned j = 0; j < 16; ++j) { const unsigned c = xb_ld(&bar[XB_XCNT(j)]); sum += c; cnt += (c > 0u) ? 1u : 0u; mine = (j == x) ? c : mine; }
        if (sum == G) break;
        __builtin_amdgcn_s_sleep(1);
        if ((++sp & 255u) == 0u) { if (xb_ld(&bar[XB_TMO])) break; if (sp > XB_SPIN_CAP) { atomicAdd(&bar[XB_TMO], 1u); break; } }
    }
    nloc = mine > 0u ? mine : 1u; nx = cnt > 0u ? cnt : 1u;
}
__device__ __forceinline__ void xcd_barrier(const XcdBarrier& b) {
    asm volatile("s_waitcnt vmcnt(0)" ::: "memory");
    __syncthreads();
    if (threadIdx.x == 0) {
        unsigned* bar = b.bar;
        __builtin_amdgcn_s_waitcnt(0);
        unsigned nloc = b.st[0], nx = b.st[1];
        if (nloc == 0u) { xcd_barrier_complete(bar, b.x, nloc, nx); b.st[0] = nloc; b.st[1] = nx; }
        const unsigned old = xb_add(&bar[XB_XSUB(b.x)], 1u);
        const unsigned gen = old / nloc;
        if (old + 1u == (gen + 1u) * nloc) {
            __builtin_amdgcn_fence(__ATOMIC_RELEASE, "agent");
            asm volatile("s_waitcnt vmcnt(0)" ::: "memory");
            const unsigned og = xb_add(&bar[XB_TOP], 1u);
            const unsigned tg = og / nx;
            if (og + 1u == (tg + 1u) * nx) xb_add(&bar[XB_TOPGEN], 1u);
            else XB_SPIN(xb_ld(&bar[XB_TOPGEN]) == tg, bar);
            __builtin_amdgcn_fence(__ATOMIC_ACQUIRE, "agent");
            xb_add(&bar[XB_XGEN(b.x)], 1u);
            asm volatile("s_waitcnt vmcnt(0)" ::: "memory");
        } else {
            XB_SPIN(xb_ld(&bar[XB_XGEN(b.x)]) == gen, bar);
            __builtin_amdgcn_fence(__ATOMIC_ACQUIRE, "agent");
            asm volatile("s_waitcnt vmcnt(0)" ::: "memory");
        }
    }
    __syncthreads();
}

struct Args { const float* in[13]; float* out; unsigned char* ws; int ph_lo, ph_hi, pad0, pad1; };
struct Frame {
    LAS unsigned char* lds;
    int vcu, G, wv;
    unsigned char* ws;
};
__device__ __forceinline__ int lane_id() { int l; asm volatile("v_mbcnt_lo_u32_b32 %0, -1, 0\n\tv_mbcnt_hi_u32_b32 %0, -1, %0" : "=v"(l)); return l; }
__device__ __forceinline__ unsigned char* launder_ptr(unsigned char* p) {
    unsigned lo = (unsigned)(unsigned long long)p, hi = (unsigned)((unsigned long long)p >> 32);
    asm volatile("" : "+s"(lo), "+s"(hi));
    return (unsigned char*)(((unsigned long long)hi << 32) | lo);
}
#define PHASE_IDS() int tid = F.wv * 64 + lane_id(); asm volatile("" : "+v"(tid)); const int lane = tid & 63, wave = __builtin_amdgcn_readfirstlane(tid >> 6); (void)lane; (void)wave; \
    unsigned char* ws = launder_ptr(F.ws); (void)ws
#define LDS_WAIT() asm volatile("s_waitcnt lgkmcnt(0)" ::: "memory")

__device__ __forceinline__ int qk_pos(int d) { const int half = d >> 7, n = (d >> 6) & 1, i = d & 63; return 128 * half + 8 * (i >> 2) + 4 * n + (i & 3); }
template <int MODE>
__device__ __forceinline__ void transpose_item(const float* W, int K, int N, int n_begin, bf16_t* WT, LAS float* scr, int item, int nblk, int lane) {
    const int kb = item / nblk, nb = item % nblk, k0 = 64 * kb, n0 = n_begin + 32 * nb;
#pragma unroll 8
    for (int i = 0; i < 32; ++i) { const int kk = 2 * i + (lane >> 5); scr[kk * 33 + (lane & 31)] = W[(size_t)(k0 + kk) * N + n0 + (lane & 31)]; }
    LDS_WAIT(); asm volatile("" ::: "memory");
    const int c = lane & 7;
#pragma unroll
    for (int j = 0; j < 4; ++j) { const int n = (lane >> 3) + 8 * j; const LAS float* s = scr + (8 * c) * 33 + n;
        u32x4 o; o.x = pk2(s[0 * 33], s[1 * 33]); o.y = pk2(s[2 * 33], s[3 * 33]); o.z = pk2(s[4 * 33], s[5 * 33]); o.w = pk2(s[6 * 33], s[7 * 33]);
        int nn = n0 + n - n_begin;
        if (MODE == 1) { const int na = n0 + n; nn = (na < 2048) ? ((na & ~255) + qk_pos(na & 255)) : na; }
        *(u32x4*)(WT + (size_t)nn * K + k0 + 8 * c) = o; }
    LDS_WAIT(); asm volatile("" ::: "memory");
}
__device__ __forceinline__ void fold_task(const float* Win  , const float* TC, bf16_t* WfT, int t, int lane) {
    const int g = t >> 8, p0 = ((t >> 5) & 7) * 32, kk0 = (t & 31) * 32, s = lane >> 5, li = lane & 31;
    f32x16 acc;
#pragma unroll
    for (int i = 0; i < 16; ++i) acc[i] = 0.f;
    const float* wrow = Win + (size_t)(kk0 + li) * 4096 + g * 256 + 4 * s;
    const float* tcol = TC + p0 + li;
#pragma unroll 4
    for (int tp = 0; tp < 32; ++tp) {
        const f32x4 wv = *(const f32x4*)(wrow + 8 * tp);
#pragma unroll
        for (int uu = 0; uu < 4; ++uu) { const float a = tcol[(8 * tp + 4 * s + uu) * 256]; acc = __builtin_amdgcn_mfma_f32_32x32x2f32(a, wv[uu], acc, 0, 0, 0); }
    }
#pragma unroll
    for (int i = 0; i < 16; ++i) { const int row = (i & 3) + 8 * (i >> 2) + 4 * s; WfT[(size_t)(g * 256 + p0 + row) * 1024 + kk0 + li] = (bf16_t)f2bf(acc[i]); }
}

__device__ __forceinline__ void p0_phase(Frame& F, const Args& a) {
    PHASE_IDS();
    float* ADA = (float*)(ws + WS_ADA);
    const float* c = a.in[1]; const float* cctx = a.in[3]; const float* ada_w = a.in[5]; const float* ada_b = a.in[6];
    LAS float* sl = (LAS float*)F.lds;
    LAS float* part = (LAS float*)(F.lds + 36864);
    bool loaded = false;
#ifndef DBG_P0
#define DBG_P0 3
#endif
    if (DBG_P0 & 1)
    for (int u = F.vcu; u < 192; u += F.G) {
        if (!loaded) { for (int idx = tid; idx < 9 * 1024; idx += 512) { const int r = idx >> 10, k = idx & 1023; const float x = r < 8 ? c[r * 1024 + k] : cctx[k]; sl[idx] = x / (1.f + expf(-x)); } loaded = true; }
        __syncthreads();
        const int i = u / 48, n0 = (u % 48) * 64;
        float acc[9];
#pragma unroll
        for (int r = 0; r < 9; ++r) acc[r] = 0.f;
        const float* wp = ada_w + ((size_t)i * 1024 + wave * 128) * 3072 + n0 + lane;
#pragma unroll 8
        for (int kk = 0; kk < 128; ++kk) { const float wv = wp[(size_t)kk * 3072]; const int k = wave * 128 + kk;
#pragma unroll
            for (int r = 0; r < 9; ++r) acc[r] += sl[r * 1024 + k] * wv; }
#pragma unroll
        for (int r = 0; r < 9; ++r) part[(wave * 9 + r) * 64 + lane] = acc[r];
        __syncthreads();
        for (int idx = tid; idx < 576; idx += 512) { const int r = idx >> 6, l = idx & 63; float s = 0.f;
#pragma unroll
            for (int w = 0; w < 8; ++w) s += part[(w * 9 + r) * 64 + l];
            ADA[(i * 9 + r) * 3072 + n0 + l] = s + ada_b[i * 3072 + n0 + l]; }
    }
    if (!(DBG_P0 & 2)) return;
    const int gt = F.vcu * 512 + tid, NT = F.G * 512;
    float* TC = (float*)(ws + WS_TC);
    for (int idx = gt; idx < 65536; idx += NT) { const int cc = idx >> 8, p = idx & 255; float v;
        if (p < 128) v = cospif((float)((p * cc) & 255) * (1.f / 128.f));
        else if (p == 128) v = (cc & 1) ? -1.f : 1.f;
        else v = sinpif((float)(((p - 128) * cc) & 255) * (1.f / 128.f));
        TC[idx] = v * 0.0625f; }
    float* RC = (float*)(ws + WS_ROPE); float* RS = RC + 4096;
    for (int idx = gt; idx < 4096; idx += NT) { const int pos = idx >> 6, i = idx & 63; const float freq = powf(10000.0f, -(float)i / 64.0f); const float ang = (float)pos * freq;
        RC[idx] = cosf(ang); RS[idx] = sinf(ang); }
    bf16_t* CS256 = (bf16_t*)(ws + WS_CS256);
    for (int idx = gt; idx < 512 * 256; idx += NT) { const int row = idx >> 8, l = idx & 255, kt = row >> 8, hf = (row >> 7) & 1, k = kt * 128 + (row & 127);
        const float x = (float)((k * l) & 255) * (1.f / 128.f); const float v = (hf ? sinpif(x) : cospif(x)) * 0.0625f; CS256[idx] = (bf16_t)f2bf(v); }
}

__device__ __forceinline__ void norm_row(const float* xrow, const float* ng, const float* adar  , bf16_t* orow, int lane) {
    const f32x4* xr = (const f32x4*)xrow + lane;
    f32x4 v[4]; float s = 0.f;
#pragma unroll
    for (int j = 0; j < 4; ++j) { v[j] = xr[64 * j]; s += (v[j].x * v[j].x + v[j].y * v[j].y) + (v[j].z * v[j].z + v[j].w * v[j].w); }
    const float rinv = rsqrtf(wave_sum(s, lane) * (1.f / DM) + EPS);
    unsigned long long* o8 = (unsigned long long*)orow + lane;
#pragma unroll
    for (int j = 0; j < 4; ++j) { const int col = 4 * lane + 256 * j; const f32x4 g = *(const f32x4*)(ng + col), sh = *(const f32x4*)(adar + col), sc = *(const f32x4*)(adar + 1024 + col);
        const f32x4 y = v[j] * rinv * g * (sc + 1.0f) + sh;
        o8[64 * j] = (unsigned long long)pk2(y.x, y.y) | ((unsigned long long)pk2(y.z, y.w) << 32); }
}
__device__ __forceinline__ void norm_rows(Frame& F, const Args& a, int layer, bf16_t* H) {
    PHASE_IDS();
    const float* xl = layer == 0 ? a.in[0] : a.out; const float* xc = layer == 0 ? a.in[2] : (const float*)(ws + WS_XCTX);
    const float* ng = a.in[4] + layer * DM; const float* ADA = (const float*)(ws + WS_ADA) + layer * 9 * 3072;
    const int gw = F.vcu * 8 + wave, NGW = F.G * 8;
    for (int m = gw; m < NTOK; m += NGW) {
        const bool lat = m < NLAT; const int r = lat ? (m >> 11) : 8;
        const float* xrow = lat ? xl + (size_t)m * DM : xc + (size_t)(m - NLAT) * DM;
        norm_row(xrow, ng, ADA + r * 3072, H + (size_t)m * DM, lane);
    }
}
__device__ __forceinline__ void n_phase(Frame& F, const Args& a, int layer) {
    PHASE_IDS();
    const bool fourier = (layer & 1) == 0; const int j = layer >> 1;
    norm_rows(F, a, layer, (bf16_t*)(ws + (fourier ? WS_H : WS_OF)));
    LAS float* scr = (LAS float*)(F.lds + wave * 16384);
    const int gw = F.vcu * 8 + wave, NGW = F.G * 8;
    bf16_t* W1 = (bf16_t*)(ws + WS_W);
    if (fourier) {
        const float* win = a.in[7] + (size_t)j * 1024 * 4096; const float* wout = a.in[8] + (size_t)j * 2048 * 1024;
        bf16_t* WfoT = W1 + (size_t)4096 * 1024;
        for (int t = gw; t < 2048; t += NGW) fold_task(win, (const float*)(ws + WS_TC), W1, t, lane);
        for (int it = gw; it < 16 * 64; it += NGW) transpose_item<0>(win, 1024, 4096, 2048, W1 + (size_t)2048 * 1024, scr, it, 64, lane);
        for (int it = gw; it < 32 * 32; it += NGW) transpose_item<0>(wout, 2048, 1024, 0, WfoT, scr, it, 32, lane);
        bf16_t* CS = (bf16_t*)(ws + WS_CS);
        const int gt = F.vcu * 512 + tid, NT = F.G * 512;
        for (int ch = gt; ch < 2048 * 128; ch += NT) { const int row = ch >> 7, l0 = (ch & 127) * 8, kt = row >> 8, hf = (row >> 7) & 1, k = kt * 128 + (row & 127);
            unsigned w[4];
#pragma unroll
            for (int e = 0; e < 4; ++e) { float v[2];
#pragma unroll
                for (int q = 0; q < 2; ++q) { const int l = l0 + 2 * e + q; const float x = (float)((k * l) & 2047) * (1.f / 1024.f); v[q] = (hf ? sinpif(x) : cospif(x)) * 0.022097087f; }
                w[e] = pk2(v[0], v[1]); }
            *(u32x4*)(CS + (size_t)row * 1024 + l0) = (u32x4){w[0], w[1], w[2], w[3]}; }
    } else {
        const float* win = a.in[9] + (size_t)j * 1024 * 6144; const float* wout = a.in[10] + (size_t)j * 2048 * 1024;
        bf16_t* WroT = W1 + (size_t)6144 * 1024;
        for (int it = gw; it < 16 * 192; it += NGW) transpose_item<1>(win, 1024, 6144, 0, W1, scr, it, 192, lane);
        for (int it = gw; it < 32 * 32; it += NGW) transpose_item<0>(wout, 2048, 1024, 0, WroT, scr, it, 32, lane);
    }
}

__device__ __forceinline__ void fold_phase(Frame& F) {
    PHASE_IDS();
    const bf16_t* UT = (const bf16_t*)(ws + WS_UTL); bf16_t* UTF = (bf16_t*)(ws + WS_H); float* AH = (float*)(ws + WS_RINV);
    LAS bf16_t* scr = (LAS bf16_t*)(F.lds + wave * 4096);
    const int gw = F.vcu * 8 + wave, NGW = F.G * 8;
    for (int row = gw; row < 8 * 2048; row += NGW) {
        const GAS u32x4* src = (const GAS u32x4*)(UT + (size_t)row * 2048);
        u32x4 v[4];
#pragma unroll
        for (int i = 0; i < 4; ++i) v[i] = src[lane + 64 * i];
#pragma unroll
        for (int i = 0; i < 4; ++i) *(LAS u32x4*)(scr + 8 * (lane + 64 * i)) = v[i];
        LDS_WAIT(); asm volatile("" ::: "memory");
        const float sg = ((row & 255) <= 128) ? 1.f : -1.f;
        const int l0 = 16 * lane; unsigned o[8];
#pragma unroll
        for (int i = 0; i < 8; ++i) { float y[2];
#pragma unroll
            for (int q = 0; q < 2; ++q) { const int l = l0 + 2 * i + q; const float a = bf1(scr[l]); const float m = (l == 0) ? 0.f : bf1(scr[2048 - (l == 0 ? 1 : l)]); y[q] = a + sg * m; }
            o[i] = pk2(y[0], y[1]); }
        GAS u32x4* dst = (GAS u32x4*)(UTF + (size_t)row * 1024 + l0);
        dst[0] = (u32x4){o[0], o[1], o[2], o[3]}; dst[1] = (u32x4){o[4], o[5], o[6], o[7]};
        if (lane == 0) AH[row] = bf1(scr[1024]);
        LDS_WAIT(); asm volatile("" ::: "memory");
    }
}
__device__ __forceinline__ void nyq_row_phase(Frame& F) {
    PHASE_IDS();
    const bf16_t* UTF = (const bf16_t*)(ws + WS_H); const float* AH = (const float*)(ws + WS_RINV); bf16_t* Z = (bf16_t*)(ws + WS_Z);
    const int gw = F.vcu * 8 + wave, NGW = F.G * 8;
    for (int t = gw; t < 64 * 129; t += NGW) {
        const int bg = t / 129, mt = t - bg * 129, b = bg >> 3, g = bg & 7; const int row = b * 2048 + g * 256 + mt;
        const GAS u32x4* src = (const GAS u32x4*)(UTF + (size_t)row * 1024);
        float s = 0.f;
#pragma unroll
        for (int i = 0; i < 2; ++i) { const u32x4 v = src[lane + 64 * i]; s += (bflo(v.x) - bfhi(v.x)) + (bflo(v.y) - bfhi(v.y)) + (bflo(v.z) - bfhi(v.z)) + (bflo(v.w) - bfhi(v.w)); }
        s = wave_sum(s, lane);
        const float y = (s + AH[row]) * 0.022097087f;
        bf16_t* zrow = Z + (size_t)(b * 2048 + 1024) * 2048 + g * 256;
        if (lane == 0) zrow[mt] = (bf16_t)f2bf(y * bf1(zrow[mt]));
        if (lane == 1 && mt >= 1 && mt <= 127) zrow[256 - mt] = (bf16_t)f2bf(y * bf1(zrow[256 - mt]));
    }
}
__device__ __forceinline__ bf16_t* s_chunk(unsigned char* ws, int h, int rc) {
    return rc < 64 ? (bf16_t*)(ws + WS_SA) + ((size_t)(h * 64 + rc) << 14) : (bf16_t*)(ws + WS_SB) + ((size_t)(h * 80 + rc - 64) << 14);
}
struct DiagOrder { int G, c; __device__ bool next(int i, pg8::Unit& u) const { const int L = i * G + c; if (L >= 72) return false; u.pm = L; u.pn = L; return true; } };
struct EpiS {
    static constexpr bool PERM = true;
    unsigned char* ws; int h;
    __device__ __forceinline__ void operator()(AccRef acc, const pg8::Unit& u, int wr, int wc, int fr, int fq) const {
#pragma unroll
        for (int ai = 0; ai < 2; ++ai) { bf16_t* sp = s_chunk(ws, h, 2 * u.pm + ai);
#pragma unroll
            for (int m = 0; m < 4; ++m) { const f32x4 v0 = acc[ai][ai][m][0], v1 = acc[ai][ai][m][1]; u32x4 w;
                w.x = cvt_pk_bf16(v0[0], v0[1]); w.y = cvt_pk_bf16(v0[2], v0[3]); w.z = cvt_pk_bf16(v1[0], v1[1]); w.w = cvt_pk_bf16(v1[2], v1[3]);
                *(u32x4*)(sp + (wr * 64 + m * 16 + fr) * 128 + wc * 32 + 8 * fq) = w; } }
    }
};
typedef short bf16x4 __attribute__((ext_vector_type(4)));
typedef short v4i16_t __attribute__((ext_vector_type(4)));
__device__ __forceinline__ bf16x8 ldtr2(const LAS unsigned char* p0, const LAS unsigned char* p1) {
    const bf16x4 lo = __builtin_bit_cast(bf16x4, __builtin_amdgcn_ds_read_tr16_b64_v4i16((LAS v4i16_t*)p0));
    const bf16x4 hi = __builtin_bit_cast(bf16x4, __builtin_amdgcn_ds_read_tr16_b64_v4i16((LAS v4i16_t*)p1));
    return __builtin_shufflevector(lo, hi, 0, 1, 2, 3, 4, 5, 6, 7);
}
__device__ __forceinline__ int blk_perm(int rb) { return (rb & ~3) | ((rb >> 1) & 1) | ((rb & 1) << 1); }
__device__ __forceinline__ int scan_t0(int dir, int b, int s) {
    return dir == 0 ? ((s < 2) ? (NLAT + b * CTXL + s * 128) : (b * SEQ + (s - 2) * 128)) : ((s < 2) ? (NLAT + b * CTXL + (1 - s) * 128) : (b * SEQ + (17 - s) * 128));
}
__device__ __forceinline__ int scan_rc(int dir, int b, int s) {
    return dir == 0 ? ((s < 2) ? (128 + b * 2 + s) : (b * 16 + (s - 2))) : ((s < 2) ? (128 + b * 2 + (1 - s)) : (b * 16 + (17 - s)));
}
__device__ __forceinline__ u32x4 ldg16(const void* ub, unsigned voff) { return *(const GAS u32x4*)((const GAS unsigned char*)ub + voff); }
__device__ __forceinline__ void scan_load_s(u32x4 (&sf)[4], unsigned char* ws, int h, int rc, int w, int r, int q) {
    const bf16_t* ub = s_chunk(ws, h, rc) + 16 * w * 128; const unsigned vo = (unsigned)(r * 128 + 8 * q) * 2u;
#pragma unroll
    for (int ks = 0; ks < 4; ++ks) sf[ks] = ldg16(ub, vo + 64u * ks);
}
__device__ __forceinline__ void scan_load_q(u32x4 (&qf)[8], const bf16_t* Qg, int h, int t0, int w, int r, int q) {
    const bf16_t* ub = Qg + (size_t)(t0 + 16 * w) * 1024 + h * 256; const unsigned vo = (unsigned)(r * 1024 + 8 * q) * 2u;
#pragma unroll
    for (int ks = 0; ks < 8; ++ks) qf[ks] = ldg16(ub, vo + 64u * ks);
}
__device__ __forceinline__ void scan_load_kv(u32x4 (&kr)[8], u32x4 (&vr)[2], const bf16_t* Kg, const bf16_t* Vg, int h, int sl, int t0, int w, int lane, int tid) {
    const bf16_t* kb = Kg + (size_t)t0 * 1024 + h * 256 + 32 * w; const unsigned ko = (unsigned)((lane >> 2) * 1024 + 8 * (lane & 3)) * 2u;
#pragma unroll
    for (int it = 0; it < 8; ++it) kr[it] = ldg16(kb + (size_t)it * 16 * 1024, ko);
    const bf16_t* vb = Vg + (size_t)t0 * 2048 + h * 512 + sl * 64; const unsigned vo = (unsigned)((tid >> 3) * 2048 + 8 * (tid & 7)) * 2u;
#pragma unroll
    for (int i = 0; i < 2; ++i) vr[i] = ldg16(vb + (size_t)i * 64 * 2048, vo);
}
template <int DIR>
__device__ __forceinline__ void scan_step(LAS unsigned char* lds, u32x4 (&sf)[4], u32x4 (&qf)[8], u32x4 (&kr)[8], u32x4 (&vr)[2], f32x4 (&Rb)[2][4], const float (&wm)[2], float rsc, float g128,
                                          int t0, int t0n, int rcn, unsigned char* ws, int h, int sl, int w, int lane, int tid, const bf16_t* Qg, const bf16_t* Kg, const bf16_t* Vg, bf16_t* OF, float* SSP) {
    const int r = lane & 15, q = lane >> 4;
    LAS unsigned char* VI = lds + SC_V_OFF; LAS unsigned char* RT = lds + SC_RT_OFF; LAS unsigned char* KI = lds + SC_K_OFF + w * 8192;
#pragma unroll
    for (int i = 0; i < 2; ++i) { const int m = (tid >> 3) + 64 * i, e0 = 8 * (tid & 7); const float sc = wm[i]; const u32x4 v = vr[i]; u32x4 o;
        o.x = cvt_pk_bf16(bflo(v.x) * sc, bfhi(v.x) * sc); o.y = cvt_pk_bf16(bflo(v.y) * sc, bfhi(v.y) * sc); o.z = cvt_pk_bf16(bflo(v.z) * sc, bfhi(v.z) * sc); o.w = cvt_pk_bf16(bflo(v.w) * sc, bfhi(v.w) * sc);
        *(LAS u32x4*)(VI + 128 * ((e0 >> 4) * 32 + blk_perm(m >> 2)) + (m & 3) * 32 + (e0 & 15) * 2) = o; }
#pragma unroll
    for (int it = 0; it < 8; ++it) { const int m = it * 16 + (lane >> 2), dc = lane & 3;
        *(LAS u32x4*)(KI + 128 * ((dc >> 1) * 32 + blk_perm(m >> 2)) + (m & 3) * 32 + (dc & 1) * 16) = kr[it]; }
    __syncthreads();
    scan_load_kv(kr, vr, Kg, Vg, h, sl, t0n, w, lane, tid);
    const int jl = 16 * w + r;
    f32x4 O[4];
#pragma unroll
    for (int eb = 0; eb < 4; ++eb) O[eb] = (f32x4){0.f, 0.f, 0.f, 0.f};
    const LAS unsigned char* rtb = RT + r * 528 + q * 16;
#pragma unroll
    for (int ks = 0; ks < 8; ++ks) { const bf16x8 qv = __builtin_bit_cast(bf16x8, qf[ks]);
#pragma unroll
        for (int eb = 0; eb < 4; ++eb) { const bf16x8 av = *(const LAS bf16x8*)(rtb + (16 * eb * 528 + 64 * ks));
            O[eb] = __builtin_amdgcn_mfma_f32_16x16x32_bf16(av, qv, O[eb], 0, 0, 0); } }
    scan_load_q(qf, Qg, h, t0n, w, r, q);
    const int lofs = 128 * (4 * (q >> 1) + (q & 1)) + 8 * r;
    const LAS unsigned char* vtb = VI + lofs; const LAS unsigned char* ktb = KI + lofs;
#pragma unroll
    for (int ks = 0; ks < 4; ++ks) {
        bf16x8 vb[4], ka[2];
#pragma unroll
        for (int eb = 0; eb < 4; ++eb) vb[eb] = ldtr2(vtb + 128 * (eb * 32 + 8 * ks), vtb + 128 * (eb * 32 + 8 * ks + 2));
#pragma unroll
        for (int db = 0; db < 2; ++db) ka[db] = ldtr2(ktb + 128 * (db * 32 + 8 * ks), ktb + 128 * (db * 32 + 8 * ks + 2));
        bf16x8 sfm;
        { unsigned wd[4] = {sf[ks].x, sf[ks].y, sf[ks].z, sf[ks].w};
#pragma unroll
          for (int i = 0; i < 4; ++i) { const int m0 = 32 * ks + 8 * q + 2 * i; const bool k0 = DIR == 0 ? (m0 <= jl) : (m0 >= jl), k1 = DIR == 0 ? (m0 + 1 <= jl) : (m0 + 1 >= jl);
              wd[i] &= (k0 ? 0xffffu : 0u) | (k1 ? 0xffff0000u : 0u); }
          sfm = __builtin_bit_cast(bf16x8, (u32x4){wd[0], wd[1], wd[2], wd[3]}); }
#pragma unroll
        for (int eb = 0; eb < 4; ++eb) O[eb] = __builtin_amdgcn_mfma_f32_16x16x32_bf16(vb[eb], sfm, O[eb], 0, 0, 0);
#pragma unroll
        for (int db = 0; db < 2; ++db)
#pragma unroll
            for (int eb = 0; eb < 4; ++eb) Rb[db][eb] = __builtin_amdgcn_mfma_f32_16x16x32_bf16(ka[db], vb[eb], Rb[db][eb], 0, 0, 0);
    }
    scan_load_s(sf, ws, h, rcn, w, r, q);
    {
        GAS unsigned char* ob = (GAS unsigned char*)(OF + (size_t)(t0 + 16 * w) * 2048 + h * 512 + sl * 64); const unsigned oo = (unsigned)(r * 2048 + 4 * q) * 2u; float ss = 0.f;
#pragma unroll
        for (int eb = 0; eb < 4; ++eb) { f32x4 v = O[eb] * rsc; GAS bf16_t* op = (GAS bf16_t*)(ob + oo) ;
            if (DIR == 1) { const u32x2 pv = *(const GAS u32x2*)(op + 16 * eb); v[0] += bflo(pv.x); v[1] += bfhi(pv.x); v[2] += bflo(pv.y); v[3] += bfhi(pv.y);
                ss += (v[0] * v[0] + v[1] * v[1]) + (v[2] * v[2] + v[3] * v[3]); }
            u32x2 o; o.x = cvt_pk_bf16(v[0], v[1]); o.y = cvt_pk_bf16(v[2], v[3]); *(GAS u32x2*)(op + 16 * eb) = o; }
        if (DIR == 1) { ss += shx(ss, 16, lane); ss += shx(ss, 32, lane); if (q == 0) *(GAS float*)((GAS unsigned char*)(SSP + (size_t)(t0 + 16 * w) * 32 + h * 8 + sl) + (unsigned)r * 128u) = ss; }
    }
#pragma unroll
    for (int db = 0; db < 2; ++db)
#pragma unroll
        for (int eb = 0; eb < 4; ++eb) Rb[db][eb] = Rb[db][eb] * g128;
    __syncthreads();
#pragma unroll
    for (int db = 0; db < 2; ++db)
#pragma unroll
        for (int eb = 0; eb < 4; ++eb) { u32x2 o; o.x = cvt_pk_bf16(Rb[db][eb][0], Rb[db][eb][1]); o.y = cvt_pk_bf16(Rb[db][eb][2], Rb[db][eb][3]);
            *(LAS u32x2*)(RT + (16 * eb + r) * 528 + (32 * w + 16 * db + 4 * q) * 2) = o; }
}
template <int DIR>
__device__ __forceinline__ void scan_unit(Frame& F, int tid, unsigned char* ws, int b, int h, int sl, float lg, const bf16_t* Qg, const bf16_t* Kg, const bf16_t* Vg, bf16_t* OF, float* SSP) {
    const int lane = tid & 63, w = __builtin_amdgcn_readfirstlane(tid >> 6), r = lane & 15, q = lane >> 4;
    const float g128 = __expf(128.f * lg);
    float wm[2];
#pragma unroll
    for (int i = 0; i < 2; ++i) { const int m = (tid >> 3) + 64 * i; wm[i] = __expf(lg * (float)(DIR == 0 ? 127 - m : m)); }
    const int jl = 16 * w + r; const float rsc = __expf(lg * (float)(DIR == 0 ? jl - 127 : -jl));
    f32x4 Rb[2][4];
#pragma unroll
    for (int db = 0; db < 2; ++db)
#pragma unroll
        for (int eb = 0; eb < 4; ++eb) Rb[db][eb] = (f32x4){0.f, 0.f, 0.f, 0.f};
    {
        LAS unsigned char* RT = F.lds + SC_RT_OFF;
#pragma unroll
        for (int db = 0; db < 2; ++db)
#pragma unroll
            for (int eb = 0; eb < 4; ++eb) *(LAS u32x2*)(RT + (16 * eb + r) * 528 + (32 * w + 16 * db + 4 * q) * 2) = (u32x2){0u, 0u};
    }
    u32x4 sf[4], qf[8], kr[8], vr[2];
    scan_load_s(sf, ws, h, scan_rc(DIR, b, 0), w, r, q);
    scan_load_q(qf, Qg, h, scan_t0(DIR, b, 0), w, r, q);
    scan_load_kv(kr, vr, Kg, Vg, h, sl, scan_t0(DIR, b, 0), w, lane, tid);
    for (int s = 0; s < 18; ++s) {
        const int sn = (s + 1 < 18) ? s + 1 : 17;
        scan_step<DIR>(F.lds, sf, qf, kr, vr, Rb, wm, rsc, g128, scan_t0(DIR, b, s), scan_t0(DIR, b, sn), scan_rc(DIR, b, sn), ws, h, sl, w, lane, tid, Qg, Kg, Vg, OF, SSP);
    }
    __syncthreads();
}
__device__ __forceinline__ void scan_phase(Frame& F, const Args& a, int layer, int dir) {
    PHASE_IDS();
    const int j = layer >> 1; const float* dec = a.in[11] + j * 8 + dir * 4;
    for (int u = F.vcu; u < 256; u += F.G) {
        const int b = u >> 5, h = (u >> 3) & 3, sl = u & 7;
        const float lg = log1pf(-exp2f(dec[h]));
        if (dir == 0) scan_unit<0>(F, tid, ws, b, h, sl, lg, (const bf16_t*)(ws + WS_Q), (const bf16_t*)(ws + WS_K), (const bf16_t*)(ws + WS_V), (bf16_t*)(ws + WS_OF), (float*)(ws + WS_SSP));
        else scan_unit<1>(F, tid, ws, b, h, sl, lg, (const bf16_t*)(ws + WS_Q), (const bf16_t*)(ws + WS_K), (const bf16_t*)(ws + WS_V), (bf16_t*)(ws + WS_OF), (float*)(ws + WS_SSP));
    }
}
__device__ __forceinline__ void n2_phase(Frame& F, const Args& a, int layer) {
    PHASE_IDS();
    norm_rows(F, a, layer, (bf16_t*)(ws + WS_Q));
    const float* SSP = (const float*)(ws + WS_SSP); float* RINV = (float*)(ws + WS_RINV);
    const int gt = F.vcu * 512 + tid, NT = F.G * 512;
    for (int idx = gt; idx < NTOK * 4; idx += NT) { const f32x4 p0 = *(const f32x4*)(SSP + (size_t)idx * 8), p1 = *(const f32x4*)(SSP + (size_t)idx * 8 + 4);
        const float ss = ((p0.x + p0.y) + (p0.z + p0.w)) + ((p1.x + p1.y) + (p1.z + p1.w)); RINV[idx] = rsqrtf(ss * (1.f / 512.f) + EPS); }
}
__device__ __forceinline__ void final_phase(Frame& F, const Args& a) {
    PHASE_IDS();
    const float* fg = a.in[12]; const int gw = F.vcu * 8 + wave, NGW = F.G * 8;
    for (int m = gw; m < NLAT; m += NGW) {
        f32x4* xr = (f32x4*)(a.out + (size_t)m * DM) + lane;
        f32x4 v[4]; float s = 0.f;
#pragma unroll
        for (int jj = 0; jj < 4; ++jj) { v[jj] = xr[64 * jj]; s += (v[jj].x * v[jj].x + v[jj].y * v[jj].y) + (v[jj].z * v[jj].z + v[jj].w * v[jj].w); }
        const float rinv = rsqrtf(wave_sum(s, lane) * (1.f / DM) + EPS);
#pragma unroll
        for (int jj = 0; jj < 4; ++jj) { const f32x4 g = *(const f32x4*)(fg + 4 * lane + 256 * jj); xr[64 * jj] = v[jj] * rinv * g; }
    }
}

constexpr int N_PHASES = 34;
__global__ void __launch_bounds__(512, 2) trunk_fwd(Args args) {
    extern __shared__ __attribute__((aligned(16))) unsigned char lds_raw[];
    Frame F;
    F.lds = (LAS unsigned char*)lds_raw;
    F.G = gridDim.x; F.wv = __builtin_amdgcn_readfirstlane((int)threadIdx.x >> 6); { const int bx = blockIdx.x; F.vcu = (F.G % 8 == 0) ? (bx % 8) * (F.G / 8) + bx / 8 : bx; }
    F.ws = args.ws;
    volatile LAS unsigned* MISC = (volatile LAS unsigned*)(F.lds + MISC_OFF);
    for (int u = threadIdx.x; u < 128; u += 512) MISC[u] = 0u;
    __syncthreads();
    const int lo = args.ph_lo, hi = args.ph_hi;
    XcdBarrier bar; bar.bar = (unsigned*)(args.ws + WS_CTL) + 4096; bar.x = 0; bar.st = nullptr;
    const bool multi = (hi - lo) > 1;
    if (multi) bar = xcd_barrier_post((unsigned*)(args.ws + WS_CTL) + 4096, MISC + 8);
#ifndef KINDS
#define KINDS 0xFFFF
#endif
#define KON(b) (((KINDS) >> (b)) & 1)
#ifndef REPK
#define REPK 0
#endif
#define NREP(b) ((((REPK) >> (b)) & 1) ? 2 : 1)
#define IN(k) (lo <= (k) && (k) < hi)
#define SEAM(k) do { if (multi && (k) + 1 < hi) xcd_barrier(bar); } while (0)
    const int bx = (int)blockIdx.x, G = F.G;
    if (KON(0) && IN(0)) { p0_phase(F, args); SEAM(0); }
    for (int layer = 0; layer < NLAYER; ++layer) {
        const int pb = 1 + 8 * layer; const bool fourier = (layer & 1) == 0;
        unsigned char* ws = launder_ptr(args.ws);
        const float* ADAg = (const float*)(ws + WS_ADA) + layer * 9 * 3072 + 2048;
        const float* xin_lat = layer == 0 ? args.in[0] : args.out; const float* xin_ctx = layer == 0 ? args.in[2] : (const float*)(ws + WS_XCTX);
        const EpiResid ER{xin_lat, xin_ctx, args.out, (float*)(ws + WS_XCTX), ADAg};
        if (KON(1) && IN(pb)) { for (int rep = 0; rep < NREP(1); ++rep) { n_phase(F, args, layer); SEAM(pb); } }
        if (fourier) {
            bf16_t* W1 = (bf16_t*)(ws + WS_W);
            if (KON(2) && IN(pb + 1)) for (int rep = 0; rep < NREP(2); ++rep) {
                { pg8::Gemm g{(const bf16_t*)(ws + WS_H), W1 + (size_t)2048 * 1024, 1024, 1024, 1024}; pg8::TileOrder S; S.init(72, 8, G, bx);
                  EpiSilu E{(bf16_t*)(ws + WS_Z), 2048}; pg8::gemm_phase(F.lds, F.wv, g, S, E); }
                { pg8::Gemm g{W1, (const bf16_t*)(ws + WS_H), 1024, 1024, 1024}; pg8::TileOrder S; S.init(8, 72, G, (bx + 64) % G);
                  EpiUT E{(bf16_t*)(ws + WS_UTL), (bf16_t*)(ws + WS_UTC)}; pg8::gemm_phase(F.lds, F.wv, g, S, E); }
                SEAM(pb + 1);
            }
            if (KON(3) && IN(pb + 2)) {
                fold_phase(F);
                if (multi) xcd_barrier(bar);
                { pg8::Gemm g{(const bf16_t*)(ws + WS_CS), (const bf16_t*)(ws + WS_H), 1024, 1024, 1024}; pg8::TileOrder S; S.init(8, 64, G, bx);
                  EpiDft<true> E{(bf16_t*)(ws + WS_Z), 2048, 0, (const float*)(ws + WS_RINV)}; pg8::gemm_phase(F.lds, F.wv, g, S, E); }
                { pg8::Gemm g{(const bf16_t*)(ws + WS_CS256), (const bf16_t*)(ws + WS_UTC), 256, 256, 256}; pg8::TileOrder S; S.init(2, 64, G, bx);
                  EpiDft<false> E{(bf16_t*)(ws + WS_Z), 256, NLAT, nullptr}; pg8::gemm_phase(F.lds, F.wv, g, S, E); }
                nyq_row_phase(F);
                SEAM(pb + 2);
            }
            if (KON(4) && IN(pb + 3)) {
                pg8::Gemm g{(const bf16_t*)(ws + WS_Z), W1 + (size_t)4096 * 1024, 2048, 2048, 2048}; pg8::TileOrder S; S.init(72, 4, G, bx);
                pg8::gemm_phase(F.lds, F.wv, g, S, ER);
                SEAM(pb + 3);
            }
        } else {
            bf16_t* W1 = (bf16_t*)(ws + WS_W);
            if (KON(5) && IN(pb + 1)) for (int rep = 0; rep < NREP(5); ++rep) {
                pg8::Gemm g{(const bf16_t*)(ws + WS_OF), W1, 1024, 1024, 1024}; pg8::TileOrder S; S.init(72, 16, G, bx);
                EpiQKV E{(bf16_t*)(ws + WS_Q), (bf16_t*)(ws + WS_K), (bf16_t*)(ws + WS_V), (const float*)(ws + WS_ROPE), (const float*)(ws + WS_ROPE) + 4096};
                pg8::gemm_phase(F.lds, F.wv, g, S, E);
                SEAM(pb + 1);
            }
            if (KON(6) && IN(pb + 2)) {
                for (int h = 0; h < 4; ++h) { pg8::Gemm g{(const bf16_t*)(ws + WS_Q) + h * 256, (const bf16_t*)(ws + WS_K) + h * 256, 1024, 1024, 256}; DiagOrder S{G, (bx + 64 * h) % G};
                    EpiS E{ws, h}; pg8::gemm_phase(F.lds, F.wv, g, S, E); }
                if (multi) xcd_barrier(bar);
                for (int rep = 0; rep < NREP(6); ++rep) { scan_phase(F, args, layer, 0); SEAM(pb + 2); }
            }
            if (KON(6) && IN(pb + 3)) { scan_phase(F, args, layer, 1); SEAM(pb + 3); }
            if (KON(7) && IN(pb + 4)) for (int rep = 0; rep < NREP(7); ++rep) { n2_phase(F, args, layer); SEAM(pb + 4); }
            if (KON(8) && IN(pb + 5)) for (int rep = 0; rep < NREP(8); ++rep) {
                pg8::Gemm g{(const bf16_t*)(ws + WS_Q), W1 + (size_t)4096 * 1024, 1024, 1024, 1024}; pg8::TileOrder S; S.init(72, 8, G, bx);
                EpiZGate E{(const bf16_t*)(ws + WS_OF), (const float*)(ws + WS_RINV), (bf16_t*)(ws + WS_V)};
                pg8::gemm_phase(F.lds, F.wv, g, S, E);
                SEAM(pb + 5);
            }
            if (KON(9) && IN(pb + 6)) {
                pg8::Gemm g{(const bf16_t*)(ws + WS_V), W1 + (size_t)6144 * 1024, 2048, 2048, 2048}; pg8::TileOrder S; S.init(72, 4, G, bx);
                pg8::gemm_phase(F.lds, F.wv, g, S, ER);
                SEAM(pb + 6);
            }
        }
    }
    if (KON(10) && IN(33)) final_phase(F, args);
#undef IN
#undef SEAM
}

static bool phase_used(int p) {
    if (p == 0 || p == 33) return true;
    const int layer = (p - 1) / 8, k = (p - 1) % 8;
    return (layer & 1) == 0 ? (k <= 3) : (k <= 6);
}
extern "C" void kernel_launch(void* const* d_in, const int* in_sizes, int n_in, void* d_out, int out_size, void* d_ws, size_t ws_size, hipStream_t stream) {
    static int grid = 0;
    if (grid == 0) {
        if (n_in != 13 || out_size != NLAT * DM || ws_size < WS_END) { fprintf(stderr, "kernel_launch: unexpected problem (n_in %d, out %d, ws %zu)\n", n_in, out_size, ws_size); grid = -1; return; }
        int dev = 0, cus = 0;
        if (hipGetDevice(&dev) != hipSuccess || hipDeviceGetAttribute(&cus, hipDeviceAttributeMultiprocessorCount, dev) != hipSuccess) { grid = -1; return; }
        if (hipFuncSetAttribute((const void*)trunk_fwd, hipFuncAttributeMaxDynamicSharedMemorySize, LDS_BYTES) != hipSuccess) { fprintf(stderr, "kernel_launch: hipFuncSetAttribute failed\n"); grid = -1; return; }
        (void)hipGetLastError();
        grid = cus;
    }
    if (grid < 0) return;
    if (hipMemsetAsync((char*)d_ws + WS_CTL, 0, CTL_ZERO_BYTES, stream) != hipSuccess) return;
    Args a{};
    for (int i = 0; i < 13; ++i) a.in[i] = (const float*)d_in[i];
    a.out = (float*)d_out; a.ws = (unsigned char*)d_ws;
#if MK_PER_PHASE_LAUNCH
#ifndef DBG_MAXPH
#define DBG_MAXPH 99
#endif
    for (int p = 0; p < N_PHASES; ++p) { if (!phase_used(p)) continue; if (p > DBG_MAXPH && p != 33) continue; a.ph_lo = p; a.ph_hi = p + 1; hipLaunchKernelGGL(trunk_fwd, dim3(grid), dim3(512), LDS_BYTES, stream, a); }
#else
    a.ph_lo = 0; a.ph_hi = N_PHASES;
    hipLaunchKernelGGL(trunk_fwd, dim3(grid), dim3(512), LDS_BYTES, stream, a);
#endif
}
```

```cpp
#include <hip/hip_runtime.h>
#include <cstdio>
#include <cstdint>

#ifndef MK_PER_PHASE_LAUNCH
#define MK_PER_PHASE_LAUNCH 0
#endif

#define LAS __attribute__((address_space(3)))
#define GAS __attribute__((address_space(1)))
typedef unsigned short bf16_t;
typedef short bf16x8 __attribute__((ext_vector_type(8)));
typedef float f32x4 __attribute__((ext_vector_type(4)));
typedef float f32x16 __attribute__((ext_vector_type(16)));
typedef unsigned u32x4 __attribute__((ext_vector_type(4)));
typedef unsigned u32x2 __attribute__((ext_vector_type(2)));

constexpr int DM = 1024, NB = 8, SEQ = 2048, CTXL = 256, DBR = 2048, NLAYER = 4;
constexpr int NLAT = NB * SEQ, NCTX = NB * CTXL, NTOK = NLAT + NCTX;
constexpr float EPS = 1e-6f;

constexpr size_t MiB = 1u << 20;
constexpr size_t KiB = 1024;
constexpr size_t WS_CTL = 0, CTL_ZERO_BYTES = 64 * KiB;
constexpr size_t WS_ADA = 256 * KiB;
constexpr size_t WS_TC = 768 * KiB;
constexpr size_t WS_ROPE = 1024 * KiB;
constexpr size_t WS_CS256 = 1088 * KiB;
constexpr size_t WS_RINV = 1344 * KiB;
constexpr size_t WS_XCTX = 2 * MiB;
constexpr size_t WS_W = 10 * MiB;
constexpr size_t WS_R = 26 * MiB;
constexpr size_t WS_H = WS_R;
constexpr size_t WS_Z = WS_R + 36 * MiB;
constexpr size_t WS_UTL = WS_R + 108 * MiB;
constexpr size_t WS_UTC = WS_R + 172 * MiB;
constexpr size_t WS_CS = WS_R + 180 * MiB;
constexpr size_t WS_Q = WS_R;
constexpr size_t WS_K = WS_R + 36 * MiB;
constexpr size_t WS_V = WS_R + 72 * MiB;
constexpr size_t WS_OF = WS_R + 144 * MiB;
constexpr size_t WS_SSP = WS_R + 216 * MiB;
constexpr size_t WS_SA = WS_W;
constexpr size_t WS_SB = WS_R + 219 * MiB;
constexpr size_t WS_END = 256 * MiB;
static_assert(WS_SSP + (size_t)NTOK * 32 * 4 <= WS_SB && WS_SB + 10 * MiB <= WS_END && WS_CS + 16 * MiB <= WS_END && WS_RINV + 288 * KiB <= WS_XCTX, "ws map");

constexpr int LDS_BYTES = 147456;
constexpr int RING_BYTES = 131072;
constexpr int SC_V_OFF = 0;
constexpr int SC_RT_OFF = 16384;
constexpr int SC_K_OFF = 16384 + 33792;
constexpr int MISC_OFF = 145408;
static_assert(SC_K_OFF + 65536 <= MISC_OFF && MISC_OFF + 512 <= LDS_BYTES, "lds map");

__device__ __forceinline__ unsigned f2bf(float f) { unsigned u = __builtin_bit_cast(unsigned, f); return (u + 0x7fffu + ((u >> 16) & 1u)) >> 16; }
__device__ __forceinline__ unsigned pk2(float lo, float hi) { return f2bf(lo) | (f2bf(hi) << 16); }
__device__ __forceinline__ float bflo(unsigned w) { return __builtin_bit_cast(float, w << 16); }
__device__ __forceinline__ float bfhi(unsigned w) { return __builtin_bit_cast(float, w & 0xffff0000u); }
__device__ __forceinline__ float bf1(bf16_t h) { return __builtin_bit_cast(float, (unsigned)h << 16); }
__device__ __forceinline__ float silu_f(float x) { return x * __builtin_amdgcn_rcpf(1.f + __expf(-x)); }
__device__ __forceinline__ float shx(float v, int o, int lane) { return __builtin_bit_cast(float, __builtin_amdgcn_ds_bpermute((lane ^ o) << 2, __builtin_bit_cast(int, v))); }
__device__ __forceinline__ float wave_sum(float v, int lane) {
#pragma unroll
    for (int o = 1; o < 64; o <<= 1) v += shx(v, o, lane);
    return v;
}

namespace pg8 {
constexpr int BM = 256, BK = 64, HALF = 128, HTB = HALF * BK * 2, STAGE_BYTES = 8 * HTB, NXCD = 8, WGM = 8;
__host__ __device__ __forceinline__ int lds_byte(int r, int c) { const int st = (r >> 4) * 2 + (c >> 5), rr = r & 15, cc = c & 31, ob = rr * 64 + cc * 2; return st * 1024 + (ob ^ (((ob >> 9) & 1) << 5)); }
__host__ __device__ __forceinline__ void stage_rc(int b, int& R, int& C) { const int st = b / 1024, sb = b % 1024, swz = sb ^ (((sb >> 9) & 1) << 5); R = (st >> 1) * 16 + swz / 64; C = (st & 1) * 32 + (swz % 64) / 2; }
__host__ __device__ __forceinline__ int perm32(int rho) { const int n = rho >> 4, i = rho & 15; return 8 * (i >> 2) + 4 * n + (i & 3); }
struct Unit { int pm, pn, aux; };
struct Gemm { const bf16_t* A; const bf16_t* Bt; int lda, ldb, K; };
struct TileOrder {
    int nM, nN, nwg, G, c;
    __device__ void init(int nM_, int nN_, int G_, int c_) { nM = nM_; nN = nN_; nwg = nM * nN; G = G_; c = c_; }
    __device__ bool next(int i, Unit& u) const {
        const long L = (long)i * G + c; if (L >= nwg) return false;
        int wgid = (int)L; { const int q = nwg / NXCD, r = nwg % NXCD, xcd = wgid % NXCD, off = wgid / NXCD; wgid = (xcd < r ? xcd * (q + 1) : r * (q + 1) + (xcd - r) * q) + off; }
        const int nig = WGM * nN, gid = wgid / nig, fm = gid * WGM, gsz = (nM - fm) < WGM ? (nM - fm) : WGM;
        u.pm = fm + ((wgid % nig) % gsz); u.pn = (wgid % nig) / gsz; u.aux = 0; return true;
    }
    __device__ __forceinline__ const char* a_ptr(const Gemm& g, const Unit& u) const { return (const char*)g.A + (size_t)u.pm * 256 * g.lda * 2; }
    __device__ __forceinline__ const char* b_ptr(const Gemm& g, const Unit& u, int half) const { return (const char*)g.Bt + (size_t)(u.pn * 256 + 128 * half) * g.ldb * 2; }
    __device__ __forceinline__ bool b_mirror(const Unit&) const { return false; }
    __device__ __forceinline__ bool b_fix(const Unit&) const { return false; }
};
__device__ __forceinline__ unsigned cvt_pk_bf16(float lo, float hi) { unsigned r; asm volatile("v_cvt_pk_bf16_f32 %0, %1, %2" : "=v"(r) : "v"(lo), "v"(hi)); return r; }

template <class Epi, class Sched, bool MIRB = false>
__device__ __forceinline__ void gemm_phase(LAS unsigned char* lds, int wv, const Gemm g, const Sched& S, const Epi& E) {
    int tid; { int l_; asm volatile("v_mbcnt_lo_u32_b32 %0, -1, 0\n\tv_mbcnt_hi_u32_b32 %0, -1, %0" : "=v"(l_)); tid = wv * 64 + l_; }
    const int wid = __builtin_amdgcn_readfirstlane(tid >> 6), lane = tid & 63, wr = wid >> 2, wc = wid & 3, fr = lane & 15, fq = lane >> 4;
    const int K = g.K, nt = K / BK;
    unsigned voffA[2], voffB[2], voffM[2], fixd[2];
#pragma unroll
    for (int i = 0; i < 2; ++i) { int R, C; stage_rc(tid * 16 + i * 8192, R, C); const int Rb = Epi::PERM ? ((R & ~31) + perm32(R & 31)) : R;
        voffA[i] = (unsigned)(R * g.lda + C) * 2u; voffB[i] = (unsigned)(Rb * g.ldb + C) * 2u; voffM[i] = (unsigned)((1024 - Rb) * g.ldb + C) * 2u; fixd[i] = (Rb == 0) ? (unsigned)(1024 * g.ldb) * 2u : 0u; }
    const size_t kstep = (size_t)(BK * 2);
    const size_t hstepA = (size_t)HALF * g.lda * 2;
    const unsigned ldsw = (unsigned)wid * 1024u;
    const int aoff = lds_byte(wr * 64 + fr, fq * 8), boff = lds_byte(wc * 32 + fr, fq * 8);
#define PG8_SA(b, h) (((b) * 2 + (h)) * HTB)
#define PG8_SB(b, h) ((4 + (b) * 2 + (h)) * HTB)
#define PG8_STAGE(bufoff, gbase, voff) do { _Pragma("unroll") for (int _i = 0; _i < 2; ++_i) \
        __builtin_amdgcn_global_load_lds((const unsigned*)((const char*)(gbase) + (voff)[_i]), (LAS unsigned*)(lds + (bufoff) + ldsw + _i * 8192), 16, 0, 0); } while (0)
#define PG8_LDA(dst, b, h) do { _Pragma("unroll") for (int m = 0; m < 4; ++m) _Pragma("unroll") for (int k = 0; k < 2; ++k) dst[m][k] = *(const LAS bf16x8*)(lds + PG8_SA(b, h) + aoff + m * 2048 + k * 1024); } while (0)
#define PG8_LDB(dst, b, h) do { _Pragma("unroll") for (int n = 0; n < 2; ++n) _Pragma("unroll") for (int k = 0; k < 2; ++k) dst[n][k] = *(const LAS bf16x8*)(lds + PG8_SB(b, h) + boff + n * 2048 + k * 1024); } while (0)
#define PG8_MMA(ai, bj, At, Bt) do { __builtin_amdgcn_s_setprio(1); _Pragma("unroll") for (int m = 0; m < 4; ++m) _Pragma("unroll") for (int n = 0; n < 2; ++n) _Pragma("unroll") for (int k = 0; k < 2; ++k) \
        acc[ai][bj][m][n] = __builtin_amdgcn_mfma_f32_16x16x32_bf16(Bt[n][k], At[m][k], acc[ai][bj][m][n], 0, 0, 0); __builtin_amdgcn_s_setprio(0); } while (0)
#define PG8_WAIT_V(n) asm volatile("s_waitcnt vmcnt(" #n ")" ::: "memory")
#define PG8_WAIT_L(n) asm volatile("s_waitcnt lgkmcnt(" #n ")" ::: "memory")
#define PG8_BAR __builtin_amdgcn_s_barrier()
#define PG8_SCHED __builtin_amdgcn_sched_barrier(0)
#define PG8_VB1(dst, u) do { if (MIRB && S.b_mirror(u)) { const bool fx_ = S.b_fix(u); dst[0] = voffM[0] - (fx_ ? fixd[0] : 0u); dst[1] = voffM[1] - (fx_ ? fixd[1] : 0u); } else { dst[0] = voffB[0]; dst[1] = voffB[1]; } } while (0)
    Unit cur, nxt; int ui = 0;
    if (!S.next(0, cur)) return;
    f32x4 acc[2][2][4][2];
#pragma unroll
    for (int a = 0; a < 2; ++a)
#pragma unroll
        for (int b = 0; b < 2; ++b)
#pragma unroll
            for (int m = 0; m < 4; ++m)
#pragma unroll
                for (int n = 0; n < 2; ++n) acc[a][b][m][n] = (f32x4){0.f, 0.f, 0.f, 0.f};
    bf16x8 At[4][2], B0[2][2], B1[2][2];
    const char* cA = S.a_ptr(g, cur); const char* cB0 = S.b_ptr(g, cur, 0); const char* cB1 = S.b_ptr(g, cur, 1);
    unsigned vc1[2]; PG8_VB1(vc1, cur);
    PG8_STAGE(PG8_SB(0, 0), cB0, voffB); PG8_STAGE(PG8_SB(0, 1), cB1, vc1); PG8_STAGE(PG8_SA(0, 0), cA, voffA); PG8_STAGE(PG8_SA(0, 1), cA + hstepA, voffA);
    if (wr == 1) PG8_BAR;
    PG8_WAIT_V(2); PG8_BAR;
    PG8_STAGE(PG8_SB(1, 0), cB0 + kstep, voffB); PG8_STAGE(PG8_SA(1, 0), cA + kstep, voffA); PG8_STAGE(PG8_SB(1, 1), cB1 + kstep, vc1);
    PG8_WAIT_V(6); PG8_BAR;
    for (;;) {
        const bool has_next = S.next(ui + 1, nxt);
        const char* nA = cA; const char* nB0 = cB0; const char* nB1 = cB1; unsigned vn1[2] = {vc1[0], vc1[1]};
        if (has_next) { nA = S.a_ptr(g, nxt); nB0 = S.b_ptr(g, nxt, 0); nB1 = S.b_ptr(g, nxt, 1); PG8_VB1(vn1, nxt); }
        for (int t = 0; t < nt; t += 2) {
            const bool last = (t == nt - 2);
            const char* a1 = cA + (size_t)(t + 1) * kstep;
            const char* a2 = last ? nA : cA + (size_t)(t + 2) * kstep; const char* b20 = last ? nB0 : cB0 + (size_t)(t + 2) * kstep; const char* b21 = last ? nB1 : cB1 + (size_t)(t + 2) * kstep;
            const char* a3 = a2 + kstep; const char* b30 = b20 + kstep; const char* b31 = b21 + kstep;
            unsigned v21[2]; v21[0] = (MIRB && last) ? vn1[0] : vc1[0]; v21[1] = (MIRB && last) ? vn1[1] : vc1[1];
            PG8_LDB(B0, 0, 0); PG8_LDB(B1, 0, 1); PG8_SCHED; PG8_LDA(At, 0, 0); PG8_STAGE(PG8_SA(1, 1), a1 + hstepA, voffA);
            PG8_WAIT_V(8); PG8_WAIT_L(0); PG8_BAR; PG8_MMA(0, 0, At, B0); PG8_MMA(0, 1, At, B1); PG8_BAR; PG8_SCHED;
            PG8_LDA(At, 0, 1); PG8_STAGE(PG8_SB(0, 0), b20, voffB); PG8_STAGE(PG8_SB(0, 1), b21, v21); PG8_STAGE(PG8_SA(0, 0), a2, voffA);
            PG8_WAIT_V(8); PG8_WAIT_L(0); PG8_BAR; PG8_MMA(1, 0, At, B0); PG8_MMA(1, 1, At, B1); PG8_BAR; PG8_SCHED;
            PG8_LDB(B0, 1, 0); PG8_LDB(B1, 1, 1); PG8_SCHED; PG8_LDA(At, 1, 0); PG8_STAGE(PG8_SA(0, 1), a2 + hstepA, voffA);
            PG8_WAIT_V(8); PG8_WAIT_L(0); PG8_BAR; PG8_MMA(0, 0, At, B0); PG8_MMA(0, 1, At, B1); PG8_BAR; PG8_SCHED;
            PG8_LDA(At, 1, 1); PG8_STAGE(PG8_SB(1, 0), b30, voffB); PG8_STAGE(PG8_SB(1, 1), b31, v21); PG8_STAGE(PG8_SA(1, 0), a3, voffA);
            PG8_WAIT_V(8); PG8_WAIT_L(0); PG8_BAR; PG8_MMA(1, 0, At, B0); PG8_MMA(1, 1, At, B1); PG8_BAR; PG8_SCHED;
        }
        if (wr == 0) PG8_BAR;
        { int l2 = lane; asm volatile("" : "+v"(l2)); E(acc, cur, wr, wc, l2 & 15, l2 >> 4); }
        if (!has_next) break;
#pragma unroll
        for (int a = 0; a < 2; ++a)
#pragma unroll
            for (int b = 0; b < 2; ++b)
#pragma unroll
                for (int m = 0; m < 4; ++m)
#pragma unroll
                    for (int n = 0; n < 2; ++n) acc[a][b][m][n] = (f32x4){0.f, 0.f, 0.f, 0.f};
        cur = nxt; cA = nA; cB0 = nB0; cB1 = nB1; vc1[0] = vn1[0]; vc1[1] = vn1[1]; ++ui;
        if (wr == 1) PG8_BAR;
    }
    PG8_WAIT_V(0);
    PG8_BAR;
#undef PG8_SA
#undef PG8_SB
#undef PG8_STAGE
#undef PG8_LDA
#undef PG8_LDB
#undef PG8_MMA
#undef PG8_WAIT_V
#undef PG8_WAIT_L
#undef PG8_BAR
#undef PG8_SCHED
#undef PG8_VB1
}
}
using pg8::cvt_pk_bf16;
__device__ __forceinline__ void stg16(void* ub, unsigned vo, u32x4 v) { *(GAS u32x4*)((GAS unsigned char*)ub + vo) = v; }
__device__ __forceinline__ u32x4 ldg16u(const void* ub, unsigned vo) { return *(const GAS u32x4*)((const GAS unsigned char*)ub + vo); }
__device__ __forceinline__ void stg16f(void* ub, unsigned vo, f32x4 v) { *(GAS f32x4*)((GAS unsigned char*)ub + vo) = v; }
__device__ __forceinline__ f32x4 ldg16f(const void* ub, unsigned vo) { return *(const GAS f32x4*)((const GAS unsigned char*)ub + vo); }
typedef const f32x4 (&AccRef)[2][2][4][2];

struct EpiSilu {
    static constexpr bool PERM = true;
    bf16_t* O; int ldc;
    __device__ __forceinline__ void operator()(AccRef acc, const pg8::Unit& u, int wr, int wc, int fr, int fq) const {
        bf16_t* ub = O + (size_t)u.pm * 256 * ldc + u.pn * 256; const unsigned vo = (unsigned)((wr * 64 + fr) * ldc + wc * 32 + 8 * fq) * 2u;
#pragma unroll
        for (int ai = 0; ai < 2; ++ai)
#pragma unroll
            for (int m = 0; m < 4; ++m)
#pragma unroll
                for (int bj = 0; bj < 2; ++bj) { const f32x4 v0 = acc[ai][bj][m][0], v1 = acc[ai][bj][m][1]; u32x4 w;
                    w.x = cvt_pk_bf16(silu_f(v0[0]), silu_f(v0[1])); w.y = cvt_pk_bf16(silu_f(v0[2]), silu_f(v0[3]));
                    w.z = cvt_pk_bf16(silu_f(v1[0]), silu_f(v1[1])); w.w = cvt_pk_bf16(silu_f(v1[2]), silu_f(v1[3]));
                    stg16(ub + (size_t)(ai * 128 + m * 16) * ldc, vo + (unsigned)(bj * 256), w); }
    }
};
struct UOrder : pg8::TileOrder {
    __device__ __forceinline__ const char* b_ptr(const pg8::Gemm& g, const pg8::Unit& u, int half) const {
        if (u.pn < 64) { const int b = u.pn >> 3, tp = u.pn & 7; return (const char*)(g.Bt + (size_t)(b * 2048 + (half ? 1024 - 128 * tp : 128 * tp)) * 1024); }
        return (const char*)(g.Bt + (size_t)(NLAT + (u.pn - 64) * 256 + 128 * half) * 1024);
    }
    __device__ __forceinline__ bool b_mirror(const pg8::Unit& u) const { return u.pn < 64; }
    __device__ __forceinline__ bool b_fix(const pg8::Unit& u) const { return (u.pn & 7) == 0; }
};
struct EpiUTF {
    static constexpr bool PERM = true;
    bf16_t* UTF; bf16_t* UTc; float* AH;
    __device__ __forceinline__ void operator()(AccRef acc, const pg8::Unit& u, int wr, int wc, int fr, int fq) const {
        const int feat0 = u.pm * 256 + wr * 64 + fr, col0 = wc * 32 + 8 * fq;
        if (u.pn >= 64) { bf16_t* ub = UTc + (size_t)(u.pn - 64) * 2048 * 256 + (size_t)u.pm * 256 * 256; const unsigned vo = (unsigned)((wr * 64 + fr) * 256 + col0) * 2u;
#pragma unroll
            for (int ai = 0; ai < 2; ++ai)
#pragma unroll
                for (int m = 0; m < 4; ++m)
#pragma unroll
                    for (int bj = 0; bj < 2; ++bj) { const f32x4 v0 = acc[ai][bj][m][0], v1 = acc[ai][bj][m][1]; u32x4 w;
                        w.x = cvt_pk_bf16(v0[0], v0[1]); w.y = cvt_pk_bf16(v0[2], v0[3]); w.z = cvt_pk_bf16(v1[0], v1[1]); w.w = cvt_pk_bf16(v1[2], v1[3]);
                        stg16(ub + (size_t)(ai * 128 + m * 16) * 256, vo + (unsigned)(bj * 256), w); }
            return; }
        const int b = u.pn >> 3, tp = u.pn & 7; const bool first = (tp == 0) && (col0 == 0);
        bf16_t* ub = UTF + ((size_t)b * 2048 + u.pm * 256) * 1024 + 128 * tp; const unsigned vo = (unsigned)((wr * 64 + fr) * 1024 + col0) * 2u;
#pragma unroll
        for (int ai = 0; ai < 2; ++ai)
#pragma unroll
            for (int m = 0; m < 4; ++m) { const int feat = feat0 + ai * 128 + m * 16; const float sg = ((feat & 255) <= 128) ? 1.f : -1.f;
                f32x4 v0 = acc[ai][0][m][0] + acc[ai][1][m][0] * sg; const f32x4 v1 = acc[ai][0][m][1] + acc[ai][1][m][1] * sg;
                if (first) { v0[0] = acc[ai][0][m][0][0]; AH[(size_t)b * 2048 + feat] = acc[ai][1][m][0][0]; }
                u32x4 w; w.x = cvt_pk_bf16(v0[0], v0[1]); w.y = cvt_pk_bf16(v0[2], v0[3]); w.z = cvt_pk_bf16(v1[0], v1[1]); w.w = cvt_pk_bf16(v1[2], v1[3]);
                stg16(ub + (size_t)(ai * 128 + m * 16) * 1024, vo, w); }
    }
};
__device__ __forceinline__ void dft_row_out(bf16_t* zrow, int mi0, const float (&d)[8], const float (&mr)[8]) {
    const u32x4 zd = *(const u32x4*)(zrow + mi0); const u32x4 zm = *(const u32x4*)(zrow + 248 - mi0);
    u32x4 o; o.x = cvt_pk_bf16(d[0] * bflo(zd.x), d[1] * bfhi(zd.x)); o.y = cvt_pk_bf16(d[2] * bflo(zd.y), d[3] * bfhi(zd.y));
    o.z = cvt_pk_bf16(d[4] * bflo(zd.z), d[5] * bfhi(zd.z)); o.w = cvt_pk_bf16(d[6] * bflo(zd.w), d[7] * bfhi(zd.w));
    *(u32x4*)(zrow + mi0) = o;
    bf16_t* mp = zrow + 248 - mi0;
    mp[1] = (bf16_t)f2bf(mr[7] * bfhi(zm.x));
    *(unsigned*)(mp + 2) = cvt_pk_bf16(mr[6] * bflo(zm.y), mr[5] * bfhi(zm.y));
    u32x2 w; w.x = cvt_pk_bf16(mr[4] * bflo(zm.z), mr[3] * bfhi(zm.z)); w.y = cvt_pk_bf16(mr[2] * bflo(zm.w), mr[1] * bfhi(zm.w));
    *(u32x2*)(mp + 4) = w;
    if (mi0 >= 8) mp[8] = (bf16_t)f2bf(mr[0] * bf1(mp[8]));
}
template <bool FOLD> struct EpiDft {
    static constexpr bool PERM = true;
    bf16_t* Z; int L; int tok_base; const float* AH;
    __device__ __forceinline__ void operator()(AccRef acc, const pg8::Unit& u, int wr, int wc, int fr, int fq) const {
        const int b = u.pn >> 3, g = u.pn & 7, k0 = u.pm * 128 + wr * 64 + fr, mi0 = wc * 32 + 8 * fq;
        f32x4 ah[2] = {(f32x4){0.f, 0.f, 0.f, 0.f}, (f32x4){0.f, 0.f, 0.f, 0.f}}; float ahn = 0.f;
        if (FOLD) { const float* ap = AH + (size_t)b * 2048 + g * 256; ah[0] = *(const f32x4*)(ap + mi0) * 0.022097087f; ah[1] = *(const f32x4*)(ap + mi0 + 4) * 0.022097087f; ahn = ap[128] * 0.022097087f; }
#pragma unroll
        for (int m = 0; m < 4; ++m) {
            const int k = k0 + 16 * m; bf16_t* zrow = Z + (size_t)(tok_base + b * L + k) * 2048 + g * 256;
            bf16_t* zmir = Z + (size_t)(tok_base + b * L + (L - k)) * 2048 + g * 256;
            const float sg = (k & 1) ? -1.f : 1.f;
            float dm[8], sm[8];
#pragma unroll
            for (int n = 0; n < 2; ++n) { f32x4 P = acc[0][0][m][n]; const f32x4 Q = acc[1][1][m][n]; if (FOLD) P = P + ah[n] * sg;
#pragma unroll
                for (int e = 0; e < 4; ++e) { dm[4 * n + e] = P[e] - Q[e]; sm[4 * n + e] = P[e] + Q[e]; }
                if (n == 0 && mi0 == 0) { dm[0] = P[0]; sm[0] = P[0]; } }
            dft_row_out(zrow, mi0, dm, sm);
            if (FOLD && k >= 1) dft_row_out(zmir, mi0, sm, dm);
            if (wc == 0 && fq == 0) { const float yn = acc[0][1][m][0][0] + (FOLD ? ahn * sg : 0.f);
                zrow[128] = (bf16_t)f2bf(yn * bf1(zrow[128]));
                if (FOLD && k >= 1) zmir[128] = (bf16_t)f2bf(yn * bf1(zmir[128])); }
            asm volatile("" ::: "memory");
        }
    }
};
struct EpiResid {
    static constexpr bool PERM = false;
    const float* xin_lat; const float* xin_ctx; float* xout_lat; float* xout_ctx; const float* gate;
    __device__ __forceinline__ void operator()(AccRef acc, const pg8::Unit& u, int wr, int wc, int fr, int fq) const {
        const int row0 = u.pm * 256 + wr * 64 + fr, col0 = u.pn * 256 + wc * 32 + 4 * fq;
        const bool lat = u.pm < 64; const int r = lat ? (u.pm >> 3) : 8;
        const float* xi = lat ? xin_lat : xin_ctx - (size_t)NLAT * DM; float* xo = lat ? xout_lat : xout_ctx - (size_t)NLAT * DM;
        const float* gp = gate + r * 3072 + col0;
        f32x4 gv[2][2];
#pragma unroll
        for (int bj = 0; bj < 2; ++bj)
#pragma unroll
            for (int n = 0; n < 2; ++n) gv[bj][n] = *(const f32x4*)(gp + bj * 128 + n * 16);
#pragma unroll
        for (int ai = 0; ai < 2; ++ai)
#pragma unroll
            for (int m = 0; m < 4; ++m) { const size_t off = (size_t)(row0 + ai * 128 + m * 16) * DM + col0;
#pragma unroll
                for (int bj = 0; bj < 2; ++bj)
#pragma unroll
                    for (int n = 0; n < 2; ++n) { const f32x4 xv = *(const f32x4*)(xi + off + bj * 128 + n * 16);
                        *(f32x4*)(xo + off + bj * 128 + n * 16) = xv + gv[bj][n] * acc[ai][bj][m][n]; }
                asm volatile("" ::: "memory"); }
    }
};
struct EpiQKV {
    static constexpr bool PERM = true;
    bf16_t* Q; bf16_t* K; bf16_t* V; const float* rcos; const float* rsin;
    __device__ __forceinline__ void operator()(AccRef acc, const pg8::Unit& u, int wr, int wc, int fr, int fq) const {
        const int row0 = u.pm * 256 + wr * 64 + fr, c0 = wc * 32 + 8 * fq;
        if (u.pn >= 8) {
#pragma unroll
            for (int ai = 0; ai < 2; ++ai)
#pragma unroll
                for (int m = 0; m < 4; ++m) { bf16_t* rowp = V + (size_t)(row0 + ai * 128 + m * 16) * 2048 + (u.pn - 8) * 256 + c0;
#pragma unroll
                    for (int bj = 0; bj < 2; ++bj) { const f32x4 v0 = acc[ai][bj][m][0], v1 = acc[ai][bj][m][1]; u32x4 w;
                        w.x = cvt_pk_bf16(v0[0], v0[1]); w.y = cvt_pk_bf16(v0[2], v0[3]); w.z = cvt_pk_bf16(v1[0], v1[1]); w.w = cvt_pk_bf16(v1[2], v1[3]);
                        *(u32x4*)(rowp + bj * 128) = w; } }
            return;
        }
        const bool isk = u.pn >= 4, lat = u.pm < 64; const int h = u.pn & 3; bf16_t* dst = isk ? K : Q; const float sc = isk ? 0.0625f : 1.0f;
        const int i0 = 16 * wc + 4 * fq;
#pragma unroll
        for (int ai = 0; ai < 2; ++ai)
#pragma unroll
            for (int m = 0; m < 4; ++m) { const int row = row0 + ai * 128 + m * 16, l = row & 2047; bf16_t* rowp = dst + (size_t)row * 1024 + h * 256 + c0;
#pragma unroll
                for (int bj = 0; bj < 2; ++bj) { f32x4 x1 = acc[ai][bj][m][0], x2 = acc[ai][bj][m][1];
                    if (lat) { const int pos = bj == 0 ? (l >> 6) : (l & 63); const f32x4 cv = *(const f32x4*)(rcos + pos * 64 + i0), sv = *(const f32x4*)(rsin + pos * 64 + i0);
                        const f32x4 o1 = x1 * cv - x2 * sv, o2 = x1 * sv + x2 * cv; x1 = o1; x2 = o2; }
                    x1 = x1 * sc; x2 = x2 * sc; u32x4 w;
                    w.x = cvt_pk_bf16(x1[0], x1[1]); w.y = cvt_pk_bf16(x1[2], x1[3]); w.z = cvt_pk_bf16(x2[0], x2[1]); w.w = cvt_pk_bf16(x2[2], x2[3]);
                    *(u32x4*)(rowp + bj * 128) = w; } }
    }
};
struct EpiZGate {
    static constexpr bool PERM = true;
    const bf16_t* O; const float* rinv; bf16_t* AO;
    __device__ __forceinline__ void operator()(AccRef acc, const pg8::Unit& u, int wr, int wc, int fr, int fq) const {
        const int row0 = u.pm * 256 + wr * 64 + fr, col0 = u.pn * 256 + wc * 32 + 8 * fq, head = u.pn >> 1;
#pragma unroll
        for (int ai = 0; ai < 2; ++ai)
#pragma unroll
            for (int m = 0; m < 4; ++m) { const int row = row0 + ai * 128 + m * 16; const float rv = rinv[row * 4 + head];
#pragma unroll
                for (int bj = 0; bj < 2; ++bj) { const size_t off = (size_t)row * 2048 + col0 + bj * 128; const u32x4 o = *(const u32x4*)(O + off);
                    const f32x4 v0 = acc[ai][bj][m][0], v1 = acc[ai][bj][m][1]; u32x4 w;
                    w.x = cvt_pk_bf16(bflo(o.x) * rv * silu_f(v0[0]), bfhi(o.x) * rv * silu_f(v0[1])); w.y = cvt_pk_bf16(bflo(o.y) * rv * silu_f(v0[2]), bfhi(o.y) * rv * silu_f(v0[3]));
                    w.z = cvt_pk_bf16(bflo(o.z) * rv * silu_f(v1[0]), bfhi(o.z) * rv * silu_f(v1[1])); w.w = cvt_pk_bf16(bflo(o.w) * rv * silu_f(v1[2]), bfhi(o.w) * rv * silu_f(v1[3]));
                    *(u32x4*)(AO + off) = w; } }
    }
};

#define XB_TMO      128
#define XB_XCNT(j)  (256  + 64 * (j))
#define XB_XSUB(j)  (1280 + 64 * (j))
#define XB_XGEN(j)  (2304 + 64 * (j))
#define XB_TOP      3328
#define XB_TOPGEN   3392
#define XCD_BAR_WORDS 3456
#define XB_SPIN_CAP (1u << 18)
__device__ __forceinline__ unsigned xb_ld(unsigned* p)              { return __hip_atomic_load(p, __ATOMIC_RELAXED, __HIP_MEMORY_SCOPE_AGENT); }
__device__ __forceinline__ unsigned xb_add(unsigned* p, unsigned v) { return __hip_atomic_fetch_add(p, v, __ATOMIC_RELAXED, __HIP_MEMORY_SCOPE_AGENT); }
__device__ __forceinline__ unsigned xb_xcc_id() { return (unsigned)__builtin_amdgcn_s_getreg((3 << 11) | 20) & 0xFu; }
#define XB_SPIN(cond, bar) do { unsigned _sp = 0; while (cond) { __builtin_amdgcn_s_sleep(1); \
    if ((++_sp & 255u) == 0u) { if (xb_ld(&(bar)[XB_TMO])) break; if (_sp > XB_SPIN_CAP) { atomicAdd(&(bar)[XB_TMO], 1u); break; } } } } while (0)
struct XcdBarrier { unsigned* bar; unsigned x; volatile LAS unsigned* st; };
__device__ __forceinline__ XcdBarrier xcd_barrier_post(unsigned* bar, volatile LAS unsigned* st) {
    XcdBarrier b; b.bar = bar; b.x = xb_xcc_id(); b.st = st;
    if (threadIdx.x == 0) (void)xb_add(&bar[XB_XCNT(b.x)], 1u);
    return b;
}
__device__ __forceinline__ void xcd_barrier_complete(unsigned* bar, unsigned x, unsigned& nloc, unsigned& nx) {
    const unsigned G = gridDim.x * gridDim.y * gridDim.z;
    unsigned sum, cnt, mine, sp = 0u;
    for (;;) {
        sum = 0u; cnt = 0u; mine = 0u;
#pragma unroll
        for (unsigned j = 0; j < 16; ++j) { const unsigned c = xb_ld(&bar[XB_XCNT(j)]); sum += c; cnt += (c > 0u) ? 1u : 0u; mine = (j == x) ? c : mine; }
        if (sum == G) break;
        __builtin_amdgcn_s_sleep(1);
        if ((++sp & 255u) == 0u) { if (xb_ld(&bar[XB_TMO])) break; if (sp > XB_SPIN_CAP) { atomicAdd(&bar[XB_TMO], 1u); break; } }
    }
    nloc = mine > 0u ? mine : 1u; nx = cnt > 0u ? cnt : 1u;
}
__device__ __forceinline__ void xcd_barrier(const XcdBarrier& b) {
    asm volatile("s_waitcnt vmcnt(0)" ::: "memory");
    __syncthreads();
    if (threadIdx.x == 0) {
        unsigned* bar = b.bar;
        __builtin_amdgcn_s_waitcnt(0);
        unsigned nloc = b.st[0], nx = b.st[1];
        if (nloc == 0u) { xcd_barrier_complete(bar, b.x, nloc, nx); b.st[0] = nloc; b.st[1] = nx; }
        const unsigned old = xb_add(&bar[XB_XSUB(b.x)], 1u);
        const unsigned gen = old / nloc;
        if (old + 1u == (gen + 1u) * nloc) {
            __builtin_amdgcn_fence(__ATOMIC_RELEASE, "agent");
            asm volatile("s_waitcnt vmcnt(0)" ::: "memory");
            const unsigned og = xb_add(&bar[XB_TOP], 1u);
            const unsigned tg = og / nx;
            if (og + 1u == (tg + 1u) * nx) xb_add(&bar[XB_TOPGEN], 1u);
            else XB_SPIN(xb_ld(&bar[XB_TOPGEN]) == tg, bar);
            __builtin_amdgcn_fence(__ATOMIC_ACQUIRE, "agent");
            xb_add(&bar[XB_XGEN(b.x)], 1u);
            asm volatile("s_waitcnt vmcnt(0)" ::: "memory");
        } else {
            XB_SPIN(xb_ld(&bar[XB_XGEN(b.x)]) == gen, bar);
            __builtin_amdgcn_fence(__ATOMIC_ACQUIRE, "agent");
            asm volatile("s_waitcnt vmcnt(0)" ::: "memory");
        }
    }
    __syncthreads();
}

struct Args { const float* in[13]; float* out; unsigned char* ws; int ph_lo, ph_hi, pad0, pad1; };
struct Frame {
    LAS unsigned char* lds;
    int vcu, G, wv;
    unsigned char* ws;
};
__device__ __forceinline__ int lane_id() { int l; asm volatile("v_mbcnt_lo_u32_b32 %0, -1, 0\n\tv_mbcnt_hi_u32_b32 %0, -1, %0" : "=v"(l)); return l; }
__device__ __forceinline__ unsigned char* launder_ptr(unsigned char* p) {
    unsigned lo = (unsigned)(unsigned long long)p, hi = (unsigned)((unsigned long long)p >> 32);
    asm volatile("" : "+s"(lo), "+s"(hi));
    return (unsigned char*)(((unsigned long long)hi << 32) | lo);
}
#define PHASE_IDS() int tid = F.wv * 64 + lane_id(); asm volatile("" : "+v"(tid)); const int lane = tid & 63, wave = __builtin_amdgcn_readfirstlane(tid >> 6); (void)lane; (void)wave; \
    unsigned char* ws = launder_ptr(F.ws); (void)ws
#define LDS_WAIT() asm volatile("s_waitcnt lgkmcnt(0)" ::: "memory")

__device__ __forceinline__ int qk_pos(int d) { const int half = d >> 7, n = (d >> 6) & 1, i = d & 63; return 128 * half + 8 * (i >> 2) + 4 * n + (i & 3); }
template <int MODE>
__device__ __forceinline__ void transpose_item(const float* W, int K, int N, int n_begin, bf16_t* WT, LAS float* scr, int item, int nblk, int lane) {
    const int kb = item / nblk, nb = item % nblk, k0 = 64 * kb, n0 = n_begin + 32 * nb;
#pragma unroll 8
    for (int i = 0; i < 32; ++i) { const int kk = 2 * i + (lane >> 5); scr[kk * 33 + (lane & 31)] = W[(size_t)(k0 + kk) * N + n0 + (lane & 31)]; }
    LDS_WAIT(); asm volatile("" ::: "memory");
    const int c = lane & 7;
#pragma unroll
    for (int j = 0; j < 4; ++j) { const int n = (lane >> 3) + 8 * j; const LAS float* s = scr + (8 * c) * 33 + n;
        u32x4 o; o.x = pk2(s[0 * 33], s[1 * 33]); o.y = pk2(s[2 * 33], s[3 * 33]); o.z = pk2(s[4 * 33], s[5 * 33]); o.w = pk2(s[6 * 33], s[7 * 33]);
        int nn = n0 + n - n_begin;
        if (MODE == 1) { const int na = n0 + n; nn = (na < 2048) ? ((na & ~255) + qk_pos(na & 255)) : na; }
        *(u32x4*)(WT + (size_t)nn * K + k0 + 8 * c) = o; }
    LDS_WAIT(); asm volatile("" ::: "memory");
}
__device__ __forceinline__ void fold_task(const float* Win  , const float* TC, bf16_t* WfT, int t, int lane) {
    const int g = t >> 8, p0 = ((t >> 5) & 7) * 32, kk0 = (t & 31) * 32, s = lane >> 5, li = lane & 31;
    f32x16 acc;
#pragma unroll
    for (int i = 0; i < 16; ++i) acc[i] = 0.f;
    const float* wrow = Win + (size_t)(kk0 + li) * 4096 + g * 256 + 4 * s;
    const float* tcol = TC + p0 + li;
#pragma unroll 4
    for (int tp = 0; tp < 32; ++tp) {
        const f32x4 wv = *(const f32x4*)(wrow + 8 * tp);
#pragma unroll
        for (int uu = 0; uu < 4; ++uu) { const float a = tcol[(8 * tp + 4 * s + uu) * 256]; acc = __builtin_amdgcn_mfma_f32_32x32x2f32(a, wv[uu], acc, 0, 0, 0); }
    }
#pragma unroll
    for (int i = 0; i < 16; ++i) { const int row = (i & 3) + 8 * (i >> 2) + 4 * s; WfT[(size_t)(g * 256 + p0 + row) * 1024 + kk0 + li] = (bf16_t)f2bf(acc[i]); }
}

__device__ __forceinline__ void p0_phase(Frame& F, const Args& a) {
    PHASE_IDS();
    float* ADA = (float*)(ws + WS_ADA);
    const float* c = a.in[1]; const float* cctx = a.in[3]; const float* ada_w = a.in[5]; const float* ada_b = a.in[6];
    LAS float* sl = (LAS float*)F.lds;
    LAS float* part = (LAS float*)(F.lds + 36864);
    bool loaded = false;
#ifndef DBG_P0
#define DBG_P0 3
#endif
    if (DBG_P0 & 1)
    for (int u = F.vcu; u < 192; u += F.G) {
        if (!loaded) { for (int idx = tid; idx < 9 * 1024; idx += 512) { const int r = idx >> 10, k = idx & 1023; const float x = r < 8 ? c[r * 1024 + k] : cctx[k]; sl[idx] = x / (1.f + expf(-x)); } loaded = true; }
        __syncthreads();
        const int i = u / 48, n0 = (u % 48) * 64;
        float acc[9];
#pragma unroll
        for (int r = 0; r < 9; ++r) acc[r] = 0.f;
        const float* wp = ada_w + ((size_t)i * 1024 + wave * 128) * 3072 + n0 + lane;
#pragma unroll 8
        for (int kk = 0; kk < 128; ++kk) { const float wv = wp[(size_t)kk * 3072]; const int k = wave * 128 + kk;
#pragma unroll
            for (int r = 0; r < 9; ++r) acc[r] += sl[r * 1024 + k] * wv; }
#pragma unroll
        for (int r = 0; r < 9; ++r) part[(wave * 9 + r) * 64 + lane] = acc[r];
        __syncthreads();
        for (int idx = tid; idx < 576; idx += 512) { const int r = idx >> 6, l = idx & 63; float s = 0.f;
#pragma unroll
            for (int w = 0; w < 8; ++w) s += part[(w * 9 + r) * 64 + l];
            ADA[(i * 9 + r) * 3072 + n0 + l] = s + ada_b[i * 3072 + n0 + l]; }
    }
    if (!(DBG_P0 & 2)) return;
    const int gt = F.vcu * 512 + tid, NT = F.G * 512;
    float* TC = (float*)(ws + WS_TC);
    for (int idx = gt; idx < 65536; idx += NT) { const int cc = idx >> 8, p = idx & 255; float v;
        if (p < 128) v = cospif((float)((p * cc) & 255) * (1.f / 128.f));
        else if (p == 128) v = (cc & 1) ? -1.f : 1.f;
        else v = sinpif((float)(((p - 128) * cc) & 255) * (1.f / 128.f));
        TC[idx] = v * 0.0625f; }
    float* RC = (float*)(ws + WS_ROPE); float* RS = RC + 4096;
    for (int idx = gt; idx < 4096; idx += NT) { const int pos = idx >> 6, i = idx & 63; const float freq = powf(10000.0f, -(float)i / 64.0f); const float ang = (float)pos * freq;
        RC[idx] = cosf(ang); RS[idx] = sinf(ang); }
    bf16_t* CS256 = (bf16_t*)(ws + WS_CS256);
    for (int idx = gt; idx < 512 * 256; idx += NT) { const int row = idx >> 8, l = idx & 255, kt = row >> 8, hf = (row >> 7) & 1, k = kt * 128 + (row & 127);
        const float x = (float)((k * l) & 255) * (1.f / 128.f); const float v = (hf ? sinpif(x) : cospif(x)) * 0.0625f; CS256[idx] = (bf16_t)f2bf(v); }
}

__device__ __forceinline__ void norm_row(const float* xrow, const float* ng, const float* adar  , bf16_t* orow, int lane) {
    const f32x4* xr = (const f32x4*)xrow + lane;
    f32x4 v[4]; float s = 0.f;
#pragma unroll
    for (int j = 0; j < 4; ++j) { v[j] = xr[64 * j]; s += (v[j].x * v[j].x + v[j].y * v[j].y) + (v[j].z * v[j].z + v[j].w * v[j].w); }
    const float rinv = rsqrtf(wave_sum(s, lane) * (1.f / DM) + EPS);
    unsigned long long* o8 = (unsigned long long*)orow + lane;
#pragma unroll
    for (int j = 0; j < 4; ++j) { const int col = 4 * lane + 256 * j; const f32x4 g = *(const f32x4*)(ng + col), sh = *(const f32x4*)(adar + col), sc = *(const f32x4*)(adar + 1024 + col);
        const f32x4 y = v[j] * rinv * g * (sc + 1.0f) + sh;
        o8[64 * j] = (unsigned long long)pk2(y.x, y.y) | ((unsigned long long)pk2(y.z, y.w) << 32); }
}
__device__ __forceinline__ void norm_rows(Frame& F, const Args& a, int layer, bf16_t* H) {
    PHASE_IDS();
    const float* xl = layer == 0 ? a.in[0] : a.out; const float* xc = layer == 0 ? a.in[2] : (const float*)(ws + WS_XCTX);
    const float* ng = a.in[4] + layer * DM; const float* ADA = (const float*)(ws + WS_ADA) + layer * 9 * 3072;
    const int gw = F.vcu * 8 + wave, NGW = F.G * 8;
    for (int m = gw; m < NTOK; m += NGW) {
        const bool lat = m < NLAT; const int r = lat ? (m >> 11) : 8;
        const float* xrow = lat ? xl + (size_t)m * DM : xc + (size_t)(m - NLAT) * DM;
        norm_row(xrow, ng, ADA + r * 3072, H + (size_t)m * DM, lane);
    }
}
__device__ __forceinline__ void n_phase(Frame& F, const Args& a, int layer) {
    PHASE_IDS();
    const bool fourier = (layer & 1) == 0; const int j = layer >> 1;
    norm_rows(F, a, layer, (bf16_t*)(ws + (fourier ? WS_H : WS_OF)));
    LAS float* scr = (LAS float*)(F.lds + wave * 16384);
    const int gw = F.vcu * 8 + wave, NGW = F.G * 8;
    bf16_t* W1 = (bf16_t*)(ws + WS_W);
    if (fourier) {
        const float* win = a.in[7] + (size_t)j * 1024 * 4096; const float* wout = a.in[8] + (size_t)j * 2048 * 1024;
        bf16_t* WfoT = W1 + (size_t)4096 * 1024;
        for (int t = gw; t < 2048; t += NGW) fold_task(win, (const float*)(ws + WS_TC), W1, t, lane);
        for (int it = gw; it < 16 * 64; it += NGW) transpose_item<0>(win, 1024, 4096, 2048, W1 + (size_t)2048 * 1024, scr, it, 64, lane);
        for (int it = gw; it < 32 * 32; it += NGW) transpose_item<0>(wout, 2048, 1024, 0, WfoT, scr, it, 32, lane);
        bf16_t* CS = (bf16_t*)(ws + WS_CS);
        const int gt = F.vcu * 512 + tid, NT = F.G * 512;
        for (int ch = gt; ch < 2048 * 128; ch += NT) { const int row = ch >> 7, l0 = (ch & 127) * 8, kt = row >> 8, hf = (row >> 7) & 1, k = kt * 128 + (row & 127);
            unsigned w[4];
#pragma unroll
            for (int e = 0; e < 4; ++e) { float v[2];
#pragma unroll
                for (int q = 0; q < 2; ++q) { const int l = l0 + 2 * e + q; const float x = (float)((k * l) & 2047) * (1.f / 1024.f); v[q] = (hf ? sinpif(x) : cospif(x)) * 0.022097087f; }
                w[e] = pk2(v[0], v[1]); }
            *(u32x4*)(CS + (size_t)row * 1024 + l0) = (u32x4){w[0], w[1], w[2], w[3]}; }
    } else {
        const float* win = a.in[9] + (size_t)j * 1024 * 6144; const float* wout = a.in[10] + (size_t)j * 2048 * 1024;
        bf16_t* WroT = W1 + (size_t)6144 * 1024;
        for (int it = gw; it < 16 * 192; it += NGW) transpose_item<1>(win, 1024, 6144, 0, W1, scr, it, 192, lane);
        for (int it = gw; it < 32 * 32; it += NGW) transpose_item<0>(wout, 2048, 1024, 0, WroT, scr, it, 32, lane);
    }
}

__device__ __forceinline__ void nyq_row_phase(Frame& F) {
    PHASE_IDS();
    const bf16_t* UTF = (const bf16_t*)(ws + WS_UTL); const float* AH = (const float*)(ws + WS_RINV); bf16_t* Z = (bf16_t*)(ws + WS_Z);
    const int gw = F.vcu * 8 + wave, NGW = F.G * 8;
    for (int t = gw; t < 64 * 129; t += NGW) {
        const int bg = t / 129, mt = t - bg * 129, b = bg >> 3, g = bg & 7; const int row = b * 2048 + g * 256 + mt;
        const GAS u32x4* src = (const GAS u32x4*)(UTF + (size_t)row * 1024);
        float s = 0.f;
#pragma unroll
        for (int i = 0; i < 2; ++i) { const u32x4 v = src[lane + 64 * i]; s += (bflo(v.x) - bfhi(v.x)) + (bflo(v.y) - bfhi(v.y)) + (bflo(v.z) - bfhi(v.z)) + (bflo(v.w) - bfhi(v.w)); }
        s = wave_sum(s, lane);
        const float y = (s + AH[row]) * 0.022097087f;
        bf16_t* zrow = Z + (size_t)(b * 2048 + 1024) * 2048 + g * 256;
        if (lane == 0) zrow[mt] = (bf16_t)f2bf(y * bf1(zrow[mt]));
        if (lane == 1 && mt >= 1 && mt <= 127) zrow[256 - mt] = (bf16_t)f2bf(y * bf1(zrow[256 - mt]));
    }
}
__device__ __forceinline__ bf16_t* s_chunk(unsigned char* ws, int h, int rc) {
    return rc < 64 ? (bf16_t*)(ws + WS_SA) + ((size_t)(h * 64 + rc) << 14) : (bf16_t*)(ws + WS_SB) + ((size_t)(h * 80 + rc - 64) << 14);
}
struct DiagOrder {
    int G, c;
    __device__ bool next(int i, pg8::Unit& u) const { const int L = i * G + c; if (L >= 288) return false; u.aux = L / 72; u.pm = L - 72 * u.aux; u.pn = u.pm; return true; }
    __device__ __forceinline__ const char* a_ptr(const pg8::Gemm& g, const pg8::Unit& u) const { return (const char*)(g.A + (size_t)u.pm * 256 * 1024 + u.aux * 256); }
    __device__ __forceinline__ const char* b_ptr(const pg8::Gemm& g, const pg8::Unit& u, int half) const { return (const char*)(g.Bt + (size_t)(u.pm * 256 + 128 * half) * 1024 + u.aux * 256); }
    __device__ __forceinline__ bool b_mirror(const pg8::Unit&) const { return false; }
    __device__ __forceinline__ bool b_fix(const pg8::Unit&) const { return false; }
};
struct EpiS {
    static constexpr bool PERM = true;
    unsigned char* ws;
    __device__ __forceinline__ void operator()(AccRef acc, const pg8::Unit& u, int wr, int wc, int fr, int fq) const {
#pragma unroll
        for (int ai = 0; ai < 2; ++ai) { bf16_t* sp = s_chunk(ws, u.aux, 2 * u.pm + ai);
#pragma unroll
            for (int m = 0; m < 4; ++m) { const f32x4 v0 = acc[ai][ai][m][0], v1 = acc[ai][ai][m][1]; u32x4 w;
                w.x = cvt_pk_bf16(v0[0], v0[1]); w.y = cvt_pk_bf16(v0[2], v0[3]); w.z = cvt_pk_bf16(v1[0], v1[1]); w.w = cvt_pk_bf16(v1[2], v1[3]);
                *(u32x4*)(sp + (wr * 64 + m * 16 + fr) * 128 + wc * 32 + 8 * fq) = w; } }
    }
};
typedef short bf16x4 __attribute__((ext_vector_type(4)));
typedef short v4i16_t __attribute__((ext_vector_type(4)));
__device__ __forceinline__ bf16x8 ldtr2(const LAS unsigned char* p0, const LAS unsigned char* p1) {
    const bf16x4 lo = __builtin_bit_cast(bf16x4, __builtin_amdgcn_ds_read_tr16_b64_v4i16((LAS v4i16_t*)p0));
    const bf16x4 hi = __builtin_bit_cast(bf16x4, __builtin_amdgcn_ds_read_tr16_b64_v4i16((LAS v4i16_t*)p1));
    return __builtin_shufflevector(lo, hi, 0, 1, 2, 3, 4, 5, 6, 7);
}
__device__ __forceinline__ int blk_perm(int rb) { return (rb & ~3) | ((rb >> 1) & 1) | ((rb & 1) << 1); }
__device__ __forceinline__ int scan_t0(int dir, int b, int s) {
    return dir == 0 ? ((s < 2) ? (NLAT + b * CTXL + s * 128) : (b * SEQ + (s - 2) * 128)) : ((s < 2) ? (NLAT + b * CTXL + (1 - s) * 128) : (b * SEQ + (17 - s) * 128));
}
__device__ __forceinline__ int scan_rc(int dir, int b, int s) {
    return dir == 0 ? ((s < 2) ? (128 + b * 2 + s) : (b * 16 + (s - 2))) : ((s < 2) ? (128 + b * 2 + (1 - s)) : (b * 16 + (17 - s)));
}
__device__ __forceinline__ u32x4 ldg16(const void* ub, unsigned voff) { return *(const GAS u32x4*)((const GAS unsigned char*)ub + voff); }
__device__ __forceinline__ void scan_load_s(u32x4 (&sf)[4], unsigned char* ws, int h, int rc, int w, int r, int q) {
    const bf16_t* ub = s_chunk(ws, h, rc) + 16 * w * 128; const unsigned vo = (unsigned)(r * 128 + 8 * q) * 2u;
#pragma unroll
    for (int ks = 0; ks < 4; ++ks) sf[ks] = ldg16(ub, vo + 64u * ks);
}
__device__ __forceinline__ void scan_load_q(u32x4 (&qf)[8], const bf16_t* Qg, int h, int t0, int w, int r, int q) {
    const bf16_t* ub = Qg + (size_t)(t0 + 16 * w) * 1024 + h * 256; const unsigned vo = (unsigned)(r * 1024 + 8 * q) * 2u;
#pragma unroll
    for (int ks = 0; ks < 8; ++ks) qf[ks] = ldg16(ub, vo + 64u * ks);
}
__device__ __forceinline__ void scan_load_kv(u32x4 (&kr)[8], u32x4 (&vr)[2], const bf16_t* Kg, const bf16_t* Vg, int h, int sl, int t0, int w, int lane, int tid) {
    const bf16_t* kb = Kg + (size_t)t0 * 1024 + h * 256 + 32 * w; const unsigned ko = (unsigned)((lane >> 2) * 1024 + 8 * (lane & 3)) * 2u;
#pragma unroll
    for (int it = 0; it < 8; ++it) kr[it] = ldg16(kb + (size_t)it * 16 * 1024, ko);
    const bf16_t* vb = Vg + (size_t)t0 * 2048 + h * 512 + sl * 64; const unsigned vo = (unsigned)((tid >> 3) * 2048 + 8 * (tid & 7)) * 2u;
#pragma unroll
    for (int i = 0; i < 2; ++i) vr[i] = ldg16(vb + (size_t)i * 64 * 2048, vo);
}
template <int DIR>
__device__ __forceinline__ void scan_step(LAS unsigned char* lds, u32x4 (&sf)[4], u32x4 (&qf)[8], u32x4 (&kr)[8], u32x4 (&vr)[2], f32x4 (&Rb)[2][4], const float (&wm)[2], float rsc, float g128,
                                          int t0, int t0n, int rcn, unsigned char* ws, int h, int sl, int w, int lane, int tid, const bf16_t* Qg, const bf16_t* Kg, const bf16_t* Vg, bf16_t* OF, float* SSP) {
    const int r = lane & 15, q = lane >> 4;
    LAS unsigned char* VI = lds + SC_V_OFF; LAS unsigned char* RT = lds + SC_RT_OFF; LAS unsigned char* KI = lds + SC_K_OFF + w * 8192;
#pragma unroll
    for (int i = 0; i < 2; ++i) { const int m = (tid >> 3) + 64 * i, e0 = 8 * (tid & 7); const float sc = wm[i]; const u32x4 v = vr[i]; u32x4 o;
        o.x = cvt_pk_bf16(bflo(v.x) * sc, bfhi(v.x) * sc); o.y = cvt_pk_bf16(bflo(v.y) * sc, bfhi(v.y) * sc); o.z = cvt_pk_bf16(bflo(v.z) * sc, bfhi(v.z) * sc); o.w = cvt_pk_bf16(bflo(v.w) * sc, bfhi(v.w) * sc);
        *(LAS u32x4*)(VI + 128 * ((e0 >> 4) * 32 + blk_perm(m >> 2)) + (m & 3) * 32 + (e0 & 15) * 2) = o; }
#pragma unroll
    for (int it = 0; it < 8; ++it) { const int m = it * 16 + (lane >> 2), dc = lane & 3;
        *(LAS u32x4*)(KI + 128 * ((dc >> 1) * 32 + blk_perm(m >> 2)) + (m & 3) * 32 + (dc & 1) * 16) = kr[it]; }
    __syncthreads();
    scan_load_kv(kr, vr, Kg, Vg, h, sl, t0n, w, lane, tid);
    const int jl = 16 * w + r;
    f32x4 O[4];
#pragma unroll
    for (int eb = 0; eb < 4; ++eb) O[eb] = (f32x4){0.f, 0.f, 0.f, 0.f};
    const LAS unsigned char* rtb = RT + r * 528 + q * 16;
#pragma unroll
    for (int ks = 0; ks < 8; ++ks) { const bf16x8 qv = __builtin_bit_cast(bf16x8, qf[ks]);
#pragma unroll
        for (int eb = 0; eb < 4; ++eb) { const bf16x8 av = *(const LAS bf16x8*)(rtb + (16 * eb * 528 + 64 * ks));
            O[eb] = __builtin_amdgcn_mfma_f32_16x16x32_bf16(av, qv, O[eb], 0, 0, 0); } }
    scan_load_q(qf, Qg, h, t0n, w, r, q);
    const int lofs = 128 * (4 * (q >> 1) + (q & 1)) + 8 * r;
    const LAS unsigned char* vtb = VI + lofs; const LAS unsigned char* ktb = KI + lofs;
#pragma unroll
    for (int ks = 0; ks < 4; ++ks) {
        bf16x8 vb[4], ka[2];
#pragma unroll
        for (int eb = 0; eb < 4; ++eb) vb[eb] = ldtr2(vtb + 128 * (eb * 32 + 8 * ks), vtb + 128 * (eb * 32 + 8 * ks + 2));
#pragma unroll
        for (int db = 0; db < 2; ++db) ka[db] = ldtr2(ktb + 128 * (db * 32 + 8 * ks), ktb + 128 * (db * 32 + 8 * ks + 2));
        bf16x8 sfm;
        { unsigned wd[4] = {sf[ks].x, sf[ks].y, sf[ks].z, sf[ks].w};
#pragma unroll
          for (int i = 0; i < 4; ++i) { const int m0 = 32 * ks + 8 * q + 2 * i; const bool k0 = DIR == 0 ? (m0 <= jl) : (m0 >= jl), k1 = DIR == 0 ? (m0 + 1 <= jl) : (m0 + 1 >= jl);
              wd[i] &= (k0 ? 0xffffu : 0u) | (k1 ? 0xffff0000u : 0u); }
          sfm = __builtin_bit_cast(bf16x8, (u32x4){wd[0], wd[1], wd[2], wd[3]}); }
#pragma unroll
        for (int eb = 0; eb < 4; ++eb) O[eb] = __builtin_amdgcn_mfma_f32_16x16x32_bf16(vb[eb], sfm, O[eb], 0, 0, 0);
#pragma unroll
        for (int db = 0; db < 2; ++db)
#pragma unroll
            for (int eb = 0; eb < 4; ++eb) Rb[db][eb] = __builtin_amdgcn_mfma_f32_16x16x32_bf16(ka[db], vb[eb], Rb[db][eb], 0, 0, 0);
    }
    scan_load_s(sf, ws, h, rcn, w, r, q);
    {
        GAS unsigned char* ob = (GAS unsigned char*)(OF + (size_t)(t0 + 16 * w) * 2048 + h * 512 + sl * 64); const unsigned oo = (unsigned)(r * 2048 + 4 * q) * 2u; float ss = 0.f;
#pragma unroll
        for (int eb = 0; eb < 4; ++eb) { f32x4 v = O[eb] * rsc; GAS bf16_t* op = (GAS bf16_t*)(ob + oo) ;
            if (DIR == 1) { const u32x2 pv = *(const GAS u32x2*)(op + 16 * eb); v[0] += bflo(pv.x); v[1] += bfhi(pv.x); v[2] += bflo(pv.y); v[3] += bfhi(pv.y);
                ss += (v[0] * v[0] + v[1] * v[1]) + (v[2] * v[2] + v[3] * v[3]); }
            u32x2 o; o.x = cvt_pk_bf16(v[0], v[1]); o.y = cvt_pk_bf16(v[2], v[3]); *(GAS u32x2*)(op + 16 * eb) = o; }
        if (DIR == 1) { ss += shx(ss, 16, lane); ss += shx(ss, 32, lane); if (q == 0) *(GAS float*)((GAS unsigned char*)(SSP + (size_t)(t0 + 16 * w) * 32 + h * 8 + sl) + (unsigned)r * 128u) = ss; }
    }
#pragma unroll
    for (int db = 0; db < 2; ++db)
#pragma unroll
        for (int eb = 0; eb < 4; ++eb) Rb[db][eb] = Rb[db][eb] * g128;
    __syncthreads();
#pragma unroll
    for (int db = 0; db < 2; ++db)
#pragma unroll
        for (int eb = 0; eb < 4; ++eb) { u32x2 o; o.x = cvt_pk_bf16(Rb[db][eb][0], Rb[db][eb][1]); o.y = cvt_pk_bf16(Rb[db][eb][2], Rb[db][eb][3]);
            *(LAS u32x2*)(RT + (16 * eb + r) * 528 + (32 * w + 16 * db + 4 * q) * 2) = o; }
}
template <int DIR>
__device__ __forceinline__ void scan_unit(Frame& F, int tid, unsigned char* ws, int b, int h, int sl, float lg, const bf16_t* Qg, const bf16_t* Kg, const bf16_t* Vg, bf16_t* OF, float* SSP) {
    const int lane = tid & 63, w = __builtin_amdgcn_readfirstlane(tid >> 6), r = lane & 15, q = lane >> 4;
    const float g128 = __expf(128.f * lg);
    float wm[2];
#pragma unroll
    for (int i = 0; i < 2; ++i) { const int m = (tid >> 3) + 64 * i; wm[i] = __expf(lg * (float)(DIR == 0 ? 127 - m : m)); }
    const int jl = 16 * w + r; const float rsc = __expf(lg * (float)(DIR == 0 ? jl - 127 : -jl));
    f32x4 Rb[2][4];
#pragma unroll
    for (int db = 0; db < 2; ++db)
#pragma unroll
        for (int eb = 0; eb < 4; ++eb) Rb[db][eb] = (f32x4){0.f, 0.f, 0.f, 0.f};
    {
        LAS unsigned char* RT = F.lds + SC_RT_OFF;
#pragma unroll
        for (int db = 0; db < 2; ++db)
#pragma unroll
            for (int eb = 0; eb < 4; ++eb) *(LAS u32x2*)(RT + (16 * eb + r) * 528 + (32 * w + 16 * db + 4 * q) * 2) = (u32x2){0u, 0u};
    }
    u32x4 sf[4], qf[8], kr[8], vr[2];
    scan_load_s(sf, ws, h, scan_rc(DIR, b, 0), w, r, q);
    scan_load_q(qf, Qg, h, scan_t0(DIR, b, 0), w, r, q);
    scan_load_kv(kr, vr, Kg, Vg, h, sl, scan_t0(DIR, b, 0), w, lane, tid);
    for (int s = 0; s < 18; ++s) {
        const int sn = (s + 1 < 18) ? s + 1 : 17;
        scan_step<DIR>(F.lds, sf, qf, kr, vr, Rb, wm, rsc, g128, scan_t0(DIR, b, s), scan_t0(DIR, b, sn), scan_rc(DIR, b, sn), ws, h, sl, w, lane, tid, Qg, Kg, Vg, OF, SSP);
    }
    __syncthreads();
}
__device__ __forceinline__ void scan_phase(Frame& F, const Args& a, int layer, int dir) {
    PHASE_IDS();
    const int j = layer >> 1; const float* dec = a.in[11] + j * 8 + dir * 4;
    for (int u = F.vcu; u < 256; u += F.G) {
        const int b = u >> 5, h = (u >> 3) & 3, sl = u & 7;
        const float lg = log1pf(-exp2f(dec[h]));
        if (dir == 0) scan_unit<0>(F, tid, ws, b, h, sl, lg, (const bf16_t*)(ws + WS_Q), (const bf16_t*)(ws + WS_K), (const bf16_t*)(ws + WS_V), (bf16_t*)(ws + WS_OF), (float*)(ws + WS_SSP));
        else scan_unit<1>(F, tid, ws, b, h, sl, lg, (const bf16_t*)(ws + WS_Q), (const bf16_t*)(ws + WS_K), (const bf16_t*)(ws + WS_V), (bf16_t*)(ws + WS_OF), (float*)(ws + WS_SSP));
    }
}
__device__ __forceinline__ void n2_phase(Frame& F, const Args& a, int layer) {
    PHASE_IDS();
    norm_rows(F, a, layer, (bf16_t*)(ws + WS_Q));
    const float* SSP = (const float*)(ws + WS_SSP); float* RINV = (float*)(ws + WS_RINV);
    const int gt = F.vcu * 512 + tid, NT = F.G * 512;
    for (int idx = gt; idx < NTOK * 4; idx += NT) { const f32x4 p0 = *(const f32x4*)(SSP + (size_t)idx * 8), p1 = *(const f32x4*)(SSP + (size_t)idx * 8 + 4);
        const float ss = ((p0.x + p0.y) + (p0.z + p0.w)) + ((p1.x + p1.y) + (p1.z + p1.w)); RINV[idx] = rsqrtf(ss * (1.f / 512.f) + EPS); }
}
__device__ __forceinline__ void final_phase(Frame& F, const Args& a) {
    PHASE_IDS();
    const float* fg = a.in[12]; const int gw = F.vcu * 8 + wave, NGW = F.G * 8;
    for (int m = gw; m < NLAT; m += NGW) {
        f32x4* xr = (f32x4*)(a.out + (size_t)m * DM) + lane;
        f32x4 v[4]; float s = 0.f;
#pragma unroll
        for (int jj = 0; jj < 4; ++jj) { v[jj] = xr[64 * jj]; s += (v[jj].x * v[jj].x + v[jj].y * v[jj].y) + (v[jj].z * v[jj].z + v[jj].w * v[jj].w); }
        const float rinv = rsqrtf(wave_sum(s, lane) * (1.f / DM) + EPS);
#pragma unroll
        for (int jj = 0; jj < 4; ++jj) { const f32x4 g = *(const f32x4*)(fg + 4 * lane + 256 * jj); xr[64 * jj] = v[jj] * rinv * g; }
    }
}

constexpr int N_PHASES = 34;
__global__ void __launch_bounds__(512, 2) trunk_fwd(Args args) {
    extern __shared__ __attribute__((aligned(16))) unsigned char lds_raw[];
    Frame F;
    F.lds = (LAS unsigned char*)lds_raw;
    F.G = gridDim.x; F.wv = __builtin_amdgcn_readfirstlane((int)threadIdx.x >> 6); { const int bx = blockIdx.x; F.vcu = (F.G % 8 == 0) ? (bx % 8) * (F.G / 8) + bx / 8 : bx; }
    F.ws = args.ws;
    volatile LAS unsigned* MISC = (volatile LAS unsigned*)(F.lds + MISC_OFF);
    for (int u = threadIdx.x; u < 128; u += 512) MISC[u] = 0u;
    __syncthreads();
    const int lo = args.ph_lo, hi = args.ph_hi;
    XcdBarrier bar; bar.bar = (unsigned*)(args.ws + WS_CTL) + 4096; bar.x = 0; bar.st = nullptr;
    const bool multi = (hi - lo) > 1;
    if (multi) bar = xcd_barrier_post((unsigned*)(args.ws + WS_CTL) + 4096, MISC + 8);
#ifndef KINDS
#define KINDS 0xFFFF
#endif
#define KON(b) (((KINDS) >> (b)) & 1)
#ifndef REPK
#define REPK 0
#endif
#define NREP(b) ((((REPK) >> (b)) & 1) ? 2 : 1)
#define IN(k) (lo <= (k) && (k) < hi)
#define SEAM(k) do { if (multi && (k) + 1 < hi) xcd_barrier(bar); } while (0)
    const int bx = (int)blockIdx.x, G = F.G;
    if (KON(0) && IN(0)) { p0_phase(F, args); SEAM(0); }
    for (int layer = 0; layer < NLAYER; ++layer) {
        const int pb = 1 + 8 * layer; const bool fourier = (layer & 1) == 0;
        unsigned char* ws = launder_ptr(args.ws);
#define MAKE_ER() const EpiResid ER{layer == 0 ? args.in[0] : args.out, layer == 0 ? args.in[2] : (const float*)(ws + WS_XCTX), args.out, (float*)(ws + WS_XCTX), (const float*)(ws + WS_ADA) + layer * 9 * 3072 + 2048}
        if (KON(1) && IN(pb)) { for (int rep = 0; rep < NREP(1); ++rep) { n_phase(F, args, layer); SEAM(pb); } }
        if (fourier) {
            bf16_t* W1 = (bf16_t*)(ws + WS_W);
            if (KON(2) && IN(pb + 1)) for (int rep = 0; rep < NREP(2); ++rep) {
                { pg8::Gemm g{(const bf16_t*)(ws + WS_H), W1 + (size_t)2048 * 1024, 1024, 1024, 1024}; pg8::TileOrder S; S.init(72, 8, G, bx);
                  EpiSilu E{(bf16_t*)(ws + WS_Z), 2048}; pg8::gemm_phase(F.lds, F.wv, g, S, E); }
                { pg8::Gemm g{W1, (const bf16_t*)(ws + WS_H), 1024, 1024, 1024}; UOrder S; S.init(8, 72, G, (bx + 64) % G);
                  EpiUTF E{(bf16_t*)(ws + WS_UTL), (bf16_t*)(ws + WS_UTC), (float*)(ws + WS_RINV)}; pg8::gemm_phase<EpiUTF, UOrder, true>(F.lds, F.wv, g, S, E); }
                SEAM(pb + 1);
            }
            if (KON(3) && IN(pb + 2)) {
                { pg8::Gemm g{(const bf16_t*)(ws + WS_CS), (const bf16_t*)(ws + WS_UTL), 1024, 1024, 1024}; pg8::TileOrder S; S.init(8, 64, G, bx);
                  EpiDft<true> E{(bf16_t*)(ws + WS_Z), 2048, 0, (const float*)(ws + WS_RINV)}; pg8::gemm_phase(F.lds, F.wv, g, S, E); }
                { pg8::Gemm g{(const bf16_t*)(ws + WS_CS256), (const bf16_t*)(ws + WS_UTC), 256, 256, 256}; pg8::TileOrder S; S.init(2, 64, G, bx);
                  EpiDft<false> E{(bf16_t*)(ws + WS_Z), 256, NLAT, nullptr}; pg8::gemm_phase(F.lds, F.wv, g, S, E); }
                nyq_row_phase(F);
                SEAM(pb + 2);
            }
            if (KON(4) && IN(pb + 3)) {
                pg8::Gemm g{(const bf16_t*)(ws + WS_Z), W1 + (size_t)4096 * 1024, 2048, 2048, 2048}; pg8::TileOrder S; S.init(72, 4, G, bx); MAKE_ER();
                pg8::gemm_phase(F.lds, F.wv, g, S, ER);
                SEAM(pb + 3);
            }
        } else {
            bf16_t* W1 = (bf16_t*)(ws + WS_W);
            if (KON(5) && IN(pb + 1)) for (int rep = 0; rep < NREP(5); ++rep) {
                pg8::Gemm g{(const bf16_t*)(ws + WS_OF), W1, 1024, 1024, 1024}; pg8::TileOrder S; S.init(72, 16, G, bx);
                EpiQKV E{(bf16_t*)(ws + WS_Q), (bf16_t*)(ws + WS_K), (bf16_t*)(ws + WS_V), (const float*)(ws + WS_ROPE), (const float*)(ws + WS_ROPE) + 4096};
                pg8::gemm_phase(F.lds, F.wv, g, S, E);
                SEAM(pb + 1);
            }
            if (KON(6) && IN(pb + 2)) {
                { pg8::Gemm g{(const bf16_t*)(ws + WS_Q), (const bf16_t*)(ws + WS_K), 1024, 1024, 256}; DiagOrder S{G, bx};
                  EpiS E{ws}; pg8::gemm_phase(F.lds, F.wv, g, S, E); }
                if (multi) xcd_barrier(bar);
                for (int rep = 0; rep < NREP(6); ++rep) { scan_phase(F, args, layer, 0); SEAM(pb + 2); }
            }
            if (KON(6) && IN(pb + 3)) { scan_phase(F, args, layer, 1); SEAM(pb + 3); }
            if (KON(7) && IN(pb + 4)) for (int rep = 0; rep < NREP(7); ++rep) { n2_phase(F, args, layer); SEAM(pb + 4); }
            if (KON(8) && IN(pb + 5)) for (int rep = 0; rep < NREP(8); ++rep) {
                pg8::Gemm g{(const bf16_t*)(ws + WS_Q), W1 + (size_t)4096 * 1024, 1024, 1024, 1024}; pg8::TileOrder S; S.init(72, 8, G, bx);
                EpiZGate E{(const bf16_t*)(ws + WS_OF), (const float*)(ws + WS_RINV), (bf16_t*)(ws + WS_V)};
                pg8::gemm_phase(F.lds, F.wv, g, S, E);
                SEAM(pb + 5);
            }
            if (KON(9) && IN(pb + 6)) {
                pg8::Gemm g{(const bf16_t*)(ws + WS_V), W1 + (size_t)6144 * 1024, 2048, 2048, 2048}; pg8::TileOrder S; S.init(72, 4, G, bx); MAKE_ER();
                pg8::gemm_phase(F.lds, F.wv, g, S, ER);
                SEAM(pb + 6);
            }
        }
    }
    if (KON(10) && IN(33)) final_phase(F, args);
#undef IN
#undef SEAM
}

static bool phase_used(int p) {
    if (p == 0 || p == 33) return true;
    const int layer = (p - 1) / 8, k = (p - 1) % 8;
    return (layer & 1) == 0 ? (k <= 3) : (k <= 6);
}
extern "C" void kernel_launch(void* const* d_in, const int* in_sizes, int n_in, void* d_out, int out_size, void* d_ws, size_t ws_size, hipStream_t stream) {
    static int grid = 0;
    if (grid == 0) {
        if (n_in != 13 || out_size != NLAT * DM || ws_size < WS_END) { fprintf(stderr, "kernel_launch: unexpected problem (n_in %d, out %d, ws %zu)\n", n_in, out_size, ws_size); grid = -1; return; }
        int dev = 0, cus = 0;
        if (hipGetDevice(&dev) != hipSuccess || hipDeviceGetAttribute(&cus, hipDeviceAttributeMultiprocessorCount, dev) != hipSuccess) { grid = -1; return; }
        if (hipFuncSetAttribute((const void*)trunk_fwd, hipFuncAttributeMaxDynamicSharedMemorySize, LDS_BYTES) != hipSuccess) { fprintf(stderr, "kernel_launch: hipFuncSetAttribute failed\n"); grid = -1; return; }
        (void)hipGetLastError();
        grid = cus;
    }
    if (grid < 0) return;
    if (hipMemsetAsync((char*)d_ws + WS_CTL, 0, CTL_ZERO_BYTES, stream) != hipSuccess) return;
    Args a{};
    for (int i = 0; i < 13; ++i) a.in[i] = (const float*)d_in[i];
    a.out = (float*)d_out; a.ws = (unsigned char*)d_ws;
#if MK_PER_PHASE_LAUNCH
#ifndef DBG_MAXPH
#define DBG_MAXPH 99
#endif
    for (int p = 0; p < N_PHASES; ++p) { if (!phase_used(p)) continue; if (p > DBG_MAXPH && p != 33) continue; a.ph_lo = p; a.ph_hi = p + 1; hipLaunchKernelGGL(trunk_fwd, dim3(grid), dim3(512), LDS_BYTES, stream, a); }
#else
    a.ph_lo = 0; a.ph_hi = N_PHASES;
    hipLaunchKernelGGL(trunk_fwd, dim3(grid), dim3(512), LDS_BYTES, stream, a);
#endif
}
```

```cpp
#include <hip/hip_runtime.h>
#include <cstdio>
#include <cstdint>

#define LAS __attribute__((address_space(3)))
#define GAS __attribute__((address_space(1)))
typedef unsigned short bf16_t;
typedef short bf16x8 __attribute__((ext_vector_type(8)));
typedef float f32x4 __attribute__((ext_vector_type(4)));
typedef float f32x16 __attribute__((ext_vector_type(16)));
typedef unsigned u32x4 __attribute__((ext_vector_type(4)));
typedef unsigned u32x2 __attribute__((ext_vector_type(2)));

constexpr int DM = 1024, NB = 8, SEQ = 2048, CTXL = 256, DBR = 2048, NLAYER = 4;
constexpr int NLAT = NB * SEQ, NCTX = NB * CTXL, NTOK = NLAT + NCTX;
constexpr float EPS = 1e-6f;

constexpr size_t MiB = 1u << 20;
constexpr size_t KiB = 1024;
constexpr size_t WS_CTL = 0, CTL_ZERO_BYTES = 64 * KiB;
constexpr size_t WS_ADA = 256 * KiB;
constexpr size_t WS_TC = 768 * KiB;
constexpr size_t WS_ROPE = 1024 * KiB;
constexpr size_t WS_CS256 = 1088 * KiB;
constexpr size_t WS_RINV = 1344 * KiB;
constexpr size_t WS_XCTX = 2 * MiB;
constexpr size_t WS_W = 10 * MiB;
constexpr size_t WS_R = 26 * MiB;
constexpr size_t WS_H = WS_R;
constexpr size_t WS_Z = WS_R + 36 * MiB;
constexpr size_t WS_UTL = WS_R + 108 * MiB;
constexpr size_t WS_UTC = WS_R + 172 * MiB;
constexpr size_t WS_CS = WS_R + 180 * MiB;
constexpr size_t WS_WF = WS_R + 144 * MiB;
constexpr size_t WS_Q = WS_R;
constexpr size_t WS_K = WS_R + 36 * MiB;
constexpr size_t WS_V = WS_R + 72 * MiB;
constexpr size_t WS_OF = WS_R + 144 * MiB;
constexpr size_t WS_PART = WS_R + 184 * MiB;
constexpr size_t WS_SSP = WS_R + 216 * MiB;
constexpr size_t WS_SA = WS_W;
constexpr size_t WS_SB = WS_R + 219 * MiB;
constexpr size_t WS_END = 256 * MiB;
static_assert(WS_SSP + (size_t)NTOK * 32 * 4 <= WS_SB && WS_SB + 10 * MiB <= WS_END && WS_CS + 16 * MiB <= WS_END && WS_RINV + 288 * KiB <= WS_XCTX, "ws map");

constexpr int LDS_BYTES = 147456;
constexpr int RING_BYTES = 131072;
constexpr int SC_V_OFF = 0;
constexpr int SC_RT_OFF = 16384;
constexpr int SC_K_OFF = 16384 + 33792;
constexpr int MISC_OFF = 145408;
static_assert(SC_K_OFF + 65536 <= MISC_OFF && MISC_OFF + 512 <= LDS_BYTES, "lds map");

__device__ __forceinline__ unsigned f2bf(float f) { unsigned u = __builtin_bit_cast(unsigned, f); return (u + 0x7fffu + ((u >> 16) & 1u)) >> 16; }
__device__ __forceinline__ unsigned pk2(float lo, float hi) { return f2bf(lo) | (f2bf(hi) << 16); }
__device__ __forceinline__ float bflo(unsigned w) { return __builtin_bit_cast(float, w << 16); }
__device__ __forceinline__ float bfhi(unsigned w) { return __builtin_bit_cast(float, w & 0xffff0000u); }
__device__ __forceinline__ float bf1(bf16_t h) { return __builtin_bit_cast(float, (unsigned)h << 16); }
__device__ __forceinline__ float silu_f(float x) { return x * __builtin_amdgcn_rcpf(1.f + __expf(-x)); }
__device__ __forceinline__ float shx(float v, int o, int lane) { return __builtin_bit_cast(float, __builtin_amdgcn_ds_bpermute((lane ^ o) << 2, __builtin_bit_cast(int, v))); }
__device__ __forceinline__ float wave_sum(float v, int lane) {
#pragma unroll
    for (int o = 1; o < 64; o <<= 1) v += shx(v, o, lane);
    return v;
}

namespace pg8 {
constexpr int BM = 256, BK = 64, HALF = 128, HTB = HALF * BK * 2, STAGE_BYTES = 8 * HTB, NXCD = 8, WGM = 8;
__host__ __device__ __forceinline__ int lds_byte(int r, int c) { const int st = (r >> 4) * 2 + (c >> 5), rr = r & 15, cc = c & 31, ob = rr * 64 + cc * 2; return st * 1024 + (ob ^ (((ob >> 9) & 1) << 5)); }
__host__ __device__ __forceinline__ void stage_rc(int b, int& R, int& C) { const int st = b / 1024, sb = b % 1024, swz = sb ^ (((sb >> 9) & 1) << 5); R = (st >> 1) * 16 + swz / 64; C = (st & 1) * 32 + (swz % 64) / 2; }
__host__ __device__ __forceinline__ int perm32(int rho) { const int n = rho >> 4, i = rho & 15; return 8 * (i >> 2) + 4 * n + (i & 3); }
struct Unit { int pm, pn, aux; };
struct Gemm { const bf16_t* A; const bf16_t* Bt; int lda, ldb, K; };
struct TileOrder {
    int nM, nN, nwg, G, c;
    __device__ void init(int nM_, int nN_, int G_, int c_) { nM = nM_; nN = nN_; nwg = nM * nN; G = G_; c = c_; }
    __device__ bool next(int i, Unit& u) const {
        const long L = (long)i * G + c; if (L >= nwg) return false;
        int wgid = (int)L; { const int q = nwg / NXCD, r = nwg % NXCD, xcd = wgid % NXCD, off = wgid / NXCD; wgid = (xcd < r ? xcd * (q + 1) : r * (q + 1) + (xcd - r) * q) + off; }
        const int nig = WGM * nN, gid = wgid / nig, fm = gid * WGM, gsz = (nM - fm) < WGM ? (nM - fm) : WGM;
        u.pm = fm + ((wgid % nig) % gsz); u.pn = (wgid % nig) / gsz; u.aux = 0; return true;
    }
    __device__ __forceinline__ const char* a_ptr(const Gemm& g, const Unit& u) const { return (const char*)g.A + (size_t)u.pm * 256 * g.lda * 2; }
    __device__ __forceinline__ const char* b_ptr(const Gemm& g, const Unit& u, int half) const { return (const char*)g.Bt + (size_t)(u.pn * 256 + 128 * half) * g.ldb * 2; }
    __device__ __forceinline__ bool b_mirror(const Unit&) const { return false; }
    __device__ __forceinline__ bool b_fix(const Unit&) const { return false; }
    __device__ __forceinline__ int ktiles(const Gemm& g, const Unit&) const { return g.K / BK; }
};
__device__ __forceinline__ unsigned cvt_pk_bf16(float lo, float hi) { unsigned r; asm volatile("v_cvt_pk_bf16_f32 %0, %1, %2" : "=v"(r) : "v"(lo), "v"(hi)); return r; }

template <class Epi, class Sched, bool MIRB = false, bool TILED = false>
__device__ __forceinline__ void gemm_phase(LAS unsigned char* lds, int wv, const Gemm g, const Sched& S, const Epi& E) {
    int tid; { int l_; asm volatile("v_mbcnt_lo_u32_b32 %0, -1, 0\n\tv_mbcnt_hi_u32_b32 %0, -1, %0" : "=v"(l_)); tid = wv * 64 + l_; }
    const int wid = __builtin_amdgcn_readfirstlane(tid >> 6), lane = tid & 63, wr = wid >> 2, wc = wid & 3, fr = lane & 15, fq = lane >> 4;
    unsigned voffA[2], voffB[2], voffM[2], fixd[2];
#pragma unroll
    for (int i = 0; i < 2; ++i) { int R, C; stage_rc(tid * 16 + i * 8192, R, C); const int Rb = Epi::PERM ? ((R & ~31) + perm32(R & 31)) : R;
        voffA[i] = (unsigned)(R * g.lda + C) * 2u; voffB[i] = (unsigned)(Rb * g.ldb + C) * 2u; voffM[i] = (unsigned)((1024 - Rb) * g.ldb + C) * 2u; fixd[i] = (Rb == 0) ? (unsigned)(1024 * g.ldb) * 2u : 0u;
        if (TILED) { voffA[i] = (unsigned)(((R >> 4) & 7) * 8192 + (C >> 5) * 1024 + (16 * ((C >> 3) & 3) + (R & 15)) * 16);
                     voffB[i] = (unsigned)(((Rb & 127) >> 4) * 1024 + (4 * (Rb & 15) + ((C >> 3) & 3)) * 16 + (C >> 5) * 8192); } }
    const size_t kstepA = TILED ? (size_t)2048 : (size_t)(BK * 2), kstepB = TILED ? (size_t)16384 : (size_t)(BK * 2);
    const size_t hstepA = TILED ? (size_t)262144 : (size_t)HALF * g.lda * 2;
    const unsigned ldsw = (unsigned)wid * 1024u;
    const int aoff = lds_byte(wr * 64 + fr, fq * 8), boff = lds_byte(wc * 32 + fr, fq * 8);
#define PG8_SA(b, h) (((b) * 2 + (h)) * HTB)
#define PG8_SB(b, h) ((4 + (b) * 2 + (h)) * HTB)
#define PG8_STAGE(bufoff, gbase, voff) do { _Pragma("unroll") for (int _i = 0; _i < 2; ++_i) \
        __builtin_amdgcn_global_load_lds((const unsigned*)((const char*)(gbase) + (voff)[_i]), (LAS unsigned*)(lds + (bufoff) + ldsw + _i * 8192), 16, 0, 0); } while (0)
#define PG8_LDA(dst, b, h) do { _Pragma("unroll") for (int m = 0; m < 4; ++m) _Pragma("unroll") for (int k = 0; k < 2; ++k) dst[m][k] = *(const LAS bf16x8*)(lds + PG8_SA(b, h) + aoff + m * 2048 + k * 1024); } while (0)
#define PG8_LDB(dst, b, h) do { _Pragma("unroll") for (int n = 0; n < 2; ++n) _Pragma("unroll") for (int k = 0; k < 2; ++k) dst[n][k] = *(const LAS bf16x8*)(lds + PG8_SB(b, h) + boff + n * 2048 + k * 1024); } while (0)
#define PG8_MMA(ai, bj, At, Bt) do { __builtin_amdgcn_s_setprio(1); _Pragma("unroll") for (int m = 0; m < 4; ++m) _Pragma("unroll") for (int n = 0; n < 2; ++n) _Pragma("unroll") for (int k = 0; k < 2; ++k) \
        acc[ai][bj][m][n] = __builtin_amdgcn_mfma_f32_16x16x32_bf16(Bt[n][k], At[m][k], acc[ai][bj][m][n], 0, 0, 0); __builtin_amdgcn_s_setprio(0); } while (0)
#define PG8_WAIT_V(n) asm volatile("s_waitcnt vmcnt(" #n ")" ::: "memory")
#define PG8_WAIT_L(n) asm volatile("s_waitcnt lgkmcnt(" #n ")" ::: "memory")
#define PG8_BAR __builtin_amdgcn_s_barrier()
#define PG8_SCHED __builtin_amdgcn_sched_barrier(0)
#define PG8_VB1(dst, u) do { if (MIRB && S.b_mirror(u)) { const bool fx_ = S.b_fix(u); dst[0] = voffM[0] - (fx_ ? fixd[0] : 0u); dst[1] = voffM[1] - (fx_ ? fixd[1] : 0u); } else { dst[0] = voffB[0]; dst[1] = voffB[1]; } } while (0)
    Unit cur, nxt; int ui = 0;
    if (!S.next(0, cur)) return;
    f32x4 acc[2][2][4][2];
#pragma unroll
    for (int a = 0; a < 2; ++a)
#pragma unroll
        for (int b = 0; b < 2; ++b)
#pragma unroll
            for (int m = 0; m < 4; ++m)
#pragma unroll
                for (int n = 0; n < 2; ++n) acc[a][b][m][n] = (f32x4){0.f, 0.f, 0.f, 0.f};
    bf16x8 At[4][2], B0[2][2], B1[2][2];
    const char* cA = S.a_ptr(g, cur); const char* cB0 = S.b_ptr(g, cur, 0); const char* cB1 = S.b_ptr(g, cur, 1);
    unsigned vc1[2]; PG8_VB1(vc1, cur);
    PG8_STAGE(PG8_SB(0, 0), cB0, voffB); PG8_STAGE(PG8_SB(0, 1), cB1, vc1); PG8_STAGE(PG8_SA(0, 0), cA, voffA); PG8_STAGE(PG8_SA(0, 1), cA + hstepA, voffA);
    if (wr == 1) PG8_BAR;
    PG8_WAIT_V(2); PG8_BAR;
    PG8_STAGE(PG8_SB(1, 0), cB0 + kstepB, voffB); PG8_STAGE(PG8_SA(1, 0), cA + kstepA, voffA); PG8_STAGE(PG8_SB(1, 1), cB1 + kstepB, vc1);
    PG8_WAIT_V(6); PG8_BAR;
    for (;;) {
        const bool has_next = S.next(ui + 1, nxt);
        const int nt = S.ktiles(g, cur);
        const char* nA = cA; const char* nB0 = cB0; const char* nB1 = cB1; unsigned vn1[2] = {vc1[0], vc1[1]};
        if (has_next) { nA = S.a_ptr(g, nxt); nB0 = S.b_ptr(g, nxt, 0); nB1 = S.b_ptr(g, nxt, 1); PG8_VB1(vn1, nxt); }
        for (int t = 0; t < nt; t += 2) {
            const bool last = (t == nt - 2);
            const char* a1 = cA + (size_t)(t + 1) * kstepA;
            const char* a2 = last ? nA : cA + (size_t)(t + 2) * kstepA; const char* b20 = last ? nB0 : cB0 + (size_t)(t + 2) * kstepB; const char* b21 = last ? nB1 : cB1 + (size_t)(t + 2) * kstepB;
            const char* a3 = a2 + kstepA; const char* b30 = b20 + kstepB; const char* b31 = b21 + kstepB;
            unsigned v21[2]; v21[0] = (MIRB && last) ? vn1[0] : vc1[0]; v21[1] = (MIRB && last) ? vn1[1] : vc1[1];
            PG8_LDB(B0, 0, 0); PG8_LDB(B1, 0, 1); PG8_SCHED; PG8_LDA(At, 0, 0); PG8_STAGE(PG8_SA(1, 1), a1 + hstepA, voffA);
            PG8_WAIT_V(8); PG8_WAIT_L(0); PG8_BAR; PG8_MMA(0, 0, At, B0); PG8_MMA(0, 1, At, B1); PG8_BAR; PG8_SCHED;
            PG8_LDA(At, 0, 1); PG8_STAGE(PG8_SB(0, 0), b20, voffB); PG8_STAGE(PG8_SB(0, 1), b21, v21); PG8_STAGE(PG8_SA(0, 0), a2, voffA);
            PG8_WAIT_V(8); PG8_WAIT_L(0); PG8_BAR; PG8_MMA(1, 0, At, B0); PG8_MMA(1, 1, At, B1); PG8_BAR; PG8_SCHED;
            PG8_LDB(B0, 1, 0); PG8_LDB(B1, 1, 1); PG8_SCHED; PG8_LDA(At, 1, 0); PG8_STAGE(PG8_SA(0, 1), a2 + hstepA, voffA);
            PG8_WAIT_V(8); PG8_WAIT_L(0); PG8_BAR; PG8_MMA(0, 0, At, B0); PG8_MMA(0, 1, At, B1); PG8_BAR; PG8_SCHED;
            PG8_LDA(At, 1, 1); PG8_STAGE(PG8_SB(1, 0), b30, voffB); PG8_STAGE(PG8_SB(1, 1), b31, v21); PG8_STAGE(PG8_SA(1, 0), a3, voffA);
            PG8_WAIT_V(8); PG8_WAIT_L(0); PG8_BAR; PG8_MMA(1, 0, At, B0); PG8_MMA(1, 1, At, B1); PG8_BAR; PG8_SCHED;
        }
        if (wr == 0) PG8_BAR;
        { int l2 = lane; asm volatile("" : "+v"(l2)); E(acc, cur, wr, wc, l2 & 15, l2 >> 4); }
        if (!has_next) break;
#pragma unroll
        for (int a = 0; a < 2; ++a)
#pragma unroll
            for (int b = 0; b < 2; ++b)
#pragma unroll
                for (int m = 0; m < 4; ++m)
#pragma unroll
                    for (int n = 0; n < 2; ++n) acc[a][b][m][n] = (f32x4){0.f, 0.f, 0.f, 0.f};
        cur = nxt; cA = nA; cB0 = nB0; cB1 = nB1; vc1[0] = vn1[0]; vc1[1] = vn1[1]; ++ui;
        if (wr == 1) PG8_BAR;
    }
    PG8_WAIT_V(0);
    PG8_BAR;
#undef PG8_SA
#undef PG8_SB
#undef PG8_STAGE
#undef PG8_LDA
#undef PG8_LDB
#undef PG8_MMA
#undef PG8_WAIT_V
#undef PG8_WAIT_L
#undef PG8_BAR
#undef PG8_SCHED
#undef PG8_VB1
}
}
using pg8::cvt_pk_bf16;
__device__ __forceinline__ void stg16(void* ub, unsigned vo, u32x4 v) { *(GAS u32x4*)((GAS unsigned char*)ub + vo) = v; }
__device__ __forceinline__ u32x4 ldg16u(const void* ub, unsigned vo) { return *(const GAS u32x4*)((const GAS unsigned char*)ub + vo); }
__device__ __forceinline__ void stg16f(void* ub, unsigned vo, f32x4 v) { *(GAS f32x4*)((GAS unsigned char*)ub + vo) = v; }
__device__ __forceinline__ f32x4 ldg16f(const void* ub, unsigned vo) { return *(const GAS f32x4*)((const GAS unsigned char*)ub + vo); }
typedef const f32x4 (&AccRef)[2][2][4][2];

struct EpiSilu {
    static constexpr bool PERM = true;
    bf16_t* O; int ldc;
    __device__ __forceinline__ void operator()(AccRef acc, const pg8::Unit& u, int wr, int wc, int fr, int fq) const {
        bf16_t* ub = O + (size_t)u.pm * 256 * ldc + u.pn * 256; const unsigned vo = (unsigned)((wr * 64 + fr) * ldc + wc * 32 + 8 * fq) * 2u;
#pragma unroll
        for (int ai = 0; ai < 2; ++ai)
#pragma unroll
            for (int m = 0; m < 4; ++m)
#pragma unroll
                for (int bj = 0; bj < 2; ++bj) { const f32x4 v0 = acc[ai][bj][m][0], v1 = acc[ai][bj][m][1]; u32x4 w;
                    w.x = cvt_pk_bf16(silu_f(v0[0]), silu_f(v0[1])); w.y = cvt_pk_bf16(silu_f(v0[2]), silu_f(v0[3]));
                    w.z = cvt_pk_bf16(silu_f(v1[0]), silu_f(v1[1])); w.w = cvt_pk_bf16(silu_f(v1[2]), silu_f(v1[3]));
                    stg16(ub + (size_t)(ai * 128 + m * 16) * ldc, vo + (unsigned)(bj * 256), w); }
    }
};
struct UOrder : pg8::TileOrder {
    __device__ __forceinline__ const char* b_ptr(const pg8::Gemm& g, const pg8::Unit& u, int half) const {
        if (u.pn < 64) { const int b = u.pn >> 3, tp = u.pn & 7; return (const char*)(g.Bt + (size_t)(b * 2048 + (half ? 1024 - 128 * tp : 128 * tp)) * 1024); }
        return (const char*)(g.Bt + (size_t)(NLAT + (u.pn - 64) * 256 + 128 * half) * 1024);
    }
    __device__ __forceinline__ bool b_mirror(const pg8::Unit& u) const { return u.pn < 64; }
    __device__ __forceinline__ bool b_fix(const pg8::Unit& u) const { return (u.pn & 7) == 0; }
};
struct EpiUTF {
    static constexpr bool PERM = true;
    bf16_t* UTF; bf16_t* UTc; float* AH;
    __device__ __forceinline__ void operator()(AccRef acc, const pg8::Unit& u, int wr, int wc, int fr, int fq) const {
        const int feat0 = u.pm * 256 + wr * 64 + fr, col0 = wc * 32 + 8 * fq;
        if (u.pn >= 64) { bf16_t* ub = UTc + (size_t)(u.pn - 64) * 2048 * 256 + (size_t)u.pm * 256 * 256; const unsigned vo = (unsigned)((wr * 64 + fr) * 256 + col0) * 2u;
#pragma unroll
            for (int ai = 0; ai < 2; ++ai)
#pragma unroll
                for (int m = 0; m < 4; ++m)
#pragma unroll
                    for (int bj = 0; bj < 2; ++bj) { const f32x4 v0 = acc[ai][bj][m][0], v1 = acc[ai][bj][m][1]; u32x4 w;
                        w.x = cvt_pk_bf16(v0[0], v0[1]); w.y = cvt_pk_bf16(v0[2], v0[3]); w.z = cvt_pk_bf16(v1[0], v1[1]); w.w = cvt_pk_bf16(v1[2], v1[3]);
                        stg16(ub + (size_t)(ai * 128 + m * 16) * 256, vo + (unsigned)(bj * 256), w); }
            return; }
        const int b = u.pn >> 3, tp = u.pn & 7; const bool first = (tp == 0) && (col0 == 0);
        bf16_t* ub = UTF + ((size_t)b * 2048 + u.pm * 256) * 1024 + 128 * tp; const unsigned vo = (unsigned)((wr * 64 + fr) * 1024 + col0) * 2u;
#pragma unroll
        for (int ai = 0; ai < 2; ++ai)
#pragma unroll
            for (int m = 0; m < 4; ++m) { const int feat = feat0 + ai * 128 + m * 16; const float sg = ((feat & 255) <= 128) ? 1.f : -1.f;
                f32x4 v0 = acc[ai][0][m][0] + acc[ai][1][m][0] * sg; const f32x4 v1 = acc[ai][0][m][1] + acc[ai][1][m][1] * sg;
                if (first) { v0[0] = acc[ai][0][m][0][0]; AH[(size_t)b * 2048 + feat] = acc[ai][1][m][0][0]; }
                u32x4 w; w.x = cvt_pk_bf16(v0[0], v0[1]); w.y = cvt_pk_bf16(v0[2], v0[3]); w.z = cvt_pk_bf16(v1[0], v1[1]); w.w = cvt_pk_bf16(v1[2], v1[3]);
                stg16(ub + (size_t)(ai * 128 + m * 16) * 1024, vo, w); }
    }
};
struct DftZ { u32x4 zd, zm; unsigned z8; };
__device__ __forceinline__ DftZ dft_row_ld(const bf16_t* zrow, int mi0) { DftZ z; z.zd = *(const u32x4*)(zrow + mi0); z.zm = *(const u32x4*)(zrow + 248 - mi0); z.z8 = (mi0 >= 8) ? (unsigned)zrow[256 - mi0] : 0u; return z; }
__device__ __forceinline__ void dft_row_st(bf16_t* zrow, int mi0, const DftZ& z, const float (&d)[8], const float (&mr)[8]) {
    const u32x4 zd = z.zd, zm = z.zm;
    u32x4 o; o.x = cvt_pk_bf16(d[0] * bflo(zd.x), d[1] * bfhi(zd.x)); o.y = cvt_pk_bf16(d[2] * bflo(zd.y), d[3] * bfhi(zd.y));
    o.z = cvt_pk_bf16(d[4] * bflo(zd.z), d[5] * bfhi(zd.z)); o.w = cvt_pk_bf16(d[6] * bflo(zd.w), d[7] * bfhi(zd.w));
    *(u32x4*)(zrow + mi0) = o;
    bf16_t* mp = zrow + 248 - mi0;
    mp[1] = (bf16_t)f2bf(mr[7] * bfhi(zm.x));
    *(unsigned*)(mp + 2) = cvt_pk_bf16(mr[6] * bflo(zm.y), mr[5] * bfhi(zm.y));
    u32x2 w; w.x = cvt_pk_bf16(mr[4] * bflo(zm.z), mr[3] * bfhi(zm.z)); w.y = cvt_pk_bf16(mr[2] * bflo(zm.w), mr[1] * bfhi(zm.w));
    *(u32x2*)(mp + 4) = w;
    if (mi0 >= 8) mp[8] = (bf16_t)f2bf(mr[0] * bf1((bf16_t)z.z8));
}
template <bool FOLD> struct EpiDft {
    static constexpr bool PERM = true;
    bf16_t* Z; int L; int tok_base; const float* AH;
    __device__ __forceinline__ void operator()(AccRef acc, const pg8::Unit& u, int wr, int wc, int fr, int fq) const {
        const int b = u.pn >> 3, g = u.pn & 7, k0 = u.pm * 128 + wr * 64 + fr, mi0 = wc * 32 + 8 * fq;
        f32x4 ah[2] = {(f32x4){0.f, 0.f, 0.f, 0.f}, (f32x4){0.f, 0.f, 0.f, 0.f}}; float ahn = 0.f;
        if (FOLD) { const float* ap = AH + (size_t)b * 2048 + g * 256; ah[0] = *(const f32x4*)(ap + mi0) * 0.022097087f; ah[1] = *(const f32x4*)(ap + mi0 + 4) * 0.022097087f; ahn = ap[128] * 0.022097087f; }
        const bool nyq = (wc == 0 && fq == 0);
#pragma unroll
        for (int mh = 0; mh < 2; ++mh) {
            DftZ zr[2], zq[2]; unsigned n0[2], n1[2];
#pragma unroll
            for (int mm = 0; mm < 2; ++mm) { const int k = k0 + 16 * (2 * mh + mm); const bf16_t* zrow = Z + (size_t)(tok_base + b * L + k) * 2048 + g * 256;
                const bf16_t* zmir = Z + (size_t)(tok_base + b * L + ((FOLD && k >= 1) ? (L - k) : k)) * 2048 + g * 256;
                zr[mm] = dft_row_ld(zrow, mi0); if (FOLD) zq[mm] = dft_row_ld(zmir, mi0);
                n0[mm] = nyq ? (unsigned)zrow[128] : 0u; n1[mm] = (nyq && FOLD) ? (unsigned)zmir[128] : 0u; }
#pragma unroll
            for (int mm = 0; mm < 2; ++mm) { const int m = 2 * mh + mm, k = k0 + 16 * m; bf16_t* zrow = Z + (size_t)(tok_base + b * L + k) * 2048 + g * 256;
                bf16_t* zmir = Z + (size_t)(tok_base + b * L + (L - k)) * 2048 + g * 256;
                const float sg = (k & 1) ? -1.f : 1.f;
                float dm[8], sm[8];
#pragma unroll
                for (int n = 0; n < 2; ++n) { f32x4 P = acc[0][0][m][n]; const f32x4 Q = acc[1][1][m][n]; if (FOLD) P = P + ah[n] * sg;
#pragma unroll
                    for (int e = 0; e < 4; ++e) { dm[4 * n + e] = P[e] - Q[e]; sm[4 * n + e] = P[e] + Q[e]; }
                    if (n == 0 && mi0 == 0) { dm[0] = P[0]; sm[0] = P[0]; } }
                dft_row_st(zrow, mi0, zr[mm], dm, sm);
                if (FOLD && k >= 1) dft_row_st(zmir, mi0, zq[mm], sm, dm);
                if (nyq) { const float yn = acc[0][1][m][0][0] + (FOLD ? ahn * sg : 0.f);
                    zrow[128] = (bf16_t)f2bf(yn * bf1((bf16_t)n0[mm]));
                    if (FOLD && k >= 1) zmir[128] = (bf16_t)f2bf(yn * bf1((bf16_t)n1[mm])); } }
            asm volatile("" ::: "memory");
        }
    }
};
struct OutOrder {
    pg8::TileOrder T; int G, c; bool with_ctx;
    __device__ void init(int G_, int c_, bool with_ctx_) { T.init(64, 4, G_, c_); G = G_; c = c_; with_ctx = with_ctx_; }
    __device__ bool next(int i, pg8::Unit& u) const {
        const int L = i * G + c;
        if (L < 256) return T.next(i, u);
        if (!with_ctx || L >= 384) return false;
        const int idx = L - 256, tile = idx >> 2; u.pm = 64 + (tile >> 2); u.pn = tile & 3; u.aux = 1 + (idx & 3); return true;
    }
    __device__ __forceinline__ int koff(const pg8::Unit& u) const { return u.aux ? 512 * (u.aux - 1) : 0; }
    __device__ __forceinline__ const char* a_ptr(const pg8::Gemm& g, const pg8::Unit& u) const { return (const char*)(g.A + (size_t)u.pm * 256 * g.lda + koff(u)); }
    __device__ __forceinline__ const char* b_ptr(const pg8::Gemm& g, const pg8::Unit& u, int half) const { return (const char*)(g.Bt + (size_t)(u.pn * 256 + 128 * half) * g.ldb + koff(u)); }
    __device__ __forceinline__ bool b_mirror(const pg8::Unit&) const { return false; }
    __device__ __forceinline__ bool b_fix(const pg8::Unit&) const { return false; }
    __device__ __forceinline__ int ktiles(const pg8::Gemm& g, const pg8::Unit& u) const { return u.aux ? 8 : g.K / pg8::BK; }
};
struct EpiResid {
    static constexpr bool PERM = false;
    const float* xin_lat; float* xout_lat; const float* gate; float* part;
    __device__ __forceinline__ void operator()(AccRef acc, const pg8::Unit& u, int wr, int wc, int fr, int fq) const {
        const int row0 = u.pm * 256 + wr * 64 + fr, col0 = u.pn * 256 + wc * 32 + 4 * fq;
        if (u.aux) {
            float* pp = part + (size_t)(u.aux - 1) * NCTX * DM + (size_t)(row0 - NLAT) * DM + col0;
#pragma unroll
            for (int ai = 0; ai < 2; ++ai)
#pragma unroll
                for (int m = 0; m < 4; ++m)
#pragma unroll
                    for (int bj = 0; bj < 2; ++bj)
#pragma unroll
                        for (int n = 0; n < 2; ++n) *(f32x4*)(pp + (size_t)(ai * 128 + m * 16) * DM + bj * 128 + n * 16) = acc[ai][bj][m][n];
            return;
        }
        const float* gp = gate + (u.pm >> 3) * 3072 + col0;
        f32x4 gv[2][2];
#pragma unroll
        for (int bj = 0; bj < 2; ++bj)
#pragma unroll
            for (int n = 0; n < 2; ++n) gv[bj][n] = *(const f32x4*)(gp + bj * 128 + n * 16);
#pragma unroll
        for (int ai = 0; ai < 2; ++ai) {
            f32x4 xv[4][2][2];
#pragma unroll
            for (int m = 0; m < 4; ++m) { const size_t off = (size_t)(row0 + ai * 128 + m * 16) * DM + col0;
#pragma unroll
                for (int bj = 0; bj < 2; ++bj)
#pragma unroll
                    for (int n = 0; n < 2; ++n) xv[m][bj][n] = *(const f32x4*)(xin_lat + off + bj * 128 + n * 16); }
#pragma unroll
            for (int m = 0; m < 4; ++m) { const size_t off = (size_t)(row0 + ai * 128 + m * 16) * DM + col0;
#pragma unroll
                for (int bj = 0; bj < 2; ++bj)
#pragma unroll
                    for (int n = 0; n < 2; ++n) *(f32x4*)(xout_lat + off + bj * 128 + n * 16) = xv[m][bj][n] + gv[bj][n] * acc[ai][bj][m][n]; }
            asm volatile("" ::: "memory"); }
    }
};
struct EpiQKV {
    static constexpr bool PERM = true;
    bf16_t* Q; bf16_t* K; bf16_t* V; const float* rcos; const float* rsin;
    __device__ __forceinline__ void operator()(AccRef acc, const pg8::Unit& u, int wr, int wc, int fr, int fq) const {
        const int row0 = u.pm * 256 + wr * 64 + fr, c0 = wc * 32 + 8 * fq;
        if (u.pn >= 8) {
#pragma unroll
            for (int ai = 0; ai < 2; ++ai)
#pragma unroll
                for (int m = 0; m < 4; ++m) { bf16_t* rowp = V + (size_t)(row0 + ai * 128 + m * 16) * 2048 + (u.pn - 8) * 256 + c0;
#pragma unroll
                    for (int bj = 0; bj < 2; ++bj) { const f32x4 v0 = acc[ai][bj][m][0], v1 = acc[ai][bj][m][1]; u32x4 w;
                        w.x = cvt_pk_bf16(v0[0], v0[1]); w.y = cvt_pk_bf16(v0[2], v0[3]); w.z = cvt_pk_bf16(v1[0], v1[1]); w.w = cvt_pk_bf16(v1[2], v1[3]);
                        *(u32x4*)(rowp + bj * 128) = w; } }
            return;
        }
        const bool isk = u.pn >= 4, lat = u.pm < 64; const int h = u.pn & 3; bf16_t* dst = isk ? K : Q; const float sc = isk ? 0.0625f : 1.0f;
        const int i0 = 16 * wc + 4 * fq;
#pragma unroll
        for (int ai = 0; ai < 2; ++ai) {
            f32x4 cv[4][2], sv[4][2];
            if (lat) {
#pragma unroll
                for (int m = 0; m < 4; ++m) { const int l = (row0 + ai * 128 + m * 16) & 2047;
#pragma unroll
                    for (int bj = 0; bj < 2; ++bj) { const int pos = bj == 0 ? (l >> 6) : (l & 63); cv[m][bj] = *(const f32x4*)(rcos + pos * 64 + i0); sv[m][bj] = *(const f32x4*)(rsin + pos * 64 + i0); } } }
#pragma unroll
            for (int m = 0; m < 4; ++m) { const int row = row0 + ai * 128 + m * 16;
                bf16_t* chp = dst + ((size_t)(row >> 7) * 4 + h) * 32768;
#pragma unroll
                for (int bj = 0; bj < 2; ++bj) { f32x4 x1 = acc[ai][bj][m][0], x2 = acc[ai][bj][m][1];
                    if (lat) { const f32x4 o1 = x1 * cv[m][bj] - x2 * sv[m][bj], o2 = x1 * sv[m][bj] + x2 * cv[m][bj]; x1 = o1; x2 = o2; }
                    x1 = x1 * sc; x2 = x2 * sc; u32x4 w;
                    w.x = cvt_pk_bf16(x1[0], x1[1]); w.y = cvt_pk_bf16(x1[2], x1[3]); w.z = cvt_pk_bf16(x2[0], x2[1]); w.w = cvt_pk_bf16(x2[2], x2[3]);
                    const int s32 = 4 * bj + wc;
                    const int off = isk ? ((s32 * 8 + ((row & 127) >> 4)) * 512 + (4 * (row & 15) + fq) * 8)
                                        : (((((row >> 4) & 7) * 8) + s32) * 512 + (16 * fq + (row & 15)) * 8);
                    *(u32x4*)(chp + off) = w; } }
            asm volatile("" ::: "memory"); }
    }
};
struct EpiZGate {
    static constexpr bool PERM = true;
    const bf16_t* O; const float* rinv; bf16_t* AO;
    __device__ __forceinline__ void operator()(AccRef acc, const pg8::Unit& u, int wr, int wc, int fr, int fq) const {
        const int row0 = u.pm * 256 + wr * 64 + fr, col0 = u.pn * 256 + wc * 32 + 8 * fq, head = u.pn >> 1;
#pragma unroll
        for (int ai = 0; ai < 2; ++ai) {
            u32x4 ov[4][2]; float rv[4];
#pragma unroll
            for (int m = 0; m < 4; ++m) { const int row = row0 + ai * 128 + m * 16; rv[m] = rinv[row * 4 + head];
#pragma unroll
                for (int bj = 0; bj < 2; ++bj) { const int c = col0 + bj * 128, e0 = c & 63;
                    const bf16_t* op = O + ((size_t)((((row >> 7) * 4 + (c >> 9)) * 8 + ((c >> 6) & 7)) * 8 + ((row >> 4) & 7)) << 10) + (e0 >> 4) * 256 + (16 * ((e0 >> 2) & 3) + (row & 15)) * 4;
                    const u32x2 lo = *(const u32x2*)op, hi = *(const u32x2*)(op + 64); ov[m][bj] = (u32x4){lo.x, lo.y, hi.x, hi.y}; } }
#pragma unroll
            for (int m = 0; m < 4; ++m) { const int row = row0 + ai * 128 + m * 16; const float r_ = rv[m];
#pragma unroll
                for (int bj = 0; bj < 2; ++bj) { const u32x4 o = ov[m][bj]; const f32x4 v0 = acc[ai][bj][m][0], v1 = acc[ai][bj][m][1]; u32x4 w;
                    w.x = cvt_pk_bf16(bflo(o.x) * r_ * silu_f(v0[0]), bfhi(o.x) * r_ * silu_f(v0[1])); w.y = cvt_pk_bf16(bflo(o.y) * r_ * silu_f(v0[2]), bfhi(o.y) * r_ * silu_f(v0[3]));
                    w.z = cvt_pk_bf16(bflo(o.z) * r_ * silu_f(v1[0]), bfhi(o.z) * r_ * silu_f(v1[1])); w.w = cvt_pk_bf16(bflo(o.w) * r_ * silu_f(v1[2]), bfhi(o.w) * r_ * silu_f(v1[3]));
                    *(u32x4*)(AO + (size_t)row * 2048 + col0 + bj * 128) = w; } }
            asm volatile("" ::: "memory"); }
    }
};

#define XB_TMO      128
#define XB_XCNT(j)  (256  + 64 * (j))
#define XB_XSUB(j)  (1280 + 64 * (j))
#define XB_XGEN(j)  (2304 + 64 * (j))
#define XB_TOP      3328
#define XB_TOPGEN   3392
#define XCD_BAR_WORDS 3456
#define XB_SPIN_CAP (1u << 18)
__device__ __forceinline__ unsigned xb_ld(unsigned* p)              { return __hip_atomic_load(p, __ATOMIC_RELAXED, __HIP_MEMORY_SCOPE_AGENT); }
__device__ __forceinline__ unsigned xb_add(unsigned* p, unsigned v) { return __hip_atomic_fetch_add(p, v, __ATOMIC_RELAXED, __HIP_MEMORY_SCOPE_AGENT); }
__device__ __forceinline__ unsigned xb_xcc_id() { return (unsigned)__builtin_amdgcn_s_getreg((3 << 11) | 20) & 0xFu; }
#define XB_SPIN(cond, bar) do { unsigned _sp = 0; while (cond) { __builtin_amdgcn_s_sleep(1); \
    if ((++_sp & 255u) == 0u) { if (xb_ld(&(bar)[XB_TMO])) break; if (_sp > XB_SPIN_CAP) { atomicAdd(&(bar)[XB_TMO], 1u); break; } } } } while (0)
struct XcdBarrier { unsigned* bar; unsigned x; volatile LAS unsigned* st; };
__device__ __forceinline__ XcdBarrier xcd_barrier_post(unsigned* bar, volatile LAS unsigned* st) {
    XcdBarrier b; b.bar = bar; b.x = xb_xcc_id(); b.st = st;
    if (threadIdx.x == 0) (void)xb_add(&bar[XB_XCNT(b.x)], 1u);
    return b;
}
__device__ __forceinline__ void xcd_barrier_complete(unsigned* bar, unsigned x, unsigned& nloc, unsigned& nx) {
    const unsigned G = gridDim.x * gridDim.y * gridDim.z;
    unsigned sum, cnt, mine, sp = 0u;
    for (;;) {
        sum = 0u; cnt = 0u; mine = 0u;
#pragma unroll 1
        for (unsigned j = 0; j < 16; ++j) { const unsigned c = xb_ld(&bar[XB_XCNT(j)]); sum += c; cnt += (c > 0u) ? 1u : 0u; mine = (j == x) ? c : mine; }
        if (sum == G) break;
        __builtin_amdgcn_s_sleep(1);
        if ((++sp & 255u) == 0u) { if (xb_ld(&bar[XB_TMO])) break; if (sp > XB_SPIN_CAP) { atomicAdd(&bar[XB_TMO], 1u); break; } }
    }
    nloc = mine > 0u ? mine : 1u; nx = cnt > 0u ? cnt : 1u;
}
__device__ __forceinline__ void xcd_barrier(const XcdBarrier& b) {
    asm volatile("s_waitcnt vmcnt(0)" ::: "memory");
    __syncthreads();
    if (threadIdx.x == 0) {
        unsigned* bar = b.bar;
        __builtin_amdgcn_s_waitcnt(0);
        unsigned nloc = b.st[0], nx = b.st[1];
        if (nloc == 0u) { xcd_barrier_complete(bar, b.x, nloc, nx); b.st[0] = nloc; b.st[1] = nx; }
        const unsigned old = xb_add(&bar[XB_XSUB(b.x)], 1u);
        const unsigned gen = old / nloc;
        if (old + 1u == (gen + 1u) * nloc) {
            __builtin_amdgcn_fence(__ATOMIC_RELEASE, "agent");
            asm volatile("s_waitcnt vmcnt(0)" ::: "memory");
            const unsigned og = xb_add(&bar[XB_TOP], 1u);
            const unsigned tg = og / nx;
            if (og + 1u == (tg + 1u) * nx) xb_add(&bar[XB_TOPGEN], 1u);
            else XB_SPIN(xb_ld(&bar[XB_TOPGEN]) == tg, bar);
            __builtin_amdgcn_fence(__ATOMIC_ACQUIRE, "agent");
            xb_add(&bar[XB_XGEN(b.x)], 1u);
            asm volatile("s_waitcnt vmcnt(0)" ::: "memory");
        } else {
            XB_SPIN(xb_ld(&bar[XB_XGEN(b.x)]) == gen, bar);
            __builtin_amdgcn_fence(__ATOMIC_ACQUIRE, "agent");
            asm volatile("s_waitcnt vmcnt(0)" ::: "memory");
        }
    }
    __syncthreads();
}

struct Args { const float* in[13]; float* out; unsigned char* ws; int ph_lo, ph_hi, pad0, pad1; };
struct Frame {
    LAS unsigned char* lds;
    int vcu, G, wv;
    unsigned char* ws;
};
__device__ __forceinline__ int lane_id() { int l; asm volatile("v_mbcnt_lo_u32_b32 %0, -1, 0\n\tv_mbcnt_hi_u32_b32 %0, -1, %0" : "=v"(l)); return l; }
__device__ __forceinline__ unsigned char* launder_ptr(unsigned char* p) {
    unsigned lo = (unsigned)(unsigned long long)p, hi = (unsigned)((unsigned long long)p >> 32);
    asm volatile("" : "+s"(lo), "+s"(hi));
    return (unsigned char*)(((unsigned long long)hi << 32) | lo);
}
#define PHASE_IDS() int tid = F.wv * 64 + lane_id(); asm volatile("" : "+v"(tid)); const int lane = tid & 63, wave = __builtin_amdgcn_readfirstlane(tid >> 6); (void)lane; (void)wave; \
    unsigned char* ws = launder_ptr(F.ws); (void)ws
#define LDS_WAIT() asm volatile("s_waitcnt lgkmcnt(0)" ::: "memory")

__device__ __forceinline__ int qk_pos(int d) { const int half = d >> 7, n = (d >> 6) & 1, i = d & 63; return 128 * half + 8 * (i >> 2) + 4 * n + (i & 3); }
template <int MODE>
__device__ __forceinline__ void transpose_item(const float* W, int K, int N, int n_begin, bf16_t* WT, LAS float* scr, int item, int nblk, int lane) {
    const int kb = item / nblk, nb = item % nblk, k0 = 64 * kb, n0 = n_begin + 64 * nb;
    const GAS f32x4* src = (const GAS f32x4*)(W + (size_t)(k0 + (lane >> 4)) * N + n0 + 4 * (lane & 15));
    f32x4 v[16];
#pragma unroll
    for (int i = 0; i < 16; ++i) v[i] = src[(size_t)i * N];
#pragma unroll
    for (int i = 0; i < 16; ++i) *(LAS f32x4*)(scr + (4 * i + (lane >> 4)) * 68 + 4 * (lane & 15)) = v[i];
    LDS_WAIT(); asm volatile("" ::: "memory");
    const int na = n0 + lane; int nn = na - n_begin;
    if (MODE == 1) nn = (na < 2048) ? ((na & ~255) + qk_pos(na & 255)) : na;
    GAS u32x4* dst = (GAS u32x4*)(WT + (size_t)nn * K + k0);
#pragma unroll
    for (int c = 0; c < 8; ++c) { const LAS float* sp = scr + (8 * c) * 68 + lane;
        u32x4 o; o.x = pk2(sp[0 * 68], sp[1 * 68]); o.y = pk2(sp[2 * 68], sp[3 * 68]); o.z = pk2(sp[4 * 68], sp[5 * 68]); o.w = pk2(sp[6 * 68], sp[7 * 68]);
        dst[c] = o; }
    LDS_WAIT(); asm volatile("" ::: "memory");
}
__device__ __forceinline__ void fold_task(const float* Win  , const LAS float* ctab  , bf16_t* WfT, int t, int lane) {
    const int g = t >> 8, p0 = ((t >> 5) & 7) * 32, kk0 = (t & 31) * 32, s = lane >> 5, li = lane & 31;
    f32x16 acc;
#pragma unroll
    for (int i = 0; i < 16; ++i) acc[i] = 0.f;
    const float* wrow = Win + (size_t)(kk0 + li) * 4096 + g * 256 + 4 * s;
    const int pcol = p0 + li;
    const int pmul = pcol < 128 ? pcol : pcol - 128, poff = pcol < 128 ? 0 : -64; const bool nyq = pcol == 128;
    f32x4 wvv[32];
#pragma unroll
    for (int tp = 0; tp < 32; ++tp) wvv[tp] = *(const GAS f32x4*)((const GAS float*)wrow + 8 * tp);
#pragma unroll
    for (int tp = 0; tp < 32; ++tp) {
        const f32x4 wv = wvv[tp];
#pragma unroll
        for (int uu = 0; uu < 4; ++uu) { const int cc = 8 * tp + 4 * s + uu; float a;
            a = ctab[(pmul * cc + poff) & 255]; if (nyq) a = (cc & 1) ? -0.0625f : 0.0625f;
            acc = __builtin_amdgcn_mfma_f32_32x32x2f32(a, wv[uu], acc, 0, 0, 0); }
    }
#pragma unroll
    for (int i = 0; i < 16; ++i) { const int row = (i & 3) + 8 * (i >> 2) + 4 * s; WfT[(size_t)(g * 256 + p0 + row) * 1024 + kk0 + li] = (bf16_t)f2bf(acc[i]); }
}

__device__ __forceinline__ void p0_phase(Frame& F, const Args& a) {
    PHASE_IDS();
    float* ADA = (float*)(ws + WS_ADA);
    const float* c = a.in[1]; const float* cctx = a.in[3]; const float* ada_w = a.in[5]; const float* ada_b = a.in[6];
    LAS float* sl = (LAS float*)F.lds;
    LAS float* part = (LAS float*)(F.lds + 36864);
    bool loaded = false;
    for (int u = F.vcu; u < 192; u += F.G) {
        if (!loaded) { for (int idx = tid; idx < 9 * 1024; idx += 512) { const int r = idx >> 10, k = idx & 1023; const float x = r < 8 ? c[r * 1024 + k] : cctx[k]; sl[idx] = x / (1.f + expf(-x)); } loaded = true; }
        __syncthreads();
        const int i = u / 48, n0 = (u % 48) * 64;
        f32x4 acc[9];
#pragma unroll
        for (int r = 0; r < 9; ++r) acc[r] = (f32x4){0.f, 0.f, 0.f, 0.f};
        const int ks4 = lane >> 4, c4 = 4 * (lane & 15);
        const float* wp = ada_w + ((size_t)i * 1024 + wave * 128 + ks4) * 3072 + n0 + c4;
#pragma unroll 8
        for (int kk = 0; kk < 32; ++kk) { const f32x4 wv = *(const f32x4*)(wp + (size_t)kk * 4 * 3072); const int k = wave * 128 + 4 * kk + ks4;
#pragma unroll
            for (int r = 0; r < 9; ++r) acc[r] += wv * sl[r * 1024 + k]; }
#pragma unroll
        for (int r = 0; r < 9; ++r) *(LAS f32x4*)(part + ((wave * 4 + ks4) * 9 + r) * 64 + c4) = acc[r];
        __syncthreads();
        for (int idx = tid; idx < 576; idx += 512) { const int r = idx >> 6, l = idx & 63; float s = 0.f;
#pragma unroll
            for (int w = 0; w < 32; ++w) s += part[(w * 9 + r) * 64 + l];
            ADA[(i * 9 + r) * 3072 + n0 + l] = s + ada_b[i * 3072 + n0 + l]; }
    }
    const int gt = F.vcu * 512 + tid, NT = F.G * 512;
    float* RC = (float*)(ws + WS_ROPE); float* RS = RC + 4096;
    for (int idx = gt; idx < 4096; idx += NT) { const int pos = idx >> 6, i = idx & 63; const float freq = powf(10000.0f, -(float)i / 64.0f); const float ang = (float)pos * freq;
        RC[idx] = cosf(ang); RS[idx] = sinf(ang); }
    bf16_t* CS256 = (bf16_t*)(ws + WS_CS256);
    for (int idx = gt; idx < 512 * 256; idx += NT) { const int row = idx >> 8, l = idx & 255, kt = row >> 8, hf = (row >> 7) & 1, k = kt * 128 + (row & 127);
        const float x = (float)((k * l) & 255) * (1.f / 128.f); const float v = (hf ? sinpif(x) : cospif(x)) * 0.0625f; CS256[idx] = (bf16_t)f2bf(v); }
}

__device__ __forceinline__ void norm_row(const float* xrow, const float* ng, const float* adar  , bf16_t* orow, int lane) {
    const f32x4* xr = (const f32x4*)xrow + lane;
    f32x4 v[4]; float s = 0.f;
#pragma unroll
    for (int j = 0; j < 4; ++j) { v[j] = xr[64 * j]; s += (v[j].x * v[j].x + v[j].y * v[j].y) + (v[j].z * v[j].z + v[j].w * v[j].w); }
    const float rinv = rsqrtf(wave_sum(s, lane) * (1.f / DM) + EPS);
    unsigned long long* o8 = (unsigned long long*)orow + lane;
#pragma unroll
    for (int j = 0; j < 4; ++j) { const int col = 4 * lane + 256 * j; const f32x4 g = *(const f32x4*)(ng + col), sh = *(const f32x4*)(adar + col), sc = *(const f32x4*)(adar + 1024 + col);
        const f32x4 y = v[j] * rinv * g * (sc + 1.0f) + sh;
        o8[64 * j] = (unsigned long long)pk2(y.x, y.y) | ((unsigned long long)pk2(y.z, y.w) << 32); }
}
template <int NR>
__device__ __forceinline__ void norm_batch(const float* const (&xrow)[NR], bf16_t* const (&hrow)[NR], int nrows, const f32x4 (&gm)[4], const f32x4 (&sh)[4], int lane) {
    f32x4 v[NR][4]; float ss[NR];
#pragma unroll
    for (int t = 0; t < NR; ++t) { const f32x4* xr = (const f32x4*)xrow[t] + lane;
#pragma unroll
        for (int j = 0; j < 4; ++j) v[t][j] = xr[64 * j]; }
#pragma unroll
    for (int t = 0; t < NR; ++t) { float s = 0.f;
#pragma unroll
        for (int j = 0; j < 4; ++j) s += (v[t][j].x * v[t][j].x + v[t][j].y * v[t][j].y) + (v[t][j].z * v[t][j].z + v[t][j].w * v[t][j].w);
        ss[t] = s; }
#pragma unroll
    for (int o = 1; o < 64; o <<= 1) {
#pragma unroll
        for (int t = 0; t < NR; ++t) ss[t] += shx(ss[t], o, lane); }
#pragma unroll
    for (int t = 0; t < NR; ++t) if (t < nrows) { const float rinv = rsqrtf(ss[t] * (1.f / DM) + EPS);
        unsigned long long* o8 = (unsigned long long*)hrow[t] + lane;
#pragma unroll
        for (int j = 0; j < 4; ++j) { const f32x4 y = v[t][j] * rinv * gm[j] + sh[j];
            o8[64 * j] = (unsigned long long)pk2(y.x, y.y) | ((unsigned long long)pk2(y.z, y.w) << 32); } }
}
template <bool ADDP>
__device__ __forceinline__ void norm_rows(Frame& F, const Args& a, int layer, bf16_t* H, int wsub = 8) {
    PHASE_IDS();
    const float* xl = layer == 0 ? a.in[0] : a.out; const float* xc = (layer == 0 || (ADDP && layer == 1)) ? a.in[2] : (const float*)(ws + WS_XCTX);
    const float* ng = a.in[4] + layer * DM; const float* ADA = (const float*)(ws + WS_ADA) + layer * 9 * 3072;
    const int gw = F.vcu * wsub + wave, NGW = F.G * wsub;
    const int wpb = NGW >> 3;
    if (wpb > 0 && (NGW & 7) == 0) {
        const int b = gw / wpb, wi = gw - b * wpb; const float* adar = ADA + b * 3072;
        f32x4 gm[4], sh[4];
#pragma unroll
        for (int j = 0; j < 4; ++j) { const int col = 4 * lane + 256 * j; gm[j] = *(const f32x4*)(ng + col) * (*(const f32x4*)(adar + 1024 + col) + 1.0f); sh[j] = *(const f32x4*)(adar + col); }
        for (int l0 = wi; l0 < SEQ; l0 += 8 * wpb) {
            const float* xr[8]; bf16_t* hr[8]; int n = 0;
#pragma unroll
            for (int t = 0; t < 8; ++t) { const int l = l0 + t * wpb; const int ll = l < SEQ ? l : wi; if (l < SEQ) n = t + 1; xr[t] = xl + (size_t)(b * SEQ + ll) * DM; hr[t] = H + (size_t)(b * SEQ + ll) * DM; }
            norm_batch<8>(xr, hr, n, gm, sh, lane);
        }
        const float* adac = ADA + 8 * 3072;
#pragma unroll
        for (int j = 0; j < 4; ++j) { const int col = 4 * lane + 256 * j; gm[j] = *(const f32x4*)(ng + col) * (*(const f32x4*)(adac + 1024 + col) + 1.0f); sh[j] = *(const f32x4*)(adac + col); }
        for (int m = gw; m < NCTX; m += NGW) {
            f32x4 xv[4];
#pragma unroll
            for (int j = 0; j < 4; ++j) xv[j] = *((const f32x4*)(xc + (size_t)m * DM) + lane + 64 * j);
            if (ADDP && layer >= 1) {
                const float* part = (const float*)(ws + WS_PART); const float* gprev = (const float*)(ws + WS_ADA) + (layer - 1) * 9 * 3072 + 8 * 3072 + 2048;
                float* xw = (float*)(ws + WS_XCTX) + (size_t)m * DM;
#pragma unroll
                for (int j = 0; j < 4; ++j) { const f32x4* pr = (const f32x4*)(part + (size_t)m * DM) + lane + 64 * j;
                    const f32x4 ps = (pr[0] + pr[(size_t)NCTX * DM / 4]) + (pr[(size_t)2 * NCTX * DM / 4] + pr[(size_t)3 * NCTX * DM / 4]);
                    xv[j] = xv[j] + *(const f32x4*)(gprev + 4 * lane + 256 * j) * ps;
                    *((f32x4*)xw + lane + 64 * j) = xv[j]; }
            }
            float s_ = 0.f;
#pragma unroll
            for (int j = 0; j < 4; ++j) s_ += (xv[j].x * xv[j].x + xv[j].y * xv[j].y) + (xv[j].z * xv[j].z + xv[j].w * xv[j].w);
            const float rinv = rsqrtf(wave_sum(s_, lane) * (1.f / DM) + EPS);
            unsigned long long* o8 = (unsigned long long*)(H + (size_t)(NLAT + m) * DM) + lane;
#pragma unroll
            for (int j = 0; j < 4; ++j) { const f32x4 y = xv[j] * rinv * gm[j] + sh[j];
                o8[64 * j] = (unsigned long long)pk2(y.x, y.y) | ((unsigned long long)pk2(y.z, y.w) << 32); }
        }
        return;
    }
    for (int m = gw; m < NTOK; m += NGW) {
        const bool lat = m < NLAT; const int r = lat ? (m >> 11) : 8; const float* adar = ADA + r * 3072;
        f32x4 gm[4], sh[4];
#pragma unroll
        for (int j = 0; j < 4; ++j) { const int col = 4 * lane + 256 * j; gm[j] = *(const f32x4*)(ng + col) * (*(const f32x4*)(adar + 1024 + col) + 1.0f); sh[j] = *(const f32x4*)(adar + col); }
        const float* xr[1] = {lat ? xl + (size_t)m * DM : xc + (size_t)(m - NLAT) * DM}; bf16_t* hr[1] = {H + (size_t)m * DM};
        norm_batch<1>(xr, hr, 1, gm, sh, lane);
    }
}
__device__ __forceinline__ void cf_prep(Frame& F, int wave, int lane) {
    LAS float* ctab = (LAS float*)(F.lds + 139264);
    { const int tt = wave * 64 + lane; if (tt < 256) ctab[tt] = cospif((float)tt * (1.f / 128.f)) * 0.0625f; }
    __syncthreads();
}
__device__ __forceinline__ void cf_main(Frame& F, const Args& a, int j, int gw, int NGW, unsigned char* ws, int wave, int lane) {
    LAS float* scr = (LAS float*)(F.lds + wave * 17408); const LAS float* ctab = (const LAS float*)(F.lds + 139264);
    bf16_t* W1 = (bf16_t*)(ws + WS_WF);
    const float* win = a.in[7] + (size_t)j * 1024 * 4096; const float* wout = a.in[8] + (size_t)j * 2048 * 1024;
    bf16_t* WfoT = W1 + (size_t)4096 * 1024;
    for (int t = gw; t < 2048; t += NGW) fold_task(win, ctab, W1, t, lane);
    for (int it = gw; it < 16 * 32; it += NGW) transpose_item<0>(win, 1024, 4096, 2048, W1 + (size_t)2048 * 1024, scr, it, 32, lane);
    for (int it = gw; it < 32 * 16; it += NGW) transpose_item<0>(wout, 2048, 1024, 0, WfoT, scr, it, 16, lane);
}
__device__ __forceinline__ void cf_cs(Frame& F, int gt, int NT, unsigned char* ws, int wave, int lane) {
    bf16_t* CS = (bf16_t*)(ws + WS_CS);
    __syncthreads();
    LAS float* ctab2 = (LAS float*)F.lds;
    for (int n = wave * 64 + lane; n < 2048; n += 512) ctab2[n] = cospif((float)n * (1.f / 1024.f)) * 0.022097087f;
    __syncthreads();
    for (int ch = gt; ch < 2048 * 128; ch += NT) { const int row = ch >> 7, l0 = (ch & 127) * 8, kt = row >> 8, hf = (row >> 7) & 1, k = kt * 128 + (row & 127);
        const int off = hf ? -512 : 0;
        unsigned w[4];
#pragma unroll
        for (int e = 0; e < 4; ++e) { float v[2];
#pragma unroll
            for (int q = 0; q < 2; ++q) { const int l = l0 + 2 * e + q; v[q] = ctab2[(k * l + off) & 2047]; }
            w[e] = pk2(v[0], v[1]); }
        *(u32x4*)(CS + (size_t)row * 1024 + l0) = (u32x4){w[0], w[1], w[2], w[3]}; }
    __syncthreads();
}
__device__ __forceinline__ void conv_fourier(Frame& F, const Args& a, int j, int gw, int NGW, int gt, int NT, unsigned char* ws, int wave, int lane) {
    cf_prep(F, wave, lane); cf_main(F, a, j, gw, NGW, ws, wave, lane); cf_cs(F, gt, NT, ws, wave, lane);
}
__device__ __forceinline__ void conv_ret(Frame& F, const Args& a, int j, int gw, int NGW, unsigned char* ws, int wave, int lane, int lo = 0, int hi = 2048) {
    LAS float* scr = (LAS float*)(F.lds + wave * 17408);
    bf16_t* W1 = (bf16_t*)(ws + WS_W);
    const float* win = a.in[9] + (size_t)j * 1024 * 6144; const float* wout = a.in[10] + (size_t)j * 2048 * 1024;
    bf16_t* WroT = W1 + (size_t)6144 * 1024;
    for (int it = lo + gw; it < hi; it += NGW) {
        if (it < 1536) transpose_item<1>(win, 1024, 6144, 0, W1, scr, it, 96, lane);
        else transpose_item<0>(wout, 2048, 1024, 0, WroT, scr, it - 1536, 16, lane);
    }
}
__device__ __forceinline__ void bg_conv_ret(Frame& F, const Args& a, int layer, int cu_lo, int lo, int hi) {
    PHASE_IDS();
    const int cu = (int)blockIdx.x - cu_lo;
    if (layer + 1 >= NLAYER || F.G != 256 || cu < 0 || cu >= 128) return;
    conv_ret(F, a, (layer + 1) >> 1, cu * 8 + wave, 1024, ws, wave, lane, lo, hi);
}
__device__ __forceinline__ void p0_conv(Frame& F, const Args& a) {
    PHASE_IDS();
    __syncthreads();
    conv_fourier(F, a, 0, F.vcu * 8 + wave, F.G * 8, F.vcu * 512 + tid, F.G * 512, ws, wave, lane);
}
__device__ __forceinline__ void n_phase(Frame& F, const Args& a, int layer) {
    PHASE_IDS();
    const bool fourier = (layer & 1) == 0;
    if (fourier && layer >= 1) {
        cf_prep(F, wave, lane);
        if (wave < 4) norm_rows<true>(F, a, layer, (bf16_t*)(ws + WS_H), 4); else cf_main(F, a, layer >> 1, F.vcu * 4 + wave - 4, F.G * 4, ws, wave, lane);
        cf_cs(F, F.vcu * 512 + tid, F.G * 512, ws, wave, lane);
        return;
    }
    norm_rows<true>(F, a, layer, (bf16_t*)(ws + (fourier ? WS_H : WS_OF)));
    if (layer >= 1) {
        if (fourier) conv_fourier(F, a, layer >> 1, F.vcu * 8 + wave, F.G * 8, F.vcu * 512 + tid, F.G * 512, ws, wave, lane);
        else if (F.G != 256) conv_ret(F, a, layer >> 1, F.vcu * 8 + wave, F.G * 8, ws, wave, lane);
    }
}
__device__ __forceinline__ void nyq_row_phase(Frame& F) {
    PHASE_IDS();
    const bf16_t* UTF = (const bf16_t*)(ws + WS_UTL); const float* AH = (const float*)(ws + WS_RINV); bf16_t* Z = (bf16_t*)(ws + WS_Z);
    const int gw = F.vcu * 8 + wave, NGW = F.G * 8;
    for (int t0 = gw; t0 < 64 * 129; t0 += 5 * NGW) {
        u32x4 v[5][2]; float ah[5]; unsigned short zv[5]; bf16_t* zp[5]; bool act[5];
#pragma unroll
        for (int i = 0; i < 5; ++i) { const int t = t0 + i * NGW; const bool ok = t < 64 * 129; const int tt = ok ? t : gw;
            const int bg = tt / 129, mt = tt - bg * 129, b = bg >> 3, g = bg & 7; const int row = b * 2048 + g * 256 + mt;
            const GAS u32x4* src = (const GAS u32x4*)(UTF + (size_t)row * 1024);
            v[i][0] = src[lane]; v[i][1] = src[lane + 64]; ah[i] = AH[row];
            bf16_t* zrow = Z + (size_t)(b * 2048 + 1024) * 2048 + g * 256;
            act[i] = ok && (lane == 0 || (lane == 1 && mt >= 1 && mt <= 127)); zp[i] = zrow + (lane == 0 ? mt : 256 - mt);
            zv[i] = act[i] ? *(const GAS unsigned short*)zp[i] : (unsigned short)0; }
#pragma unroll
        for (int i = 0; i < 5; ++i) { float s = 0.f;
#pragma unroll
            for (int h2 = 0; h2 < 2; ++h2) { const u32x4 x = v[i][h2]; s += (bflo(x.x) - bfhi(x.x)) + (bflo(x.y) - bfhi(x.y)) + (bflo(x.z) - bfhi(x.z)) + (bflo(x.w) - bfhi(x.w)); }
            s = wave_sum(s, lane);
            const float y = (s + ah[i]) * 0.022097087f;
            if (act[i]) *zp[i] = (bf16_t)f2bf(y * bf1((bf16_t)zv[i])); }
    }
}
__device__ __forceinline__ bf16_t* s_chunk(unsigned char* ws, int h, int rc) {
    return rc < 64 ? (bf16_t*)(ws + WS_SA) + ((size_t)(h * 64 + rc) << 14) : (bf16_t*)(ws + WS_SB) + ((size_t)(h * 80 + rc - 64) << 14);
}
struct DiagOrder {
    int G, c;
    __device__ bool next(int i, pg8::Unit& u) const { const int L = i * G + c; if (L >= 288) return false; u.aux = L / 72; u.pm = L - 72 * u.aux; u.pn = u.pm; return true; }
    __device__ __forceinline__ const char* a_ptr(const pg8::Gemm& g, const pg8::Unit& u) const { return (const char*)(g.A + ((size_t)(2 * u.pm) * 4 + u.aux) * 32768); }
    __device__ __forceinline__ const char* b_ptr(const pg8::Gemm& g, const pg8::Unit& u, int half) const { return (const char*)(g.Bt + ((size_t)(2 * u.pm + half) * 4 + u.aux) * 32768); }
    __device__ __forceinline__ bool b_mirror(const pg8::Unit&) const { return false; }
    __device__ __forceinline__ bool b_fix(const pg8::Unit&) const { return false; }
    __device__ __forceinline__ int ktiles(const pg8::Gemm& g, const pg8::Unit&) const { return g.K / pg8::BK; }
};
struct EpiS {
    static constexpr bool PERM = true;
    unsigned char* ws;
    __device__ __forceinline__ void operator()(AccRef acc, const pg8::Unit& u, int wr, int wc, int fr, int fq) const {
#pragma unroll
        for (int ai = 0; ai < 2; ++ai) { bf16_t* sp = s_chunk(ws, u.aux, 2 * u.pm + ai);
#pragma unroll
            for (int m = 0; m < 4; ++m) { const f32x4 v0 = acc[ai][ai][m][0], v1 = acc[ai][ai][m][1]; u32x4 w;
                w.x = cvt_pk_bf16(v0[0], v0[1]); w.y = cvt_pk_bf16(v0[2], v0[3]); w.z = cvt_pk_bf16(v1[0], v1[1]); w.w = cvt_pk_bf16(v1[2], v1[3]);
                *(u32x4*)(sp + ((((wr * 4 + m) * 4 + wc) * 64 + fq * 16 + fr) << 3)) = w; } }
    }
};
typedef short bf16x4 __attribute__((ext_vector_type(4)));
typedef short v4i16_t __attribute__((ext_vector_type(4)));
__device__ __forceinline__ bf16x8 ldtr2(const LAS unsigned char* p0, const LAS unsigned char* p1) {
    const bf16x4 lo = __builtin_bit_cast(bf16x4, __builtin_amdgcn_ds_read_tr16_b64_v4i16((LAS v4i16_t*)p0));
    const bf16x4 hi = __builtin_bit_cast(bf16x4, __builtin_amdgcn_ds_read_tr16_b64_v4i16((LAS v4i16_t*)p1));
    return __builtin_shufflevector(lo, hi, 0, 1, 2, 3, 4, 5, 6, 7);
}
__device__ __forceinline__ int blk_perm(int rb) { return (rb & ~3) | ((rb >> 1) & 1) | ((rb & 1) << 1); }
__device__ __forceinline__ int scan_t0(int dir, int b, int s) {
    return dir == 0 ? ((s < 2) ? (NLAT + b * CTXL + s * 128) : (b * SEQ + (s - 2) * 128)) : ((s < 2) ? (NLAT + b * CTXL + (1 - s) * 128) : (b * SEQ + (17 - s) * 128));
}
__device__ __forceinline__ int scan_rc(int dir, int b, int s) {
    return dir == 0 ? ((s < 2) ? (128 + b * 2 + s) : (b * 16 + (s - 2))) : ((s < 2) ? (128 + b * 2 + (1 - s)) : (b * 16 + (17 - s)));
}
__device__ __forceinline__ u32x4 ldg16(const void* ub, unsigned voff) { return *(const GAS u32x4*)((const GAS unsigned char*)ub + voff); }
__device__ __forceinline__ void scan_load_s(u32x4 (&sf)[4], unsigned char* ws, int h, int rc, int w, int r, int q) {
    const bf16_t* ub = s_chunk(ws, h, rc) + w * 2048; const unsigned vo = (unsigned)(16 * q + r) * 16u;
#pragma unroll
    for (int ks = 0; ks < 4; ++ks) sf[ks] = ldg16(ub, vo + 1024u * ks);
}
__device__ __forceinline__ void scan_load_q(u32x4 (&qf)[8], const bf16_t* Qg, int h, int t0, int w, int r, int q) {
    const bf16_t* ub = Qg + (((size_t)(t0 >> 7) * 4 + h) * 8 + w) * 4096; const unsigned vo = (unsigned)(16 * q + r) * 16u;
#pragma unroll
    for (int ks = 0; ks < 8; ++ks) qf[ks] = ldg16(ub, vo + 1024u * ks);
}
__device__ __forceinline__ void scan_load_kv(u32x4 (&kr)[8], u32x4 (&vr)[2], const bf16_t* Kg, const bf16_t* Vg, int h, int sl, int t0, int w, int lane, int tid) {
    const bf16_t* kb = Kg + (((size_t)(t0 >> 7) * 4 + h) * 8 + w) * 4096; const unsigned ko = (unsigned)lane * 16u;
#pragma unroll
    for (int it = 0; it < 8; ++it) kr[it] = ldg16(kb, ko + 1024u * it);
    const bf16_t* vb = Vg + (size_t)t0 * 2048 + h * 512 + sl * 64; const unsigned vo = (unsigned)((tid >> 3) * 2048 + 8 * (tid & 7)) * 2u;
#pragma unroll
    for (int i = 0; i < 2; ++i) vr[i] = ldg16(vb + (size_t)i * 64 * 2048, vo);
}
#ifndef DBG_SEG
#define DBG_SEG -1
#endif
#define SEG_MARK(k) do { if (DBG_SEG >= 0) { __builtin_amdgcn_sched_barrier(0); const unsigned long long t_ = __builtin_amdgcn_s_memtime(); if (DBG_SEG == (k)) segacc += t_ - segt; segt = t_; __builtin_amdgcn_sched_barrier(0); } } while (0)
template <int DIR>
__device__ __forceinline__ void scan_step(unsigned long long& segacc, unsigned long long& segt, LAS unsigned char* lds, u32x4 (&sf)[4], u32x4 (&qf)[8], u32x4 (&kr)[8], u32x4 (&vr)[2], f32x4 (&Rb)[2][4], const float (&wm)[2], float rsc, float g128,
                                          int t0, int t0n, int rcn, unsigned char* ws, int h, int sl, int w, int lane_in, int tid_in, const bf16_t* Qg, const bf16_t* Kg, const bf16_t* Vg, bf16_t* OF, float* SSP) {
    int lane = lane_in; asm volatile("" : "+v"(lane));
    const int tid = (tid_in & ~63) | lane;
    const int r = lane & 15, q = lane >> 4;
    LAS unsigned char* VI = lds + SC_V_OFF; LAS unsigned char* RT = lds + SC_RT_OFF; LAS unsigned char* KI = lds + SC_K_OFF + w * 8192;
    SEG_MARK(5);
#pragma unroll
    for (int i = 0; i < 2; ++i) { const int m = (tid >> 3) + 64 * i, e0 = 8 * (tid & 7); const float sc = wm[i]; const u32x4 v = vr[i]; u32x4 o;
        o.x = cvt_pk_bf16(bflo(v.x) * sc, bfhi(v.x) * sc); o.y = cvt_pk_bf16(bflo(v.y) * sc, bfhi(v.y) * sc); o.z = cvt_pk_bf16(bflo(v.z) * sc, bfhi(v.z) * sc); o.w = cvt_pk_bf16(bflo(v.w) * sc, bfhi(v.w) * sc);
        *(LAS u32x4*)(VI + 128 * ((e0 >> 4) * 32 + blk_perm(m >> 2)) + (m & 3) * 32 + (e0 & 15) * 2) = o; }
#pragma unroll
    for (int it = 0; it < 8; ++it) { const int m = it * 16 + (lane >> 2), dc = lane & 3;
        *(LAS u32x4*)(KI + 128 * ((dc >> 1) * 32 + blk_perm(m >> 2)) + (m & 3) * 32 + (dc & 1) * 16) = kr[it]; }
    SEG_MARK(0);
    asm volatile("s_waitcnt lgkmcnt(0)" ::: "memory"); __builtin_amdgcn_s_barrier(); asm volatile("" ::: "memory");
    SEG_MARK(1);
    const int jl = 16 * w + r;
    { const bf16_t* vb = Vg + (size_t)t0n * 2048 + h * 512 + sl * 64; const unsigned vo = (unsigned)((tid >> 3) * 2048 + 8 * (tid & 7)) * 2u;
#pragma unroll
      for (int i = 0; i < 2; ++i) vr[i] = ldg16(vb + (size_t)i * 64 * 2048, vo); }
    GAS unsigned char* ob = (GAS unsigned char*)(OF + ((size_t)((((t0 >> 7) * 4 + h) * 8 + sl) * 8 + w) << 10)); const unsigned oo = (unsigned)lane * 8u;
    f32x4 O[4];
#pragma unroll
    for (int eb = 0; eb < 4; ++eb) O[eb] = (f32x4){0.f, 0.f, 0.f, 0.f};
    const LAS unsigned char* rtb = RT + r * 528 + q * 16;
    const bf16_t* qub = Qg + (((size_t)(t0n >> 7) * 4 + h) * 8 + w) * 4096; const unsigned qvo = (unsigned)(16 * q + r) * 16u;
    const bf16_t* kub = Kg + (((size_t)(t0n >> 7) * 4 + h) * 8 + w) * 4096; const unsigned kvo = (unsigned)lane * 16u;
    bf16x8 avp[2][4];
#pragma unroll
    for (int eb = 0; eb < 4; ++eb) avp[0][eb] = *(const LAS bf16x8*)(rtb + (16 * eb * 528));
#pragma unroll
    for (int ks = 0; ks < 8; ++ks) { const bf16x8 qv = __builtin_bit_cast(bf16x8, qf[ks]);
        if (ks < 7) {
#pragma unroll
            for (int eb = 0; eb < 4; ++eb) avp[(ks + 1) & 1][eb] = *(const LAS bf16x8*)(rtb + (16 * eb * 528 + 64 * (ks + 1)));
            asm volatile("s_waitcnt lgkmcnt(4)" ::: "memory"); }
        else asm volatile("s_waitcnt lgkmcnt(0)" ::: "memory");
        __builtin_amdgcn_sched_barrier(0);
#pragma unroll
        for (int eb = 0; eb < 4; ++eb) O[eb] = __builtin_amdgcn_mfma_f32_16x16x32_bf16(avp[ks & 1][eb], qv, O[eb], 0, 0, 0);
        if (w < 4) { qf[ks] = ldg16(qub, qvo + 1024u * ks); kr[ks] = ldg16(kub, kvo + 1024u * ks); }
        __builtin_amdgcn_sched_barrier(0); }
    u32x2 pvf[4];
    if (DIR == 1) {
#pragma unroll
        for (int eb = 0; eb < 4; ++eb) pvf[eb] = *(const GAS u32x2*)(ob + oo + 512 * eb); }
    SEG_MARK(2);
    const int lofs = 128 * (4 * (q >> 1) + (q & 1)) + 8 * r;
    const LAS unsigned char* vtb = VI + lofs; const LAS unsigned char* ktb = KI + lofs;
#pragma unroll
    for (int ks = 0; ks < 4; ++ks) {
        bf16x8 vb[4], ka[2];
#pragma unroll
        for (int eb = 0; eb < 4; ++eb) vb[eb] = ldtr2(vtb + 128 * (eb * 32 + 8 * ks), vtb + 128 * (eb * 32 + 8 * ks + 2));
#pragma unroll
        for (int db = 0; db < 2; ++db) ka[db] = ldtr2(ktb + 128 * (db * 32 + 8 * ks), ktb + 128 * (db * 32 + 8 * ks + 2));
        bf16x8 sfm;
        { unsigned wd[4] = {sf[ks].x, sf[ks].y, sf[ks].z, sf[ks].w};
#pragma unroll
          for (int i = 0; i < 4; ++i) { const int m0 = 32 * ks + 8 * q + 2 * i; const bool k0 = DIR == 0 ? (m0 <= jl) : (m0 >= jl), k1 = DIR == 0 ? (m0 + 1 <= jl) : (m0 + 1 >= jl);
              wd[i] &= (k0 ? 0xffffu : 0u) | (k1 ? 0xffff0000u : 0u); }
          sfm = __builtin_bit_cast(bf16x8, (u32x4){wd[0], wd[1], wd[2], wd[3]}); }
#pragma unroll
        for (int eb = 0; eb < 4; ++eb) O[eb] = __builtin_amdgcn_mfma_f32_16x16x32_bf16(vb[eb], sfm, O[eb], 0, 0, 0);
#pragma unroll
        for (int db = 0; db < 2; ++db)
#pragma unroll
            for (int eb = 0; eb < 4; ++eb) Rb[db][eb] = __builtin_amdgcn_mfma_f32_16x16x32_bf16(ka[db], vb[eb], Rb[db][eb], 0, 0, 0);
        if (w >= 4) {
            qf[2 * ks] = ldg16(qub, qvo + 1024u * (2 * ks)); qf[2 * ks + 1] = ldg16(qub, qvo + 1024u * (2 * ks + 1));
            kr[2 * ks] = ldg16(kub, kvo + 1024u * (2 * ks)); kr[2 * ks + 1] = ldg16(kub, kvo + 1024u * (2 * ks + 1)); }
    }
    SEG_MARK(3);
    scan_load_s(sf, ws, h, rcn, w, r, q);
    {
        float ss = 0.f;
#pragma unroll
        for (int eb = 0; eb < 4; ++eb) { f32x4 v = O[eb] * rsc;
            if (DIR == 1) { const u32x2 pv = pvf[eb]; v[0] += bflo(pv.x); v[1] += bfhi(pv.x); v[2] += bflo(pv.y); v[3] += bfhi(pv.y);
                ss += (v[0] * v[0] + v[1] * v[1]) + (v[2] * v[2] + v[3] * v[3]); }
            u32x2 o; o.x = cvt_pk_bf16(v[0], v[1]); o.y = cvt_pk_bf16(v[2], v[3]); *(GAS u32x2*)(ob + oo + 512 * eb) = o; }
        if (DIR == 1) { ss += shx(ss, 16, lane); ss += shx(ss, 32, lane); if (q == 0) *(GAS float*)((GAS unsigned char*)(SSP + (size_t)(t0 + 16 * w) * 32 + h * 8 + sl) + (unsigned)r * 128u) = ss; }
    }
#pragma unroll
    for (int db = 0; db < 2; ++db)
#pragma unroll
        for (int eb = 0; eb < 4; ++eb) Rb[db][eb] = Rb[db][eb] * g128;
    SEG_MARK(4);
    asm volatile("s_waitcnt lgkmcnt(0)" ::: "memory"); __builtin_amdgcn_s_barrier(); asm volatile("" ::: "memory");
    SEG_MARK(6);
#pragma unroll
    for (int db = 0; db < 2; ++db)
#pragma unroll
        for (int eb = 0; eb < 4; ++eb) { u32x2 o; o.x = cvt_pk_bf16(Rb[db][eb][0], Rb[db][eb][1]); o.y = cvt_pk_bf16(Rb[db][eb][2], Rb[db][eb][3]);
            *(LAS u32x2*)(RT + (16 * eb + r) * 528 + (32 * w + 16 * db + 4 * q) * 2) = o; }
}
template <int DIR>
__device__ __forceinline__ void scan_unit(Frame& F, int tid, unsigned char* ws, int b, int h, int sl, float lg, const bf16_t* Qg, const bf16_t* Kg, const bf16_t* Vg, bf16_t* OF, float* SSP) {
    const int lane = tid & 63, w = __builtin_amdgcn_readfirstlane(tid >> 6), r = lane & 15, q = lane >> 4;
    const float g128 = __expf(128.f * lg);
    float wm[2];
#pragma unroll
    for (int i = 0; i < 2; ++i) { const int m = (tid >> 3) + 64 * i; wm[i] = __expf(lg * (float)(DIR == 0 ? 127 - m : m)); }
    const int jl = 16 * w + r; const float rsc = __expf(lg * (float)(DIR == 0 ? jl - 127 : -jl));
    f32x4 Rb[2][4];
#pragma unroll
    for (int db = 0; db < 2; ++db)
#pragma unroll
        for (int eb = 0; eb < 4; ++eb) Rb[db][eb] = (f32x4){0.f, 0.f, 0.f, 0.f};
    {
        LAS unsigned char* RT = F.lds + SC_RT_OFF;
#pragma unroll
        for (int db = 0; db < 2; ++db)
#pragma unroll
            for (int eb = 0; eb < 4; ++eb) *(LAS u32x2*)(RT + (16 * eb + r) * 528 + (32 * w + 16 * db + 4 * q) * 2) = (u32x2){0u, 0u};
    }
    u32x4 sf[4], qf[8], kr[8], vr[2];
    unsigned long long segacc = 0ull, segt = (DBG_SEG >= 0) ? __builtin_amdgcn_s_memtime() : 0ull;
    scan_load_s(sf, ws, h, scan_rc(DIR, b, 0), w, r, q);
    scan_load_q(qf, Qg, h, scan_t0(DIR, b, 0), w, r, q);
    scan_load_kv(kr, vr, Kg, Vg, h, sl, scan_t0(DIR, b, 0), w, lane, tid);
    for (int s = 0; s < 18; ++s) {
        const int sn = (s + 1 < 18) ? s + 1 : 17;
        scan_step<DIR>(segacc, segt, F.lds, sf, qf, kr, vr, Rb, wm, rsc, g128, scan_t0(DIR, b, s), scan_t0(DIR, b, sn), scan_rc(DIR, b, sn), ws, h, sl, w, lane, tid, Qg, Kg, Vg, OF, SSP);
    }
    if (DBG_SEG >= 0) { const unsigned long long te_ = __builtin_amdgcn_s_memtime() + segacc; while (__builtin_amdgcn_s_memtime() < te_) __builtin_amdgcn_s_sleep(4); }
    __syncthreads();
}
__device__ __forceinline__ void scan_phase(Frame& F, const Args& a, int layer, int dir) {
    PHASE_IDS();
    const int j = layer >> 1; const float* dec = a.in[11] + j * 8 + dir * 4;
    for (int u = F.vcu; u < 256; u += F.G) {
        const int b = u >> 5, h = (u >> 3) & 3, sl = u & 7;
        const float lg = log1pf(-exp2f(dec[h]));
        if (dir == 0) scan_unit<0>(F, tid, ws, b, h, sl, lg, (const bf16_t*)(ws + WS_Q), (const bf16_t*)(ws + WS_K), (const bf16_t*)(ws + WS_V), (bf16_t*)(ws + WS_OF), (float*)(ws + WS_SSP));
        else scan_unit<1>(F, tid, ws, b, h, sl, lg, (const bf16_t*)(ws + WS_Q), (const bf16_t*)(ws + WS_K), (const bf16_t*)(ws + WS_V), (bf16_t*)(ws + WS_OF), (float*)(ws + WS_SSP));
    }
}
__device__ __forceinline__ void n2_phase(Frame& F, const Args& a, int layer) {
    PHASE_IDS();
    norm_rows<false>(F, a, layer, (bf16_t*)(ws + WS_Q));
    const float* SSP = (const float*)(ws + WS_SSP); float* RINV = (float*)(ws + WS_RINV);
    const int gt = F.vcu * 512 + tid, NT = F.G * 512;
    for (int idx = gt; idx < NTOK * 4; idx += NT) { const f32x4 p0 = *(const f32x4*)(SSP + (size_t)idx * 8), p1 = *(const f32x4*)(SSP + (size_t)idx * 8 + 4);
        const float ss = ((p0.x + p0.y) + (p0.z + p0.w)) + ((p1.x + p1.y) + (p1.z + p1.w)); RINV[idx] = rsqrtf(ss * (1.f / 512.f) + EPS); }
}
__device__ __forceinline__ void final_phase(Frame& F, const Args& a) {
    PHASE_IDS();
    const float* fg = a.in[12]; const int gw = F.vcu * 8 + wave, NGW = F.G * 8;
    f32x4 g[4];
#pragma unroll
    for (int jj = 0; jj < 4; ++jj) g[jj] = *(const f32x4*)(fg + 4 * lane + 256 * jj);
    for (int m0 = gw; m0 < NLAT; m0 += 4 * NGW) {
        f32x4 v[4][4]; float ss[4];
#pragma unroll
        for (int t = 0; t < 4; ++t) { const int m = (m0 + t * NGW) < NLAT ? (m0 + t * NGW) : gw; const f32x4* xr = (const f32x4*)(a.out + (size_t)m * DM) + lane;
#pragma unroll
            for (int jj = 0; jj < 4; ++jj) v[t][jj] = xr[64 * jj]; }
#pragma unroll
        for (int t = 0; t < 4; ++t) { float s = 0.f;
#pragma unroll
            for (int jj = 0; jj < 4; ++jj) s += (v[t][jj].x * v[t][jj].x + v[t][jj].y * v[t][jj].y) + (v[t][jj].z * v[t][jj].z + v[t][jj].w * v[t][jj].w);
            ss[t] = s; }
#pragma unroll
        for (int o = 1; o < 64; o <<= 1) {
#pragma unroll
            for (int t = 0; t < 4; ++t) ss[t] += shx(ss[t], o, lane); }
#pragma unroll
        for (int t = 0; t < 4; ++t) { const int m = m0 + t * NGW; if (m < NLAT) { const float rinv = rsqrtf(ss[t] * (1.f / DM) + EPS); f32x4* xw = (f32x4*)(a.out + (size_t)m * DM) + lane;
#pragma unroll
            for (int jj = 0; jj < 4; ++jj) xw[64 * jj] = v[t][jj] * rinv * g[jj]; } }
    }
}

constexpr int N_PHASES = 34;
__global__ void __launch_bounds__(512, 2) trunk_fwd(Args args) {
    extern __shared__ __attribute__((aligned(16))) unsigned char lds_raw[];
    Frame F;
    F.lds = (LAS unsigned char*)lds_raw;
    F.G = gridDim.x; F.wv = __builtin_amdgcn_readfirstlane((int)threadIdx.x >> 6); { const int bx = blockIdx.x; F.vcu = (F.G % 8 == 0) ? (bx % 8) * (F.G / 8) + bx / 8 : bx; }
    F.ws = args.ws;
    volatile LAS unsigned* MISC = (volatile LAS unsigned*)(F.lds + MISC_OFF);
    for (int u = threadIdx.x; u < 128; u += 512) MISC[u] = 0u;
    __syncthreads();
    const int lo = args.ph_lo, hi = args.ph_hi;
    XcdBarrier bar; bar.bar = (unsigned*)(args.ws + WS_CTL) + 4096; bar.x = 0; bar.st = nullptr;
    const bool multi = (hi - lo) > 1;
    if (multi) bar = xcd_barrier_post((unsigned*)(args.ws + WS_CTL) + 4096, MISC + 8);
#ifndef KINDS
#define KINDS 0xFFFF
#endif
#define KON(b) (((KINDS) >> (b)) & 1)
#define IN(k) (lo <= (k) && (k) < hi)
#ifndef DBG_PROBE
#define DBG_PROBE -1
#endif
    unsigned long long tph0 = (DBG_PROBE >= 0) ? __builtin_amdgcn_s_memrealtime() : 0ull; int cur_layer = -1;
#ifndef DBG_PLAYER
#define DBG_PLAYER -1
#endif
#define PROBE(kind) do { if (DBG_PROBE == (kind) && (DBG_PLAYER < 0 || DBG_PLAYER == cur_layer)) { const unsigned long long t1_ = __builtin_amdgcn_s_memrealtime(); const unsigned long long te_ = t1_ + (t1_ - tph0); while (__builtin_amdgcn_s_memrealtime() < te_) __builtin_amdgcn_s_sleep(8); } } while (0)
#define SEAM(k) do { if (multi && (k) + 1 < hi) xcd_barrier(bar); if (DBG_PROBE >= 0) tph0 = __builtin_amdgcn_s_memrealtime(); } while (0)
    const int bx = (int)blockIdx.x, G = F.G;
    if (KON(0) && IN(0)) { p0_phase(F, args); p0_conv(F, args); PROBE(0); SEAM(0); }
    for (int layer = 0; layer < NLAYER; ++layer) {
        const int pb = 1 + 8 * layer; const bool fourier = (layer & 1) == 0; cur_layer = layer;
        unsigned char* ws = launder_ptr(args.ws);
#define MAKE_ER() const EpiResid ER{layer == 0 ? args.in[0] : args.out, args.out, (const float*)(ws + WS_ADA) + layer * 9 * 3072 + 2048, (float*)(ws + WS_PART)}
        if (KON(1) && IN(pb)) { n_phase(F, args, layer); PROBE(1); SEAM(pb); }
        if (fourier) {
            bf16_t* W1 = (bf16_t*)(ws + WS_WF);
            if (KON(2) && IN(pb + 1)) {
                { pg8::Gemm g{(const bf16_t*)(ws + WS_H), W1 + (size_t)2048 * 1024, 1024, 1024, 1024}; pg8::TileOrder S; S.init(72, 8, G, bx);
                  EpiSilu E{(bf16_t*)(ws + WS_Z), 2048}; pg8::gemm_phase(F.lds, F.wv, g, S, E); }
                { pg8::Gemm g{W1, (const bf16_t*)(ws + WS_H), 1024, 1024, 1024}; UOrder S; S.init(8, 72, G, (bx + 64) % G);
                  EpiUTF E{(bf16_t*)(ws + WS_UTL), (bf16_t*)(ws + WS_UTC), (float*)(ws + WS_RINV)}; pg8::gemm_phase<EpiUTF, UOrder, true>(F.lds, F.wv, g, S, E); }
                bg_conv_ret(F, args, layer, 64, 0, 1024);
                PROBE(2); SEAM(pb + 1);
            }
            if (KON(3) && IN(pb + 2)) {
                { pg8::Gemm g{(const bf16_t*)(ws + WS_CS), (const bf16_t*)(ws + WS_UTL), 1024, 1024, 1024}; pg8::TileOrder S; S.init(8, 64, G, bx);
                  EpiDft<true> E{(bf16_t*)(ws + WS_Z), 2048, 0, (const float*)(ws + WS_RINV)}; pg8::gemm_phase(F.lds, F.wv, g, S, E); }
                { pg8::Gemm g{(const bf16_t*)(ws + WS_CS256), (const bf16_t*)(ws + WS_UTC), 256, 256, 256}; pg8::TileOrder S; S.init(2, 64, G, bx);
                  EpiDft<false> E{(bf16_t*)(ws + WS_Z), 256, NLAT, nullptr}; pg8::gemm_phase(F.lds, F.wv, g, S, E); }
                nyq_row_phase(F);
                bg_conv_ret(F, args, layer, 128, 1024, 1536);
                PROBE(3); SEAM(pb + 2);
            }
            if (KON(4) && IN(pb + 3)) {
                pg8::Gemm g{(const bf16_t*)(ws + WS_Z), W1 + (size_t)4096 * 1024, 2048, 2048, 2048}; OutOrder S; S.init(G, bx, true); MAKE_ER();
                pg8::gemm_phase(F.lds, F.wv, g, S, ER);
                bg_conv_ret(F, args, layer, 128, 1536, 2048);
                PROBE(4); SEAM(pb + 3);
            }
        } else {
            bf16_t* W1 = (bf16_t*)(ws + WS_W);
            if (KON(5) && IN(pb + 1)) {
                pg8::Gemm g{(const bf16_t*)(ws + WS_OF), W1, 1024, 1024, 1024}; pg8::TileOrder S; S.init(72, 16, G, bx);
                EpiQKV E{(bf16_t*)(ws + WS_Q), (bf16_t*)(ws + WS_K), (bf16_t*)(ws + WS_V), (const float*)(ws + WS_ROPE), (const float*)(ws + WS_ROPE) + 4096};
                pg8::gemm_phase(F.lds, F.wv, g, S, E);
                PROBE(5); SEAM(pb + 1);
            }
            if (KON(6) && IN(pb + 2)) {
                { pg8::Gemm g{(const bf16_t*)(ws + WS_Q), (const bf16_t*)(ws + WS_K), 1024, 1024, 256}; DiagOrder S{G, bx};
                  EpiS E{ws}; pg8::gemm_phase<EpiS, DiagOrder, false, true>(F.lds, F.wv, g, S, E); }
                PROBE(11); if (multi) xcd_barrier(bar); if (DBG_PROBE >= 0) tph0 = __builtin_amdgcn_s_memrealtime();
                scan_phase(F, args, layer, 0); PROBE(6);
            }
            if (KON(6) && IN(pb + 3)) {
                if (multi) { asm volatile("s_waitcnt vmcnt(0)" ::: "memory"); __syncthreads();
                    if (threadIdx.x == 0) { __builtin_amdgcn_fence(__ATOMIC_ACQUIRE, "agent"); asm volatile("s_waitcnt vmcnt(0)" ::: "memory"); }
                    __syncthreads(); if (DBG_PROBE >= 0) tph0 = __builtin_amdgcn_s_memrealtime(); }
                scan_phase(F, args, layer, 1); PROBE(12); SEAM(pb + 3); }
            if (KON(7) && IN(pb + 4)) { n2_phase(F, args, layer); PROBE(7); SEAM(pb + 4); }
            if (KON(8) && IN(pb + 5)) {
                pg8::Gemm g{(const bf16_t*)(ws + WS_Q), W1 + (size_t)4096 * 1024, 1024, 1024, 1024}; pg8::TileOrder S; S.init(layer == NLAYER - 1 ? 64 : 72, 8, G, bx);
                EpiZGate E{(const bf16_t*)(ws + WS_OF), (const float*)(ws + WS_RINV), (bf16_t*)(ws + WS_V)};
                pg8::gemm_phase(F.lds, F.wv, g, S, E);
                PROBE(8); SEAM(pb + 5);
            }
            if (KON(9) && IN(pb + 6)) {
                pg8::Gemm g{(const bf16_t*)(ws + WS_V), W1 + (size_t)6144 * 1024, 2048, 2048, 2048}; OutOrder S; S.init(G, bx, layer != NLAYER - 1); MAKE_ER();
                pg8::gemm_phase(F.lds, F.wv, g, S, ER);
                PROBE(9); SEAM(pb + 6);
            }
        }
    }
    if (KON(10) && IN(33)) { final_phase(F, args); PROBE(10); }
#undef IN
#undef SEAM
}

extern "C" void kernel_launch(void* const* d_in, const int* in_sizes, int n_in, void* d_out, int out_size, void* d_ws, size_t ws_size, hipStream_t stream) {
    static int grid = 0;
    if (grid == 0) {
        if (n_in != 13 || out_size != NLAT * DM || ws_size < WS_END) { fprintf(stderr, "kernel_launch: unexpected problem (n_in %d, out %d, ws %zu)\n", n_in, out_size, ws_size); grid = -1; return; }
        int dev = 0, cus = 0;
        if (hipGetDevice(&dev) != hipSuccess || hipDeviceGetAttribute(&cus, hipDeviceAttributeMultiprocessorCount, dev) != hipSuccess) { grid = -1; return; }
        if (hipFuncSetAttribute((const void*)trunk_fwd, hipFuncAttributeMaxDynamicSharedMemorySize, LDS_BYTES) != hipSuccess) { fprintf(stderr, "kernel_launch: hipFuncSetAttribute failed\n"); grid = -1; return; }
        (void)hipGetLastError();
        grid = cus;
    }
    if (grid < 0) return;
    if (hipMemsetAsync((char*)d_ws + WS_CTL, 0, CTL_ZERO_BYTES, stream) != hipSuccess) return;
    Args a{};
    for (int i = 0; i < 13; ++i) a.in[i] = (const float*)d_in[i];
    a.out = (float*)d_out; a.ws = (unsigned char*)d_ws;
    a.ph_lo = 0; a.ph_hi = N_PHASES;
    hipLaunchKernelGGL(trunk_fwd, dim3(grid), dim3(512), LDS_BYTES, stream, a);
}
```

```cpp
#include <hip/hip_runtime.h>
#include <cstdio>
#include <cstdint>

#define LAS __attribute__((address_space(3)))
#define GAS __attribute__((address_space(1)))
typedef unsigned short bf16_t;
typedef short bf16x8 __attribute__((ext_vector_type(8)));
typedef float f32x4 __attribute__((ext_vector_type(4)));
typedef float f32x16 __attribute__((ext_vector_type(16)));
typedef unsigned u32x4 __attribute__((ext_vector_type(4)));
typedef unsigned u32x2 __attribute__((ext_vector_type(2)));

constexpr int DM = 1024, NB = 8, SEQ = 2048, CTXL = 256, DBR = 2048, NLAYER = 4;
constexpr int NLAT = NB * SEQ, NCTX = NB * CTXL, NTOK = NLAT + NCTX;
constexpr float EPS = 1e-6f;

constexpr size_t MiB = 1u << 20;
constexpr size_t KiB = 1024;
constexpr size_t WS_CTL = 0, CTL_ZERO_BYTES = 64 * KiB;
constexpr size_t WS_ADA = 256 * KiB;
constexpr size_t WS_TC = 768 * KiB;
constexpr size_t WS_ROPE = 1024 * KiB;
constexpr size_t WS_CS256 = 1088 * KiB;
constexpr size_t WS_RINV = 1344 * KiB;
constexpr size_t WS_XCTX = 2 * MiB;
constexpr size_t WS_W = 10 * MiB;
constexpr size_t WS_R = 26 * MiB;
constexpr size_t WS_H = WS_R;
constexpr size_t WS_Z = WS_R + 36 * MiB;
constexpr size_t WS_UTL = WS_R + 108 * MiB;
constexpr size_t WS_UTC = WS_R + 172 * MiB;
constexpr size_t WS_CS = WS_R + 180 * MiB;
constexpr size_t WS_WF = WS_R + 144 * MiB;
constexpr size_t WS_Q = WS_R;
constexpr size_t WS_K = WS_R + 36 * MiB;
constexpr size_t WS_V = WS_R + 72 * MiB;
constexpr size_t WS_OF = WS_R + 144 * MiB;
constexpr size_t WS_PART = WS_R + 184 * MiB;
constexpr size_t WS_SSP = WS_R + 216 * MiB;
constexpr size_t WS_SA = WS_W;
constexpr size_t WS_SB = WS_R + 219 * MiB;
constexpr size_t WS_END = 256 * MiB;
static_assert(WS_SSP + (size_t)NTOK * 32 * 4 <= WS_SB && WS_SB + 10 * MiB <= WS_END && WS_CS + 16 * MiB <= WS_END && WS_RINV + 288 * KiB <= WS_XCTX, "ws map");

constexpr int LDS_BYTES = 147456;
constexpr int RING_BYTES = 131072;
constexpr int SC_V_OFF = 0;
constexpr int SC_RT_OFF = 16384;
constexpr int SC_K_OFF = 16384 + 33792;
constexpr int MISC_OFF = 145408;
static_assert(SC_K_OFF + 65536 <= MISC_OFF && MISC_OFF + 512 <= LDS_BYTES, "lds map");

__device__ __forceinline__ unsigned f2bf(float f) { unsigned u = __builtin_bit_cast(unsigned, f); return (u + 0x7fffu + ((u >> 16) & 1u)) >> 16; }
__device__ __forceinline__ unsigned pk2(float lo, float hi) { return f2bf(lo) | (f2bf(hi) << 16); }
__device__ __forceinline__ float bflo(unsigned w) { return __builtin_bit_cast(float, w << 16); }
__device__ __forceinline__ float bfhi(unsigned w) { return __builtin_bit_cast(float, w & 0xffff0000u); }
__device__ __forceinline__ float bf1(bf16_t h) { return __builtin_bit_cast(float, (unsigned)h << 16); }
__device__ __forceinline__ float silu_f(float x) { return x * __builtin_amdgcn_rcpf(1.f + __expf(-x)); }
__device__ __forceinline__ float shx(float v, int o, int lane) { return __builtin_bit_cast(float, __builtin_amdgcn_ds_bpermute((lane ^ o) << 2, __builtin_bit_cast(int, v))); }
__device__ __forceinline__ float wave_sum(float v, int lane) {
#pragma unroll
    for (int o = 1; o < 64; o <<= 1) v += shx(v, o, lane);
    return v;
}

namespace pg8 {
constexpr int BM = 256, BK = 64, HALF = 128, HTB = HALF * BK * 2, STAGE_BYTES = 8 * HTB, NXCD = 8, WGM = 8;
__host__ __device__ __forceinline__ int lds_byte(int r, int c) { const int st = (r >> 4) * 2 + (c >> 5), rr = r & 15, cc = c & 31, ob = rr * 64 + cc * 2; return st * 1024 + (ob ^ (((ob >> 9) & 1) << 5)); }
__host__ __device__ __forceinline__ void stage_rc(int b, int& R, int& C) { const int st = b / 1024, sb = b % 1024, swz = sb ^ (((sb >> 9) & 1) << 5); R = (st >> 1) * 16 + swz / 64; C = (st & 1) * 32 + (swz % 64) / 2; }
__host__ __device__ __forceinline__ int perm32(int rho) { const int n = rho >> 4, i = rho & 15; return 8 * (i >> 2) + 4 * n + (i & 3); }
struct Unit { int pm, pn, aux; };
struct Gemm { const bf16_t* A; const bf16_t* Bt; int lda, ldb, K; };
struct TileOrder {
    int nM, nN, nwg, G, c;
    __device__ void init(int nM_, int nN_, int G_, int c_) { nM = nM_; nN = nN_; nwg = nM * nN; G = G_; c = c_; }
    __device__ bool next(int i, Unit& u) const {
        const long L = (long)i * G + c; if (L >= nwg) return false;
        int wgid = (int)L; { const int q = nwg / NXCD, r = nwg % NXCD, xcd = wgid % NXCD, off = wgid / NXCD; wgid = (xcd < r ? xcd * (q + 1) : r * (q + 1) + (xcd - r) * q) + off; }
        const int nig = WGM * nN, gid = wgid / nig, fm = gid * WGM, gsz = (nM - fm) < WGM ? (nM - fm) : WGM;
        u.pm = fm + ((wgid % nig) % gsz); u.pn = (wgid % nig) / gsz; u.aux = 0; return true;
    }
    __device__ __forceinline__ const char* a_ptr(const Gemm& g, const Unit& u) const { return (const char*)g.A + (size_t)u.pm * 256 * g.lda * 2; }
    __device__ __forceinline__ const char* b_ptr(const Gemm& g, const Unit& u, int half) const { return (const char*)g.Bt + (size_t)(u.pn * 256 + 128 * half) * g.ldb * 2; }
    __device__ __forceinline__ bool b_mirror(const Unit&) const { return false; }
    __device__ __forceinline__ bool b_fix(const Unit&) const { return false; }
    __device__ __forceinline__ int ktiles(const Gemm& g, const Unit&) const { return g.K / BK; }
};
__device__ __forceinline__ unsigned cvt_pk_bf16(float lo, float hi) { unsigned r; asm volatile("v_cvt_pk_bf16_f32 %0, %1, %2" : "=v"(r) : "v"(lo), "v"(hi)); return r; }

template <class Epi, class Sched, bool MIRB = false, bool TILED = false>
__device__ __forceinline__ void gemm_phase(LAS unsigned char* lds, int wv, const Gemm g, const Sched& S, const Epi& E) {
    int tid; { int l_; asm volatile("v_mbcnt_lo_u32_b32 %0, -1, 0\n\tv_mbcnt_hi_u32_b32 %0, -1, %0" : "=v"(l_)); tid = wv * 64 + l_; }
    const int wid = __builtin_amdgcn_readfirstlane(tid >> 6), lane = tid & 63, wr = wid >> 2, wc = wid & 3, fr = lane & 15, fq = lane >> 4;
    unsigned voffA[2], voffB[2], voffM[2], fixd[2];
#pragma unroll
    for (int i = 0; i < 2; ++i) { int R, C; stage_rc(tid * 16 + i * 8192, R, C); const int Rb = Epi::PERM ? ((R & ~31) + perm32(R & 31)) : R;
        voffA[i] = (unsigned)(R * g.lda + C) * 2u; voffB[i] = (unsigned)(Rb * g.ldb + C) * 2u; voffM[i] = (unsigned)((1024 - Rb) * g.ldb + C) * 2u; fixd[i] = (Rb == 0) ? (unsigned)(1024 * g.ldb) * 2u : 0u;
        if (TILED) { voffA[i] = (unsigned)(((R >> 4) & 7) * 8192 + (C >> 5) * 1024 + (16 * ((C >> 3) & 3) + (R & 15)) * 16);
                     voffB[i] = (unsigned)(((Rb & 127) >> 4) * 1024 + (4 * (Rb & 15) + ((C >> 3) & 3)) * 16 + (C >> 5) * 8192); } }
    const size_t kstepA = TILED ? (size_t)2048 : (size_t)(BK * 2), kstepB = TILED ? (size_t)16384 : (size_t)(BK * 2);
    const size_t hstepA = TILED ? (size_t)262144 : (size_t)HALF * g.lda * 2;
    const unsigned ldsw = (unsigned)wid * 1024u;
    const int aoff = lds_byte(wr * 64 + fr, fq * 8), boff = lds_byte(wc * 32 + fr, fq * 8);
#define PG8_SA(b, h) (((b) * 2 + (h)) * HTB)
#define PG8_SB(b, h) ((4 + (b) * 2 + (h)) * HTB)
#define PG8_STAGE(bufoff, gbase, voff) do { _Pragma("unroll") for (int _i = 0; _i < 2; ++_i) \
        __builtin_amdgcn_global_load_lds((const unsigned*)((const char*)(gbase) + (voff)[_i]), (LAS unsigned*)(lds + (bufoff) + ldsw + _i * 8192), 16, 0, 0); } while (0)
#define PG8_LDA(dst, b, h) do { _Pragma("unroll") for (int m = 0; m < 4; ++m) _Pragma("unroll") for (int k = 0; k < 2; ++k) dst[m][k] = *(const LAS bf16x8*)(lds + PG8_SA(b, h) + aoff + m * 2048 + k * 1024); } while (0)
#define PG8_LDB(dst, b, h) do { _Pragma("unroll") for (int n = 0; n < 2; ++n) _Pragma("unroll") for (int k = 0; k < 2; ++k) dst[n][k] = *(const LAS bf16x8*)(lds + PG8_SB(b, h) + boff + n * 2048 + k * 1024); } while (0)
#define PG8_MMA(ai, bj, At, Bt) do { __builtin_amdgcn_s_setprio(1); _Pragma("unroll") for (int m = 0; m < 4; ++m) _Pragma("unroll") for (int n = 0; n < 2; ++n) _Pragma("unroll") for (int k = 0; k < 2; ++k) \
        acc[ai][bj][m][n] = __builtin_amdgcn_mfma_f32_16x16x32_bf16(Bt[n][k], At[m][k], acc[ai][bj][m][n], 0, 0, 0); __builtin_amdgcn_s_setprio(0); } while (0)
#define PG8_WAIT_V(n) asm volatile("s_waitcnt vmcnt(" #n ")" ::: "memory")
#define PG8_WAIT_L(n) asm volatile("s_waitcnt lgkmcnt(" #n ")" ::: "memory")
#define PG8_BAR __builtin_amdgcn_s_barrier()
#define PG8_SCHED __builtin_amdgcn_sched_barrier(0)
#define PG8_VB1(dst, u) do { if (MIRB && S.b_mirror(u)) { const bool fx_ = S.b_fix(u); dst[0] = voffM[0] - (fx_ ? fixd[0] : 0u); dst[1] = voffM[1] - (fx_ ? fixd[1] : 0u); } else { dst[0] = voffB[0]; dst[1] = voffB[1]; } } while (0)
    Unit cur, nxt; int ui = 0;
    if (!S.next(0, cur)) return;
    f32x4 acc[2][2][4][2];
#pragma unroll
    for (int a = 0; a < 2; ++a)
#pragma unroll
        for (int b = 0; b < 2; ++b)
#pragma unroll
            for (int m = 0; m < 4; ++m)
#pragma unroll
                for (int n = 0; n < 2; ++n) acc[a][b][m][n] = (f32x4){0.f, 0.f, 0.f, 0.f};
    bf16x8 At[4][2], B0[2][2], B1[2][2];
    const char* cA = S.a_ptr(g, cur); const char* cB0 = S.b_ptr(g, cur, 0); const char* cB1 = S.b_ptr(g, cur, 1);
    unsigned vc1[2]; PG8_VB1(vc1, cur);
    PG8_STAGE(PG8_SB(0, 0), cB0, voffB); PG8_STAGE(PG8_SB(0, 1), cB1, vc1); PG8_STAGE(PG8_SA(0, 0), cA, voffA); PG8_STAGE(PG8_SA(0, 1), cA + hstepA, voffA);
    if (wr == 1) PG8_BAR;
    PG8_WAIT_V(2); PG8_BAR;
    PG8_STAGE(PG8_SB(1, 0), cB0 + kstepB, voffB); PG8_STAGE(PG8_SA(1, 0), cA + kstepA, voffA); PG8_STAGE(PG8_SB(1, 1), cB1 + kstepB, vc1);
    PG8_WAIT_V(6); PG8_BAR;
    for (;;) {
        const bool has_next = S.next(ui + 1, nxt);
        const int nt = S.ktiles(g, cur);
        const char* nA = cA; const char* nB0 = cB0; const char* nB1 = cB1; unsigned vn1[2] = {vc1[0], vc1[1]};
        if (has_next) { nA = S.a_ptr(g, nxt); nB0 = S.b_ptr(g, nxt, 0); nB1 = S.b_ptr(g, nxt, 1); PG8_VB1(vn1, nxt); }
        for (int t = 0; t < nt; t += 2) {
            const bool last = (t == nt - 2);
            const char* a1 = cA + (size_t)(t + 1) * kstepA;
            const char* a2 = last ? nA : cA + (size_t)(t + 2) * kstepA; const char* b20 = last ? nB0 : cB0 + (size_t)(t + 2) * kstepB; const char* b21 = last ? nB1 : cB1 + (size_t)(t + 2) * kstepB;
            const char* a3 = a2 + kstepA; const char* b30 = b20 + kstepB; const char* b31 = b21 + kstepB;
            unsigned v21[2]; v21[0] = (MIRB && last) ? vn1[0] : vc1[0]; v21[1] = (MIRB && last) ? vn1[1] : vc1[1];
            PG8_LDB(B0, 0, 0); PG8_LDB(B1, 0, 1); PG8_SCHED; PG8_LDA(At, 0, 0); PG8_STAGE(PG8_SA(1, 1), a1 + hstepA, voffA);
            PG8_WAIT_V(8); PG8_WAIT_L(0); PG8_BAR; PG8_MMA(0, 0, At, B0); PG8_MMA(0, 1, At, B1); PG8_BAR; PG8_SCHED;
            PG8_LDA(At, 0, 1); PG8_STAGE(PG8_SB(0, 0), b20, voffB); PG8_STAGE(PG8_SB(0, 1), b21, v21); PG8_STAGE(PG8_SA(0, 0), a2, voffA);
            PG8_WAIT_V(8); PG8_WAIT_L(0); PG8_BAR; PG8_MMA(1, 0, At, B0); PG8_MMA(1, 1, At, B1); PG8_BAR; PG8_SCHED;
            PG8_LDB(B0, 1, 0); PG8_LDB(B1, 1, 1); PG8_SCHED; PG8_LDA(At, 1, 0); PG8_STAGE(PG8_SA(0, 1), a2 + hstepA, voffA);
            PG8_WAIT_V(8); PG8_WAIT_L(0); PG8_BAR; PG8_MMA(0, 0, At, B0); PG8_MMA(0, 1, At, B1); PG8_BAR; PG8_SCHED;
            PG8_LDA(At, 1, 1); PG8_STAGE(PG8_SB(1, 0), b30, voffB); PG8_STAGE(PG8_SB(1, 1), b31, v21); PG8_STAGE(PG8_SA(1, 0), a3, voffA);
            PG8_WAIT_V(8); PG8_WAIT_L(0); PG8_BAR; PG8_MMA(1, 0, At, B0); PG8_MMA(1, 1, At, B1); PG8_BAR; PG8_SCHED;
        }
        if (wr == 0) PG8_BAR;
        { int l2 = lane; asm volatile("" : "+v"(l2)); E(acc, cur, wr, wc, l2 & 15, l2 >> 4); }
        if (!has_next) break;
#pragma unroll
        for (int a = 0; a < 2; ++a)
#pragma unroll
            for (int b = 0; b < 2; ++b)
#pragma unroll
                for (int m = 0; m < 4; ++m)
#pragma unroll
                    for (int n = 0; n < 2; ++n) acc[a][b][m][n] = (f32x4){0.f, 0.f, 0.f, 0.f};
        cur = nxt; cA = nA; cB0 = nB0; cB1 = nB1; vc1[0] = vn1[0]; vc1[1] = vn1[1]; ++ui;
        if (wr == 1) PG8_BAR;
    }
    PG8_WAIT_V(0);
    PG8_BAR;
#undef PG8_SA
#undef PG8_SB
#undef PG8_STAGE
#undef PG8_LDA
#undef PG8_LDB
#undef PG8_MMA
#undef PG8_WAIT_V
#undef PG8_WAIT_L
#undef PG8_BAR
#undef PG8_SCHED
#undef PG8_VB1
}
}
using pg8::cvt_pk_bf16;
__device__ __forceinline__ void stg16(void* ub, unsigned vo, u32x4 v) { *(GAS u32x4*)((GAS unsigned char*)ub + vo) = v; }
__device__ __forceinline__ u32x4 ldg16u(const void* ub, unsigned vo) { return *(const GAS u32x4*)((const GAS unsigned char*)ub + vo); }
__device__ __forceinline__ void stg16f(void* ub, unsigned vo, f32x4 v) { *(GAS f32x4*)((GAS unsigned char*)ub + vo) = v; }
__device__ __forceinline__ f32x4 ldg16f(const void* ub, unsigned vo) { return *(const GAS f32x4*)((const GAS unsigned char*)ub + vo); }
typedef const f32x4 (&AccRef)[2][2][4][2];

struct EpiSilu {
    static constexpr bool PERM = true;
    bf16_t* O; int ldc;
    __device__ __forceinline__ void operator()(AccRef acc, const pg8::Unit& u, int wr, int wc, int fr, int fq) const {
        bf16_t* ub = O + (size_t)u.pm * 256 * ldc + u.pn * 256; const unsigned vo = (unsigned)((wr * 64 + fr) * ldc + wc * 32 + 8 * fq) * 2u;
#pragma unroll
        for (int ai = 0; ai < 2; ++ai)
#pragma unroll
            for (int m = 0; m < 4; ++m)
#pragma unroll
                for (int bj = 0; bj < 2; ++bj) { const f32x4 v0 = acc[ai][bj][m][0], v1 = acc[ai][bj][m][1]; u32x4 w;
                    w.x = cvt_pk_bf16(silu_f(v0[0]), silu_f(v0[1])); w.y = cvt_pk_bf16(silu_f(v0[2]), silu_f(v0[3]));
                    w.z = cvt_pk_bf16(silu_f(v1[0]), silu_f(v1[1])); w.w = cvt_pk_bf16(silu_f(v1[2]), silu_f(v1[3]));
                    stg16(ub + (size_t)(ai * 128 + m * 16) * ldc, vo + (unsigned)(bj * 256), w); }
    }
};
struct UOrder : pg8::TileOrder {
    __device__ __forceinline__ const char* b_ptr(const pg8::Gemm& g, const pg8::Unit& u, int half) const {
        if (u.pn < 64) { const int b = u.pn >> 3, tp = u.pn & 7; return (const char*)(g.Bt + (size_t)(b * 2048 + (half ? 1024 - 128 * tp : 128 * tp)) * 1024); }
        return (const char*)(g.Bt + (size_t)(NLAT + (u.pn - 64) * 256 + 128 * half) * 1024);
    }
    __device__ __forceinline__ bool b_mirror(const pg8::Unit& u) const { return u.pn < 64; }
    __device__ __forceinline__ bool b_fix(const pg8::Unit& u) const { return (u.pn & 7) == 0; }
};
struct EpiUTF {
    static constexpr bool PERM = true;
    bf16_t* UTF; bf16_t* UTc; float* AH;
    __device__ __forceinline__ void operator()(AccRef acc, const pg8::Unit& u, int wr, int wc, int fr, int fq) const {
        const int feat0 = u.pm * 256 + wr * 64 + fr, col0 = wc * 32 + 8 * fq;
        if (u.pn >= 64) { bf16_t* ub = UTc + (size_t)(u.pn - 64) * 2048 * 256 + (size_t)u.pm * 256 * 256; const unsigned vo = (unsigned)((wr * 64 + fr) * 256 + col0) * 2u;
#pragma unroll
            for (int ai = 0; ai < 2; ++ai)
#pragma unroll
                for (int m = 0; m < 4; ++m)
#pragma unroll
                    for (int bj = 0; bj < 2; ++bj) { const f32x4 v0 = acc[ai][bj][m][0], v1 = acc[ai][bj][m][1]; u32x4 w;
                        w.x = cvt_pk_bf16(v0[0], v0[1]); w.y = cvt_pk_bf16(v0[2], v0[3]); w.z = cvt_pk_bf16(v1[0], v1[1]); w.w = cvt_pk_bf16(v1[2], v1[3]);
                        stg16(ub + (size_t)(ai * 128 + m * 16) * 256, vo + (unsigned)(bj * 256), w); }
            return; }
        const int b = u.pn >> 3, tp = u.pn & 7; const bool first = (tp == 0) && (col0 == 0);
        bf16_t* ub = UTF + ((size_t)b * 2048 + u.pm * 256) * 1024 + 128 * tp; const unsigned vo = (unsigned)((wr * 64 + fr) * 1024 + col0) * 2u;
#pragma unroll
        for (int ai = 0; ai < 2; ++ai)
#pragma unroll
            for (int m = 0; m < 4; ++m) { const int feat = feat0 + ai * 128 + m * 16; const float sg = ((feat & 255) <= 128) ? 1.f : -1.f;
                f32x4 v0 = acc[ai][0][m][0] + acc[ai][1][m][0] * sg; const f32x4 v1 = acc[ai][0][m][1] + acc[ai][1][m][1] * sg;
                if (first) { v0[0] = acc[ai][0][m][0][0]; AH[(size_t)b * 2048 + feat] = acc[ai][1][m][0][0]; }
                u32x4 w; w.x = cvt_pk_bf16(v0[0], v0[1]); w.y = cvt_pk_bf16(v0[2], v0[3]); w.z = cvt_pk_bf16(v1[0], v1[1]); w.w = cvt_pk_bf16(v1[2], v1[3]);
                stg16(ub + (size_t)(ai * 128 + m * 16) * 1024, vo, w); }
    }
};
struct DftZ { u32x4 zd, zm; unsigned z8; };
__device__ __forceinline__ DftZ dft_row_ld(const bf16_t* zrow, int mi0) { DftZ z; z.zd = *(const u32x4*)(zrow + mi0); z.zm = *(const u32x4*)(zrow + 248 - mi0); z.z8 = (mi0 >= 8) ? (unsigned)zrow[256 - mi0] : 0u; return z; }
__device__ __forceinline__ void dft_row_st(bf16_t* zrow, int mi0, const DftZ& z, const float (&d)[8], const float (&mr)[8]) {
    const u32x4 zd = z.zd, zm = z.zm;
    u32x4 o; o.x = cvt_pk_bf16(d[0] * bflo(zd.x), d[1] * bfhi(zd.x)); o.y = cvt_pk_bf16(d[2] * bflo(zd.y), d[3] * bfhi(zd.y));
    o.z = cvt_pk_bf16(d[4] * bflo(zd.z), d[5] * bfhi(zd.z)); o.w = cvt_pk_bf16(d[6] * bflo(zd.w), d[7] * bfhi(zd.w));
    *(u32x4*)(zrow + mi0) = o;
    bf16_t* mp = zrow + 248 - mi0;
    mp[1] = (bf16_t)f2bf(mr[7] * bfhi(zm.x));
    *(unsigned*)(mp + 2) = cvt_pk_bf16(mr[6] * bflo(zm.y), mr[5] * bfhi(zm.y));
    u32x2 w; w.x = cvt_pk_bf16(mr[4] * bflo(zm.z), mr[3] * bfhi(zm.z)); w.y = cvt_pk_bf16(mr[2] * bflo(zm.w), mr[1] * bfhi(zm.w));
    *(u32x2*)(mp + 4) = w;
    if (mi0 >= 8) mp[8] = (bf16_t)f2bf(mr[0] * bf1((bf16_t)z.z8));
}
template <bool FOLD> struct EpiDft {
    static constexpr bool PERM = true;
    bf16_t* Z; int L; int tok_base; const float* AH;
    __device__ __forceinline__ void operator()(AccRef acc, const pg8::Unit& u, int wr, int wc, int fr, int fq) const {
        const int b = u.pn >> 3, g = u.pn & 7, k0 = u.pm * 128 + wr * 64 + fr, mi0 = wc * 32 + 8 * fq;
        f32x4 ah[2] = {(f32x4){0.f, 0.f, 0.f, 0.f}, (f32x4){0.f, 0.f, 0.f, 0.f}}; float ahn = 0.f;
        if (FOLD) { const float* ap = AH + (size_t)b * 2048 + g * 256; ah[0] = *(const f32x4*)(ap + mi0) * 0.022097087f; ah[1] = *(const f32x4*)(ap + mi0 + 4) * 0.022097087f; ahn = ap[128] * 0.022097087f; }
        const bool nyq = (wc == 0 && fq == 0);
#pragma unroll
        for (int mh = 0; mh < 2; ++mh) {
            DftZ zr[2], zq[2]; unsigned n0[2], n1[2];
#pragma unroll
            for (int mm = 0; mm < 2; ++mm) { const int k = k0 + 16 * (2 * mh + mm); const bf16_t* zrow = Z + (size_t)(tok_base + b * L + k) * 2048 + g * 256;
                const bf16_t* zmir = Z + (size_t)(tok_base + b * L + ((FOLD && k >= 1) ? (L - k) : k)) * 2048 + g * 256;
                zr[mm] = dft_row_ld(zrow, mi0); if (FOLD) zq[mm] = dft_row_ld(zmir, mi0);
                n0[mm] = nyq ? (unsigned)zrow[128] : 0u; n1[mm] = (nyq && FOLD) ? (unsigned)zmir[128] : 0u; }
#pragma unroll
            for (int mm = 0; mm < 2; ++mm) { const int m = 2 * mh + mm, k = k0 + 16 * m; bf16_t* zrow = Z + (size_t)(tok_base + b * L + k) * 2048 + g * 256;
                bf16_t* zmir = Z + (size_t)(tok_base + b * L + (L - k)) * 2048 + g * 256;
                const float sg = (k & 1) ? -1.f : 1.f;
                float dm[8], sm[8];
#pragma unroll
                for (int n = 0; n < 2; ++n) { f32x4 P = acc[0][0][m][n]; const f32x4 Q = acc[1][1][m][n]; if (FOLD) P = P + ah[n] * sg;
#pragma unroll
                    for (int e = 0; e < 4; ++e) { dm[4 * n + e] = P[e] - Q[e]; sm[4 * n + e] = P[e] + Q[e]; }
                    if (n == 0 && mi0 == 0) { dm[0] = P[0]; sm[0] = P[0]; } }
                dft_row_st(zrow, mi0, zr[mm], dm, sm);
                if (FOLD && k >= 1) dft_row_st(zmir, mi0, zq[mm], sm, dm);
                if (nyq) { const float yn = acc[0][1][m][0][0] + (FOLD ? ahn * sg : 0.f);
                    zrow[128] = (bf16_t)f2bf(yn * bf1((bf16_t)n0[mm]));
                    if (FOLD && k >= 1) zmir[128] = (bf16_t)f2bf(yn * bf1((bf16_t)n1[mm])); } }
            asm volatile("" ::: "memory");
        }
    }
};
struct OutOrder {
    pg8::TileOrder T; int G, c; bool with_ctx;
    __device__ void init(int G_, int c_, bool with_ctx_) { T.init(64, 4, G_, c_); G = G_; c = c_; with_ctx = with_ctx_; }
    __device__ bool next(int i, pg8::Unit& u) const {
        const int L = i * G + c;
        if (L < 256) return T.next(i, u);
        if (!with_ctx || L >= 384) return false;
        const int idx = L - 256, tile = idx >> 2; u.pm = 64 + (tile >> 2); u.pn = tile & 3; u.aux = 1 + (idx & 3); return true;
    }
    __device__ __forceinline__ int koff(const pg8::Unit& u) const { return u.aux ? 512 * (u.aux - 1) : 0; }
    __device__ __forceinline__ const char* a_ptr(const pg8::Gemm& g, const pg8::Unit& u) const { return (const char*)(g.A + (size_t)u.pm * 256 * g.lda + koff(u)); }
    __device__ __forceinline__ const char* b_ptr(const pg8::Gemm& g, const pg8::Unit& u, int half) const { return (const char*)(g.Bt + (size_t)(u.pn * 256 + 128 * half) * g.ldb + koff(u)); }
    __device__ __forceinline__ bool b_mirror(const pg8::Unit&) const { return false; }
    __device__ __forceinline__ bool b_fix(const pg8::Unit&) const { return false; }
    __device__ __forceinline__ int ktiles(const pg8::Gemm& g, const pg8::Unit& u) const { return u.aux ? 8 : g.K / pg8::BK; }
};
struct EpiResid {
    static constexpr bool PERM = false;
    const float* xin_lat; float* xout_lat; const float* gate; float* part;
    __device__ __forceinline__ void operator()(AccRef acc, const pg8::Unit& u, int wr, int wc, int fr, int fq) const {
        const int row0 = u.pm * 256 + wr * 64 + fr, col0 = u.pn * 256 + wc * 32 + 4 * fq;
        if (u.aux) {
            float* pp = part + (size_t)(u.aux - 1) * NCTX * DM + (size_t)(row0 - NLAT) * DM + col0;
#pragma unroll
            for (int ai = 0; ai < 2; ++ai)
#pragma unroll
                for (int m = 0; m < 4; ++m)
#pragma unroll
                    for (int bj = 0; bj < 2; ++bj)
#pragma unroll
                        for (int n = 0; n < 2; ++n) *(f32x4*)(pp + (size_t)(ai * 128 + m * 16) * DM + bj * 128 + n * 16) = acc[ai][bj][m][n];
            return;
        }
        const float* gp = gate + (u.pm >> 3) * 3072 + col0;
        f32x4 gv[2][2];
#pragma unroll
        for (int bj = 0; bj < 2; ++bj)
#pragma unroll
            for (int n = 0; n < 2; ++n) gv[bj][n] = *(const f32x4*)(gp + bj * 128 + n * 16);
#pragma unroll
        for (int ai = 0; ai < 2; ++ai) {
            f32x4 xv[4][2][2];
#pragma unroll
            for (int m = 0; m < 4; ++m) { const size_t off = (size_t)(row0 + ai * 128 + m * 16) * DM + col0;
#pragma unroll
                for (int bj = 0; bj < 2; ++bj)
#pragma unroll
                    for (int n = 0; n < 2; ++n) xv[m][bj][n] = *(const f32x4*)(xin_lat + off + bj * 128 + n * 16); }
#pragma unroll
            for (int m = 0; m < 4; ++m) { const size_t off = (size_t)(row0 + ai * 128 + m * 16) * DM + col0;
#pragma unroll
                for (int bj = 0; bj < 2; ++bj)
#pragma unroll
                    for (int n = 0; n < 2; ++n) *(f32x4*)(xout_lat + off + bj * 128 + n * 16) = xv[m][bj][n] + gv[bj][n] * acc[ai][bj][m][n]; }
            asm volatile("" ::: "memory"); }
    }
};
struct EpiQKV {
    static constexpr bool PERM = true;
    bf16_t* Q; bf16_t* K; bf16_t* V; const float* rcos; const float* rsin;
    __device__ __forceinline__ void operator()(AccRef acc, const pg8::Unit& u, int wr, int wc, int fr, int fq) const {
        const int row0 = u.pm * 256 + wr * 64 + fr, c0 = wc * 32 + 8 * fq;
        if (u.pn >= 8) {
#pragma unroll
            for (int ai = 0; ai < 2; ++ai)
#pragma unroll
                for (int m = 0; m < 4; ++m) { bf16_t* rowp = V + (size_t)(row0 + ai * 128 + m * 16) * 2048 + (u.pn - 8) * 256 + c0;
#pragma unroll
                    for (int bj = 0; bj < 2; ++bj) { const f32x4 v0 = acc[ai][bj][m][0], v1 = acc[ai][bj][m][1]; u32x4 w;
                        w.x = cvt_pk_bf16(v0[0], v0[1]); w.y = cvt_pk_bf16(v0[2], v0[3]); w.z = cvt_pk_bf16(v1[0], v1[1]); w.w = cvt_pk_bf16(v1[2], v1[3]);
                        *(u32x4*)(rowp + bj * 128) = w; } }
            return;
        }
        const bool isk = u.pn >= 4, lat = u.pm < 64; const int h = u.pn & 3; bf16_t* dst = isk ? K : Q; const float sc = isk ? 0.0625f : 1.0f;
        const int i0 = 16 * wc + 4 * fq;
#pragma unroll
        for (int ai = 0; ai < 2; ++ai) {
            f32x4 cv[4][2], sv[4][2];
            if (lat) {
#pragma unroll
                for (int m = 0; m < 4; ++m) { const int l = (row0 + ai * 128 + m * 16) & 2047;
#pragma unroll
                    for (int bj = 0; bj < 2; ++bj) { const int pos = bj == 0 ? (l >> 6) : (l & 63); cv[m][bj] = *(const f32x4*)(rcos + pos * 64 + i0); sv[m][bj] = *(const f32x4*)(rsin + pos * 64 + i0); } } }
#pragma unroll
            for (int m = 0; m < 4; ++m) { const int row = row0 + ai * 128 + m * 16;
                bf16_t* chp = dst + ((size_t)(row >> 7) * 4 + h) * 32768;
#pragma unroll
                for (int bj = 0; bj < 2; ++bj) { f32x4 x1 = acc[ai][bj][m][0], x2 = acc[ai][bj][m][1];
                    if (lat) { const f32x4 o1 = x1 * cv[m][bj] - x2 * sv[m][bj], o2 = x1 * sv[m][bj] + x2 * cv[m][bj]; x1 = o1; x2 = o2; }
                    x1 = x1 * sc; x2 = x2 * sc; u32x4 w;
                    w.x = cvt_pk_bf16(x1[0], x1[1]); w.y = cvt_pk_bf16(x1[2], x1[3]); w.z = cvt_pk_bf16(x2[0], x2[1]); w.w = cvt_pk_bf16(x2[2], x2[3]);
                    const int s32 = 4 * bj + wc;
                    const int off = isk ? ((s32 * 8 + ((row & 127) >> 4)) * 512 + (4 * (row & 15) + fq) * 8)
                                        : (((((row >> 4) & 7) * 8) + s32) * 512 + (16 * fq + (row & 15)) * 8);
                    *(u32x4*)(chp + off) = w; } }
            asm volatile("" ::: "memory"); }
    }
};
struct EpiZGate {
    static constexpr bool PERM = true;
    const bf16_t* O; const float* rinv; bf16_t* AO;
    __device__ __forceinline__ void operator()(AccRef acc, const pg8::Unit& u, int wr, int wc, int fr, int fq) const {
        const int row0 = u.pm * 256 + wr * 64 + fr, col0 = u.pn * 256 + wc * 32 + 8 * fq, head = u.pn >> 1;
#pragma unroll
        for (int ai = 0; ai < 2; ++ai) {
            u32x4 ov[4][2]; float rv[4];
#pragma unroll
            for (int m = 0; m < 4; ++m) { const int row = row0 + ai * 128 + m * 16; rv[m] = rinv[row * 4 + head];
#pragma unroll
                for (int bj = 0; bj < 2; ++bj) { const int c = col0 + bj * 128, e0 = c & 63;
                    const bf16_t* op = O + ((size_t)((((row >> 7) * 4 + (c >> 9)) * 8 + ((c >> 6) & 7)) * 8 + ((row >> 4) & 7)) << 10) + (e0 >> 4) * 256 + (16 * ((e0 >> 2) & 3) + (row & 15)) * 4;
                    const u32x2 lo = *(const u32x2*)op, hi = *(const u32x2*)(op + 64); ov[m][bj] = (u32x4){lo.x, lo.y, hi.x, hi.y}; } }
#pragma unroll
            for (int m = 0; m < 4; ++m) { const int row = row0 + ai * 128 + m * 16; const float r_ = rv[m];
#pragma unroll
                for (int bj = 0; bj < 2; ++bj) { const u32x4 o = ov[m][bj]; const f32x4 v0 = acc[ai][bj][m][0], v1 = acc[ai][bj][m][1]; u32x4 w;
                    w.x = cvt_pk_bf16(bflo(o.x) * r_ * silu_f(v0[0]), bfhi(o.x) * r_ * silu_f(v0[1])); w.y = cvt_pk_bf16(bflo(o.y) * r_ * silu_f(v0[2]), bfhi(o.y) * r_ * silu_f(v0[3]));
                    w.z = cvt_pk_bf16(bflo(o.z) * r_ * silu_f(v1[0]), bfhi(o.z) * r_ * silu_f(v1[1])); w.w = cvt_pk_bf16(bflo(o.w) * r_ * silu_f(v1[2]), bfhi(o.w) * r_ * silu_f(v1[3]));
                    *(u32x4*)(AO + (size_t)row * 2048 + col0 + bj * 128) = w; } }
            asm volatile("" ::: "memory"); }
    }
};

#define XB_TMO      128
#define XB_XCNT(j)  (256  + 64 * (j))
#define XB_XSUB(j)  (1280 + 64 * (j))
#define XB_XGEN(j)  (2304 + 64 * (j))
#define XB_TOP      3328
#define XB_TOPGEN   3392
#define XCD_BAR_WORDS 3456
#define XB_SPIN_CAP (1u << 18)
__device__ __forceinline__ unsigned xb_ld(unsigned* p)              { return __hip_atomic_load(p, __ATOMIC_RELAXED, __HIP_MEMORY_SCOPE_AGENT); }
__device__ __forceinline__ unsigned xb_add(unsigned* p, unsigned v) { return __hip_atomic_fetch_add(p, v, __ATOMIC_RELAXED, __HIP_MEMORY_SCOPE_AGENT); }
__device__ __forceinline__ unsigned xb_xcc_id() { return (unsigned)__builtin_amdgcn_s_getreg((3 << 11) | 20) & 0xFu; }
#define XB_SPIN(cond, bar) do { unsigned _sp = 0; while (cond) { __builtin_amdgcn_s_sleep(1); \
    if ((++_sp & 255u) == 0u) { if (xb_ld(&(bar)[XB_TMO])) break; if (_sp > XB_SPIN_CAP) { atomicAdd(&(bar)[XB_TMO], 1u); break; } } } } while (0)
struct XcdBarrier { unsigned* bar; unsigned x; volatile LAS unsigned* st; };
__device__ __forceinline__ XcdBarrier xcd_barrier_post(unsigned* bar, volatile LAS unsigned* st) {
    XcdBarrier b; b.bar = bar; b.x = xb_xcc_id(); b.st = st;
    if (threadIdx.x == 0) (void)xb_add(&bar[XB_XCNT(b.x)], 1u);
    return b;
}
__device__ __forceinline__ void xcd_barrier_complete(unsigned* bar, unsigned x, unsigned& nloc, unsigned& nx) {
    const unsigned G = gridDim.x * gridDim.y * gridDim.z;
    unsigned sum, cnt, mine, sp = 0u;
    for (;;) {
        sum = 0u; cnt = 0u; mine = 0u;
#pragma unroll 1
        for (unsigned j = 0; j < 16; ++j) { const unsigned c = xb_ld(&bar[XB_XCNT(j)]); sum += c; cnt += (c > 0u) ? 1u : 0u; mine = (j == x) ? c : mine; }
        if (sum == G) break;
        __builtin_amdgcn_s_sleep(1);
        if ((++sp & 255u) == 0u) { if (xb_ld(&bar[XB_TMO])) break; if (sp > XB_SPIN_CAP) { atomicAdd(&bar[XB_TMO], 1u); break; } }
    }
    nloc = mine > 0u ? mine : 1u; nx = cnt > 0u ? cnt : 1u;
}
__device__ __forceinline__ void xcd_barrier(const XcdBarrier& b) {
    asm volatile("s_waitcnt vmcnt(0)" ::: "memory");
    __syncthreads();
    if (threadIdx.x == 0) {
        unsigned* bar = b.bar;
        __builtin_amdgcn_s_waitcnt(0);
        unsigned nloc = b.st[0], nx = b.st[1];
        if (nloc == 0u) { xcd_barrier_complete(bar, b.x, nloc, nx); b.st[0] = nloc; b.st[1] = nx; }
        const unsigned old = xb_add(&bar[XB_XSUB(b.x)], 1u);
        const unsigned gen = old / nloc;
        if (old + 1u == (gen + 1u) * nloc) {
            __builtin_amdgcn_fence(__ATOMIC_RELEASE, "agent");
            asm volatile("s_waitcnt vmcnt(0)" ::: "memory");
            const unsigned og = xb_add(&bar[XB_TOP], 1u);
            const unsigned tg = og / nx;
            if (og + 1u == (tg + 1u) * nx) xb_add(&bar[XB_TOPGEN], 1u);
            else XB_SPIN(xb_ld(&bar[XB_TOPGEN]) == tg, bar);
            __builtin_amdgcn_fence(__ATOMIC_ACQUIRE, "agent");
            xb_add(&bar[XB_XGEN(b.x)], 1u);
            asm volatile("s_waitcnt vmcnt(0)" ::: "memory");
        } else {
            XB_SPIN(xb_ld(&bar[XB_XGEN(b.x)]) == gen, bar);
            __builtin_amdgcn_fence(__ATOMIC_ACQUIRE, "agent");
            asm volatile("s_waitcnt vmcnt(0)" ::: "memory");
        }
    }
    __syncthreads();
}

struct Args { const float* in[13]; float* out; unsigned char* ws; int ph_lo, ph_hi, pad0, pad1; };
struct Frame {
    LAS unsigned char* lds;
    int vcu, G, wv;
    unsigned char* ws;
};
__device__ __forceinline__ int lane_id() { int l; asm volatile("v_mbcnt_lo_u32_b32 %0, -1, 0\n\tv_mbcnt_hi_u32_b32 %0, -1, %0" : "=v"(l)); return l; }
__device__ __forceinline__ unsigned char* launder_ptr(unsigned char* p) {
    unsigned lo = (unsigned)(unsigned long long)p, hi = (unsigned)((unsigned long long)p >> 32);
    asm volatile("" : "+s"(lo), "+s"(hi));
    return (unsigned char*)(((unsigned long long)hi << 32) | lo);
}
#define PHASE_IDS() int tid = F.wv * 64 + lane_id(); asm volatile("" : "+v"(tid)); const int lane = tid & 63, wave = __builtin_amdgcn_readfirstlane(tid >> 6); (void)lane; (void)wave; \
    unsigned char* ws = launder_ptr(F.ws); (void)ws
#define LDS_WAIT() asm volatile("s_waitcnt lgkmcnt(0)" ::: "memory")

__device__ __forceinline__ int qk_pos(int d) { const int half = d >> 7, n = (d >> 6) & 1, i = d & 63; return 128 * half + 8 * (i >> 2) + 4 * n + (i & 3); }
template <int MODE>
__device__ __forceinline__ void transpose_item(const float* W, int K, int N, int n_begin, bf16_t* WT, LAS float* scr, int item, int nblk, int lane) {
    const int kb = item / nblk, nb = item % nblk, k0 = 64 * kb, n0 = n_begin + 64 * nb;
    const GAS f32x4* src = (const GAS f32x4*)(W + (size_t)(k0 + (lane >> 4)) * N + n0 + 4 * (lane & 15));
    f32x4 v[16];
#pragma unroll
    for (int i = 0; i < 16; ++i) v[i] = src[(size_t)i * N];
#pragma unroll
    for (int i = 0; i < 16; ++i) *(LAS f32x4*)(scr + (4 * i + (lane >> 4)) * 68 + 4 * (lane & 15)) = v[i];
    LDS_WAIT(); asm volatile("" ::: "memory");
    const int na = n0 + lane; int nn = na - n_begin;
    if (MODE == 1) nn = (na < 2048) ? ((na & ~255) + qk_pos(na & 255)) : na;
    GAS u32x4* dst = (GAS u32x4*)(WT + (size_t)nn * K + k0);
#pragma unroll
    for (int c = 0; c < 8; ++c) { const LAS float* sp = scr + (8 * c) * 68 + lane;
        u32x4 o; o.x = pk2(sp[0 * 68], sp[1 * 68]); o.y = pk2(sp[2 * 68], sp[3 * 68]); o.z = pk2(sp[4 * 68], sp[5 * 68]); o.w = pk2(sp[6 * 68], sp[7 * 68]);
        dst[c] = o; }
    LDS_WAIT(); asm volatile("" ::: "memory");
}
__device__ __forceinline__ void fold_task(const float* Win  , const LAS float* ctab  , bf16_t* WfT, int t, int lane) {
    const int g = t >> 8, p0 = ((t >> 5) & 7) * 32, kk0 = (t & 31) * 32, s = lane >> 5, li = lane & 31;
    f32x16 acc;
#pragma unroll
    for (int i = 0; i < 16; ++i) acc[i] = 0.f;
    const float* wrow = Win + (size_t)(kk0 + li) * 4096 + g * 256 + 4 * s;
    const int pcol = p0 + li;
    const int pmul = pcol < 128 ? pcol : pcol - 128, poff = pcol < 128 ? 0 : -64; const bool nyq = pcol == 128;
    f32x4 wvv[32];
#pragma unroll
    for (int tp = 0; tp < 32; ++tp) wvv[tp] = *(const GAS f32x4*)((const GAS float*)wrow + 8 * tp);
#pragma unroll
    for (int tp = 0; tp < 32; ++tp) {
        const f32x4 wv = wvv[tp];
#pragma unroll
        for (int uu = 0; uu < 4; ++uu) { const int cc = 8 * tp + 4 * s + uu; float a;
            a = ctab[(pmul * cc + poff) & 255]; if (nyq) a = (cc & 1) ? -0.0625f : 0.0625f;
            acc = __builtin_amdgcn_mfma_f32_32x32x2f32(a, wv[uu], acc, 0, 0, 0); }
    }
#pragma unroll
    for (int i = 0; i < 16; ++i) { const int row = (i & 3) + 8 * (i >> 2) + 4 * s; WfT[(size_t)(g * 256 + p0 + row) * 1024 + kk0 + li] = (bf16_t)f2bf(acc[i]); }
}

__device__ __forceinline__ void p0_phase(Frame& F, const Args& a) {
    PHASE_IDS();
    float* ADA = (float*)(ws + WS_ADA);
    const float* c = a.in[1]; const float* cctx = a.in[3]; const float* ada_w = a.in[5]; const float* ada_b = a.in[6];
    LAS float* sl = (LAS float*)F.lds;
    LAS float* part = (LAS float*)(F.lds + 36864);
    bool loaded = false;
    for (int u = F.vcu; u < 192; u += F.G) {
        if (!loaded) { for (int idx = tid; idx < 9 * 1024; idx += 512) { const int r = idx >> 10, k = idx & 1023; const float x = r < 8 ? c[r * 1024 + k] : cctx[k]; sl[idx] = x / (1.f + expf(-x)); } loaded = true; }
        __syncthreads();
        const int i = u / 48, n0 = (u % 48) * 64;
        f32x4 acc[9];
#pragma unroll
        for (int r = 0; r < 9; ++r) acc[r] = (f32x4){0.f, 0.f, 0.f, 0.f};
        const int ks4 = lane >> 4, c4 = 4 * (lane & 15);
        const float* wp = ada_w + ((size_t)i * 1024 + wave * 128 + ks4) * 3072 + n0 + c4;
#pragma unroll 8
        for (int kk = 0; kk < 32; ++kk) { const f32x4 wv = *(const f32x4*)(wp + (size_t)kk * 4 * 3072); const int k = wave * 128 + 4 * kk + ks4;
#pragma unroll
            for (int r = 0; r < 9; ++r) acc[r] += wv * sl[r * 1024 + k]; }
#pragma unroll
        for (int r = 0; r < 9; ++r) *(LAS f32x4*)(part + ((wave * 4 + ks4) * 9 + r) * 64 + c4) = acc[r];
        __syncthreads();
        for (int idx = tid; idx < 576; idx += 512) { const int r = idx >> 6, l = idx & 63; float s = 0.f;
#pragma unroll
            for (int w = 0; w < 32; ++w) s += part[(w * 9 + r) * 64 + l];
            ADA[(i * 9 + r) * 3072 + n0 + l] = s + ada_b[i * 3072 + n0 + l]; }
    }
    const int gt = F.vcu * 512 + tid, NT = F.G * 512;
    float* RC = (float*)(ws + WS_ROPE); float* RS = RC + 4096;
    for (int idx = gt; idx < 4096; idx += NT) { const int pos = idx >> 6, i = idx & 63; const float freq = powf(10000.0f, -(float)i / 64.0f); const float ang = (float)pos * freq;
        RC[idx] = cosf(ang); RS[idx] = sinf(ang); }
    bf16_t* CS256 = (bf16_t*)(ws + WS_CS256);
    for (int idx = gt; idx < 512 * 256; idx += NT) { const int row = idx >> 8, l = idx & 255, kt = row >> 8, hf = (row >> 7) & 1, k = kt * 128 + (row & 127);
        const float x = (float)((k * l) & 255) * (1.f / 128.f); const float v = (hf ? sinpif(x) : cospif(x)) * 0.0625f; CS256[idx] = (bf16_t)f2bf(v); }
}

__device__ __forceinline__ void norm_row(const float* xrow, const float* ng, const float* adar  , bf16_t* orow, int lane) {
    const f32x4* xr = (const f32x4*)xrow + lane;
    f32x4 v[4]; float s = 0.f;
#pragma unroll
    for (int j = 0; j < 4; ++j) { v[j] = xr[64 * j]; s += (v[j].x * v[j].x + v[j].y * v[j].y) + (v[j].z * v[j].z + v[j].w * v[j].w); }
    const float rinv = rsqrtf(wave_sum(s, lane) * (1.f / DM) + EPS);
    unsigned long long* o8 = (unsigned long long*)orow + lane;
#pragma unroll
    for (int j = 0; j < 4; ++j) { const int col = 4 * lane + 256 * j; const f32x4 g = *(const f32x4*)(ng + col), sh = *(const f32x4*)(adar + col), sc = *(const f32x4*)(adar + 1024 + col);
        const f32x4 y = v[j] * rinv * g * (sc + 1.0f) + sh;
        o8[64 * j] = (unsigned long long)pk2(y.x, y.y) | ((unsigned long long)pk2(y.z, y.w) << 32); }
}
template <int NR>
__device__ __forceinline__ void norm_batch(const float* const (&xrow)[NR], bf16_t* const (&hrow)[NR], int nrows, const f32x4 (&gm)[4], const f32x4 (&sh)[4], int lane) {
    f32x4 v[NR][4]; float ss[NR];
#pragma unroll
    for (int t = 0; t < NR; ++t) { const f32x4* xr = (const f32x4*)xrow[t] + lane;
#pragma unroll
        for (int j = 0; j < 4; ++j) v[t][j] = xr[64 * j]; }
#pragma unroll
    for (int t = 0; t < NR; ++t) { float s = 0.f;
#pragma unroll
        for (int j = 0; j < 4; ++j) s += (v[t][j].x * v[t][j].x + v[t][j].y * v[t][j].y) + (v[t][j].z * v[t][j].z + v[t][j].w * v[t][j].w);
        ss[t] = s; }
#pragma unroll
    for (int o = 1; o < 64; o <<= 1) {
#pragma unroll
        for (int t = 0; t < NR; ++t) ss[t] += shx(ss[t], o, lane); }
#pragma unroll
    for (int t = 0; t < NR; ++t) if (t < nrows) { const float rinv = rsqrtf(ss[t] * (1.f / DM) + EPS);
        unsigned long long* o8 = (unsigned long long*)hrow[t] + lane;
#pragma unroll
        for (int j = 0; j < 4; ++j) { const f32x4 y = v[t][j] * rinv * gm[j] + sh[j];
            o8[64 * j] = (unsigned long long)pk2(y.x, y.y) | ((unsigned long long)pk2(y.z, y.w) << 32); } }
}
template <bool ADDP>
__device__ __forceinline__ void norm_rows(Frame& F, const Args& a, int layer, bf16_t* H, int wsub = 8) {
    PHASE_IDS();
    const float* xl = layer == 0 ? a.in[0] : a.out; const float* xc = (layer == 0 || (ADDP && layer == 1)) ? a.in[2] : (const float*)(ws + WS_XCTX);
    const float* ng = a.in[4] + layer * DM; const float* ADA = (const float*)(ws + WS_ADA) + layer * 9 * 3072;
    const int gw = F.vcu * wsub + wave, NGW = F.G * wsub;
    const int wpb = NGW >> 3;
    if (wpb > 0 && (NGW & 7) == 0) {
        const int b = gw / wpb, wi = gw - b * wpb; const float* adar = ADA + b * 3072;
        f32x4 gm[4], sh[4];
#pragma unroll
        for (int j = 0; j < 4; ++j) { const int col = 4 * lane + 256 * j; gm[j] = *(const f32x4*)(ng + col) * (*(const f32x4*)(adar + 1024 + col) + 1.0f); sh[j] = *(const f32x4*)(adar + col); }
        for (int l0 = wi; l0 < SEQ; l0 += 8 * wpb) {
            const float* xr[8]; bf16_t* hr[8]; int n = 0;
#pragma unroll
            for (int t = 0; t < 8; ++t) { const int l = l0 + t * wpb; const int ll = l < SEQ ? l : wi; if (l < SEQ) n = t + 1; xr[t] = xl + (size_t)(b * SEQ + ll) * DM; hr[t] = H + (size_t)(b * SEQ + ll) * DM; }
            norm_batch<8>(xr, hr, n, gm, sh, lane);
        }
        const float* adac = ADA + 8 * 3072;
#pragma unroll
        for (int j = 0; j < 4; ++j) { const int col = 4 * lane + 256 * j; gm[j] = *(const f32x4*)(ng + col) * (*(const f32x4*)(adac + 1024 + col) + 1.0f); sh[j] = *(const f32x4*)(adac + col); }
        for (int m = gw; m < NCTX; m += NGW) {
            f32x4 xv[4];
#pragma unroll
            for (int j = 0; j < 4; ++j) xv[j] = *((const f32x4*)(xc + (size_t)m * DM) + lane + 64 * j);
            if (ADDP && layer >= 1) {
                const float* part = (const float*)(ws + WS_PART); const float* gprev = (const float*)(ws + WS_ADA) + (layer - 1) * 9 * 3072 + 8 * 3072 + 2048;
                float* xw = (float*)(ws + WS_XCTX) + (size_t)m * DM;
#pragma unroll
                for (int j = 0; j < 4; ++j) { const f32x4* pr = (const f32x4*)(part + (size_t)m * DM) + lane + 64 * j;
                    const f32x4 ps = (pr[0] + pr[(size_t)NCTX * DM / 4]) + (pr[(size_t)2 * NCTX * DM / 4] + pr[(size_t)3 * NCTX * DM / 4]);
                    xv[j] = xv[j] + *(const f32x4*)(gprev + 4 * lane + 256 * j) * ps;
                    *((f32x4*)xw + lane + 64 * j) = xv[j]; }
            }
            float s_ = 0.f;
#pragma unroll
            for (int j = 0; j < 4; ++j) s_ += (xv[j].x * xv[j].x + xv[j].y * xv[j].y) + (xv[j].z * xv[j].z + xv[j].w * xv[j].w);
            const float rinv = rsqrtf(wave_sum(s_, lane) * (1.f / DM) + EPS);
            unsigned long long* o8 = (unsigned long long*)(H + (size_t)(NLAT + m) * DM) + lane;
#pragma unroll
            for (int j = 0; j < 4; ++j) { const f32x4 y = xv[j] * rinv * gm[j] + sh[j];
                o8[64 * j] = (unsigned long long)pk2(y.x, y.y) | ((unsigned long long)pk2(y.z, y.w) << 32); }
        }
        return;
    }
    for (int m = gw; m < NTOK; m += NGW) {
        const bool lat = m < NLAT; const int r = lat ? (m >> 11) : 8; const float* adar = ADA + r * 3072;
        f32x4 gm[4], sh[4];
#pragma unroll
        for (int j = 0; j < 4; ++j) { const int col = 4 * lane + 256 * j; gm[j] = *(const f32x4*)(ng + col) * (*(const f32x4*)(adar + 1024 + col) + 1.0f); sh[j] = *(const f32x4*)(adar + col); }
        const float* xr[1] = {lat ? xl + (size_t)m * DM : xc + (size_t)(m - NLAT) * DM}; bf16_t* hr[1] = {H + (size_t)m * DM};
        norm_batch<1>(xr, hr, 1, gm, sh, lane);
    }
}
__device__ __forceinline__ void cf_prep(Frame& F, int wave, int lane) {
    LAS float* ctab = (LAS float*)(F.lds + 139264);
    { const int tt = wave * 64 + lane; if (tt < 256) ctab[tt] = cospif((float)tt * (1.f / 128.f)) * 0.0625f; }
    __syncthreads();
}
__device__ __forceinline__ void cf_main(Frame& F, const Args& a, int j, int gw, int NGW, unsigned char* ws, int wave, int lane) {
    LAS float* scr = (LAS float*)(F.lds + wave * 17408); const LAS float* ctab = (const LAS float*)(F.lds + 139264);
    bf16_t* W1 = (bf16_t*)(ws + WS_WF);
    const float* win = a.in[7] + (size_t)j * 1024 * 4096; const float* wout = a.in[8] + (size_t)j * 2048 * 1024;
    bf16_t* WfoT = W1 + (size_t)4096 * 1024;
    for (int t = gw; t < 2048; t += NGW) fold_task(win, ctab, W1, t, lane);
    for (int it = gw; it < 16 * 32; it += NGW) transpose_item<0>(win, 1024, 4096, 2048, W1 + (size_t)2048 * 1024, scr, it, 32, lane);
    for (int it = gw; it < 32 * 16; it += NGW) transpose_item<0>(wout, 2048, 1024, 0, WfoT, scr, it, 16, lane);
}
__device__ __forceinline__ void cf_cs(Frame& F, int gt, int NT, unsigned char* ws, int wave, int lane) {
    bf16_t* CS = (bf16_t*)(ws + WS_CS);
    __syncthreads();
    LAS float* ctab2 = (LAS float*)F.lds;
    for (int n = wave * 64 + lane; n < 2048; n += 512) ctab2[n] = cospif((float)n * (1.f / 1024.f)) * 0.022097087f;
    __syncthreads();
    for (int ch = gt; ch < 2048 * 128; ch += NT) { const int row = ch >> 7, l0 = (ch & 127) * 8, kt = row >> 8, hf = (row >> 7) & 1, k = kt * 128 + (row & 127);
        const int off = hf ? -512 : 0;
        unsigned w[4];
#pragma unroll
        for (int e = 0; e < 4; ++e) { float v[2];
#pragma unroll
            for (int q = 0; q < 2; ++q) { const int l = l0 + 2 * e + q; v[q] = ctab2[(k * l + off) & 2047]; }
            w[e] = pk2(v[0], v[1]); }
        *(u32x4*)(CS + (size_t)row * 1024 + l0) = (u32x4){w[0], w[1], w[2], w[3]}; }
    __syncthreads();
}
__device__ __forceinline__ void conv_fourier(Frame& F, const Args& a, int j, int gw, int NGW, int gt, int NT, unsigned char* ws, int wave, int lane) {
    cf_prep(F, wave, lane); cf_main(F, a, j, gw, NGW, ws, wave, lane); cf_cs(F, gt, NT, ws, wave, lane);
}
__device__ __forceinline__ void conv_ret(Frame& F, const Args& a, int j, int gw, int NGW, unsigned char* ws, int wave, int lane, int lo = 0, int hi = 2048) {
    LAS float* scr = (LAS float*)(F.lds + wave * 17408);
    bf16_t* W1 = (bf16_t*)(ws + WS_W);
    const float* win = a.in[9] + (size_t)j * 1024 * 6144; const float* wout = a.in[10] + (size_t)j * 2048 * 1024;
    bf16_t* WroT = W1 + (size_t)6144 * 1024;
    for (int it = lo + gw; it < hi; it += NGW) {
        if (it < 1536) transpose_item<1>(win, 1024, 6144, 0, W1, scr, it, 96, lane);
        else transpose_item<0>(wout, 2048, 1024, 0, WroT, scr, it - 1536, 16, lane);
    }
}
__device__ __forceinline__ void bg_conv_ret(Frame& F, const Args& a, int layer, int cu_lo, int lo, int hi) {
    PHASE_IDS();
    const int cu = (int)blockIdx.x - cu_lo;
    if (layer + 1 >= NLAYER || F.G != 256 || cu < 0 || cu >= 128) return;
    conv_ret(F, a, (layer + 1) >> 1, cu * 8 + wave, 1024, ws, wave, lane, lo, hi);
}
__device__ __forceinline__ void p0_conv(Frame& F, const Args& a) {
    PHASE_IDS();
    __syncthreads();
    conv_fourier(F, a, 0, F.vcu * 8 + wave, F.G * 8, F.vcu * 512 + tid, F.G * 512, ws, wave, lane);
}
__device__ __forceinline__ void n_phase(Frame& F, const Args& a, int layer) {
    PHASE_IDS();
    const bool fourier = (layer & 1) == 0;
    if (fourier && layer >= 1) {
        cf_prep(F, wave, lane);
        if (wave < 4) norm_rows<true>(F, a, layer, (bf16_t*)(ws + WS_H), 4); else cf_main(F, a, layer >> 1, F.vcu * 4 + wave - 4, F.G * 4, ws, wave, lane);
        cf_cs(F, F.vcu * 512 + tid, F.G * 512, ws, wave, lane);
        return;
    }
    norm_rows<true>(F, a, layer, (bf16_t*)(ws + (fourier ? WS_H : WS_OF)));
    if (layer >= 1) {
        if (fourier) conv_fourier(F, a, layer >> 1, F.vcu * 8 + wave, F.G * 8, F.vcu * 512 + tid, F.G * 512, ws, wave, lane);
        else if (F.G != 256) conv_ret(F, a, layer >> 1, F.vcu * 8 + wave, F.G * 8, ws, wave, lane);
    }
}
__device__ __forceinline__ void nyq_row_phase(Frame& F) {
    PHASE_IDS();
    const bf16_t* UTF = (const bf16_t*)(ws + WS_UTL); const float* AH = (const float*)(ws + WS_RINV); bf16_t* Z = (bf16_t*)(ws + WS_Z);
    const int gw = F.vcu * 8 + wave, NGW = F.G * 8;
    for (int t = gw; t < 64 * 129; t += NGW) {
        const int bg = t / 129, mt = t - bg * 129, b = bg >> 3, g = bg & 7; const int row = b * 2048 + g * 256 + mt;
        const GAS u32x4* src = (const GAS u32x4*)(UTF + (size_t)row * 1024);
        float s = 0.f;
#pragma unroll
        for (int i = 0; i < 2; ++i) { const u32x4 v = src[lane + 64 * i]; s += (bflo(v.x) - bfhi(v.x)) + (bflo(v.y) - bfhi(v.y)) + (bflo(v.z) - bfhi(v.z)) + (bflo(v.w) - bfhi(v.w)); }
        s = wave_sum(s, lane);
        const float y = (s + AH[row]) * 0.022097087f;
        bf16_t* zrow = Z + (size_t)(b * 2048 + 1024) * 2048 + g * 256;
        if (lane == 0) zrow[mt] = (bf16_t)f2bf(y * bf1(zrow[mt]));
        if (lane == 1 && mt >= 1 && mt <= 127) zrow[256 - mt] = (bf16_t)f2bf(y * bf1(zrow[256 - mt]));
    }
}
__device__ __forceinline__ bf16_t* s_chunk(unsigned char* ws, int h, int rc) {
    return rc < 64 ? (bf16_t*)(ws + WS_SA) + ((size_t)(h * 64 + rc) << 14) : (bf16_t*)(ws + WS_SB) + ((size_t)(h * 80 + rc - 64) << 14);
}
struct DiagOrder {
    int G, c;
    __device__ bool next(int i, pg8::Unit& u) const { const int L = i * G + c; if (L >= 288) return false; u.aux = L / 72; u.pm = L - 72 * u.aux; u.pn = u.pm; return true; }
    __device__ __forceinline__ const char* a_ptr(const pg8::Gemm& g, const pg8::Unit& u) const { return (const char*)(g.A + ((size_t)(2 * u.pm) * 4 + u.aux) * 32768); }
    __device__ __forceinline__ const char* b_ptr(const pg8::Gemm& g, const pg8::Unit& u, int half) const { return (const char*)(g.Bt + ((size_t)(2 * u.pm + half) * 4 + u.aux) * 32768); }
    __device__ __forceinline__ bool b_mirror(const pg8::Unit&) const { return false; }
    __device__ __forceinline__ bool b_fix(const pg8::Unit&) const { return false; }
    __device__ __forceinline__ int ktiles(const pg8::Gemm& g, const pg8::Unit&) const { return g.K / pg8::BK; }
};
struct EpiS {
    static constexpr bool PERM = true;
    unsigned char* ws;
    __device__ __forceinline__ void operator()(AccRef acc, const pg8::Unit& u, int wr, int wc, int fr, int fq) const {
#pragma unroll
        for (int ai = 0; ai < 2; ++ai) { bf16_t* sp = s_chunk(ws, u.aux, 2 * u.pm + ai);
#pragma unroll
            for (int m = 0; m < 4; ++m) { const f32x4 v0 = acc[ai][ai][m][0], v1 = acc[ai][ai][m][1]; u32x4 w;
                w.x = cvt_pk_bf16(v0[0], v0[1]); w.y = cvt_pk_bf16(v0[2], v0[3]); w.z = cvt_pk_bf16(v1[0], v1[1]); w.w = cvt_pk_bf16(v1[2], v1[3]);
                *(u32x4*)(sp + ((((wr * 4 + m) * 4 + wc) * 64 + fq * 16 + fr) << 3)) = w; } }
    }
};
typedef short bf16x4 __attribute__((ext_vector_type(4)));
typedef short v4i16_t __attribute__((ext_vector_type(4)));
__device__ __forceinline__ bf16x8 ldtr2(const LAS unsigned char* p0, const LAS unsigned char* p1) {
    const bf16x4 lo = __builtin_bit_cast(bf16x4, __builtin_amdgcn_ds_read_tr16_b64_v4i16((LAS v4i16_t*)p0));
    const bf16x4 hi = __builtin_bit_cast(bf16x4, __builtin_amdgcn_ds_read_tr16_b64_v4i16((LAS v4i16_t*)p1));
    return __builtin_shufflevector(lo, hi, 0, 1, 2, 3, 4, 5, 6, 7);
}
__device__ __forceinline__ int blk_perm(int rb) { return (rb & ~3) | ((rb >> 1) & 1) | ((rb & 1) << 1); }
__device__ __forceinline__ int scan_t0(int dir, int b, int s) {
    return dir == 0 ? ((s < 2) ? (NLAT + b * CTXL + s * 128) : (b * SEQ + (s - 2) * 128)) : ((s < 2) ? (NLAT + b * CTXL + (1 - s) * 128) : (b * SEQ + (17 - s) * 128));
}
__device__ __forceinline__ int scan_rc(int dir, int b, int s) {
    return dir == 0 ? ((s < 2) ? (128 + b * 2 + s) : (b * 16 + (s - 2))) : ((s < 2) ? (128 + b * 2 + (1 - s)) : (b * 16 + (17 - s)));
}
__device__ __forceinline__ u32x4 ldg16(const void* ub, unsigned voff) { return *(const GAS u32x4*)((const GAS unsigned char*)ub + voff); }
__device__ __forceinline__ void scan_load_s(u32x4 (&sf)[4], unsigned char* ws, int h, int rc, int w, int r, int q) {
    const bf16_t* ub = s_chunk(ws, h, rc) + w * 2048; const unsigned vo = (unsigned)(16 * q + r) * 16u;
#pragma unroll
    for (int ks = 0; ks < 4; ++ks) sf[ks] = ldg16(ub, vo + 1024u * ks);
}
__device__ __forceinline__ void scan_load_q(u32x4 (&qf)[8], const bf16_t* Qg, int h, int t0, int w, int r, int q) {
    const bf16_t* ub = Qg + (((size_t)(t0 >> 7) * 4 + h) * 8 + w) * 4096; const unsigned vo = (unsigned)(16 * q + r) * 16u;
#pragma unroll
    for (int ks = 0; ks < 8; ++ks) qf[ks] = ldg16(ub, vo + 1024u * ks);
}
__device__ __forceinline__ void scan_load_kv(u32x4 (&kr)[8], u32x4 (&vr)[2], const bf16_t* Kg, const bf16_t* Vg, int h, int sl, int t0, int w, int lane, int tid) {
    const bf16_t* kb = Kg + (((size_t)(t0 >> 7) * 4 + h) * 8 + w) * 4096; const unsigned ko = (unsigned)lane * 16u;
#pragma unroll
    for (int it = 0; it < 8; ++it) kr[it] = ldg16(kb, ko + 1024u * it);
    const bf16_t* vb = Vg + (size_t)t0 * 2048 + h * 512 + sl * 64; const unsigned vo = (unsigned)((tid >> 3) * 2048 + 8 * (tid & 7)) * 2u;
#pragma unroll
    for (int i = 0; i < 2; ++i) vr[i] = ldg16(vb + (size_t)i * 64 * 2048, vo);
}
#ifndef DBG_SEG
#define DBG_SEG -1
#endif
#define SEG_MARK(k) do { if (DBG_SEG >= 0) { __builtin_amdgcn_sched_barrier(0); const unsigned long long t_ = __builtin_amdgcn_s_memtime(); if (DBG_SEG == (k)) segacc += t_ - segt; segt = t_; __builtin_amdgcn_sched_barrier(0); } } while (0)
template <int DIR>
__device__ __forceinline__ void scan_step(unsigned long long& segacc, unsigned long long& segt, LAS unsigned char* lds, u32x4 (&sf)[4], u32x4 (&qf)[8], u32x4 (&kr)[8], u32x4 (&vr)[2], f32x4 (&Rb)[2][4], const float (&wm)[2], float rsc, float g128,
                                          int t0, int t0n, int rcn, unsigned char* ws, int h, int sl, int w, int lane_in, int tid_in, const bf16_t* Qg, const bf16_t* Kg, const bf16_t* Vg, bf16_t* OF, float* SSP) {
    int lane = lane_in; asm volatile("" : "+v"(lane));
    const int tid = (tid_in & ~63) | lane;
    const int r = lane & 15, q = lane >> 4;
    LAS unsigned char* VI = lds + SC_V_OFF; LAS unsigned char* RT = lds + SC_RT_OFF; LAS unsigned char* KI = lds + SC_K_OFF + w * 8192;
    SEG_MARK(5);
#pragma unroll
    for (int i = 0; i < 2; ++i) { const int m = (tid >> 3) + 64 * i, e0 = 8 * (tid & 7); const float sc = wm[i]; const u32x4 v = vr[i]; u32x4 o;
        o.x = cvt_pk_bf16(bflo(v.x) * sc, bfhi(v.x) * sc); o.y = cvt_pk_bf16(bflo(v.y) * sc, bfhi(v.y) * sc); o.z = cvt_pk_bf16(bflo(v.z) * sc, bfhi(v.z) * sc); o.w = cvt_pk_bf16(bflo(v.w) * sc, bfhi(v.w) * sc);
        *(LAS u32x4*)(VI + 128 * ((e0 >> 4) * 32 + blk_perm(m >> 2)) + (m & 3) * 32 + (e0 & 15) * 2) = o; }
#pragma unroll
    for (int it = 0; it < 8; ++it) { const int m = it * 16 + (lane >> 2), dc = lane & 3;
        *(LAS u32x4*)(KI + 128 * ((dc >> 1) * 32 + blk_perm(m >> 2)) + (m & 3) * 32 + (dc & 1) * 16) = kr[it]; }
    SEG_MARK(0);
    asm volatile("s_waitcnt lgkmcnt(0)" ::: "memory"); __builtin_amdgcn_s_barrier(); asm volatile("" ::: "memory");
    SEG_MARK(1);
    const int jl = 16 * w + r;
    { const bf16_t* vb = Vg + (size_t)t0n * 2048 + h * 512 + sl * 64; const unsigned vo = (unsigned)((tid >> 3) * 2048 + 8 * (tid & 7)) * 2u;
#pragma unroll
      for (int i = 0; i < 2; ++i) vr[i] = ldg16(vb + (size_t)i * 64 * 2048, vo); }
    GAS unsigned char* ob = (GAS unsigned char*)(OF + ((size_t)((((t0 >> 7) * 4 + h) * 8 + sl) * 8 + w) << 10)); const unsigned oo = (unsigned)lane * 8u;
    f32x4 O[4];
#pragma unroll
    for (int eb = 0; eb < 4; ++eb) O[eb] = (f32x4){0.f, 0.f, 0.f, 0.f};
    const LAS unsigned char* rtb = RT + r * 528 + q * 16;
    const bf16_t* qub = Qg + (((size_t)(t0n >> 7) * 4 + h) * 8 + w) * 4096; const unsigned qvo = (unsigned)(16 * q + r) * 16u;
    const bf16_t* kub = Kg + (((size_t)(t0n >> 7) * 4 + h) * 8 + w) * 4096; const unsigned kvo = (unsigned)lane * 16u;
    bf16x8 avp[2][4];
#pragma unroll
    for (int eb = 0; eb < 4; ++eb) avp[0][eb] = *(const LAS bf16x8*)(rtb + (16 * eb * 528));
#pragma unroll
    for (int ks = 0; ks < 8; ++ks) { const bf16x8 qv = __builtin_bit_cast(bf16x8, qf[ks]);
        if (ks < 7) {
#pragma unroll
            for (int eb = 0; eb < 4; ++eb) avp[(ks + 1) & 1][eb] = *(const LAS bf16x8*)(rtb + (16 * eb * 528 + 64 * (ks + 1)));
            asm volatile("s_waitcnt lgkmcnt(4)" ::: "memory"); }
        else asm volatile("s_waitcnt lgkmcnt(0)" ::: "memory");
        __builtin_amdgcn_sched_barrier(0);
#pragma unroll
        for (int eb = 0; eb < 4; ++eb) O[eb] = __builtin_amdgcn_mfma_f32_16x16x32_bf16(avp[ks & 1][eb], qv, O[eb], 0, 0, 0);
        if (w < 4) { qf[ks] = ldg16(qub, qvo + 1024u * ks); kr[ks] = ldg16(kub, kvo + 1024u * ks); }
        __builtin_amdgcn_sched_barrier(0); }
    u32x2 pvf[4];
    if (DIR == 1) {
#pragma unroll
        for (int eb = 0; eb < 4; ++eb) pvf[eb] = *(const GAS u32x2*)(ob + oo + 512 * eb); }
    SEG_MARK(2);
    const int lofs = 128 * (4 * (q >> 1) + (q & 1)) + 8 * r;
    const LAS unsigned char* vtb = VI + lofs; const LAS unsigned char* ktb = KI + lofs;
#pragma unroll
    for (int ks = 0; ks < 4; ++ks) {
        bf16x8 vb[4], ka[2];
#pragma unroll
        for (int eb = 0; eb < 4; ++eb) vb[eb] = ldtr2(vtb + 128 * (eb * 32 + 8 * ks), vtb + 128 * (eb * 32 + 8 * ks + 2));
#pragma unroll
        for (int db = 0; db < 2; ++db) ka[db] = ldtr2(ktb + 128 * (db * 32 + 8 * ks), ktb + 128 * (db * 32 + 8 * ks + 2));
        __builtin_amdgcn_sched_barrier(0);
        bf16x8 sfm;
        { unsigned wd[4] = {sf[ks].x, sf[ks].y, sf[ks].z, sf[ks].w};
#pragma unroll
          for (int i = 0; i < 4; ++i) { const int m0 = 32 * ks + 8 * q + 2 * i; const bool k0 = DIR == 0 ? (m0 <= jl) : (m0 >= jl), k1 = DIR == 0 ? (m0 + 1 <= jl) : (m0 + 1 >= jl);
              wd[i] &= (k0 ? 0xffffu : 0u) | (k1 ? 0xffff0000u : 0u); }
          sfm = __builtin_bit_cast(bf16x8, (u32x4){wd[0], wd[1], wd[2], wd[3]}); }
#pragma unroll
        for (int eb = 0; eb < 4; ++eb) O[eb] = __builtin_amdgcn_mfma_f32_16x16x32_bf16(vb[eb], sfm, O[eb], 0, 0, 0);
#pragma unroll
        for (int db = 0; db < 2; ++db)
#pragma unroll
            for (int eb = 0; eb < 4; ++eb) Rb[db][eb] = __builtin_amdgcn_mfma_f32_16x16x32_bf16(ka[db], vb[eb], Rb[db][eb], 0, 0, 0);
        if (w >= 4) {
            qf[2 * ks] = ldg16(qub, qvo + 1024u * (2 * ks)); qf[2 * ks + 1] = ldg16(qub, qvo + 1024u * (2 * ks + 1));
            kr[2 * ks] = ldg16(kub, kvo + 1024u * (2 * ks)); kr[2 * ks + 1] = ldg16(kub, kvo + 1024u * (2 * ks + 1)); }
    }
    SEG_MARK(3);
    scan_load_s(sf, ws, h, rcn, w, r, q);
    {
        float ss = 0.f;
#pragma unroll
        for (int eb = 0; eb < 4; ++eb) { f32x4 v = O[eb] * rsc;
            if (DIR == 1) { const u32x2 pv = pvf[eb]; v[0] += bflo(pv.x); v[1] += bfhi(pv.x); v[2] += bflo(pv.y); v[3] += bfhi(pv.y);
                ss += (v[0] * v[0] + v[1] * v[1]) + (v[2] * v[2] + v[3] * v[3]); }
            u32x2 o; o.x = cvt_pk_bf16(v[0], v[1]); o.y = cvt_pk_bf16(v[2], v[3]); *(GAS u32x2*)(ob + oo + 512 * eb) = o; }
        if (DIR == 1) { ss += shx(ss, 16, lane); ss += shx(ss, 32, lane); if (q == 0) *(GAS float*)((GAS unsigned char*)(SSP + (size_t)(t0 + 16 * w) * 32 + h * 8 + sl) + (unsigned)r * 128u) = ss; }
    }
#pragma unroll
    for (int db = 0; db < 2; ++db)
#pragma unroll
        for (int eb = 0; eb < 4; ++eb) Rb[db][eb] = Rb[db][eb] * g128;
    SEG_MARK(4);
    asm volatile("s_waitcnt lgkmcnt(0)" ::: "memory"); __builtin_amdgcn_s_barrier(); asm volatile("" ::: "memory");
    SEG_MARK(6);
#pragma unroll
    for (int db = 0; db < 2; ++db)
#pragma unroll
        for (int eb = 0; eb < 4; ++eb) { u32x2 o; o.x = cvt_pk_bf16(Rb[db][eb][0], Rb[db][eb][1]); o.y = cvt_pk_bf16(Rb[db][eb][2], Rb[db][eb][3]);
            *(LAS u32x2*)(RT + (16 * eb + r) * 528 + (32 * w + 16 * db + 4 * q) * 2) = o; }
}
template <int DIR>
__device__ __forceinline__ void scan_unit(Frame& F, int tid, unsigned char* ws, int b, int h, int sl, float lg, const bf16_t* Qg, const bf16_t* Kg, const bf16_t* Vg, bf16_t* OF, float* SSP) {
    const int lane = tid & 63, w = __builtin_amdgcn_readfirstlane(tid >> 6), r = lane & 15, q = lane >> 4;
    const float g128 = __expf(128.f * lg);
    float wm[2];
#pragma unroll
    for (int i = 0; i < 2; ++i) { const int m = (tid >> 3) + 64 * i; wm[i] = __expf(lg * (float)(DIR == 0 ? 127 - m : m)); }
    const int jl = 16 * w + r; const float rsc = __expf(lg * (float)(DIR == 0 ? jl - 127 : -jl));
    f32x4 Rb[2][4];
#pragma unroll
    for (int db = 0; db < 2; ++db)
#pragma unroll
        for (int eb = 0; eb < 4; ++eb) Rb[db][eb] = (f32x4){0.f, 0.f, 0.f, 0.f};
    {
        LAS unsigned char* RT = F.lds + SC_RT_OFF;
#pragma unroll
        for (int db = 0; db < 2; ++db)
#pragma unroll
            for (int eb = 0; eb < 4; ++eb) *(LAS u32x2*)(RT + (16 * eb + r) * 528 + (32 * w + 16 * db + 4 * q) * 2) = (u32x2){0u, 0u};
    }
    u32x4 sf[4], qf[8], kr[8], vr[2];
    unsigned long long segacc = 0ull, segt = (DBG_SEG >= 0) ? __builtin_amdgcn_s_memtime() : 0ull;
    scan_load_s(sf, ws, h, scan_rc(DIR, b, 0), w, r, q);
    scan_load_q(qf, Qg, h, scan_t0(DIR, b, 0), w, r, q);
    scan_load_kv(kr, vr, Kg, Vg, h, sl, scan_t0(DIR, b, 0), w, lane, tid);
    for (int s = 0; s < 18; ++s) {
        const int sn = (s + 1 < 18) ? s + 1 : 17;
        scan_step<DIR>(segacc, segt, F.lds, sf, qf, kr, vr, Rb, wm, rsc, g128, scan_t0(DIR, b, s), scan_t0(DIR, b, sn), scan_rc(DIR, b, sn), ws, h, sl, w, lane, tid, Qg, Kg, Vg, OF, SSP);
    }
    if (DBG_SEG >= 0) { const unsigned long long te_ = __builtin_amdgcn_s_memtime() + segacc; while (__builtin_amdgcn_s_memtime() < te_) __builtin_amdgcn_s_sleep(4); }
    __syncthreads();
}
__device__ __forceinline__ void scan_phase(Frame& F, const Args& a, int layer, int dir) {
    PHASE_IDS();
    const int j = layer >> 1; const float* dec = a.in[11] + j * 8 + dir * 4;
    for (int u = F.vcu; u < 256; u += F.G) {
        const int b = u >> 5, h = (u >> 3) & 3, sl = u & 7;
        const float lg = log1pf(-exp2f(dec[h]));
        if (dir == 0) scan_unit<0>(F, tid, ws, b, h, sl, lg, (const bf16_t*)(ws + WS_Q), (const bf16_t*)(ws + WS_K), (const bf16_t*)(ws + WS_V), (bf16_t*)(ws + WS_OF), (float*)(ws + WS_SSP));
        else scan_unit<1>(F, tid, ws, b, h, sl, lg, (const bf16_t*)(ws + WS_Q), (const bf16_t*)(ws + WS_K), (const bf16_t*)(ws + WS_V), (bf16_t*)(ws + WS_OF), (float*)(ws + WS_SSP));
    }
}
__device__ __forceinline__ void n2_phase(Frame& F, const Args& a, int layer) {
    PHASE_IDS();
    norm_rows<false>(F, a, layer, (bf16_t*)(ws + WS_Q));
    const float* SSP = (const float*)(ws + WS_SSP); float* RINV = (float*)(ws + WS_RINV);
    const int gt = F.vcu * 512 + tid, NT = F.G * 512;
    for (int idx = gt; idx < NTOK * 4; idx += NT) { const f32x4 p0 = *(const f32x4*)(SSP + (size_t)idx * 8), p1 = *(const f32x4*)(SSP + (size_t)idx * 8 + 4);
        const float ss = ((p0.x + p0.y) + (p0.z + p0.w)) + ((p1.x + p1.y) + (p1.z + p1.w)); RINV[idx] = rsqrtf(ss * (1.f / 512.f) + EPS); }
}
__device__ __forceinline__ void final_phase(Frame& F, const Args& a) {
    PHASE_IDS();
    const float* fg = a.in[12]; const int gw = F.vcu * 8 + wave, NGW = F.G * 8;
    f32x4 g[4];
#pragma unroll
    for (int jj = 0; jj < 4; ++jj) g[jj] = *(const f32x4*)(fg + 4 * lane + 256 * jj);
    for (int m0 = gw; m0 < NLAT; m0 += 4 * NGW) {
        f32x4 v[4][4]; float ss[4];
#pragma unroll
        for (int t = 0; t < 4; ++t) { const int m = (m0 + t * NGW) < NLAT ? (m0 + t * NGW) : gw; const f32x4* xr = (const f32x4*)(a.out + (size_t)m * DM) + lane;
#pragma unroll
            for (int jj = 0; jj < 4; ++jj) v[t][jj] = xr[64 * jj]; }
#pragma unroll
        for (int t = 0; t < 4; ++t) { float s = 0.f;
#pragma unroll
            for (int jj = 0; jj < 4; ++jj) s += (v[t][jj].x * v[t][jj].x + v[t][jj].y * v[t][jj].y) + (v[t][jj].z * v[t][jj].z + v[t][jj].w * v[t][jj].w);
            ss[t] = s; }
#pragma unroll
        for (int o = 1; o < 64; o <<= 1) {
#pragma unroll
            for (int t = 0; t < 4; ++t) ss[t] += shx(ss[t], o, lane); }
#pragma unroll
        for (int t = 0; t < 4; ++t) { const int m = m0 + t * NGW; if (m < NLAT) { const float rinv = rsqrtf(ss[t] * (1.f / DM) + EPS); f32x4* xw = (f32x4*)(a.out + (size_t)m * DM) + lane;
#pragma unroll
            for (int jj = 0; jj < 4; ++jj) xw[64 * jj] = v[t][jj] * rinv * g[jj]; } }
    }
}

constexpr int N_PHASES = 34;
__global__ void __launch_bounds__(512, 2) trunk_fwd(Args args) {
    extern __shared__ __attribute__((aligned(16))) unsigned char lds_raw[];
    Frame F;
    F.lds = (LAS unsigned char*)lds_raw;
    F.G = gridDim.x; F.wv = __builtin_amdgcn_readfirstlane((int)threadIdx.x >> 6); { const int bx = blockIdx.x; F.vcu = (F.G % 8 == 0) ? (bx % 8) * (F.G / 8) + bx / 8 : bx; }
    F.ws = args.ws;
    volatile LAS unsigned* MISC = (volatile LAS unsigned*)(F.lds + MISC_OFF);
    for (int u = threadIdx.x; u < 128; u += 512) MISC[u] = 0u;
    __syncthreads();
    const int lo = args.ph_lo, hi = args.ph_hi;
    XcdBarrier bar; bar.bar = (unsigned*)(args.ws + WS_CTL) + 4096; bar.x = 0; bar.st = nullptr;
    const bool multi = (hi - lo) > 1;
    if (multi) bar = xcd_barrier_post((unsigned*)(args.ws + WS_CTL) + 4096, MISC + 8);
#ifndef KINDS
#define KINDS 0xFFFF
#endif
#define KON(b) (((KINDS) >> (b)) & 1)
#define IN(k) (lo <= (k) && (k) < hi)
#ifndef DBG_PROBE
#define DBG_PROBE -1
#endif
    unsigned long long tph0 = (DBG_PROBE >= 0) ? __builtin_amdgcn_s_memrealtime() : 0ull; int cur_layer = -1;
#ifndef DBG_PLAYER
#define DBG_PLAYER -1
#endif
#define PROBE(kind) do { if (DBG_PROBE == (kind) && (DBG_PLAYER < 0 || DBG_PLAYER == cur_layer)) { const unsigned long long t1_ = __builtin_amdgcn_s_memrealtime(); const unsigned long long te_ = t1_ + (t1_ - tph0); while (__builtin_amdgcn_s_memrealtime() < te_) __builtin_amdgcn_s_sleep(8); } } while (0)
#define SEAM(k) do { if (multi && (k) + 1 < hi) xcd_barrier(bar); if (DBG_PROBE >= 0) tph0 = __builtin_amdgcn_s_memrealtime(); } while (0)
    const int bx = (int)blockIdx.x, G = F.G;
    if (KON(0) && IN(0)) { p0_phase(F, args); p0_conv(F, args); PROBE(0); SEAM(0); }
    for (int layer = 0; layer < NLAYER; ++layer) {
        const int pb = 1 + 8 * layer; const bool fourier = (layer & 1) == 0; cur_layer = layer;
        unsigned char* ws = launder_ptr(args.ws);
#define MAKE_ER() const EpiResid ER{layer == 0 ? args.in[0] : args.out, args.out, (const float*)(ws + WS_ADA) + layer * 9 * 3072 + 2048, (float*)(ws + WS_PART)}
        if (KON(1) && IN(pb)) { n_phase(F, args, layer); PROBE(1); SEAM(pb); }
        if (fourier) {
            bf16_t* W1 = (bf16_t*)(ws + WS_WF);
            if (KON(2) && IN(pb + 1)) {
                { pg8::Gemm g{(const bf16_t*)(ws + WS_H), W1 + (size_t)2048 * 1024, 1024, 1024, 1024}; pg8::TileOrder S; S.init(72, 8, G, bx);
                  EpiSilu E{(bf16_t*)(ws + WS_Z), 2048}; pg8::gemm_phase(F.lds, F.wv, g, S, E); }
                { pg8::Gemm g{W1, (const bf16_t*)(ws + WS_H), 1024, 1024, 1024}; UOrder S; S.init(8, 72, G, (bx + 64) % G);
                  EpiUTF E{(bf16_t*)(ws + WS_UTL), (bf16_t*)(ws + WS_UTC), (float*)(ws + WS_RINV)}; pg8::gemm_phase<EpiUTF, UOrder, true>(F.lds, F.wv, g, S, E); }
                bg_conv_ret(F, args, layer, 64, 0, 1024);
                PROBE(2); SEAM(pb + 1);
            }
            if (KON(3) && IN(pb + 2)) {
                { pg8::Gemm g{(const bf16_t*)(ws + WS_CS), (const bf16_t*)(ws + WS_UTL), 1024, 1024, 1024}; pg8::TileOrder S; S.init(8, 64, G, bx);
                  EpiDft<true> E{(bf16_t*)(ws + WS_Z), 2048, 0, (const float*)(ws + WS_RINV)}; pg8::gemm_phase(F.lds, F.wv, g, S, E); }
                { pg8::Gemm g{(const bf16_t*)(ws + WS_CS256), (const bf16_t*)(ws + WS_UTC), 256, 256, 256}; pg8::TileOrder S; S.init(2, 64, G, bx);
                  EpiDft<false> E{(bf16_t*)(ws + WS_Z), 256, NLAT, nullptr}; pg8::gemm_phase(F.lds, F.wv, g, S, E); }
                nyq_row_phase(F);
                bg_conv_ret(F, args, layer, 128, 1024, 1536);
                PROBE(3); SEAM(pb + 2);
            }
            if (KON(4) && IN(pb + 3)) {
                pg8::Gemm g{(const bf16_t*)(ws + WS_Z), W1 + (size_t)4096 * 1024, 2048, 2048, 2048}; OutOrder S; S.init(G, bx, true); MAKE_ER();
                pg8::gemm_phase(F.lds, F.wv, g, S, ER);
                bg_conv_ret(F, args, layer, 128, 1536, 2048);
                PROBE(4); SEAM(pb + 3);
            }
        } else {
            bf16_t* W1 = (bf16_t*)(ws + WS_W);
            if (KON(5) && IN(pb + 1)) {
                pg8::Gemm g{(const bf16_t*)(ws + WS_OF), W1, 1024, 1024, 1024}; pg8::TileOrder S; S.init(72, 16, G, bx);
                EpiQKV E{(bf16_t*)(ws + WS_Q), (bf16_t*)(ws + WS_K), (bf16_t*)(ws + WS_V), (const float*)(ws + WS_ROPE), (const float*)(ws + WS_ROPE) + 4096};
                pg8::gemm_phase(F.lds, F.wv, g, S, E);
                PROBE(5); SEAM(pb + 1);
            }
            if (KON(6) && IN(pb + 2)) {
                { pg8::Gemm g{(const bf16_t*)(ws + WS_Q), (const bf16_t*)(ws + WS_K), 1024, 1024, 256}; DiagOrder S{G, bx};
                  EpiS E{ws}; pg8::gemm_phase<EpiS, DiagOrder, false, true>(F.lds, F.wv, g, S, E); }
                PROBE(11); if (multi) xcd_barrier(bar); if (DBG_PROBE >= 0) tph0 = __builtin_amdgcn_s_memrealtime();
                scan_phase(F, args, layer, 0); PROBE(6);
            }
            if (KON(6) && IN(pb + 3)) {
                if (multi) { asm volatile("s_waitcnt vmcnt(0)" ::: "memory"); __syncthreads();
                    if (threadIdx.x == 0) { __builtin_amdgcn_fence(__ATOMIC_ACQUIRE, "agent"); asm volatile("s_waitcnt vmcnt(0)" ::: "memory"); }
                    __syncthreads(); if (DBG_PROBE >= 0) tph0 = __builtin_amdgcn_s_memrealtime(); }
                scan_phase(F, args, layer, 1); PROBE(12); SEAM(pb + 3); }
            if (KON(7) && IN(pb + 4)) { n2_phase(F, args, layer); PROBE(7); SEAM(pb + 4); }
            if (KON(8) && IN(pb + 5)) {
                pg8::Gemm g{(const bf16_t*)(ws + WS_Q), W1 + (size_t)4096 * 1024, 1024, 1024, 1024}; pg8::TileOrder S; S.init(layer == NLAYER - 1 ? 64 : 72, 8, G, bx);
                EpiZGate E{(const bf16_t*)(ws + WS_OF), (const float*)(ws + WS_RINV), (bf16_t*)(ws + WS_V)};
                pg8::gemm_phase(F.lds, F.wv, g, S, E);
                PROBE(8); SEAM(pb + 5);
            }
            if (KON(9) && IN(pb + 6)) {
                pg8::Gemm g{(const bf16_t*)(ws + WS_V), W1 + (size_t)6144 * 1024, 2048, 2048, 2048}; OutOrder S; S.init(G, bx, layer != NLAYER - 1); MAKE_ER();
                pg8::gemm_phase(F.lds, F.wv, g, S, ER);
                PROBE(9); SEAM(pb + 6);
            }
        }
    }
    if (KON(10) && IN(33)) { final_phase(F, args); PROBE(10); }
#undef IN
#undef SEAM
}

extern "C" void kernel_launch(void* const* d_in, const int* in_sizes, int n_in, void* d_out, int out_size, void* d_ws, size_t ws_size, hipStream_t stream) {
    static int grid = 0;
    if (grid == 0) {
        if (n_in != 13 || out_size != NLAT * DM || ws_size < WS_END) { fprintf(stderr, "kernel_launch: unexpected problem (n_in %d, out %d, ws %zu)\n", n_in, out_size, ws_size); grid = -1; return; }
        int dev = 0, cus = 0;
        if (hipGetDevice(&dev) != hipSuccess || hipDeviceGetAttribute(&cus, hipDeviceAttributeMultiprocessorCount, dev) != hipSuccess) { grid = -1; return; }
        if (hipFuncSetAttribute((const void*)trunk_fwd, hipFuncAttributeMaxDynamicSharedMemorySize, LDS_BYTES) != hipSuccess) { fprintf(stderr, "kernel_launch: hipFuncSetAttribute failed\n"); grid = -1; return; }
        (void)hipGetLastError();
        grid = cus;
    }
    if (grid < 0) return;
    if (hipMemsetAsync((char*)d_ws + WS_CTL, 0, CTL_ZERO_BYTES, stream) != hipSuccess) return;
    Args a{};
    for (int i = 0; i < 13; ++i) a.in[i] = (const float*)d_in[i];
    a.out = (float*)d_out; a.ws = (unsigned char*)d_ws;
    a.ph_lo = 0; a.ph_hi = N_PHASES;
    hipLaunchKernelGGL(trunk_fwd, dim3(grid), dim3(512), LDS_BYTES, stream, a);
}
```

```cpp
#include <hip/hip_runtime.h>
#include <cstdio>
#include <cstdint>

#define LAS __attribute__((address_space(3)))
#define GAS __attribute__((address_space(1)))
typedef unsigned short bf16_t;
typedef short bf16x8 __attribute__((ext_vector_type(8)));
typedef float f32x4 __attribute__((ext_vector_type(4)));
typedef float f32x16 __attribute__((ext_vector_type(16)));
typedef unsigned u32x4 __attribute__((ext_vector_type(4)));
typedef unsigned u32x2 __attribute__((ext_vector_type(2)));

constexpr int DM = 1024, NB = 8, SEQ = 2048, CTXL = 256, DBR = 2048, NLAYER = 4;
constexpr int NLAT = NB * SEQ, NCTX = NB * CTXL, NTOK = NLAT + NCTX;
constexpr float EPS = 1e-6f;

constexpr size_t MiB = 1u << 20;
constexpr size_t KiB = 1024;
constexpr size_t WS_CTL = 0, CTL_ZERO_BYTES = 64 * KiB;
constexpr size_t WS_ADA = 256 * KiB;
constexpr size_t WS_TC = 768 * KiB;
constexpr size_t WS_ROPE = 1024 * KiB;
constexpr size_t WS_CS256 = 1088 * KiB;
constexpr size_t WS_RINV = 1344 * KiB;
constexpr size_t WS_XCTX = 2 * MiB;
constexpr size_t WS_W = 10 * MiB;
constexpr size_t WS_R = 26 * MiB;
constexpr size_t WS_H = WS_R;
constexpr size_t WS_Z = WS_R + 36 * MiB;
constexpr size_t WS_UTL = WS_R + 108 * MiB;
constexpr size_t WS_UTC = WS_R + 172 * MiB;
constexpr size_t WS_CS = WS_R + 180 * MiB;
constexpr size_t WS_WF = WS_R + 144 * MiB;
constexpr size_t WS_Q = WS_R;
constexpr size_t WS_K = WS_R + 36 * MiB;
constexpr size_t WS_V = WS_R + 72 * MiB;
constexpr size_t WS_OF = WS_R + 144 * MiB;
constexpr size_t WS_PART = WS_R + 184 * MiB;
constexpr size_t WS_SSP = WS_R + 216 * MiB;
constexpr size_t WS_SA = WS_W;
constexpr size_t WS_SB = WS_R + 219 * MiB;
constexpr size_t WS_END = 256 * MiB;
static_assert(WS_SSP + (size_t)NTOK * 32 * 4 <= WS_SB && WS_SB + 11 * MiB <= WS_END && WS_CS + 16 * MiB <= WS_END && WS_RINV + 288 * KiB <= WS_XCTX, "ws map");

constexpr int LDS_BYTES = 147456;
constexpr int RING_BYTES = 131072;
constexpr int SC_V_OFF = 0;
constexpr int SC_RT_OFF = 16384;
constexpr int SC_K_OFF = 16384 + 33792;
constexpr int MISC_OFF = 145408;
static_assert(SC_K_OFF + 65536 <= MISC_OFF && MISC_OFF + 512 <= LDS_BYTES, "lds map");

__device__ __forceinline__ unsigned f2bf(float f) { unsigned u = __builtin_bit_cast(unsigned, f); return (u + 0x7fffu + ((u >> 16) & 1u)) >> 16; }
__device__ __forceinline__ unsigned pk2(float lo, float hi) { return f2bf(lo) | (f2bf(hi) << 16); }
__device__ __forceinline__ float bflo(unsigned w) { return __builtin_bit_cast(float, w << 16); }
__device__ __forceinline__ float bfhi(unsigned w) { return __builtin_bit_cast(float, w & 0xffff0000u); }
__device__ __forceinline__ float bf1(bf16_t h) { return __builtin_bit_cast(float, (unsigned)h << 16); }
__device__ __forceinline__ float silu_f(float x) { return x * __builtin_amdgcn_rcpf(1.f + __expf(-x)); }
__device__ __forceinline__ float shx(float v, int o, int lane) { return __builtin_bit_cast(float, __builtin_amdgcn_ds_bpermute((lane ^ o) << 2, __builtin_bit_cast(int, v))); }
__device__ __forceinline__ float wave_sum(float v, int lane) {
#pragma unroll
    for (int o = 1; o < 64; o <<= 1) v += shx(v, o, lane);
    return v;
}

namespace pg8 {
constexpr int BM = 256, BK = 64, HALF = 128, HTB = HALF * BK * 2, STAGE_BYTES = 8 * HTB, NXCD = 8, WGM = 8;
__host__ __device__ __forceinline__ int lds_byte(int r, int c) { const int st = (r >> 4) * 2 + (c >> 5), rr = r & 15, cc = c & 31, ob = rr * 64 + cc * 2; return st * 1024 + (ob ^ (((ob >> 9) & 1) << 5)); }
__host__ __device__ __forceinline__ void stage_rc(int b, int& R, int& C) { const int st = b / 1024, sb = b % 1024, swz = sb ^ (((sb >> 9) & 1) << 5); R = (st >> 1) * 16 + swz / 64; C = (st & 1) * 32 + (swz % 64) / 2; }
__host__ __device__ __forceinline__ int perm32(int rho) { const int n = rho >> 4, i = rho & 15; return 8 * (i >> 2) + 4 * n + (i & 3); }
struct Unit { int pm, pn, aux; };
struct Gemm { const bf16_t* A; const bf16_t* Bt; int lda, ldb, K; };
struct TileOrder {
    int nM, nN, nwg, G, c;
    __device__ void init(int nM_, int nN_, int G_, int c_) { nM = nM_; nN = nN_; nwg = nM * nN; G = G_; c = c_; }
    __device__ static void map(int wgid, int nM, int nN, Unit& u) {
        const int nwg = nM * nN;
        { const int q = nwg / NXCD, r = nwg % NXCD, xcd = wgid % NXCD, off = wgid / NXCD; wgid = (xcd < r ? xcd * (q + 1) : r * (q + 1) + (xcd - r) * q) + off; }
        const int nig = WGM * nN, gid = wgid / nig, fm = gid * WGM, gsz = (nM - fm) < WGM ? (nM - fm) : WGM;
        u.pm = fm + ((wgid % nig) % gsz); u.pn = (wgid % nig) / gsz; u.aux = 0;
    }
    __device__ bool next(int i, Unit& u) const {
        const long L = (long)i * G + c; if (L >= nwg) return false;
        map((int)L, nM, nN, u); return true;
    }
    __device__ __forceinline__ const char* a_ptr(const Gemm& g, const Unit& u) const { return (const char*)g.A + (size_t)u.pm * 256 * g.lda * 2; }
    __device__ __forceinline__ const char* b_ptr(const Gemm& g, const Unit& u, int half) const { return (const char*)g.Bt + (size_t)(u.pn * 256 + 128 * half) * g.ldb * 2; }
    __device__ __forceinline__ bool b_mirror(const Unit&) const { return false; }
    __device__ __forceinline__ bool b_fix(const Unit&) const { return false; }
    __device__ __forceinline__ int ktiles(const Gemm& g, const Unit&) const { return g.K / BK; }
};
__device__ __forceinline__ unsigned cvt_pk_bf16(float lo, float hi) { unsigned r; asm volatile("v_cvt_pk_bf16_f32 %0, %1, %2" : "=v"(r) : "v"(lo), "v"(hi)); return r; }

template <class Epi, class Sched, bool MIRB = false, bool TILED = false>
__device__ __forceinline__ void gemm_phase(LAS unsigned char* lds, int wv, const Gemm g, const Sched& S, const Epi& E) {
    int tid; { int l_; asm volatile("v_mbcnt_lo_u32_b32 %0, -1, 0\n\tv_mbcnt_hi_u32_b32 %0, -1, %0" : "=v"(l_)); tid = wv * 64 + l_; }
    const int wid = __builtin_amdgcn_readfirstlane(tid >> 6), lane = tid & 63, wr = wid >> 2, wc = wid & 3, fr = lane & 15, fq = lane >> 4;
    unsigned voffA[2], voffB[2], voffM[2], fixd[2];
#pragma unroll
    for (int i = 0; i < 2; ++i) { int R, C; stage_rc(tid * 16 + i * 8192, R, C); const int Rb = Epi::PERM ? ((R & ~31) + perm32(R & 31)) : R;
        voffA[i] = (unsigned)(R * g.lda + C) * 2u; voffB[i] = (unsigned)(Rb * g.ldb + C) * 2u; voffM[i] = (unsigned)((1024 - Rb) * g.ldb + C) * 2u; fixd[i] = (Rb == 0) ? (unsigned)(1024 * g.ldb) * 2u : 0u;
        if (TILED) { voffA[i] = (unsigned)(((R >> 4) & 7) * 8192 + (C >> 5) * 1024 + (16 * ((C >> 3) & 3) + (R & 15)) * 16);
                     voffB[i] = (unsigned)(((Rb & 127) >> 4) * 1024 + (4 * (Rb & 15) + ((C >> 3) & 3)) * 16 + (C >> 5) * 8192); } }
    const size_t kstepA = TILED ? (size_t)2048 : (size_t)(BK * 2), kstepB = TILED ? (size_t)16384 : (size_t)(BK * 2);
    const size_t hstepA = TILED ? (size_t)262144 : (size_t)HALF * g.lda * 2;
    const unsigned ldsw = (unsigned)wid * 1024u;
    const int aoff = lds_byte(wr * 64 + fr, fq * 8), boff = lds_byte(wc * 32 + fr, fq * 8);
#define PG8_SA(b, h) (((b) * 2 + (h)) * HTB)
#define PG8_SB(b, h) ((4 + (b) * 2 + (h)) * HTB)
#define PG8_STAGE(bufoff, gbase, voff) do { _Pragma("unroll") for (int _i = 0; _i < 2; ++_i) \
        __builtin_amdgcn_global_load_lds((const unsigned*)((const char*)(gbase) + (voff)[_i]), (LAS unsigned*)(lds + (bufoff) + ldsw + _i * 8192), 16, 0, 0); } while (0)
#define PG8_LDA(dst, b, h) do { _Pragma("unroll") for (int m = 0; m < 4; ++m) _Pragma("unroll") for (int k = 0; k < 2; ++k) dst[m][k] = *(const LAS bf16x8*)(lds + PG8_SA(b, h) + aoff + m * 2048 + k * 1024); } while (0)
#define PG8_LDB(dst, b, h) do { _Pragma("unroll") for (int n = 0; n < 2; ++n) _Pragma("unroll") for (int k = 0; k < 2; ++k) dst[n][k] = *(const LAS bf16x8*)(lds + PG8_SB(b, h) + boff + n * 2048 + k * 1024); } while (0)
#define PG8_MMA(ai, bj, At, Bt) do { __builtin_amdgcn_s_setprio(1); _Pragma("unroll") for (int m = 0; m < 4; ++m) _Pragma("unroll") for (int n = 0; n < 2; ++n) _Pragma("unroll") for (int k = 0; k < 2; ++k) \
        acc[ai][bj][m][n] = __builtin_amdgcn_mfma_f32_16x16x32_bf16(Bt[n][k], At[m][k], acc[ai][bj][m][n], 0, 0, 0); __builtin_amdgcn_s_setprio(0); } while (0)
#define PG8_WAIT_V(n) asm volatile("s_waitcnt vmcnt(" #n ")" ::: "memory")
#define PG8_WAIT_L(n) asm volatile("s_waitcnt lgkmcnt(" #n ")" ::: "memory")
#define PG8_BAR __builtin_amdgcn_s_barrier()
#define PG8_SCHED __builtin_amdgcn_sched_barrier(0)
#define PG8_VB1(dst, u) do { if (MIRB && S.b_mirror(u)) { const bool fx_ = S.b_fix(u); dst[0] = voffM[0] - (fx_ ? fixd[0] : 0u); dst[1] = voffM[1] - (fx_ ? fixd[1] : 0u); } else { dst[0] = voffB[0]; dst[1] = voffB[1]; } } while (0)
    Unit cur, nxt; int ui = 0;
    if (!S.next(0, cur)) return;
    f32x4 acc[2][2][4][2];
#pragma unroll
    for (int a = 0; a < 2; ++a)
#pragma unroll
        for (int b = 0; b < 2; ++b)
#pragma unroll
            for (int m = 0; m < 4; ++m)
#pragma unroll
                for (int n = 0; n < 2; ++n) acc[a][b][m][n] = (f32x4){0.f, 0.f, 0.f, 0.f};
    bf16x8 At[4][2], B0[2][2], B1[2][2];
    const char* cA = S.a_ptr(g, cur); const char* cB0 = S.b_ptr(g, cur, 0); const char* cB1 = S.b_ptr(g, cur, 1);
    unsigned vc1[2]; PG8_VB1(vc1, cur);
    PG8_STAGE(PG8_SB(0, 0), cB0, voffB); PG8_STAGE(PG8_SB(0, 1), cB1, vc1); PG8_STAGE(PG8_SA(0, 0), cA, voffA); PG8_STAGE(PG8_SA(0, 1), cA + hstepA, voffA);
    if (wr == 1) PG8_BAR;
    PG8_WAIT_V(2); PG8_BAR;
    PG8_STAGE(PG8_SB(1, 0), cB0 + kstepB, voffB); PG8_STAGE(PG8_SA(1, 0), cA + kstepA, voffA); PG8_STAGE(PG8_SB(1, 1), cB1 + kstepB, vc1);
    PG8_WAIT_V(6); PG8_BAR;
    for (;;) {
        const bool has_next = S.next(ui + 1, nxt);
        const int nt = S.ktiles(g, cur);
        const char* nA = cA; const char* nB0 = cB0; const char* nB1 = cB1; unsigned vn1[2] = {vc1[0], vc1[1]};
        if (has_next) { nA = S.a_ptr(g, nxt); nB0 = S.b_ptr(g, nxt, 0); nB1 = S.b_ptr(g, nxt, 1); PG8_VB1(vn1, nxt); }
        for (int t = 0; t < nt; t += 2) {
            const bool last = (t == nt - 2);
            const char* a1 = cA + (size_t)(t + 1) * kstepA;
            const char* a2 = last ? nA : cA + (size_t)(t + 2) * kstepA; const char* b20 = last ? nB0 : cB0 + (size_t)(t + 2) * kstepB; const char* b21 = last ? nB1 : cB1 + (size_t)(t + 2) * kstepB;
            const char* a3 = a2 + kstepA; const char* b30 = b20 + kstepB; const char* b31 = b21 + kstepB;
            unsigned v21[2]; v21[0] = (MIRB && last) ? vn1[0] : vc1[0]; v21[1] = (MIRB && last) ? vn1[1] : vc1[1];
            PG8_LDB(B0, 0, 0); PG8_LDB(B1, 0, 1); PG8_SCHED; PG8_LDA(At, 0, 0); PG8_STAGE(PG8_SA(1, 1), a1 + hstepA, voffA);
            PG8_WAIT_V(8); PG8_WAIT_L(0); PG8_BAR; PG8_MMA(0, 0, At, B0); PG8_MMA(0, 1, At, B1); PG8_BAR; PG8_SCHED;
            PG8_LDA(At, 0, 1); PG8_STAGE(PG8_SB(0, 0), b20, voffB); PG8_STAGE(PG8_SB(0, 1), b21, v21); PG8_STAGE(PG8_SA(0, 0), a2, voffA);
            PG8_WAIT_V(8); PG8_WAIT_L(0); PG8_BAR; PG8_MMA(1, 0, At, B0); PG8_MMA(1, 1, At, B1); PG8_BAR; PG8_SCHED;
            PG8_LDB(B0, 1, 0); PG8_LDB(B1, 1, 1); PG8_SCHED; PG8_LDA(At, 1, 0); PG8_STAGE(PG8_SA(0, 1), a2 + hstepA, voffA);
            PG8_WAIT_V(8); PG8_WAIT_L(0); PG8_BAR; PG8_MMA(0, 0, At, B0); PG8_MMA(0, 1, At, B1); PG8_BAR; PG8_SCHED;
            PG8_LDA(At, 1, 1); PG8_STAGE(PG8_SB(1, 0), b30, voffB); PG8_STAGE(PG8_SB(1, 1), b31, v21); PG8_STAGE(PG8_SA(1, 0), a3, voffA);
            PG8_WAIT_V(8); PG8_WAIT_L(0); PG8_BAR; PG8_MMA(1, 0, At, B0); PG8_MMA(1, 1, At, B1); PG8_BAR; PG8_SCHED;
        }
        if (wr == 0) PG8_BAR;
        { int l2 = lane; asm volatile("" : "+v"(l2)); E(acc, cur, wr, wc, l2 & 15, l2 >> 4); }
        if (!has_next) break;
#pragma unroll
        for (int a = 0; a < 2; ++a)
#pragma unroll
            for (int b = 0; b < 2; ++b)
#pragma unroll
                for (int m = 0; m < 4; ++m)
#pragma unroll
                    for (int n = 0; n < 2; ++n) acc[a][b][m][n] = (f32x4){0.f, 0.f, 0.f, 0.f};
        cur = nxt; cA = nA; cB0 = nB0; cB1 = nB1; vc1[0] = vn1[0]; vc1[1] = vn1[1]; ++ui;
        if (wr == 1) PG8_BAR;
    }
    PG8_WAIT_V(0);
    PG8_BAR;
#undef PG8_SA
#undef PG8_SB
#undef PG8_STAGE
#undef PG8_LDA
#undef PG8_LDB
#undef PG8_MMA
#undef PG8_WAIT_V
#undef PG8_WAIT_L
#undef PG8_BAR
#undef PG8_SCHED
#undef PG8_VB1
}
}
using pg8::cvt_pk_bf16;
__device__ __forceinline__ void stg16(void* ub, unsigned vo, u32x4 v) { *(GAS u32x4*)((GAS unsigned char*)ub + vo) = v; }
__device__ __forceinline__ u32x4 ldg16u(const void* ub, unsigned vo) { return *(const GAS u32x4*)((const GAS unsigned char*)ub + vo); }
__device__ __forceinline__ void stg16f(void* ub, unsigned vo, f32x4 v) { *(GAS f32x4*)((GAS unsigned char*)ub + vo) = v; }
__device__ __forceinline__ f32x4 ldg16f(const void* ub, unsigned vo) { return *(const GAS f32x4*)((const GAS unsigned char*)ub + vo); }
typedef const f32x4 (&AccRef)[2][2][4][2];

struct EpiSilu {
    static constexpr bool PERM = true;
    bf16_t* O; int ldc;
    __device__ __forceinline__ void operator()(AccRef acc, const pg8::Unit& u, int wr, int wc, int fr, int fq) const {
        bf16_t* ub = O + (size_t)u.pm * 256 * ldc + u.pn * 256; const unsigned vo = (unsigned)((wr * 64 + fr) * ldc + wc * 32 + 8 * fq) * 2u;
#pragma unroll
        for (int ai = 0; ai < 2; ++ai)
#pragma unroll
            for (int m = 0; m < 4; ++m)
#pragma unroll
                for (int bj = 0; bj < 2; ++bj) { const f32x4 v0 = acc[ai][bj][m][0], v1 = acc[ai][bj][m][1]; u32x4 w;
                    w.x = cvt_pk_bf16(silu_f(v0[0]), silu_f(v0[1])); w.y = cvt_pk_bf16(silu_f(v0[2]), silu_f(v0[3]));
                    w.z = cvt_pk_bf16(silu_f(v1[0]), silu_f(v1[1])); w.w = cvt_pk_bf16(silu_f(v1[2]), silu_f(v1[3]));
                    stg16(ub + (size_t)(ai * 128 + m * 16) * ldc, vo + (unsigned)(bj * 256), w); }
    }
};
struct UOrder : pg8::TileOrder {
    __device__ __forceinline__ const char* b_ptr(const pg8::Gemm& g, const pg8::Unit& u, int half) const {
        if (u.pn < 64) { const int b = u.pn >> 3, tp = u.pn & 7; return (const char*)(g.Bt + (size_t)(b * 2048 + (half ? 1024 - 128 * tp : 128 * tp)) * 1024); }
        return (const char*)(g.Bt + (size_t)(NLAT + (u.pn - 64) * 256 + 128 * half) * 1024);
    }
    __device__ __forceinline__ bool b_mirror(const pg8::Unit& u) const { return u.pn < 64; }
    __device__ __forceinline__ bool b_fix(const pg8::Unit& u) const { return (u.pn & 7) == 0; }
};
struct EpiUTF {
    static constexpr bool PERM = true;
    bf16_t* UTF; bf16_t* UTc; float* AH;
    __device__ __forceinline__ void operator()(AccRef acc, const pg8::Unit& u, int wr, int wc, int fr, int fq) const {
        const int feat0 = u.pm * 256 + wr * 64 + fr, col0 = wc * 32 + 8 * fq;
        if (u.pn >= 64) { bf16_t* ub = UTc + (size_t)(u.pn - 64) * 2048 * 256 + (size_t)u.pm * 256 * 256; const unsigned vo = (unsigned)((wr * 64 + fr) * 256 + col0) * 2u;
#pragma unroll
            for (int ai = 0; ai < 2; ++ai)
#pragma unroll
                for (int m = 0; m < 4; ++m)
#pragma unroll
                    for (int bj = 0; bj < 2; ++bj) { const f32x4 v0 = acc[ai][bj][m][0], v1 = acc[ai][bj][m][1]; u32x4 w;
                        w.x = cvt_pk_bf16(v0[0], v0[1]); w.y = cvt_pk_bf16(v0[2], v0[3]); w.z = cvt_pk_bf16(v1[0], v1[1]); w.w = cvt_pk_bf16(v1[2], v1[3]);
                        stg16(ub + (size_t)(ai * 128 + m * 16) * 256, vo + (unsigned)(bj * 256), w); }
            return; }
        const int b = u.pn >> 3, tp = u.pn & 7; const bool first = (tp == 0) && (col0 == 0);
        bf16_t* ub = UTF + ((size_t)b * 2048 + u.pm * 256) * 1024 + 128 * tp; const unsigned vo = (unsigned)((wr * 64 + fr) * 1024 + col0) * 2u;
#pragma unroll
        for (int ai = 0; ai < 2; ++ai)
#pragma unroll
            for (int m = 0; m < 4; ++m) { const int feat = feat0 + ai * 128 + m * 16; const float sg = ((feat & 255) <= 128) ? 1.f : -1.f;
                f32x4 v0 = acc[ai][0][m][0] + acc[ai][1][m][0] * sg; const f32x4 v1 = acc[ai][0][m][1] + acc[ai][1][m][1] * sg;
                if (first) { v0[0] = acc[ai][0][m][0][0]; AH[(size_t)b * 2048 + feat] = acc[ai][1][m][0][0]; }
                u32x4 w; w.x = cvt_pk_bf16(v0[0], v0[1]); w.y = cvt_pk_bf16(v0[2], v0[3]); w.z = cvt_pk_bf16(v1[0], v1[1]); w.w = cvt_pk_bf16(v1[2], v1[3]);
                stg16(ub + (size_t)(ai * 128 + m * 16) * 1024, vo, w); }
    }
};
struct DftZ { u32x4 zd, zm; unsigned z8; };
__device__ __forceinline__ DftZ dft_row_ld(const bf16_t* zrow, int mi0) { DftZ z; z.zd = *(const u32x4*)(zrow + mi0); z.zm = *(const u32x4*)(zrow + 248 - mi0); z.z8 = (mi0 >= 8) ? (unsigned)zrow[256 - mi0] : 0u; return z; }
__device__ __forceinline__ void dft_row_st(bf16_t* zrow, int mi0, const DftZ& z, const float (&d)[8], const float (&mr)[8]) {
    const u32x4 zd = z.zd, zm = z.zm;
    u32x4 o; o.x = cvt_pk_bf16(d[0] * bflo(zd.x), d[1] * bfhi(zd.x)); o.y = cvt_pk_bf16(d[2] * bflo(zd.y), d[3] * bfhi(zd.y));
    o.z = cvt_pk_bf16(d[4] * bflo(zd.z), d[5] * bfhi(zd.z)); o.w = cvt_pk_bf16(d[6] * bflo(zd.w), d[7] * bfhi(zd.w));
    *(u32x4*)(zrow + mi0) = o;
    bf16_t* mp = zrow + 248 - mi0;
    mp[1] = (bf16_t)f2bf(mr[7] * bfhi(zm.x));
    *(unsigned*)(mp + 2) = cvt_pk_bf16(mr[6] * bflo(zm.y), mr[5] * bfhi(zm.y));
    u32x2 w; w.x = cvt_pk_bf16(mr[4] * bflo(zm.z), mr[3] * bfhi(zm.z)); w.y = cvt_pk_bf16(mr[2] * bflo(zm.w), mr[1] * bfhi(zm.w));
    *(u32x2*)(mp + 4) = w;
    if (mi0 >= 8) mp[8] = (bf16_t)f2bf(mr[0] * bf1((bf16_t)z.z8));
}
template <bool FOLD> struct EpiDft {
    static constexpr bool PERM = true;
    bf16_t* Z; int L; int tok_base; const float* AH;
    __device__ __forceinline__ void operator()(AccRef acc, const pg8::Unit& u, int wr, int wc, int fr, int fq) const {
        const int b = u.pn >> 3, g = u.pn & 7, k0 = u.pm * 128 + wr * 64 + fr, mi0 = wc * 32 + 8 * fq;
        f32x4 ah[2] = {(f32x4){0.f, 0.f, 0.f, 0.f}, (f32x4){0.f, 0.f, 0.f, 0.f}}; float ahn = 0.f;
        if (FOLD) { const float* ap = AH + (size_t)b * 2048 + g * 256; ah[0] = *(const f32x4*)(ap + mi0) * 0.022097087f; ah[1] = *(const f32x4*)(ap + mi0 + 4) * 0.022097087f; ahn = ap[128] * 0.022097087f; }
        const bool nyq = (wc == 0 && fq == 0);
#pragma unroll
        for (int mh = 0; mh < 2; ++mh) {
            DftZ zr[2], zq[2]; unsigned n0[2], n1[2];
#pragma unroll
            for (int mm = 0; mm < 2; ++mm) { const int k = k0 + 16 * (2 * mh + mm); const bf16_t* zrow = Z + (size_t)(tok_base + b * L + k) * 2048 + g * 256;
                const bf16_t* zmir = Z + (size_t)(tok_base + b * L + ((FOLD && k >= 1) ? (L - k) : k)) * 2048 + g * 256;
                zr[mm] = dft_row_ld(zrow, mi0); if (FOLD) zq[mm] = dft_row_ld(zmir, mi0);
                n0[mm] = nyq ? (unsigned)zrow[128] : 0u; n1[mm] = (nyq && FOLD) ? (unsigned)zmir[128] : 0u; }
#pragma unroll
            for (int mm = 0; mm < 2; ++mm) { const int m = 2 * mh + mm, k = k0 + 16 * m; bf16_t* zrow = Z + (size_t)(tok_base + b * L + k) * 2048 + g * 256;
                bf16_t* zmir = Z + (size_t)(tok_base + b * L + (L - k)) * 2048 + g * 256;
                const float sg = (k & 1) ? -1.f : 1.f;
                float dm[8], sm[8];
#pragma unroll
                for (int n = 0; n < 2; ++n) { f32x4 P = acc[0][0][m][n]; const f32x4 Q = acc[1][1][m][n]; if (FOLD) P = P + ah[n] * sg;
#pragma unroll
                    for (int e = 0; e < 4; ++e) { dm[4 * n + e] = P[e] - Q[e]; sm[4 * n + e] = P[e] + Q[e]; }
                    if (n == 0 && mi0 == 0) { dm[0] = P[0]; sm[0] = P[0]; } }
                dft_row_st(zrow, mi0, zr[mm], dm, sm);
                if (FOLD && k >= 1) dft_row_st(zmir, mi0, zq[mm], sm, dm);
                if (nyq) { const float yn = acc[0][1][m][0][0] + (FOLD ? ahn * sg : 0.f);
                    zrow[128] = (bf16_t)f2bf(yn * bf1((bf16_t)n0[mm]));
                    if (FOLD && k >= 1) zmir[128] = (bf16_t)f2bf(yn * bf1((bf16_t)n1[mm])); } }
            asm volatile("" ::: "memory");
        }
    }
};
struct OutOrder {
    pg8::TileOrder T; int G, c; bool with_ctx;
    __device__ void init(int G_, int c_, bool with_ctx_) { T.init(64, 4, G_, c_); G = G_; c = c_; with_ctx = with_ctx_; }
    __device__ bool next(int i, pg8::Unit& u) const {
        const int L = i * G + c;
        if (L < 256) return T.next(i, u);
        if (!with_ctx || L >= 384) return false;
        const int idx = L - 256, tile = idx >> 2; u.pm = 64 + (tile >> 2); u.pn = tile & 3; u.aux = 1 + (idx & 3); return true;
    }
    __device__ __forceinline__ int koff(const pg8::Unit& u) const { return u.aux ? 512 * (u.aux - 1) : 0; }
    __device__ __forceinline__ const char* a_ptr(const pg8::Gemm& g, const pg8::Unit& u) const { return (const char*)(g.A + (size_t)u.pm * 256 * g.lda + koff(u)); }
    __device__ __forceinline__ const char* b_ptr(const pg8::Gemm& g, const pg8::Unit& u, int half) const { return (const char*)(g.Bt + (size_t)(u.pn * 256 + 128 * half) * g.ldb + koff(u)); }
    __device__ __forceinline__ bool b_mirror(const pg8::Unit&) const { return false; }
    __device__ __forceinline__ bool b_fix(const pg8::Unit&) const { return false; }
    __device__ __forceinline__ int ktiles(const pg8::Gemm& g, const pg8::Unit& u) const { return u.aux ? 8 : g.K / pg8::BK; }
};
struct EpiResid {
    static constexpr bool PERM = false;
    const float* xin_lat; float* xout_lat; const float* gate; float* part;
    __device__ __forceinline__ void operator()(AccRef acc, const pg8::Unit& u, int wr, int wc, int fr, int fq) const {
        const int row0 = u.pm * 256 + wr * 64 + fr, col0 = u.pn * 256 + wc * 32 + 4 * fq;
        if (u.aux) {
            float* pp = part + (size_t)(u.aux - 1) * NCTX * DM + (size_t)(row0 - NLAT) * DM + col0;
#pragma unroll
            for (int ai = 0; ai < 2; ++ai)
#pragma unroll
                for (int m = 0; m < 4; ++m)
#pragma unroll
                    for (int bj = 0; bj < 2; ++bj)
#pragma unroll
                        for (int n = 0; n < 2; ++n) *(f32x4*)(pp + (size_t)(ai * 128 + m * 16) * DM + bj * 128 + n * 16) = acc[ai][bj][m][n];
            return;
        }
        const float* gp = gate + (u.pm >> 3) * 3072 + col0;
        f32x4 gv[2][2];
#pragma unroll
        for (int bj = 0; bj < 2; ++bj)
#pragma unroll
            for (int n = 0; n < 2; ++n) gv[bj][n] = *(const f32x4*)(gp + bj * 128 + n * 16);
#pragma unroll
        for (int ai = 0; ai < 2; ++ai) {
            f32x4 xv[4][2][2];
#pragma unroll
            for (int m = 0; m < 4; ++m) { const size_t off = (size_t)(row0 + ai * 128 + m * 16) * DM + col0;
#pragma unroll
                for (int bj = 0; bj < 2; ++bj)
#pragma unroll
                    for (int n = 0; n < 2; ++n) xv[m][bj][n] = *(const f32x4*)(xin_lat + off + bj * 128 + n * 16); }
#pragma unroll
            for (int m = 0; m < 4; ++m) { const size_t off = (size_t)(row0 + ai * 128 + m * 16) * DM + col0;
#pragma unroll
                for (int bj = 0; bj < 2; ++bj)
#pragma unroll
                    for (int n = 0; n < 2; ++n) *(f32x4*)(xout_lat + off + bj * 128 + n * 16) = xv[m][bj][n] + gv[bj][n] * acc[ai][bj][m][n]; }
            asm volatile("" ::: "memory"); }
    }
};
struct EpiQKV {
    static constexpr bool PERM = true;
    bf16_t* Q; bf16_t* K; bf16_t* V; const float* rcos; const float* rsin;
    __device__ __forceinline__ void operator()(AccRef acc, const pg8::Unit& u, int wr, int wc, int fr, int fq) const {
        const int row0 = u.pm * 256 + wr * 64 + fr, c0 = wc * 32 + 8 * fq;
        if (u.pn >= 8) {
#pragma unroll
            for (int ai = 0; ai < 2; ++ai)
#pragma unroll
                for (int m = 0; m < 4; ++m) { bf16_t* rowp = V + (size_t)(row0 + ai * 128 + m * 16) * 2048 + (u.pn - 8) * 256 + c0;
#pragma unroll
                    for (int bj = 0; bj < 2; ++bj) { const f32x4 v0 = acc[ai][bj][m][0], v1 = acc[ai][bj][m][1]; u32x4 w;
                        w.x = cvt_pk_bf16(v0[0], v0[1]); w.y = cvt_pk_bf16(v0[2], v0[3]); w.z = cvt_pk_bf16(v1[0], v1[1]); w.w = cvt_pk_bf16(v1[2], v1[3]);
                        *(u32x4*)(rowp + bj * 128) = w; } }
            return;
        }
        const bool isk = u.pn >= 4, lat = u.pm < 64; const int h = u.pn & 3; bf16_t* dst = isk ? K : Q; const float sc = isk ? 0.0625f : 1.0f;
        const int i0 = 16 * wc + 4 * fq;
#pragma unroll
        for (int ai = 0; ai < 2; ++ai) {
            f32x4 cv[4][2], sv[4][2];
            if (lat) {
#pragma unroll
                for (int m = 0; m < 4; ++m) { const int l = (row0 + ai * 128 + m * 16) & 2047;
#pragma unroll
                    for (int bj = 0; bj < 2; ++bj) { const int pos = bj == 0 ? (l >> 6) : (l & 63); cv[m][bj] = *(const f32x4*)(rcos + pos * 64 + i0); sv[m][bj] = *(const f32x4*)(rsin + pos * 64 + i0); } } }
#pragma unroll
            for (int m = 0; m < 4; ++m) { const int row = row0 + ai * 128 + m * 16;
                bf16_t* chp = dst + ((size_t)(row >> 7) * 4 + h) * 32768;
#pragma unroll
                for (int bj = 0; bj < 2; ++bj) { f32x4 x1 = acc[ai][bj][m][0], x2 = acc[ai][bj][m][1];
                    if (lat) { const f32x4 o1 = x1 * cv[m][bj] - x2 * sv[m][bj], o2 = x1 * sv[m][bj] + x2 * cv[m][bj]; x1 = o1; x2 = o2; }
                    x1 = x1 * sc; x2 = x2 * sc; u32x4 w;
                    w.x = cvt_pk_bf16(x1[0], x1[1]); w.y = cvt_pk_bf16(x1[2], x1[3]); w.z = cvt_pk_bf16(x2[0], x2[1]); w.w = cvt_pk_bf16(x2[2], x2[3]);
                    const int s32 = 4 * bj + wc;
                    const int off = isk ? ((s32 * 8 + ((row & 127) >> 4)) * 512 + (4 * (row & 15) + fq) * 8)
                                        : (((((row >> 4) & 7) * 8) + s32) * 512 + (16 * fq + (row & 15)) * 8);
                    *(u32x4*)(chp + off) = w; } }
            asm volatile("" ::: "memory"); }
    }
};
struct EpiZGate {
    static constexpr bool PERM = true;
    const bf16_t* O; const float* rinv; bf16_t* AO;
    __device__ __forceinline__ void operator()(AccRef acc, const pg8::Unit& u, int wr, int wc, int fr, int fq) const {
        const int row0 = u.pm * 256 + wr * 64 + fr, col0 = u.pn * 256 + wc * 32 + 8 * fq, head = u.pn >> 1;
#pragma unroll
        for (int ai = 0; ai < 2; ++ai) {
            u32x4 ov[4][2]; float rv[4];
#pragma unroll
            for (int m = 0; m < 4; ++m) { const int row = row0 + ai * 128 + m * 16; rv[m] = rinv[row * 4 + head];
#pragma unroll
                for (int bj = 0; bj < 2; ++bj) { const int c = col0 + bj * 128, e0 = c & 63;
                    const bf16_t* op = O + ((size_t)((((row >> 7) * 4 + (c >> 9)) * 8 + ((c >> 6) & 7)) * 8 + ((row >> 4) & 7)) << 10) + (e0 >> 4) * 256 + (16 * ((e0 >> 2) & 3) + (row & 15)) * 4;
                    const u32x2 lo = *(const u32x2*)op, hi = *(const u32x2*)(op + 64); ov[m][bj] = (u32x4){lo.x, lo.y, hi.x, hi.y}; } }
#pragma unroll
            for (int m = 0; m < 4; ++m) { const int row = row0 + ai * 128 + m * 16; const float r_ = rv[m];
#pragma unroll
                for (int bj = 0; bj < 2; ++bj) { const u32x4 o = ov[m][bj]; const f32x4 v0 = acc[ai][bj][m][0], v1 = acc[ai][bj][m][1]; u32x4 w;
                    w.x = cvt_pk_bf16(bflo(o.x) * r_ * silu_f(v0[0]), bfhi(o.x) * r_ * silu_f(v0[1])); w.y = cvt_pk_bf16(bflo(o.y) * r_ * silu_f(v0[2]), bfhi(o.y) * r_ * silu_f(v0[3]));
                    w.z = cvt_pk_bf16(bflo(o.z) * r_ * silu_f(v1[0]), bfhi(o.z) * r_ * silu_f(v1[1])); w.w = cvt_pk_bf16(bflo(o.w) * r_ * silu_f(v1[2]), bfhi(o.w) * r_ * silu_f(v1[3]));
                    *(u32x4*)(AO + (size_t)row * 2048 + col0 + bj * 128) = w; } }
            asm volatile("" ::: "memory"); }
    }
};

#define XB_TMO      128
#define XB_XCNT(j)  (256  + 64 * (j))
#define XB_XSUB(j)  (1280 + 64 * (j))
#define XB_XGEN(j)  (2304 + 64 * (j))
#define XB_TOP      3328
#define XB_TOPGEN   3392
#define XCD_BAR_WORDS 3456
#define XB_SPIN_CAP (1u << 18)
__device__ __forceinline__ unsigned xb_ld(unsigned* p)              { return __hip_atomic_load(p, __ATOMIC_RELAXED, __HIP_MEMORY_SCOPE_AGENT); }
__device__ __forceinline__ unsigned xb_add(unsigned* p, unsigned v) { return __hip_atomic_fetch_add(p, v, __ATOMIC_RELAXED, __HIP_MEMORY_SCOPE_AGENT); }
__device__ __forceinline__ unsigned xb_xcc_id() { return (unsigned)__builtin_amdgcn_s_getreg((3 << 11) | 20) & 0xFu; }
#define XB_SPIN(cond, bar) do { unsigned _sp = 0; while (cond) { __builtin_amdgcn_s_sleep(1); \
    if ((++_sp & 255u) == 0u) { if (xb_ld(&(bar)[XB_TMO])) break; if (_sp > XB_SPIN_CAP) { atomicAdd(&(bar)[XB_TMO], 1u); break; } } } } while (0)
struct XcdBarrier { unsigned* bar; unsigned x; volatile LAS unsigned* st; };
__device__ __forceinline__ XcdBarrier xcd_barrier_post(unsigned* bar, volatile LAS unsigned* st) {
    XcdBarrier b; b.bar = bar; b.x = xb_xcc_id(); b.st = st;
    if (threadIdx.x == 0) (void)xb_add(&bar[XB_XCNT(b.x)], 1u);
    return b;
}
__device__ __forceinline__ void xcd_barrier_complete(unsigned* bar, unsigned x, unsigned& nloc, unsigned& nx) {
    const unsigned G = gridDim.x * gridDim.y * gridDim.z;
    unsigned sum, cnt, mine, sp = 0u;
    for (;;) {
        sum = 0u; cnt = 0u; mine = 0u;
#pragma unroll 1
        for (unsigned j = 0; j < 16; ++j) { const unsigned c = xb_ld(&bar[XB_XCNT(j)]); sum += c; cnt += (c > 0u) ? 1u : 0u; mine = (j == x) ? c : mine; }
        if (sum == G) break;
        __builtin_amdgcn_s_sleep(1);
        if ((++sp & 255u) == 0u) { if (xb_ld(&bar[XB_TMO])) break; if (sp > XB_SPIN_CAP) { atomicAdd(&bar[XB_TMO], 1u); break; } }
    }
    nloc = mine > 0u ? mine : 1u; nx = cnt > 0u ? cnt : 1u;
}
__device__ __forceinline__ void xcd_barrier(const XcdBarrier& b) {
    asm volatile("s_waitcnt vmcnt(0)" ::: "memory");
    __syncthreads();
    if (threadIdx.x == 0) {
        unsigned* bar = b.bar;
        __builtin_amdgcn_s_waitcnt(0);
        unsigned nloc = b.st[0], nx = b.st[1];
        if (nloc == 0u) { xcd_barrier_complete(bar, b.x, nloc, nx); b.st[0] = nloc; b.st[1] = nx; }
        const unsigned old = xb_add(&bar[XB_XSUB(b.x)], 1u);
        const unsigned gen = old / nloc;
        if (old + 1u == (gen + 1u) * nloc) {
            __builtin_amdgcn_fence(__ATOMIC_RELEASE, "agent");
            asm volatile("s_waitcnt vmcnt(0)" ::: "memory");
            const unsigned og = xb_add(&bar[XB_TOP], 1u);
            const unsigned tg = og / nx;
            if (og + 1u == (tg + 1u) * nx) xb_add(&bar[XB_TOPGEN], 1u);
            else XB_SPIN(xb_ld(&bar[XB_TOPGEN]) == tg, bar);
            __builtin_amdgcn_fence(__ATOMIC_ACQUIRE, "agent");
            xb_add(&bar[XB_XGEN(b.x)], 1u);
            asm volatile("s_waitcnt vmcnt(0)" ::: "memory");
        } else {
            XB_SPIN(xb_ld(&bar[XB_XGEN(b.x)]) == gen, bar);
            __builtin_amdgcn_fence(__ATOMIC_ACQUIRE, "agent");
            asm volatile("s_waitcnt vmcnt(0)" ::: "memory");
        }
    }
    __syncthreads();
}

struct Args { const float* in[13]; float* out; unsigned char* ws; int ph_lo, ph_hi, pad0, pad1; };
struct Frame {
    LAS unsigned char* lds;
    int vcu, G, wv;
    unsigned char* ws;
};
__device__ __forceinline__ int lane_id() { int l; asm volatile("v_mbcnt_lo_u32_b32 %0, -1, 0\n\tv_mbcnt_hi_u32_b32 %0, -1, %0" : "=v"(l)); return l; }
__device__ __forceinline__ unsigned char* launder_ptr(unsigned char* p) {
    unsigned lo = (unsigned)(unsigned long long)p, hi = (unsigned)((unsigned long long)p >> 32);
    asm volatile("" : "+s"(lo), "+s"(hi));
    return (unsigned char*)(((unsigned long long)hi << 32) | lo);
}
#define PHASE_IDS() int tid = F.wv * 64 + lane_id(); asm volatile("" : "+v"(tid)); const int lane = tid & 63, wave = __builtin_amdgcn_readfirstlane(tid >> 6); (void)lane; (void)wave; \
    unsigned char* ws = launder_ptr(F.ws); (void)ws
#define LDS_WAIT() asm volatile("s_waitcnt lgkmcnt(0)" ::: "memory")

__device__ __forceinline__ int qk_pos(int d) { const int half = d >> 7, n = (d >> 6) & 1, i = d & 63; return 128 * half + 8 * (i >> 2) + 4 * n + (i & 3); }
template <int MODE>
__device__ __forceinline__ void transpose_item(const float* W, int K, int N, int n_begin, bf16_t* WT, LAS float* scr, int item, int nblk, int lane) {
    const int kb = item / nblk, nb = item % nblk, k0 = 64 * kb, n0 = n_begin + 64 * nb;
    const GAS f32x4* src = (const GAS f32x4*)(W + (size_t)(k0 + (lane >> 4)) * N + n0 + 4 * (lane & 15));
    f32x4 v[16];
#pragma unroll
    for (int i = 0; i < 16; ++i) v[i] = src[(size_t)i * N];
#pragma unroll
    for (int i = 0; i < 16; ++i) *(LAS f32x4*)(scr + (4 * i + (lane >> 4)) * 68 + 4 * (lane & 15)) = v[i];
    LDS_WAIT(); asm volatile("" ::: "memory");
    const int na = n0 + lane; int nn = na - n_begin;
    if (MODE == 1) nn = (na < 2048) ? ((na & ~255) + qk_pos(na & 255)) : na;
    GAS u32x4* dst = (GAS u32x4*)(WT + (size_t)nn * K + k0);
#pragma unroll
    for (int c = 0; c < 8; ++c) { const LAS float* sp = scr + (8 * c) * 68 + lane;
        u32x4 o; o.x = pk2(sp[0 * 68], sp[1 * 68]); o.y = pk2(sp[2 * 68], sp[3 * 68]); o.z = pk2(sp[4 * 68], sp[5 * 68]); o.w = pk2(sp[6 * 68], sp[7 * 68]);
        dst[c] = o; }
    LDS_WAIT(); asm volatile("" ::: "memory");
}
__device__ __forceinline__ void fold_task(const float* Win  , const LAS float* ctab  , bf16_t* WfT, int t, int lane) {
    const int g = t >> 8, p0 = ((t >> 5) & 7) * 32, kk0 = (t & 31) * 32, s = lane >> 5, li = lane & 31;
    f32x16 acc;
#pragma unroll
    for (int i = 0; i < 16; ++i) acc[i] = 0.f;
    const float* wrow = Win + (size_t)(kk0 + li) * 4096 + g * 256 + 4 * s;
    const int pcol = p0 + li;
    const int pmul = pcol < 128 ? pcol : pcol - 128, poff = pcol < 128 ? 0 : -64; const bool nyq = pcol == 128;
    f32x4 wvv[32];
#pragma unroll
    for (int tp = 0; tp < 32; ++tp) wvv[tp] = *(const GAS f32x4*)((const GAS float*)wrow + 8 * tp);
#pragma unroll
    for (int tp = 0; tp < 32; ++tp) {
        const f32x4 wv = wvv[tp];
#pragma unroll
        for (int uu = 0; uu < 4; ++uu) { const int cc = 8 * tp + 4 * s + uu; float a;
            a = ctab[(pmul * cc + poff) & 255]; if (nyq) a = (cc & 1) ? -0.0625f : 0.0625f;
            acc = __builtin_amdgcn_mfma_f32_32x32x2f32(a, wv[uu], acc, 0, 0, 0); }
    }
#pragma unroll
    for (int i = 0; i < 16; ++i) { const int row = (i & 3) + 8 * (i >> 2) + 4 * s; WfT[(size_t)(g * 256 + p0 + row) * 1024 + kk0 + li] = (bf16_t)f2bf(acc[i]); }
}

__device__ __forceinline__ void p0_phase(Frame& F, const Args& a) {
    PHASE_IDS();
    float* ADA = (float*)(ws + WS_ADA);
    const float* c = a.in[1]; const float* cctx = a.in[3]; const float* ada_w = a.in[5]; const float* ada_b = a.in[6];
    LAS float* sl = (LAS float*)F.lds;
    LAS float* part = (LAS float*)(F.lds + 36864);
    bool loaded = false;
    for (int u = F.vcu; u < 192; u += F.G) {
        if (!loaded) { for (int idx = tid; idx < 9 * 1024; idx += 512) { const int r = idx >> 10, k = idx & 1023; const float x = r < 8 ? c[r * 1024 + k] : cctx[k]; sl[idx] = x / (1.f + expf(-x)); } loaded = true; }
        __syncthreads();
        const int i = u / 48, n0 = (u % 48) * 64;
        f32x4 acc[9];
#pragma unroll
        for (int r = 0; r < 9; ++r) acc[r] = (f32x4){0.f, 0.f, 0.f, 0.f};
        const int ks4 = lane >> 4, c4 = 4 * (lane & 15);
        const float* wp = ada_w + ((size_t)i * 1024 + wave * 128 + ks4) * 3072 + n0 + c4;
#pragma unroll 8
        for (int kk = 0; kk < 32; ++kk) { const f32x4 wv = *(const f32x4*)(wp + (size_t)kk * 4 * 3072); const int k = wave * 128 + 4 * kk + ks4;
#pragma unroll
            for (int r = 0; r < 9; ++r) acc[r] += wv * sl[r * 1024 + k]; }
#pragma unroll
        for (int r = 0; r < 9; ++r) *(LAS f32x4*)(part + ((wave * 4 + ks4) * 9 + r) * 64 + c4) = acc[r];
        __syncthreads();
        for (int idx = tid; idx < 576; idx += 512) { const int r = idx >> 6, l = idx & 63; float s = 0.f;
#pragma unroll
            for (int w = 0; w < 32; ++w) s += part[(w * 9 + r) * 64 + l];
            ADA[(i * 9 + r) * 3072 + n0 + l] = s + ada_b[i * 3072 + n0 + l]; }
    }
    const int gt = F.vcu * 512 + tid, NT = F.G * 512;
    float* RC = (float*)(ws + WS_ROPE); float* RS = RC + 4096;
    for (int idx = gt; idx < 4096; idx += NT) { const int pos = idx >> 6, i = idx & 63; const float freq = powf(10000.0f, -(float)i / 64.0f); const float ang = (float)pos * freq;
        RC[idx] = cosf(ang); RS[idx] = sinf(ang); }
    bf16_t* CS256 = (bf16_t*)(ws + WS_CS256);
    for (int idx = gt; idx < 512 * 256; idx += NT) { const int row = idx >> 8, l = idx & 255, kt = row >> 8, hf = (row >> 7) & 1, k = kt * 128 + (row & 127);
        const float x = (float)((k * l) & 255) * (1.f / 128.f); const float v = (hf ? sinpif(x) : cospif(x)) * 0.0625f; CS256[idx] = (bf16_t)f2bf(v); }
}

__device__ __forceinline__ void norm_row(const float* xrow, const float* ng, const float* adar  , bf16_t* orow, int lane) {
    const f32x4* xr = (const f32x4*)xrow + lane;
    f32x4 v[4]; float s = 0.f;
#pragma unroll
    for (int j = 0; j < 4; ++j) { v[j] = xr[64 * j]; s += (v[j].x * v[j].x + v[j].y * v[j].y) + (v[j].z * v[j].z + v[j].w * v[j].w); }
    const float rinv = rsqrtf(wave_sum(s, lane) * (1.f / DM) + EPS);
    unsigned long long* o8 = (unsigned long long*)orow + lane;
#pragma unroll
    for (int j = 0; j < 4; ++j) { const int col = 4 * lane + 256 * j; const f32x4 g = *(const f32x4*)(ng + col), sh = *(const f32x4*)(adar + col), sc = *(const f32x4*)(adar + 1024 + col);
        const f32x4 y = v[j] * rinv * g * (sc + 1.0f) + sh;
        o8[64 * j] = (unsigned long long)pk2(y.x, y.y) | ((unsigned long long)pk2(y.z, y.w) << 32); }
}
template <int NR>
__device__ __forceinline__ void norm_batch(const float* const (&xrow)[NR], bf16_t* const (&hrow)[NR], int nrows, const f32x4 (&gm)[4], const f32x4 (&sh)[4], int lane) {
    f32x4 v[NR][4]; float ss[NR];
#pragma unroll
    for (int t = 0; t < NR; ++t) { const f32x4* xr = (const f32x4*)xrow[t] + lane;
#pragma unroll
        for (int j = 0; j < 4; ++j) v[t][j] = xr[64 * j]; }
#pragma unroll
    for (int t = 0; t < NR; ++t) { float s = 0.f;
#pragma unroll
        for (int j = 0; j < 4; ++j) s += (v[t][j].x * v[t][j].x + v[t][j].y * v[t][j].y) + (v[t][j].z * v[t][j].z + v[t][j].w * v[t][j].w);
        ss[t] = s; }
#pragma unroll
    for (int o = 1; o < 64; o <<= 1) {
#pragma unroll
        for (int t = 0; t < NR; ++t) ss[t] += shx(ss[t], o, lane); }
#pragma unroll
    for (int t = 0; t < NR; ++t) if (t < nrows) { const float rinv = rsqrtf(ss[t] * (1.f / DM) + EPS);
        unsigned long long* o8 = (unsigned long long*)hrow[t] + lane;
#pragma unroll
        for (int j = 0; j < 4; ++j) { const f32x4 y = v[t][j] * rinv * gm[j] + sh[j];
            o8[64 * j] = (unsigned long long)pk2(y.x, y.y) | ((unsigned long long)pk2(y.z, y.w) << 32); } }
}
template <bool ADDP>
__device__ __forceinline__ void norm_rows(Frame& F, const Args& a, int layer, bf16_t* H, int wsub = 8) {
    PHASE_IDS();
    const float* xl = layer == 0 ? a.in[0] : a.out; const float* xc = (layer == 0 || (ADDP && layer == 1)) ? a.in[2] : (const float*)(ws + WS_XCTX);
    const float* ng = a.in[4] + layer * DM; const float* ADA = (const float*)(ws + WS_ADA) + layer * 9 * 3072;
    const int gw = F.vcu * wsub + wave, NGW = F.G * wsub;
    const int wpb = NGW >> 3;
    if (wpb > 0 && (NGW & 7) == 0) {
        const int b = gw / wpb, wi = gw - b * wpb; const float* adar = ADA + b * 3072;
        f32x4 gm[4], sh[4];
#pragma unroll
        for (int j = 0; j < 4; ++j) { const int col = 4 * lane + 256 * j; gm[j] = *(const f32x4*)(ng + col) * (*(const f32x4*)(adar + 1024 + col) + 1.0f); sh[j] = *(const f32x4*)(adar + col); }
        for (int l0 = wi; l0 < SEQ; l0 += 8 * wpb) {
            const float* xr[8]; bf16_t* hr[8]; int n = 0;
#pragma unroll
            for (int t = 0; t < 8; ++t) { const int l = l0 + t * wpb; const int ll = l < SEQ ? l : wi; if (l < SEQ) n = t + 1; xr[t] = xl + (size_t)(b * SEQ + ll) * DM; hr[t] = H + (size_t)(b * SEQ + ll) * DM; }
            norm_batch<8>(xr, hr, n, gm, sh, lane);
        }
        const float* adac = ADA + 8 * 3072;
#pragma unroll
        for (int j = 0; j < 4; ++j) { const int col = 4 * lane + 256 * j; gm[j] = *(const f32x4*)(ng + col) * (*(const f32x4*)(adac + 1024 + col) + 1.0f); sh[j] = *(const f32x4*)(adac + col); }
        for (int m = gw; m < NCTX; m += NGW) {
            f32x4 xv[4];
#pragma unroll
            for (int j = 0; j < 4; ++j) xv[j] = *((const f32x4*)(xc + (size_t)m * DM) + lane + 64 * j);
            if (ADDP && layer >= 1) {
                const float* part = (const float*)(ws + WS_PART); const float* gprev = (const float*)(ws + WS_ADA) + (layer - 1) * 9 * 3072 + 8 * 3072 + 2048;
                float* xw = (float*)(ws + WS_XCTX) + (size_t)m * DM;
#pragma unroll
                for (int j = 0; j < 4; ++j) { const f32x4* pr = (const f32x4*)(part + (size_t)m * DM) + lane + 64 * j;
                    const f32x4 ps = (pr[0] + pr[(size_t)NCTX * DM / 4]) + (pr[(size_t)2 * NCTX * DM / 4] + pr[(size_t)3 * NCTX * DM / 4]);
                    xv[j] = xv[j] + *(const f32x4*)(gprev + 4 * lane + 256 * j) * ps;
                    *((f32x4*)xw + lane + 64 * j) = xv[j]; }
            }
            float s_ = 0.f;
#pragma unroll
            for (int j = 0; j < 4; ++j) s_ += (xv[j].x * xv[j].x + xv[j].y * xv[j].y) + (xv[j].z * xv[j].z + xv[j].w * xv[j].w);
            const float rinv = rsqrtf(wave_sum(s_, lane) * (1.f / DM) + EPS);
            unsigned long long* o8 = (unsigned long long*)(H + (size_t)(NLAT + m) * DM) + lane;
#pragma unroll
            for (int j = 0; j < 4; ++j) { const f32x4 y = xv[j] * rinv * gm[j] + sh[j];
                o8[64 * j] = (unsigned long long)pk2(y.x, y.y) | ((unsigned long long)pk2(y.z, y.w) << 32); }
        }
        return;
    }
    for (int m = gw; m < NTOK; m += NGW) {
        const bool lat = m < NLAT; const int r = lat ? (m >> 11) : 8; const float* adar = ADA + r * 3072;
        f32x4 gm[4], sh[4];
#pragma unroll
        for (int j = 0; j < 4; ++j) { const int col = 4 * lane + 256 * j; gm[j] = *(const f32x4*)(ng + col) * (*(const f32x4*)(adar + 1024 + col) + 1.0f); sh[j] = *(const f32x4*)(adar + col); }
        const float* xr[1] = {lat ? xl + (size_t)m * DM : xc + (size_t)(m - NLAT) * DM}; bf16_t* hr[1] = {H + (size_t)m * DM};
        norm_batch<1>(xr, hr, 1, gm, sh, lane);
    }
}
__device__ __forceinline__ void cf_prep(Frame& F, int wave, int lane) {
    LAS float* ctab = (LAS float*)(F.lds + 139264);
    { const int tt = wave * 64 + lane; if (tt < 256) ctab[tt] = cospif((float)tt * (1.f / 128.f)) * 0.0625f; }
    __syncthreads();
}
__device__ __forceinline__ void cf_main(Frame& F, const Args& a, int j, int gw, int NGW, unsigned char* ws, int wave, int lane) {
    LAS float* scr = (LAS float*)(F.lds + wave * 17408); const LAS float* ctab = (const LAS float*)(F.lds + 139264);
    bf16_t* W1 = (bf16_t*)(ws + WS_WF);
    const float* win = a.in[7] + (size_t)j * 1024 * 4096; const float* wout = a.in[8] + (size_t)j * 2048 * 1024;
    bf16_t* WfoT = W1 + (size_t)4096 * 1024;
    for (int t = gw; t < 2048; t += NGW) fold_task(win, ctab, W1, t, lane);
    for (int it = gw; it < 16 * 32; it += NGW) transpose_item<0>(win, 1024, 4096, 2048, W1 + (size_t)2048 * 1024, scr, it, 32, lane);
    for (int it = gw; it < 32 * 16; it += NGW) transpose_item<0>(wout, 2048, 1024, 0, WfoT, scr, it, 16, lane);
}
__device__ __forceinline__ void cf_cs(Frame& F, int gt, int NT, unsigned char* ws, int wave, int lane) {
    bf16_t* CS = (bf16_t*)(ws + WS_CS);
    __syncthreads();
    LAS float* ctab2 = (LAS float*)F.lds;
    for (int n = wave * 64 + lane; n < 2048; n += 512) ctab2[n] = cospif((float)n * (1.f / 1024.f)) * 0.022097087f;
    __syncthreads();
    for (int ch = gt; ch < 2048 * 128; ch += NT) { const int row = ch >> 7, l0 = (ch & 127) * 8, kt = row >> 8, hf = (row >> 7) & 1, k = kt * 128 + (row & 127);
        const int off = hf ? -512 : 0;
        unsigned w[4];
#pragma unroll
        for (int e = 0; e < 4; ++e) { float v[2];
#pragma unroll
            for (int q = 0; q < 2; ++q) { const int l = l0 + 2 * e + q; v[q] = ctab2[(k * l + off) & 2047]; }
            w[e] = pk2(v[0], v[1]); }
        *(u32x4*)(CS + (size_t)row * 1024 + l0) = (u32x4){w[0], w[1], w[2], w[3]}; }
    __syncthreads();
}
__device__ __forceinline__ void conv_fourier(Frame& F, const Args& a, int j, int gw, int NGW, int gt, int NT, unsigned char* ws, int wave, int lane) {
    cf_prep(F, wave, lane); cf_main(F, a, j, gw, NGW, ws, wave, lane); cf_cs(F, gt, NT, ws, wave, lane);
}
__device__ __forceinline__ void conv_ret(Frame& F, const Args& a, int j, int gw, int NGW, unsigned char* ws, int wave, int lane, int lo = 0, int hi = 2048) {
    LAS float* scr = (LAS float*)(F.lds + wave * 17408);
    bf16_t* W1 = (bf16_t*)(ws + WS_W);
    const float* win = a.in[9] + (size_t)j * 1024 * 6144; const float* wout = a.in[10] + (size_t)j * 2048 * 1024;
    bf16_t* WroT = W1 + (size_t)6144 * 1024;
    for (int it = lo + gw; it < hi; it += NGW) {
        if (it < 1536) transpose_item<1>(win, 1024, 6144, 0, W1, scr, it, 96, lane);
        else transpose_item<0>(wout, 2048, 1024, 0, WroT, scr, it - 1536, 16, lane);
    }
}
__device__ __forceinline__ void bg_conv_ret(Frame& F, const Args& a, int layer, int cu_lo, int lo, int hi) {
    PHASE_IDS();
    const int cu = (int)blockIdx.x - cu_lo;
    if (layer + 1 >= NLAYER || F.G != 256 || cu < 0 || cu >= 128) return;
    conv_ret(F, a, (layer + 1) >> 1, cu * 8 + wave, 1024, ws, wave, lane, lo, hi);
}
__device__ __forceinline__ void p0_conv(Frame& F, const Args& a) {
    PHASE_IDS();
    __syncthreads();
    conv_fourier(F, a, 0, F.vcu * 8 + wave, F.G * 8, F.vcu * 512 + tid, F.G * 512, ws, wave, lane);
}
__device__ __forceinline__ void n_phase(Frame& F, const Args& a, int layer) {
    PHASE_IDS();
    const bool fourier = (layer & 1) == 0;
    if (fourier && layer >= 1) {
        cf_prep(F, wave, lane);
        if (wave < 4) norm_rows<true>(F, a, layer, (bf16_t*)(ws + WS_H), 4); else cf_main(F, a, layer >> 1, F.vcu * 4 + wave - 4, F.G * 4, ws, wave, lane);
        cf_cs(F, F.vcu * 512 + tid, F.G * 512, ws, wave, lane);
        return;
    }
    norm_rows<true>(F, a, layer, (bf16_t*)(ws + (fourier ? WS_H : WS_OF)));
    if (layer >= 1) {
        if (fourier) conv_fourier(F, a, layer >> 1, F.vcu * 8 + wave, F.G * 8, F.vcu * 512 + tid, F.G * 512, ws, wave, lane);
        else if (F.G != 256) conv_ret(F, a, layer >> 1, F.vcu * 8 + wave, F.G * 8, ws, wave, lane);
    }
}
__device__ __forceinline__ void nyq_row_phase(Frame& F) {
    PHASE_IDS();
    const bf16_t* UTF = (const bf16_t*)(ws + WS_UTL); const float* AH = (const float*)(ws + WS_RINV); bf16_t* Z = (bf16_t*)(ws + WS_Z);
    const int gw = F.vcu * 8 + wave, NGW = F.G * 8;
    for (int t = gw; t < 64 * 129; t += NGW) {
        const int bg = t / 129, mt = t - bg * 129, b = bg >> 3, g = bg & 7; const int row = b * 2048 + g * 256 + mt;
        const GAS u32x4* src = (const GAS u32x4*)(UTF + (size_t)row * 1024);
        float s = 0.f;
#pragma unroll
        for (int i = 0; i < 2; ++i) { const u32x4 v = src[lane + 64 * i]; s += (bflo(v.x) - bfhi(v.x)) + (bflo(v.y) - bfhi(v.y)) + (bflo(v.z) - bfhi(v.z)) + (bflo(v.w) - bfhi(v.w)); }
        s = wave_sum(s, lane);
        const float y = (s + AH[row]) * 0.022097087f;
        bf16_t* zrow = Z + (size_t)(b * 2048 + 1024) * 2048 + g * 256;
        if (lane == 0) zrow[mt] = (bf16_t)f2bf(y * bf1(zrow[mt]));
        if (lane == 1 && mt >= 1 && mt <= 127) zrow[256 - mt] = (bf16_t)f2bf(y * bf1(zrow[256 - mt]));
    }
}
__device__ __forceinline__ bf16_t* s_chunk(unsigned char* ws, int h, int rc) {
    return rc < 56 ? (bf16_t*)(ws + WS_SA) + ((size_t)(h * 56 + rc) << 14) : (bf16_t*)(ws + WS_SB) + ((size_t)(h * 88 + rc - 56) << 14);
}
struct DiagOrder {
    int G, c;
    __device__ bool next(int i, pg8::Unit& u) const { const int L = i * G + c; if (L >= 288) return false; u.aux = L / 72; u.pm = L - 72 * u.aux; u.pn = u.pm; return true; }
    __device__ __forceinline__ const char* a_ptr(const pg8::Gemm& g, const pg8::Unit& u) const { return (const char*)(g.A + ((size_t)(2 * u.pm) * 4 + u.aux) * 32768); }
    __device__ __forceinline__ const char* b_ptr(const pg8::Gemm& g, const pg8::Unit& u, int half) const { return (const char*)(g.Bt + ((size_t)(2 * u.pm + half) * 4 + u.aux) * 32768); }
    __device__ __forceinline__ bool b_mirror(const pg8::Unit&) const { return false; }
    __device__ __forceinline__ bool b_fix(const pg8::Unit&) const { return false; }
    __device__ __forceinline__ int ktiles(const pg8::Gemm& g, const pg8::Unit&) const { return g.K / pg8::BK; }
};
struct EpiS {
    static constexpr bool PERM = true;
    unsigned char* ws;
    __device__ __forceinline__ void operator()(AccRef acc, const pg8::Unit& u, int wr, int wc, int fr, int fq) const {
#pragma unroll
        for (int ai = 0; ai < 2; ++ai) { bf16_t* sp = s_chunk(ws, u.aux, 2 * u.pm + ai);
#pragma unroll
            for (int m = 0; m < 4; ++m) { const f32x4 v0 = acc[ai][ai][m][0], v1 = acc[ai][ai][m][1]; u32x4 w;
                w.x = cvt_pk_bf16(v0[0], v0[1]); w.y = cvt_pk_bf16(v0[2], v0[3]); w.z = cvt_pk_bf16(v1[0], v1[1]); w.w = cvt_pk_bf16(v1[2], v1[3]);
                *(u32x4*)(sp + ((((wr * 4 + m) * 4 + wc) * 64 + fq * 16 + fr) << 3)) = w; } }
    }
};
struct QKVOrder : pg8::TileOrder {
    int i0, i1;
    __device__ void init2(int G_, int c_, int i0_, int i1_) { nM = 72; nN = 16; nwg = 1152; G = G_; c = c_; i0 = i0_; i1 = i1_; }
    __device__ bool next(int i, pg8::Unit& u) const {
        const int ii = i + i0; if (ii >= i1) return false;
        const int L = ii * G + c; if (L >= 1152) return false;
        if (L < 576) { map(L, 72, 8, u); } else if (L < 1008) { map(L - 576, 72, 6, u); u.pn += 8; } else { map(L - 1008, 72, 2, u); u.pn += 14; }
        return true;
    }
};
#define XQ_SUB(l, j) (3584 + 64 * ((l) * 16 + (j)))
#define XQ_TOP(l)    (7744 + 64 * (l))
__device__ __forceinline__ void xq_arrive(const XcdBarrier& b, int layer) {
    asm volatile("s_waitcnt vmcnt(0)" ::: "memory");
    __syncthreads();
    if (threadIdx.x == 0) {
        const unsigned nloc = b.st[0];
        const unsigned old = xb_add(&b.bar[XQ_SUB(layer, b.x)], 1u);
        if (old + 1u == nloc) { __builtin_amdgcn_fence(__ATOMIC_RELEASE, "agent"); asm volatile("s_waitcnt vmcnt(0)" ::: "memory"); xb_add(&b.bar[XQ_TOP(layer)], 1u); }
    }
}
__device__ __forceinline__ void xq_wait(const XcdBarrier& b, int layer) {
    if (threadIdx.x == 0) {
        const unsigned nx = b.st[1];
        XB_SPIN(xb_ld(&b.bar[XQ_TOP(layer)]) < nx, b.bar);
        __builtin_amdgcn_fence(__ATOMIC_ACQUIRE, "agent");
        asm volatile("s_waitcnt vmcnt(0)" ::: "memory");
    }
    __syncthreads();
}
typedef short bf16x4 __attribute__((ext_vector_type(4)));
typedef short v4i16_t __attribute__((ext_vector_type(4)));
__device__ __forceinline__ bf16x8 ldtr2(const LAS unsigned char* p0, const LAS unsigned char* p1) {
    const bf16x4 lo = __builtin_bit_cast(bf16x4, __builtin_amdgcn_ds_read_tr16_b64_v4i16((LAS v4i16_t*)p0));
    const bf16x4 hi = __builtin_bit_cast(bf16x4, __builtin_amdgcn_ds_read_tr16_b64_v4i16((LAS v4i16_t*)p1));
    return __builtin_shufflevector(lo, hi, 0, 1, 2, 3, 4, 5, 6, 7);
}
__device__ __forceinline__ int blk_perm(int rb) { return (rb & ~3) | ((rb >> 1) & 1) | ((rb & 1) << 1); }
__device__ __forceinline__ int scan_t0(int dir, int b, int s) {
    return dir == 0 ? ((s < 2) ? (NLAT + b * CTXL + s * 128) : (b * SEQ + (s - 2) * 128)) : ((s < 2) ? (NLAT + b * CTXL + (1 - s) * 128) : (b * SEQ + (17 - s) * 128));
}
__device__ __forceinline__ int scan_rc(int dir, int b, int s) {
    return dir == 0 ? ((s < 2) ? (128 + b * 2 + s) : (b * 16 + (s - 2))) : ((s < 2) ? (128 + b * 2 + (1 - s)) : (b * 16 + (17 - s)));
}
__device__ __forceinline__ u32x4 ldg16(const void* ub, unsigned voff) { return *(const GAS u32x4*)((const GAS unsigned char*)ub + voff); }
__device__ __forceinline__ void scan_load_s(u32x4 (&sf)[4], unsigned char* ws, int h, int rc, int w, int r, int q) {
    const bf16_t* ub = s_chunk(ws, h, rc) + w * 2048; const unsigned vo = (unsigned)(16 * q + r) * 16u;
#pragma unroll
    for (int ks = 0; ks < 4; ++ks) sf[ks] = ldg16(ub, vo + 1024u * ks);
}
__device__ __forceinline__ void scan_load_q(u32x4 (&qf)[8], const bf16_t* Qg, int h, int t0, int w, int r, int q) {
    const bf16_t* ub = Qg + (((size_t)(t0 >> 7) * 4 + h) * 8 + w) * 4096; const unsigned vo = (unsigned)(16 * q + r) * 16u;
#pragma unroll
    for (int ks = 0; ks < 8; ++ks) qf[ks] = ldg16(ub, vo + 1024u * ks);
}
__device__ __forceinline__ void scan_load_kv(u32x4 (&kr)[8], u32x4 (&vr)[2], const bf16_t* Kg, const bf16_t* Vg, int h, int sl, int t0, int w, int lane, int tid) {
    const bf16_t* kb = Kg + (((size_t)(t0 >> 7) * 4 + h) * 8 + w) * 4096; const unsigned ko = (unsigned)lane * 16u;
#pragma unroll
    for (int it = 0; it < 8; ++it) kr[it] = ldg16(kb, ko + 1024u * it);
    const bf16_t* vb = Vg + (size_t)t0 * 2048 + h * 512 + sl * 64; const unsigned vo = (unsigned)((tid >> 3) * 2048 + 8 * (tid & 7)) * 2u;
#pragma unroll
    for (int i = 0; i < 2; ++i) vr[i] = ldg16(vb + (size_t)i * 64 * 2048, vo);
}
#ifndef DBG_SEG
#define DBG_SEG -1
#endif
#define SEG_MARK(k) do { if (DBG_SEG >= 0) { __builtin_amdgcn_sched_barrier(0); const unsigned long long t_ = __builtin_amdgcn_s_memtime(); if (DBG_SEG == (k)) segacc += t_ - segt; segt = t_; __builtin_amdgcn_sched_barrier(0); } } while (0)
template <int DIR>
__device__ __forceinline__ void scan_step(unsigned long long& segacc, unsigned long long& segt, LAS unsigned char* lds, u32x4 (&sf)[4], u32x4 (&qf)[8], u32x4 (&kr)[8], u32x4 (&vr)[2], f32x4 (&Rb)[2][4], const float (&wm)[2], float rsc, float g128,
                                          int t0, int t0n, int rcn, unsigned char* ws, int h, int sl, int w, int lane_in, int tid_in, const bf16_t* Qg, const bf16_t* Kg, const bf16_t* Vg, bf16_t* OF, float* SSP) {
    int lane = lane_in; asm volatile("" : "+v"(lane));
    const int tid = (tid_in & ~63) | lane;
    const int r = lane & 15, q = lane >> 4;
    LAS unsigned char* VI = lds + SC_V_OFF; LAS unsigned char* RT = lds + SC_RT_OFF; LAS unsigned char* KI = lds + SC_K_OFF + w * 8192;
    SEG_MARK(5);
#pragma unroll
    for (int i = 0; i < 2; ++i) { const int m = (tid >> 3) + 64 * i, e0 = 8 * (tid & 7); const float sc = wm[i]; const u32x4 v = vr[i]; u32x4 o;
        o.x = cvt_pk_bf16(bflo(v.x) * sc, bfhi(v.x) * sc); o.y = cvt_pk_bf16(bflo(v.y) * sc, bfhi(v.y) * sc); o.z = cvt_pk_bf16(bflo(v.z) * sc, bfhi(v.z) * sc); o.w = cvt_pk_bf16(bflo(v.w) * sc, bfhi(v.w) * sc);
        *(LAS u32x4*)(VI + 128 * ((e0 >> 4) * 32 + blk_perm(m >> 2)) + (m & 3) * 32 + (e0 & 15) * 2) = o; }
#pragma unroll
    for (int it = 0; it < 8; ++it) { const int m = it * 16 + (lane >> 2), dc = lane & 3;
        *(LAS u32x4*)(KI + 128 * ((dc >> 1) * 32 + blk_perm(m >> 2)) + (m & 3) * 32 + (dc & 1) * 16) = kr[it]; }
    SEG_MARK(0);
    asm volatile("s_waitcnt lgkmcnt(0)" ::: "memory"); __builtin_amdgcn_s_barrier(); asm volatile("" ::: "memory");
    SEG_MARK(1);
    const int jl = 16 * w + r;
    { const bf16_t* vb = Vg + (size_t)t0n * 2048 + h * 512 + sl * 64; const unsigned vo = (unsigned)((tid >> 3) * 2048 + 8 * (tid & 7)) * 2u;
#pragma unroll
      for (int i = 0; i < 2; ++i) vr[i] = ldg16(vb + (size_t)i * 64 * 2048, vo); }
    GAS unsigned char* ob = (GAS unsigned char*)(OF + ((size_t)((((t0 >> 7) * 4 + h) * 8 + sl) * 8 + w) << 10)); const unsigned oo = (unsigned)lane * 8u;
    f32x4 O[4];
#pragma unroll
    for (int eb = 0; eb < 4; ++eb) O[eb] = (f32x4){0.f, 0.f, 0.f, 0.f};
    const LAS unsigned char* rtb = RT + r * 528 + q * 16;
    const bf16_t* qub = Qg + (((size_t)(t0n >> 7) * 4 + h) * 8 + w) * 4096; const unsigned qvo = (unsigned)(16 * q + r) * 16u;
    const bf16_t* kub = Kg + (((size_t)(t0n >> 7) * 4 + h) * 8 + w) * 4096; const unsigned kvo = (unsigned)lane * 16u;
    bf16x8 avp[2][4];
#pragma unroll
    for (int eb = 0; eb < 4; ++eb) avp[0][eb] = *(const LAS bf16x8*)(rtb + (16 * eb * 528));
#pragma unroll
    for (int ks = 0; ks < 8; ++ks) { const bf16x8 qv = __builtin_bit_cast(bf16x8, qf[ks]);
        if (ks < 7) {
#pragma unroll
            for (int eb = 0; eb < 4; ++eb) avp[(ks + 1) & 1][eb] = *(const LAS bf16x8*)(rtb + (16 * eb * 528 + 64 * (ks + 1)));
            asm volatile("s_waitcnt lgkmcnt(4)" ::: "memory"); }
        else asm volatile("s_waitcnt lgkmcnt(0)" ::: "memory");
        __builtin_amdgcn_sched_barrier(0);
#pragma unroll
        for (int eb = 0; eb < 4; ++eb) O[eb] = __builtin_amdgcn_mfma_f32_16x16x32_bf16(avp[ks & 1][eb], qv, O[eb], 0, 0, 0);
        if (w < 4) { qf[ks] = ldg16(qub, qvo + 1024u * ks); kr[ks] = ldg16(kub, kvo + 1024u * ks); }
        __builtin_amdgcn_sched_barrier(0); }
    u32x2 pvf[4];
    if (DIR == 1) {
#pragma unroll
        for (int eb = 0; eb < 4; ++eb) pvf[eb] = *(const GAS u32x2*)(ob + oo + 512 * eb); }
    SEG_MARK(2);
    const int lofs = 128 * (4 * (q >> 1) + (q & 1)) + 8 * r;
    const LAS unsigned char* vtb = VI + lofs; const LAS unsigned char* ktb = KI + lofs;
#pragma unroll
    for (int ks = 0; ks < 4; ++ks) {
        bf16x8 vb[4], ka[2];
#pragma unroll
        for (int eb = 0; eb < 4; ++eb) vb[eb] = ldtr2(vtb + 128 * (eb * 32 + 8 * ks), vtb + 128 * (eb * 32 + 8 * ks + 2));
#pragma unroll
        for (int db = 0; db < 2; ++db) ka[db] = ldtr2(ktb + 128 * (db * 32 + 8 * ks), ktb + 128 * (db * 32 + 8 * ks + 2));
        __builtin_amdgcn_sched_barrier(0);
        bf16x8 sfm;
        { unsigned wd[4] = {sf[ks].x, sf[ks].y, sf[ks].z, sf[ks].w};
#pragma unroll
          for (int i = 0; i < 4; ++i) { const int m0 = 32 * ks + 8 * q + 2 * i; const bool k0 = DIR == 0 ? (m0 <= jl) : (m0 >= jl), k1 = DIR == 0 ? (m0 + 1 <= jl) : (m0 + 1 >= jl);
              wd[i] &= (k0 ? 0xffffu : 0u) | (k1 ? 0xffff0000u : 0u); }
          sfm = __builtin_bit_cast(bf16x8, (u32x4){wd[0], wd[1], wd[2], wd[3]}); }
#pragma unroll
        for (int eb = 0; eb < 4; ++eb) O[eb] = __builtin_amdgcn_mfma_f32_16x16x32_bf16(vb[eb], sfm, O[eb], 0, 0, 0);
#pragma unroll
        for (int db = 0; db < 2; ++db)
#pragma unroll
            for (int eb = 0; eb < 4; ++eb) Rb[db][eb] = __builtin_amdgcn_mfma_f32_16x16x32_bf16(ka[db], vb[eb], Rb[db][eb], 0, 0, 0);
        if (w >= 4) {
            qf[2 * ks] = ldg16(qub, qvo + 1024u * (2 * ks)); qf[2 * ks + 1] = ldg16(qub, qvo + 1024u * (2 * ks + 1));
            kr[2 * ks] = ldg16(kub, kvo + 1024u * (2 * ks)); kr[2 * ks + 1] = ldg16(kub, kvo + 1024u * (2 * ks + 1)); }
    }
    SEG_MARK(3);
    scan_load_s(sf, ws, h, rcn, w, r, q);
    {
        float ss = 0.f;
#pragma unroll
        for (int eb = 0; eb < 4; ++eb) { f32x4 v = O[eb] * rsc;
            if (DIR == 1) { const u32x2 pv = pvf[eb]; v[0] += bflo(pv.x); v[1] += bfhi(pv.x); v[2] += bflo(pv.y); v[3] += bfhi(pv.y);
                ss += (v[0] * v[0] + v[1] * v[1]) + (v[2] * v[2] + v[3] * v[3]); }
            u32x2 o; o.x = cvt_pk_bf16(v[0], v[1]); o.y = cvt_pk_bf16(v[2], v[3]); *(GAS u32x2*)(ob + oo + 512 * eb) = o; }
        if (DIR == 1) { ss += shx(ss, 16, lane); ss += shx(ss, 32, lane); if (q == 0) *(GAS float*)((GAS unsigned char*)(SSP + (size_t)(t0 + 16 * w) * 32 + h * 8 + sl) + (unsigned)r * 128u) = ss; }
    }
#pragma unroll
    for (int db = 0; db < 2; ++db)
#pragma unroll
        for (int eb = 0; eb < 4; ++eb) Rb[db][eb] = Rb[db][eb] * g128;
    SEG_MARK(4);
    asm volatile("s_waitcnt lgkmcnt(0)" ::: "memory"); __builtin_amdgcn_s_barrier(); asm volatile("" ::: "memory");
    SEG_MARK(6);
#pragma unroll
    for (int db = 0; db < 2; ++db)
#pragma unroll
        for (int eb = 0; eb < 4; ++eb) { u32x2 o; o.x = cvt_pk_bf16(Rb[db][eb][0], Rb[db][eb][1]); o.y = cvt_pk_bf16(Rb[db][eb][2], Rb[db][eb][3]);
            *(LAS u32x2*)(RT + (16 * eb + r) * 528 + (32 * w + 16 * db + 4 * q) * 2) = o; }
}
template <int DIR>
__device__ __forceinline__ void scan_unit(Frame& F, int tid, unsigned char* ws, int b, int h, int sl, float lg, const bf16_t* Qg, const bf16_t* Kg, const bf16_t* Vg, bf16_t* OF, float* SSP) {
    const int lane = tid & 63, w = __builtin_amdgcn_readfirstlane(tid >> 6), r = lane & 15, q = lane >> 4;
    const float g128 = __expf(128.f * lg);
    float wm[2];
#pragma unroll
    for (int i = 0; i < 2; ++i) { const int m = (tid >> 3) + 64 * i; wm[i] = __expf(lg * (float)(DIR == 0 ? 127 - m : m)); }
    const int jl = 16 * w + r; const float rsc = __expf(lg * (float)(DIR == 0 ? jl - 127 : -jl));
    f32x4 Rb[2][4];
#pragma unroll
    for (int db = 0; db < 2; ++db)
#pragma unroll
        for (int eb = 0; eb < 4; ++eb) Rb[db][eb] = (f32x4){0.f, 0.f, 0.f, 0.f};
    {
        LAS unsigned char* RT = F.lds + SC_RT_OFF;
#pragma unroll
        for (int db = 0; db < 2; ++db)
#pragma unroll
            for (int eb = 0; eb < 4; ++eb) *(LAS u32x2*)(RT + (16 * eb + r) * 528 + (32 * w + 16 * db + 4 * q) * 2) = (u32x2){0u, 0u};
    }
    u32x4 sf[4], qf[8], kr[8], vr[2];
    unsigned long long segacc = 0ull, segt = (DBG_SEG >= 0) ? __builtin_amdgcn_s_memtime() : 0ull;
    scan_load_s(sf, ws, h, scan_rc(DIR, b, 0), w, r, q);
    scan_load_q(qf, Qg, h, scan_t0(DIR, b, 0), w, r, q);
    scan_load_kv(kr, vr, Kg, Vg, h, sl, scan_t0(DIR, b, 0), w, lane, tid);
    for (int s = 0; s < 18; ++s) {
        const int sn = (s + 1 < 18) ? s + 1 : 17;
        scan_step<DIR>(segacc, segt, F.lds, sf, qf, kr, vr, Rb, wm, rsc, g128, scan_t0(DIR, b, s), scan_t0(DIR, b, sn), scan_rc(DIR, b, sn), ws, h, sl, w, lane, tid, Qg, Kg, Vg, OF, SSP);
    }
    if (DBG_SEG >= 0) { const unsigned long long te_ = __builtin_amdgcn_s_memtime() + segacc; while (__builtin_amdgcn_s_memtime() < te_) __builtin_amdgcn_s_sleep(4); }
    __syncthreads();
}
__device__ __forceinline__ void scan_phase(Frame& F, const Args& a, int layer, int dir) {
    PHASE_IDS();
    const int j = layer >> 1; const float* dec = a.in[11] + j * 8 + dir * 4;
    for (int u = F.vcu; u < 256; u += F.G) {
        const int b = u >> 5, h = (u >> 3) & 3, sl = u & 7;
        const float lg = log1pf(-exp2f(dec[h]));
        if (dir == 0) scan_unit<0>(F, tid, ws, b, h, sl, lg, (const bf16_t*)(ws + WS_Q), (const bf16_t*)(ws + WS_K), (const bf16_t*)(ws + WS_V), (bf16_t*)(ws + WS_OF), (float*)(ws + WS_SSP));
        else scan_unit<1>(F, tid, ws, b, h, sl, lg, (const bf16_t*)(ws + WS_Q), (const bf16_t*)(ws + WS_K), (const bf16_t*)(ws + WS_V), (bf16_t*)(ws + WS_OF), (float*)(ws + WS_SSP));
    }
}
__device__ __forceinline__ void n2_phase(Frame& F, const Args& a, int layer) {
    PHASE_IDS();
    norm_rows<false>(F, a, layer, (bf16_t*)(ws + WS_Q));
    const float* SSP = (const float*)(ws + WS_SSP); float* RINV = (float*)(ws + WS_RINV);
    const int gt = F.vcu * 512 + tid, NT = F.G * 512;
    for (int idx = gt; idx < NTOK * 4; idx += NT) { const f32x4 p0 = *(const f32x4*)(SSP + (size_t)idx * 8), p1 = *(const f32x4*)(SSP + (size_t)idx * 8 + 4);
        const float ss = ((p0.x + p0.y) + (p0.z + p0.w)) + ((p1.x + p1.y) + (p1.z + p1.w)); RINV[idx] = rsqrtf(ss * (1.f / 512.f) + EPS); }
}
__device__ __forceinline__ void final_phase(Frame& F, const Args& a) {
    PHASE_IDS();
    const float* fg = a.in[12]; const int gw = F.vcu * 8 + wave, NGW = F.G * 8;
    f32x4 g[4];
#pragma unroll
    for (int jj = 0; jj < 4; ++jj) g[jj] = *(const f32x4*)(fg + 4 * lane + 256 * jj);
    for (int m0 = gw; m0 < NLAT; m0 += 4 * NGW) {
        f32x4 v[4][4]; float ss[4];
#pragma unroll
        for (int t = 0; t < 4; ++t) { const int m = (m0 + t * NGW) < NLAT ? (m0 + t * NGW) : gw; const f32x4* xr = (const f32x4*)(a.out + (size_t)m * DM) + lane;
#pragma unroll
            for (int jj = 0; jj < 4; ++jj) v[t][jj] = xr[64 * jj]; }
#pragma unroll
        for (int t = 0; t < 4; ++t) { float s = 0.f;
#pragma unroll
            for (int jj = 0; jj < 4; ++jj) s += (v[t][jj].x * v[t][jj].x + v[t][jj].y * v[t][jj].y) + (v[t][jj].z * v[t][jj].z + v[t][jj].w * v[t][jj].w);
            ss[t] = s; }
#pragma unroll
        for (int o = 1; o < 64; o <<= 1) {
#pragma unroll
            for (int t = 0; t < 4; ++t) ss[t] += shx(ss[t], o, lane); }
#pragma unroll
        for (int t = 0; t < 4; ++t) { const int m = m0 + t * NGW; if (m < NLAT) { const float rinv = rsqrtf(ss[t] * (1.f / DM) + EPS); f32x4* xw = (f32x4*)(a.out + (size_t)m * DM) + lane;
#pragma unroll
            for (int jj = 0; jj < 4; ++jj) xw[64 * jj] = v[t][jj] * rinv * g[jj]; } }
    }
}

constexpr int N_PHASES = 34;
__global__ void __launch_bounds__(512, 2) trunk_fwd(Args args) {
    extern __shared__ __attribute__((aligned(16))) unsigned char lds_raw[];
    Frame F;
    F.lds = (LAS unsigned char*)lds_raw;
    F.G = gridDim.x; F.wv = __builtin_amdgcn_readfirstlane((int)threadIdx.x >> 6); { const int bx = blockIdx.x; F.vcu = (F.G % 8 == 0) ? (bx % 8) * (F.G / 8) + bx / 8 : bx; }
    F.ws = args.ws;
    volatile LAS unsigned* MISC = (volatile LAS unsigned*)(F.lds + MISC_OFF);
    for (int u = threadIdx.x; u < 128; u += 512) MISC[u] = 0u;
    __syncthreads();
    const int lo = args.ph_lo, hi = args.ph_hi;
    XcdBarrier bar; bar.bar = (unsigned*)(args.ws + WS_CTL) + 4096; bar.x = 0; bar.st = nullptr;
    const bool multi = (hi - lo) > 1;
    if (multi) bar = xcd_barrier_post((unsigned*)(args.ws + WS_CTL) + 4096, MISC + 8);
#ifndef KINDS
#define KINDS 0xFFFF
#endif
#define KON(b) (((KINDS) >> (b)) & 1)
#define IN(k) (lo <= (k) && (k) < hi)
#ifndef DBG_PROBE
#define DBG_PROBE -1
#endif
    unsigned long long tph0 = (DBG_PROBE >= 0) ? __builtin_amdgcn_s_memrealtime() : 0ull; int cur_layer = -1;
#ifndef DBG_PLAYER
#define DBG_PLAYER -1
#endif
#define PROBE(kind) do { if (DBG_PROBE == (kind) && (DBG_PLAYER < 0 || DBG_PLAYER == cur_layer)) { const unsigned long long t1_ = __builtin_amdgcn_s_memrealtime(); const unsigned long long te_ = t1_ + (t1_ - tph0); while (__builtin_amdgcn_s_memrealtime() < te_) __builtin_amdgcn_s_sleep(8); } } while (0)
#define SEAM(k) do { if (multi && (k) + 1 < hi) xcd_barrier(bar); if (DBG_PROBE >= 0) tph0 = __builtin_amdgcn_s_memrealtime(); } while (0)
    const int bx = (int)blockIdx.x, G = F.G;
    const bool mergeS = multi && G == 256 && lo == 0;
    if (KON(0) && IN(0)) { p0_phase(F, args); p0_conv(F, args); PROBE(0); SEAM(0); }
    for (int layer = 0; layer < NLAYER; ++layer) {
        const int pb = 1 + 8 * layer; const bool fourier = (layer & 1) == 0; cur_layer = layer;
        unsigned char* ws = launder_ptr(args.ws);
#define MAKE_ER() const EpiResid ER{layer == 0 ? args.in[0] : args.out, args.out, (const float*)(ws + WS_ADA) + layer * 9 * 3072 + 2048, (float*)(ws + WS_PART)}
        if (KON(1) && IN(pb)) { n_phase(F, args, layer); PROBE(1); SEAM(pb); }
        if (fourier) {
            bf16_t* W1 = (bf16_t*)(ws + WS_WF);
            if (KON(2) && IN(pb + 1)) {
                { pg8::Gemm g{(const bf16_t*)(ws + WS_H), W1 + (size_t)2048 * 1024, 1024, 1024, 1024}; pg8::TileOrder S; S.init(72, 8, G, bx);
                  EpiSilu E{(bf16_t*)(ws + WS_Z), 2048}; pg8::gemm_phase(F.lds, F.wv, g, S, E); }
                { pg8::Gemm g{W1, (const bf16_t*)(ws + WS_H), 1024, 1024, 1024}; UOrder S; S.init(8, 72, G, (bx + 64) % G);
                  EpiUTF E{(bf16_t*)(ws + WS_UTL), (bf16_t*)(ws + WS_UTC), (float*)(ws + WS_RINV)}; pg8::gemm_phase<EpiUTF, UOrder, true>(F.lds, F.wv, g, S, E); }
                bg_conv_ret(F, args, layer, 64, 0, 1024);
                PROBE(2); SEAM(pb + 1);
            }
            if (KON(3) && IN(pb + 2)) {
                { pg8::Gemm g{(const bf16_t*)(ws + WS_CS), (const bf16_t*)(ws + WS_UTL), 1024, 1024, 1024}; pg8::TileOrder S; S.init(8, 64, G, bx);
                  EpiDft<true> E{(bf16_t*)(ws + WS_Z), 2048, 0, (const float*)(ws + WS_RINV)}; pg8::gemm_phase(F.lds, F.wv, g, S, E); }
                { pg8::Gemm g{(const bf16_t*)(ws + WS_CS256), (const bf16_t*)(ws + WS_UTC), 256, 256, 256}; pg8::TileOrder S; S.init(2, 64, G, bx);
                  EpiDft<false> E{(bf16_t*)(ws + WS_Z), 256, NLAT, nullptr}; pg8::gemm_phase(F.lds, F.wv, g, S, E); }
                nyq_row_phase(F);
                bg_conv_ret(F, args, layer, 128, 1024, 1536);
                PROBE(3); SEAM(pb + 2);
            }
            if (KON(4) && IN(pb + 3)) {
                pg8::Gemm g{(const bf16_t*)(ws + WS_Z), W1 + (size_t)4096 * 1024, 2048, 2048, 2048}; OutOrder S; S.init(G, bx, true); MAKE_ER();
                pg8::gemm_phase(F.lds, F.wv, g, S, ER);
                bg_conv_ret(F, args, layer, 128, 1536, 2048);
                PROBE(4); SEAM(pb + 3);
            }
        } else {
            bf16_t* W1 = (bf16_t*)(ws + WS_W);
            if (KON(5) && IN(pb + 1)) {
                pg8::Gemm g{(const bf16_t*)(ws + WS_OF), W1, 1024, 1024, 1024};
                EpiQKV E{(bf16_t*)(ws + WS_Q), (bf16_t*)(ws + WS_K), (bf16_t*)(ws + WS_V), (const float*)(ws + WS_ROPE), (const float*)(ws + WS_ROPE) + 4096};
                if (mergeS) {
                    { QKVOrder S; S.init2(G, bx, 0, 4); pg8::gemm_phase(F.lds, F.wv, g, S, E); }
                    xq_arrive(bar, layer);
                    if (bx < 128) { QKVOrder S; S.init2(G, bx, 4, 5); pg8::gemm_phase(F.lds, F.wv, g, S, E); }
                    else { xq_wait(bar, layer);
                        pg8::Gemm gs{(const bf16_t*)(ws + WS_Q), (const bf16_t*)(ws + WS_K), 1024, 1024, 256}; DiagOrder S{128, bx - 128};
                        EpiS ES{ws}; pg8::gemm_phase<EpiS, DiagOrder, false, true>(F.lds, F.wv, gs, S, ES); }
                } else { pg8::TileOrder S; S.init(72, 16, G, bx); pg8::gemm_phase(F.lds, F.wv, g, S, E); }
                PROBE(5); SEAM(pb + 1);
            }
            if (KON(6) && IN(pb + 2)) {
                if (!mergeS) {
                    { pg8::Gemm g{(const bf16_t*)(ws + WS_Q), (const bf16_t*)(ws + WS_K), 1024, 1024, 256}; DiagOrder S{G, bx};
                      EpiS E{ws}; pg8::gemm_phase<EpiS, DiagOrder, false, true>(F.lds, F.wv, g, S, E); }
                    PROBE(11); if (multi) xcd_barrier(bar); if (DBG_PROBE >= 0) tph0 = __builtin_amdgcn_s_memrealtime(); }
                scan_phase(F, args, layer, 0); PROBE(6);
            }
            if (KON(6) && IN(pb + 3)) {
                if (multi) { asm volatile("s_waitcnt vmcnt(0)" ::: "memory"); __syncthreads();
                    if (threadIdx.x == 0) { __builtin_amdgcn_fence(__ATOMIC_ACQUIRE, "agent"); asm volatile("s_waitcnt vmcnt(0)" ::: "memory"); }
                    __syncthreads(); if (DBG_PROBE >= 0) tph0 = __builtin_amdgcn_s_memrealtime(); }
                scan_phase(F, args, layer, 1); PROBE(12); SEAM(pb + 3); }
            if (KON(7) && IN(pb + 4)) { n2_phase(F, args, layer); PROBE(7); SEAM(pb + 4); }
            if (KON(8) && IN(pb + 5)) {
                pg8::Gemm g{(const bf16_t*)(ws + WS_Q), W1 + (size_t)4096 * 1024, 1024, 1024, 1024}; pg8::TileOrder S; S.init(layer == NLAYER - 1 ? 64 : 72, 8, G, bx);
                EpiZGate E{(const bf16_t*)(ws + WS_OF), (const float*)(ws + WS_RINV), (bf16_t*)(ws + WS_V)};
                pg8::gemm_phase(F.lds, F.wv, g, S, E);
                PROBE(8); SEAM(pb + 5);
            }
            if (KON(9) && IN(pb + 6)) {
                pg8::Gemm g{(const bf16_t*)(ws + WS_V), W1 + (size_t)6144 * 1024, 2048, 2048, 2048}; OutOrder S; S.init(G, bx, layer != NLAYER - 1); MAKE_ER();
                pg8::gemm_phase(F.lds, F.wv, g, S, ER);
                PROBE(9); SEAM(pb + 6);
            }
        }
    }
    if (KON(10) && IN(33)) { final_phase(F, args); PROBE(10); }
#undef IN
#undef SEAM
}

extern "C" void kernel_launch(void* const* d_in, const int* in_sizes, int n_in, void* d_out, int out_size, void* d_ws, size_t ws_size, hipStream_t stream) {
    static int grid = 0;
    if (grid == 0) {
        if (n_in != 13 || out_size != NLAT * DM || ws_size < WS_END) { fprintf(stderr, "kernel_launch: unexpected problem (n_in %d, out %d, ws %zu)\n", n_in, out_size, ws_size); grid = -1; return; }
        int dev = 0, cus = 0;
        if (hipGetDevice(&dev) != hipSuccess || hipDeviceGetAttribute(&cus, hipDeviceAttributeMultiprocessorCount, dev) != hipSuccess) { grid = -1; return; }
        if (hipFuncSetAttribute((const void*)trunk_fwd, hipFuncAttributeMaxDynamicSharedMemorySize, LDS_BYTES) != hipSuccess) { fprintf(stderr, "kernel_launch: hipFuncSetAttribute failed\n"); grid = -1; return; }
        (void)hipGetLastError();
        grid = cus;
    }
    if (grid < 0) return;
    if (hipMemsetAsync((char*)d_ws + WS_CTL, 0, CTL_ZERO_BYTES, stream) != hipSuccess) return;
    Args a{};
    for (int i = 0; i < 13; ++i) a.in[i] = (const float*)d_in[i];
    a.out = (float*)d_out; a.ws = (unsigned char*)d_ws;
    a.ph_lo = 0; a.ph_hi = N_PHASES;
    hipLaunchKernelGGL(trunk_fwd, dim3(grid), dim3(512), LDS_BYTES, stream, a);
}
```

```cpp
#include <hip/hip_runtime.h>
#include <cstdio>
#include <cstdint>

#define LAS __attribute__((address_space(3)))
#define GAS __attribute__((address_space(1)))
typedef unsigned short bf16_t;
typedef short bf16x8 __attribute__((ext_vector_type(8)));
typedef float f32x4 __attribute__((ext_vector_type(4)));
typedef float f32x16 __attribute__((ext_vector_type(16)));
typedef unsigned u32x4 __attribute__((ext_vector_type(4)));
typedef unsigned u32x2 __attribute__((ext_vector_type(2)));

constexpr int DM = 1024, NB = 8, SEQ = 2048, CTXL = 256, DBR = 2048, NLAYER = 4;
constexpr int NLAT = NB * SEQ, NCTX = NB * CTXL, NTOK = NLAT + NCTX;
constexpr float EPS = 1e-6f;

constexpr size_t MiB = 1u << 20;
constexpr size_t KiB = 1024;
constexpr size_t WS_CTL = 0, CTL_ZERO_BYTES = 64 * KiB;
constexpr size_t WS_ADA = 256 * KiB;
constexpr size_t WS_TC = 768 * KiB;
constexpr size_t WS_ROPE = 1024 * KiB;
constexpr size_t WS_CS256 = 1088 * KiB;
constexpr size_t WS_RINV = 1344 * KiB;
constexpr size_t WS_XCTX = 2 * MiB;
constexpr size_t WS_W = 10 * MiB;
constexpr size_t WS_R = 26 * MiB;
constexpr size_t WS_H = WS_R;
constexpr size_t WS_Z = WS_R + 36 * MiB;
constexpr size_t WS_UTL = WS_R + 108 * MiB;
constexpr size_t WS_UTC = WS_R + 172 * MiB;
constexpr size_t WS_CS = WS_R + 180 * MiB;
constexpr size_t WS_WF = WS_R + 144 * MiB;
constexpr size_t WS_Q = WS_R;
constexpr size_t WS_K = WS_R + 36 * MiB;
constexpr size_t WS_V = WS_R + 72 * MiB;
constexpr size_t WS_OF = WS_R + 144 * MiB;
constexpr size_t WS_PART = WS_R + 184 * MiB;
constexpr size_t WS_SSP = WS_R + 216 * MiB;
constexpr size_t WS_SA = WS_W;
constexpr size_t WS_SB = WS_R + 219 * MiB;
constexpr size_t WS_END = 256 * MiB;
static_assert(WS_SSP + (size_t)NTOK * 32 * 4 <= WS_SB && WS_SB + 11 * MiB <= WS_END && WS_CS + 16 * MiB <= WS_END && WS_RINV + 288 * KiB <= WS_XCTX, "ws map");

constexpr int LDS_BYTES = 147456;
constexpr int RING_BYTES = 131072;
constexpr int SC_V_OFF = 0;
constexpr int SC_RT_OFF = 16384;
constexpr int SC_K_OFF = 16384 + 33792;
constexpr int MISC_OFF = 145408;
static_assert(SC_K_OFF + 65536 <= MISC_OFF && MISC_OFF + 512 <= LDS_BYTES, "lds map");

__device__ __forceinline__ unsigned f2bf(float f) { unsigned u = __builtin_bit_cast(unsigned, f); return (u + 0x7fffu + ((u >> 16) & 1u)) >> 16; }
__device__ __forceinline__ unsigned pk2(float lo, float hi) { return f2bf(lo) | (f2bf(hi) << 16); }
__device__ __forceinline__ float bflo(unsigned w) { return __builtin_bit_cast(float, w << 16); }
__device__ __forceinline__ float bfhi(unsigned w) { return __builtin_bit_cast(float, w & 0xffff0000u); }
__device__ __forceinline__ float bf1(bf16_t h) { return __builtin_bit_cast(float, (unsigned)h << 16); }
__device__ __forceinline__ float silu_f(float x) { return x * __builtin_amdgcn_rcpf(1.f + __expf(-x)); }
__device__ __forceinline__ float shx(float v, int o, int lane) { return __builtin_bit_cast(float, __builtin_amdgcn_ds_bpermute((lane ^ o) << 2, __builtin_bit_cast(int, v))); }
__device__ __forceinline__ float wave_sum(float v, int lane) {
#pragma unroll
    for (int o = 1; o < 64; o <<= 1) v += shx(v, o, lane);
    return v;
}

namespace pg8 {
constexpr int BM = 256, BK = 64, HALF = 128, HTB = HALF * BK * 2, STAGE_BYTES = 8 * HTB, NXCD = 8, WGM = 8;
__host__ __device__ __forceinline__ int lds_byte(int r, int c) { const int st = (r >> 4) * 2 + (c >> 5), rr = r & 15, cc = c & 31, ob = rr * 64 + cc * 2; return st * 1024 + (ob ^ (((ob >> 9) & 1) << 5)); }
__host__ __device__ __forceinline__ void stage_rc(int b, int& R, int& C) { const int st = b / 1024, sb = b % 1024, swz = sb ^ (((sb >> 9) & 1) << 5); R = (st >> 1) * 16 + swz / 64; C = (st & 1) * 32 + (swz % 64) / 2; }
__host__ __device__ __forceinline__ int perm32(int rho) { const int n = rho >> 4, i = rho & 15; return 8 * (i >> 2) + 4 * n + (i & 3); }
struct Unit { int pm, pn, aux; };
struct Gemm { const bf16_t* A; const bf16_t* Bt; int lda, ldb, K; };
struct TileOrder {
    int nM, nN, nwg, G, c;
    __device__ void init(int nM_, int nN_, int G_, int c_) { nM = nM_; nN = nN_; nwg = nM * nN; G = G_; c = c_; }
    __device__ static void map(int wgid, int nM, int nN, Unit& u) {
        const int nwg = nM * nN;
        { const int q = nwg / NXCD, r = nwg % NXCD, xcd = wgid % NXCD, off = wgid / NXCD; wgid = (xcd < r ? xcd * (q + 1) : r * (q + 1) + (xcd - r) * q) + off; }
        const int nig = WGM * nN, gid = wgid / nig, fm = gid * WGM, gsz = (nM - fm) < WGM ? (nM - fm) : WGM;
        u.pm = fm + ((wgid % nig) % gsz); u.pn = (wgid % nig) / gsz; u.aux = 0;
    }
    __device__ bool next(int i, Unit& u) const {
        const long L = (long)i * G + c; if (L >= nwg) return false;
        map((int)L, nM, nN, u); return true;
    }
    __device__ __forceinline__ const char* a_ptr(const Gemm& g, const Unit& u) const { return (const char*)g.A + (size_t)u.pm * 256 * g.lda * 2; }
    __device__ __forceinline__ const char* b_ptr(const Gemm& g, const Unit& u, int half) const { return (const char*)g.Bt + (size_t)(u.pn * 256 + 128 * half) * g.ldb * 2; }
    __device__ __forceinline__ bool b_mirror(const Unit&) const { return false; }
    __device__ __forceinline__ bool b_fix(const Unit&) const { return false; }
    __device__ __forceinline__ int ktiles(const Gemm& g, const Unit&) const { return g.K / BK; }
};
__device__ __forceinline__ unsigned cvt_pk_bf16(float lo, float hi) { unsigned r; asm volatile("v_cvt_pk_bf16_f32 %0, %1, %2" : "=v"(r) : "v"(lo), "v"(hi)); return r; }

template <class Epi, class Sched, bool MIRB = false, bool TILED = false>
__device__ __forceinline__ void gemm_phase(LAS unsigned char* lds, int wv, const Gemm g, const Sched& S, const Epi& E) {
    int tid; { int l_; asm volatile("v_mbcnt_lo_u32_b32 %0, -1, 0\n\tv_mbcnt_hi_u32_b32 %0, -1, %0" : "=v"(l_)); tid = wv * 64 + l_; }
    const int wid = __builtin_amdgcn_readfirstlane(tid >> 6), lane = tid & 63, wr = wid >> 2, wc = wid & 3, fr = lane & 15, fq = lane >> 4;
    unsigned voffA[2], voffB[2], voffM[2], fixd[2];
#pragma unroll
    for (int i = 0; i < 2; ++i) { int R, C; stage_rc(tid * 16 + i * 8192, R, C); const int Rb = Epi::PERM ? ((R & ~31) + perm32(R & 31)) : R;
        voffA[i] = (unsigned)(R * g.lda + C) * 2u; voffB[i] = (unsigned)(Rb * g.ldb + C) * 2u; voffM[i] = (unsigned)((1024 - Rb) * g.ldb + C) * 2u; fixd[i] = (Rb == 0) ? (unsigned)(1024 * g.ldb) * 2u : 0u;
        if (TILED) { voffA[i] = (unsigned)(((R >> 4) & 7) * 8192 + (C >> 5) * 1024 + (16 * ((C >> 3) & 3) + (R & 15)) * 16);
                     voffB[i] = (unsigned)(((Rb & 127) >> 4) * 1024 + (4 * (Rb & 15) + ((C >> 3) & 3)) * 16 + (C >> 5) * 8192); } }
    const size_t kstepA = TILED ? (size_t)2048 : (size_t)(BK * 2), kstepB = TILED ? (size_t)16384 : (size_t)(BK * 2);
    const size_t hstepA = TILED ? (size_t)262144 : (size_t)HALF * g.lda * 2;
    const unsigned ldsw = (unsigned)wid * 1024u;
    const int aoff = lds_byte(wr * 64 + fr, fq * 8), boff = lds_byte(wc * 32 + fr, fq * 8);
#define PG8_SA(b, h) (((b) * 2 + (h)) * HTB)
#define PG8_SB(b, h) ((4 + (b) * 2 + (h)) * HTB)
#define PG8_STAGE(bufoff, gbase, voff) do { _Pragma("unroll") for (int _i = 0; _i < 2; ++_i) \
        __builtin_amdgcn_global_load_lds((const unsigned*)((const char*)(gbase) + (voff)[_i]), (LAS unsigned*)(lds + (bufoff) + ldsw + _i * 8192), 16, 0, 0); } while (0)
#define PG8_LDA(dst, b, h) do { _Pragma("unroll") for (int m = 0; m < 4; ++m) _Pragma("unroll") for (int k = 0; k < 2; ++k) dst[m][k] = *(const LAS bf16x8*)(lds + PG8_SA(b, h) + aoff + m * 2048 + k * 1024); } while (0)
#define PG8_LDB(dst, b, h) do { _Pragma("unroll") for (int n = 0; n < 2; ++n) _Pragma("unroll") for (int k = 0; k < 2; ++k) dst[n][k] = *(const LAS bf16x8*)(lds + PG8_SB(b, h) + boff + n * 2048 + k * 1024); } while (0)
#define PG8_MMA(ai, bj, At, Bt) do { __builtin_amdgcn_s_setprio(1); _Pragma("unroll") for (int m = 0; m < 4; ++m) _Pragma("unroll") for (int n = 0; n < 2; ++n) _Pragma("unroll") for (int k = 0; k < 2; ++k) \
        acc[ai][bj][m][n] = __builtin_amdgcn_mfma_f32_16x16x32_bf16(Bt[n][k], At[m][k], acc[ai][bj][m][n], 0, 0, 0); __builtin_amdgcn_s_setprio(0); } while (0)
#define PG8_WAIT_V(n) asm volatile("s_waitcnt vmcnt(" #n ")" ::: "memory")
#define PG8_WAIT_L(n) asm volatile("s_waitcnt lgkmcnt(" #n ")" ::: "memory")
#define PG8_BAR __builtin_amdgcn_s_barrier()
#define PG8_SCHED __builtin_amdgcn_sched_barrier(0)
#define PG8_VB1(dst, u) do { if (MIRB && S.b_mirror(u)) { const bool fx_ = S.b_fix(u); dst[0] = voffM[0] - (fx_ ? fixd[0] : 0u); dst[1] = voffM[1] - (fx_ ? fixd[1] : 0u); } else { dst[0] = voffB[0]; dst[1] = voffB[1]; } } while (0)
    Unit cur, nxt; int ui = 0;
    if (!S.next(0, cur)) return;
    f32x4 acc[2][2][4][2];
#pragma unroll
    for (int a = 0; a < 2; ++a)
#pragma unroll
        for (int b = 0; b < 2; ++b)
#pragma unroll
            for (int m = 0; m < 4; ++m)
#pragma unroll
                for (int n = 0; n < 2; ++n) acc[a][b][m][n] = (f32x4){0.f, 0.f, 0.f, 0.f};
    bf16x8 At[4][2], B0[2][2], B1[2][2];
    const char* cA = S.a_ptr(g, cur); const char* cB0 = S.b_ptr(g, cur, 0); const char* cB1 = S.b_ptr(g, cur, 1);
    unsigned vc1[2]; PG8_VB1(vc1, cur);
    PG8_STAGE(PG8_SB(0, 0), cB0, voffB); PG8_STAGE(PG8_SB(0, 1), cB1, vc1); PG8_STAGE(PG8_SA(0, 0), cA, voffA); PG8_STAGE(PG8_SA(0, 1), cA + hstepA, voffA);
    if (wr == 1) PG8_BAR;
    PG8_WAIT_V(2); PG8_BAR;
    PG8_STAGE(PG8_SB(1, 0), cB0 + kstepB, voffB); PG8_STAGE(PG8_SA(1, 0), cA + kstepA, voffA); PG8_STAGE(PG8_SB(1, 1), cB1 + kstepB, vc1);
    PG8_WAIT_V(6); PG8_BAR;
    for (;;) {
        const bool has_next = S.next(ui + 1, nxt);
        const int nt = S.ktiles(g, cur);
        const char* nA = cA; const char* nB0 = cB0; const char* nB1 = cB1; unsigned vn1[2] = {vc1[0], vc1[1]};
        if (has_next) { nA = S.a_ptr(g, nxt); nB0 = S.b_ptr(g, nxt, 0); nB1 = S.b_ptr(g, nxt, 1); PG8_VB1(vn1, nxt); }
        for (int t = 0; t < nt; t += 2) {
            const bool last = (t == nt - 2);
            const char* a1 = cA + (size_t)(t + 1) * kstepA;
            const char* a2 = last ? nA : cA + (size_t)(t + 2) * kstepA; const char* b20 = last ? nB0 : cB0 + (size_t)(t + 2) * kstepB; const char* b21 = last ? nB1 : cB1 + (size_t)(t + 2) * kstepB;
            const char* a3 = a2 + kstepA; const char* b30 = b20 + kstepB; const char* b31 = b21 + kstepB;
            unsigned v21[2]; v21[0] = (MIRB && last) ? vn1[0] : vc1[0]; v21[1] = (MIRB && last) ? vn1[1] : vc1[1];
            PG8_LDB(B0, 0, 0); PG8_LDB(B1, 0, 1); PG8_SCHED; PG8_LDA(At, 0, 0); PG8_STAGE(PG8_SA(1, 1), a1 + hstepA, voffA);
            PG8_WAIT_V(8); PG8_WAIT_L(0); PG8_BAR; PG8_MMA(0, 0, At, B0); PG8_MMA(0, 1, At, B1); PG8_BAR; PG8_SCHED;
            PG8_LDA(At, 0, 1); PG8_STAGE(PG8_SB(0, 0), b20, voffB); PG8_STAGE(PG8_SB(0, 1), b21, v21); PG8_STAGE(PG8_SA(0, 0), a2, voffA);
            PG8_WAIT_V(8); PG8_WAIT_L(0); PG8_BAR; PG8_MMA(1, 0, At, B0); PG8_MMA(1, 1, At, B1); PG8_BAR; PG8_SCHED;
            PG8_LDB(B0, 1, 0); PG8_LDB(B1, 1, 1); PG8_SCHED; PG8_LDA(At, 1, 0); PG8_STAGE(PG8_SA(0, 1), a2 + hstepA, voffA);
            PG8_WAIT_V(8); PG8_WAIT_L(0); PG8_BAR; PG8_MMA(0, 0, At, B0); PG8_MMA(0, 1, At, B1); PG8_BAR; PG8_SCHED;
            PG8_LDA(At, 1, 1); PG8_STAGE(PG8_SB(1, 0), b30, voffB); PG8_STAGE(PG8_SB(1, 1), b31, v21); PG8_STAGE(PG8_SA(1, 0), a3, voffA);
            PG8_WAIT_V(8); PG8_WAIT_L(0); PG8_BAR; PG8_MMA(1, 0, At, B0); PG8_MMA(1, 1, At, B1); PG8_BAR; PG8_SCHED;
        }
        if (wr == 0) PG8_BAR;
        { int l2 = lane; asm volatile("" : "+v"(l2)); E(acc, cur, wr, wc, l2 & 15, l2 >> 4); }
        if (!has_next) break;
#pragma unroll
        for (int a = 0; a < 2; ++a)
#pragma unroll
            for (int b = 0; b < 2; ++b)
#pragma unroll
                for (int m = 0; m < 4; ++m)
#pragma unroll
                    for (int n = 0; n < 2; ++n) acc[a][b][m][n] = (f32x4){0.f, 0.f, 0.f, 0.f};
        cur = nxt; cA = nA; cB0 = nB0; cB1 = nB1; vc1[0] = vn1[0]; vc1[1] = vn1[1]; ++ui;
        if (wr == 1) PG8_BAR;
    }
    PG8_WAIT_V(0);
    PG8_BAR;
#undef PG8_SA
#undef PG8_SB
#undef PG8_STAGE
#undef PG8_LDA
#undef PG8_LDB
#undef PG8_MMA
#undef PG8_WAIT_V
#undef PG8_WAIT_L
#undef PG8_BAR
#undef PG8_SCHED
#undef PG8_VB1
}
}
using pg8::cvt_pk_bf16;
__device__ __forceinline__ void stg16(void* ub, unsigned vo, u32x4 v) { *(GAS u32x4*)((GAS unsigned char*)ub + vo) = v; }
__device__ __forceinline__ u32x4 ldg16u(const void* ub, unsigned vo) { return *(const GAS u32x4*)((const GAS unsigned char*)ub + vo); }
__device__ __forceinline__ void stg16f(void* ub, unsigned vo, f32x4 v) { *(GAS f32x4*)((GAS unsigned char*)ub + vo) = v; }
__device__ __forceinline__ f32x4 ldg16f(const void* ub, unsigned vo) { return *(const GAS f32x4*)((const GAS unsigned char*)ub + vo); }
typedef const f32x4 (&AccRef)[2][2][4][2];

struct EpiSilu {
    static constexpr bool PERM = true;
    bf16_t* O; int ldc;
    __device__ __forceinline__ void operator()(AccRef acc, const pg8::Unit& u, int wr, int wc, int fr, int fq) const {
        bf16_t* ub = O + (size_t)u.pm * 256 * ldc + u.pn * 256; const unsigned vo = (unsigned)((wr * 64 + fr) * ldc + wc * 32 + 8 * fq) * 2u;
#pragma unroll
        for (int ai = 0; ai < 2; ++ai)
#pragma unroll
            for (int m = 0; m < 4; ++m)
#pragma unroll
                for (int bj = 0; bj < 2; ++bj) { const f32x4 v0 = acc[ai][bj][m][0], v1 = acc[ai][bj][m][1]; u32x4 w;
                    w.x = cvt_pk_bf16(silu_f(v0[0]), silu_f(v0[1])); w.y = cvt_pk_bf16(silu_f(v0[2]), silu_f(v0[3]));
                    w.z = cvt_pk_bf16(silu_f(v1[0]), silu_f(v1[1])); w.w = cvt_pk_bf16(silu_f(v1[2]), silu_f(v1[3]));
                    stg16(ub + (size_t)(ai * 128 + m * 16) * ldc, vo + (unsigned)(bj * 256), w); }
    }
};
struct UOrder : pg8::TileOrder {
    __device__ __forceinline__ const char* b_ptr(const pg8::Gemm& g, const pg8::Unit& u, int half) const {
        if (u.pn < 64) { const int b = u.pn >> 3, tp = u.pn & 7; return (const char*)(g.Bt + (size_t)(b * 2048 + (half ? 1024 - 128 * tp : 128 * tp)) * 1024); }
        return (const char*)(g.Bt + (size_t)(NLAT + (u.pn - 64) * 256 + 128 * half) * 1024);
    }
    __device__ __forceinline__ bool b_mirror(const pg8::Unit& u) const { return u.pn < 64; }
    __device__ __forceinline__ bool b_fix(const pg8::Unit& u) const { return (u.pn & 7) == 0; }
};
struct EpiUTF {
    static constexpr bool PERM = true;
    bf16_t* UTF; bf16_t* UTc; float* AH;
    __device__ __forceinline__ void operator()(AccRef acc, const pg8::Unit& u, int wr, int wc, int fr, int fq) const {
        const int feat0 = u.pm * 256 + wr * 64 + fr, col0 = wc * 32 + 8 * fq;
        if (u.pn >= 64) { bf16_t* ub = UTc + (size_t)(u.pn - 64) * 2048 * 256 + (size_t)u.pm * 256 * 256; const unsigned vo = (unsigned)((wr * 64 + fr) * 256 + col0) * 2u;
#pragma unroll
            for (int ai = 0; ai < 2; ++ai)
#pragma unroll
                for (int m = 0; m < 4; ++m)
#pragma unroll
                    for (int bj = 0; bj < 2; ++bj) { const f32x4 v0 = acc[ai][bj][m][0], v1 = acc[ai][bj][m][1]; u32x4 w;
                        w.x = cvt_pk_bf16(v0[0], v0[1]); w.y = cvt_pk_bf16(v0[2], v0[3]); w.z = cvt_pk_bf16(v1[0], v1[1]); w.w = cvt_pk_bf16(v1[2], v1[3]);
                        stg16(ub + (size_t)(ai * 128 + m * 16) * 256, vo + (unsigned)(bj * 256), w); }
            return; }
        const int b = u.pn >> 3, tp = u.pn & 7; const bool first = (tp == 0) && (col0 == 0);
        bf16_t* ub = UTF + ((size_t)b * 2048 + u.pm * 256) * 1024 + 128 * tp; const unsigned vo = (unsigned)((wr * 64 + fr) * 1024 + col0) * 2u;
#pragma unroll
        for (int ai = 0; ai < 2; ++ai)
#pragma unroll
            for (int m = 0; m < 4; ++m) { const int feat = feat0 + ai * 128 + m * 16; const float sg = ((feat & 255) <= 128) ? 1.f : -1.f;
                f32x4 v0 = acc[ai][0][m][0] + acc[ai][1][m][0] * sg; const f32x4 v1 = acc[ai][0][m][1] + acc[ai][1][m][1] * sg;
                if (first) { v0[0] = acc[ai][0][m][0][0]; AH[(size_t)b * 2048 + feat] = acc[ai][1][m][0][0]; }
                u32x4 w; w.x = cvt_pk_bf16(v0[0], v0[1]); w.y = cvt_pk_bf16(v0[2], v0[3]); w.z = cvt_pk_bf16(v1[0], v1[1]); w.w = cvt_pk_bf16(v1[2], v1[3]);
                stg16(ub + (size_t)(ai * 128 + m * 16) * 1024, vo, w); }
    }
};
struct DftZ { u32x4 zd, zm; unsigned z8; };
__device__ __forceinline__ DftZ dft_row_ld(const bf16_t* zrow, int mi0) { DftZ z; z.zd = *(const u32x4*)(zrow + mi0); z.zm = *(const u32x4*)(zrow + 248 - mi0); z.z8 = (mi0 >= 8) ? (unsigned)zrow[256 - mi0] : 0u; return z; }
__device__ __forceinline__ void dft_row_st(bf16_t* zrow, int mi0, const DftZ& z, const float (&d)[8], const float (&mr)[8]) {
    const u32x4 zd = z.zd, zm = z.zm;
    u32x4 o; o.x = cvt_pk_bf16(d[0] * bflo(zd.x), d[1] * bfhi(zd.x)); o.y = cvt_pk_bf16(d[2] * bflo(zd.y), d[3] * bfhi(zd.y));
    o.z = cvt_pk_bf16(d[4] * bflo(zd.z), d[5] * bfhi(zd.z)); o.w = cvt_pk_bf16(d[6] * bflo(zd.w), d[7] * bfhi(zd.w));
    *(u32x4*)(zrow + mi0) = o;
    bf16_t* mp = zrow + 248 - mi0;
    mp[1] = (bf16_t)f2bf(mr[7] * bfhi(zm.x));
    *(unsigned*)(mp + 2) = cvt_pk_bf16(mr[6] * bflo(zm.y), mr[5] * bfhi(zm.y));
    u32x2 w; w.x = cvt_pk_bf16(mr[4] * bflo(zm.z), mr[3] * bfhi(zm.z)); w.y = cvt_pk_bf16(mr[2] * bflo(zm.w), mr[1] * bfhi(zm.w));
    *(u32x2*)(mp + 4) = w;
    if (mi0 >= 8) mp[8] = (bf16_t)f2bf(mr[0] * bf1((bf16_t)z.z8));
}
template <bool FOLD> struct EpiDft {
    static constexpr bool PERM = true;
    bf16_t* Z; int L; int tok_base; const float* AH;
    __device__ __forceinline__ void operator()(AccRef acc, const pg8::Unit& u, int wr, int wc, int fr, int fq) const {
        const int b = u.pn >> 3, g = u.pn & 7, k0 = u.pm * 128 + wr * 64 + fr, mi0 = wc * 32 + 8 * fq;
        f32x4 ah[2] = {(f32x4){0.f, 0.f, 0.f, 0.f}, (f32x4){0.f, 0.f, 0.f, 0.f}}; float ahn = 0.f;
        if (FOLD) { const float* ap = AH + (size_t)b * 2048 + g * 256; ah[0] = *(const f32x4*)(ap + mi0) * 0.022097087f; ah[1] = *(const f32x4*)(ap + mi0 + 4) * 0.022097087f; ahn = ap[128] * 0.022097087f; }
        const bool nyq = (wc == 0 && fq == 0);
#pragma unroll
        for (int mh = 0; mh < 2; ++mh) {
            DftZ zr[2], zq[2]; unsigned n0[2], n1[2];
#pragma unroll
            for (int mm = 0; mm < 2; ++mm) { const int k = k0 + 16 * (2 * mh + mm); const bf16_t* zrow = Z + (size_t)(tok_base + b * L + k) * 2048 + g * 256;
                const bf16_t* zmir = Z + (size_t)(tok_base + b * L + ((FOLD && k >= 1) ? (L - k) : k)) * 2048 + g * 256;
                zr[mm] = dft_row_ld(zrow, mi0); if (FOLD) zq[mm] = dft_row_ld(zmir, mi0);
                n0[mm] = nyq ? (unsigned)zrow[128] : 0u; n1[mm] = (nyq && FOLD) ? (unsigned)zmir[128] : 0u; }
#pragma unroll
            for (int mm = 0; mm < 2; ++mm) { const int m = 2 * mh + mm, k = k0 + 16 * m; bf16_t* zrow = Z + (size_t)(tok_base + b * L + k) * 2048 + g * 256;
                bf16_t* zmir = Z + (size_t)(tok_base + b * L + (L - k)) * 2048 + g * 256;
                const float sg = (k & 1) ? -1.f : 1.f;
                float dm[8], sm[8];
#pragma unroll
                for (int n = 0; n < 2; ++n) { f32x4 P = acc[0][0][m][n]; const f32x4 Q = acc[1][1][m][n]; if (FOLD) P = P + ah[n] * sg;
#pragma unroll
                    for (int e = 0; e < 4; ++e) { dm[4 * n + e] = P[e] - Q[e]; sm[4 * n + e] = P[e] + Q[e]; }
                    if (n == 0 && mi0 == 0) { dm[0] = P[0]; sm[0] = P[0]; } }
                dft_row_st(zrow, mi0, zr[mm], dm, sm);
                if (FOLD && k >= 1) dft_row_st(zmir, mi0, zq[mm], sm, dm);
                if (nyq) { const float yn = acc[0][1][m][0][0] + (FOLD ? ahn * sg : 0.f);
                    zrow[128] = (bf16_t)f2bf(yn * bf1((bf16_t)n0[mm]));
                    if (FOLD && k >= 1) zmir[128] = (bf16_t)f2bf(yn * bf1((bf16_t)n1[mm])); } }
            asm volatile("" ::: "memory");
        }
    }
};
struct OutOrder {
    pg8::TileOrder T; int G, c; bool with_ctx;
    __device__ void init(int G_, int c_, bool with_ctx_) { T.init(64, 4, G_, c_); G = G_; c = c_; with_ctx = with_ctx_; }
    __device__ bool next(int i, pg8::Unit& u) const {
        const int L = i * G + c;
        if (L < 256) return T.next(i, u);
        if (!with_ctx || L >= 384) return false;
        const int idx = L - 256, tile = idx >> 2; u.pm = 64 + (tile >> 2); u.pn = tile & 3; u.aux = 1 + (idx & 3); return true;
    }
    __device__ __forceinline__ int koff(const pg8::Unit& u) const { return u.aux ? 512 * (u.aux - 1) : 0; }
    __device__ __forceinline__ const char* a_ptr(const pg8::Gemm& g, const pg8::Unit& u) const { return (const char*)(g.A + (size_t)u.pm * 256 * g.lda + koff(u)); }
    __device__ __forceinline__ const char* b_ptr(const pg8::Gemm& g, const pg8::Unit& u, int half) const { return (const char*)(g.Bt + (size_t)(u.pn * 256 + 128 * half) * g.ldb + koff(u)); }
    __device__ __forceinline__ bool b_mirror(const pg8::Unit&) const { return false; }
    __device__ __forceinline__ bool b_fix(const pg8::Unit&) const { return false; }
    __device__ __forceinline__ int ktiles(const pg8::Gemm& g, const pg8::Unit& u) const { return u.aux ? 8 : g.K / pg8::BK; }
};
struct EpiResid {
    static constexpr bool PERM = false;
    const float* xin_lat; float* xout_lat; const float* gate; float* part;
    __device__ __forceinline__ void operator()(AccRef acc, const pg8::Unit& u, int wr, int wc, int fr, int fq) const {
        const int row0 = u.pm * 256 + wr * 64 + fr, col0 = u.pn * 256 + wc * 32 + 4 * fq;
        if (u.aux) {
            float* pp = part + (size_t)(u.aux - 1) * NCTX * DM + (size_t)(row0 - NLAT) * DM + col0;
#pragma unroll
            for (int ai = 0; ai < 2; ++ai)
#pragma unroll
                for (int m = 0; m < 4; ++m)
#pragma unroll
                    for (int bj = 0; bj < 2; ++bj)
#pragma unroll
                        for (int n = 0; n < 2; ++n) *(f32x4*)(pp + (size_t)(ai * 128 + m * 16) * DM + bj * 128 + n * 16) = acc[ai][bj][m][n];
            return;
        }
        const float* gp = gate + (u.pm >> 3) * 3072 + col0;
        f32x4 gv[2][2];
#pragma unroll
        for (int bj = 0; bj < 2; ++bj)
#pragma unroll
            for (int n = 0; n < 2; ++n) gv[bj][n] = *(const f32x4*)(gp + bj * 128 + n * 16);
#pragma unroll
        for (int ai = 0; ai < 2; ++ai) {
            f32x4 xv[4][2][2];
#pragma unroll
            for (int m = 0; m < 4; ++m) { const size_t off = (size_t)(row0 + ai * 128 + m * 16) * DM + col0;
#pragma unroll
                for (int bj = 0; bj < 2; ++bj)
#pragma unroll
                    for (int n = 0; n < 2; ++n) xv[m][bj][n] = *(const f32x4*)(xin_lat + off + bj * 128 + n * 16); }
#pragma unroll
            for (int m = 0; m < 4; ++m) { const size_t off = (size_t)(row0 + ai * 128 + m * 16) * DM + col0;
#pragma unroll
                for (int bj = 0; bj < 2; ++bj)
#pragma unroll
                    for (int n = 0; n < 2; ++n) *(f32x4*)(xout_lat + off + bj * 128 + n * 16) = xv[m][bj][n] + gv[bj][n] * acc[ai][bj][m][n]; }
            asm volatile("" ::: "memory"); }
    }
};
struct EpiQKV {
    static constexpr bool PERM = true;
    bf16_t* Q; bf16_t* K; bf16_t* V; const float* rcos; const float* rsin;
    __device__ __forceinline__ void operator()(AccRef acc, const pg8::Unit& u, int wr, int wc, int fr, int fq) const {
        const int row0 = u.pm * 256 + wr * 64 + fr, c0 = wc * 32 + 8 * fq;
        if (u.pn >= 8) {
#pragma unroll
            for (int ai = 0; ai < 2; ++ai)
#pragma unroll
                for (int m = 0; m < 4; ++m) { bf16_t* rowp = V + (size_t)(row0 + ai * 128 + m * 16) * 2048 + (u.pn - 8) * 256 + c0;
#pragma unroll
                    for (int bj = 0; bj < 2; ++bj) { const f32x4 v0 = acc[ai][bj][m][0], v1 = acc[ai][bj][m][1]; u32x4 w;
                        w.x = cvt_pk_bf16(v0[0], v0[1]); w.y = cvt_pk_bf16(v0[2], v0[3]); w.z = cvt_pk_bf16(v1[0], v1[1]); w.w = cvt_pk_bf16(v1[2], v1[3]);
                        *(u32x4*)(rowp + bj * 128) = w; } }
            return;
        }
        const bool isk = u.pn >= 4, lat = u.pm < 64; const int h = u.pn & 3; bf16_t* dst = isk ? K : Q; const float sc = isk ? 0.0625f : 1.0f;
        const int i0 = 16 * wc + 4 * fq;
#pragma unroll
        for (int ai = 0; ai < 2; ++ai) {
            f32x4 cv[4][2], sv[4][2];
            if (lat) {
#pragma unroll
                for (int m = 0; m < 4; ++m) { const int l = (row0 + ai * 128 + m * 16) & 2047;
#pragma unroll
                    for (int bj = 0; bj < 2; ++bj) { const int pos = bj == 0 ? (l >> 6) : (l & 63); cv[m][bj] = *(const f32x4*)(rcos + pos * 64 + i0); sv[m][bj] = *(const f32x4*)(rsin + pos * 64 + i0); } } }
#pragma unroll
            for (int m = 0; m < 4; ++m) { const int row = row0 + ai * 128 + m * 16;
                bf16_t* chp = dst + ((size_t)(row >> 7) * 4 + h) * 32768;
#pragma unroll
                for (int bj = 0; bj < 2; ++bj) { f32x4 x1 = acc[ai][bj][m][0], x2 = acc[ai][bj][m][1];
                    if (lat) { const f32x4 o1 = x1 * cv[m][bj] - x2 * sv[m][bj], o2 = x1 * sv[m][bj] + x2 * cv[m][bj]; x1 = o1; x2 = o2; }
                    x1 = x1 * sc; x2 = x2 * sc; u32x4 w;
                    w.x = cvt_pk_bf16(x1[0], x1[1]); w.y = cvt_pk_bf16(x1[2], x1[3]); w.z = cvt_pk_bf16(x2[0], x2[1]); w.w = cvt_pk_bf16(x2[2], x2[3]);
                    const int s32 = 4 * bj + wc;
                    const int off = isk ? ((s32 * 8 + ((row & 127) >> 4)) * 512 + (4 * (row & 15) + fq) * 8)
                                        : (((((row >> 4) & 7) * 8) + s32) * 512 + (16 * fq + (row & 15)) * 8);
                    *(u32x4*)(chp + off) = w; } }
            asm volatile("" ::: "memory"); }
    }
};
struct EpiZGate {
    static constexpr bool PERM = true;
    const bf16_t* O; const float* rinv; bf16_t* AO;
    __device__ __forceinline__ void operator()(AccRef acc, const pg8::Unit& u, int wr, int wc, int fr, int fq) const {
        const int row0 = u.pm * 256 + wr * 64 + fr, col0 = u.pn * 256 + wc * 32 + 8 * fq, head = u.pn >> 1;
#pragma unroll
        for (int ai = 0; ai < 2; ++ai) {
            u32x4 ov[4][2]; float rv[4];
#pragma unroll
            for (int m = 0; m < 4; ++m) { const int row = row0 + ai * 128 + m * 16; rv[m] = rinv[row * 4 + head];
#pragma unroll
                for (int bj = 0; bj < 2; ++bj) { const int c = col0 + bj * 128, e0 = c & 63;
                    const bf16_t* op = O + ((size_t)((((row >> 7) * 4 + (c >> 9)) * 8 + ((c >> 6) & 7)) * 8 + ((row >> 4) & 7)) << 10) + (e0 >> 4) * 256 + (16 * ((e0 >> 2) & 3) + (row & 15)) * 4;
                    const u32x2 lo = *(const u32x2*)op, hi = *(const u32x2*)(op + 64); ov[m][bj] = (u32x4){lo.x, lo.y, hi.x, hi.y}; } }
#pragma unroll
            for (int m = 0; m < 4; ++m) { const int row = row0 + ai * 128 + m * 16; const float r_ = rv[m];
#pragma unroll
                for (int bj = 0; bj < 2; ++bj) { const u32x4 o = ov[m][bj]; const f32x4 v0 = acc[ai][bj][m][0], v1 = acc[ai][bj][m][1]; u32x4 w;
                    w.x = cvt_pk_bf16(bflo(o.x) * r_ * silu_f(v0[0]), bfhi(o.x) * r_ * silu_f(v0[1])); w.y = cvt_pk_bf16(bflo(o.y) * r_ * silu_f(v0[2]), bfhi(o.y) * r_ * silu_f(v0[3]));
                    w.z = cvt_pk_bf16(bflo(o.z) * r_ * silu_f(v1[0]), bfhi(o.z) * r_ * silu_f(v1[1])); w.w = cvt_pk_bf16(bflo(o.w) * r_ * silu_f(v1[2]), bfhi(o.w) * r_ * silu_f(v1[3]));
                    *(u32x4*)(AO + (size_t)row * 2048 + col0 + bj * 128) = w; } }
            asm volatile("" ::: "memory"); }
    }
};

#define XB_TMO      128
#define XB_XCNT(j)  (256  + 64 * (j))
#define XB_XSUB(j)  (1280 + 64 * (j))
#define XB_XGEN(j)  (2304 + 64 * (j))
#define XB_TOP      3328
#define XB_TOPGEN   3392
#define XCD_BAR_WORDS 3456
#define XB_SPIN_CAP (1u << 18)
__device__ __forceinline__ unsigned xb_ld(unsigned* p)              { return __hip_atomic_load(p, __ATOMIC_RELAXED, __HIP_MEMORY_SCOPE_AGENT); }
__device__ __forceinline__ unsigned xb_add(unsigned* p, unsigned v) { return __hip_atomic_fetch_add(p, v, __ATOMIC_RELAXED, __HIP_MEMORY_SCOPE_AGENT); }
__device__ __forceinline__ unsigned xb_xcc_id() { return (unsigned)__builtin_amdgcn_s_getreg((3 << 11) | 20) & 0xFu; }
#define XB_SPIN(cond, bar) do { unsigned _sp = 0; while (cond) { __builtin_amdgcn_s_sleep(1); \
    if ((++_sp & 255u) == 0u) { if (xb_ld(&(bar)[XB_TMO])) break; if (_sp > XB_SPIN_CAP) { atomicAdd(&(bar)[XB_TMO], 1u); break; } } } } while (0)
struct XcdBarrier { unsigned* bar; unsigned x; volatile LAS unsigned* st; };
__device__ __forceinline__ XcdBarrier xcd_barrier_post(unsigned* bar, volatile LAS unsigned* st) {
    XcdBarrier b; b.bar = bar; b.x = xb_xcc_id(); b.st = st;
    if (threadIdx.x == 0) (void)xb_add(&bar[XB_XCNT(b.x)], 1u);
    return b;
}
__device__ __forceinline__ void xcd_barrier_complete(unsigned* bar, unsigned x, unsigned& nloc, unsigned& nx) {
    const unsigned G = gridDim.x * gridDim.y * gridDim.z;
    unsigned sum, cnt, mine, sp = 0u;
    for (;;) {
        sum = 0u; cnt = 0u; mine = 0u;
#pragma unroll 1
        for (unsigned j = 0; j < 16; ++j) { const unsigned c = xb_ld(&bar[XB_XCNT(j)]); sum += c; cnt += (c > 0u) ? 1u : 0u; mine = (j == x) ? c : mine; }
        if (sum == G) break;
        __builtin_amdgcn_s_sleep(1);
        if ((++sp & 255u) == 0u) { if (xb_ld(&bar[XB_TMO])) break; if (sp > XB_SPIN_CAP) { atomicAdd(&bar[XB_TMO], 1u); break; } }
    }
    nloc = mine > 0u ? mine : 1u; nx = cnt > 0u ? cnt : 1u;
}
__device__ __forceinline__ void xcd_barrier(const XcdBarrier& b) {
    asm volatile("s_waitcnt vmcnt(0)" ::: "memory");
    __syncthreads();
    if (threadIdx.x == 0) {
        unsigned* bar = b.bar;
        __builtin_amdgcn_s_waitcnt(0);
        unsigned nloc = b.st[0], nx = b.st[1];
        if (nloc == 0u) { xcd_barrier_complete(bar, b.x, nloc, nx); b.st[0] = nloc; b.st[1] = nx; }
        const unsigned old = xb_add(&bar[XB_XSUB(b.x)], 1u);
        const unsigned gen = old / nloc;
        if (old + 1u == (gen + 1u) * nloc) {
            __builtin_amdgcn_fence(__ATOMIC_RELEASE, "agent");
            asm volatile("s_waitcnt vmcnt(0)" ::: "memory");
            const unsigned og = xb_add(&bar[XB_TOP], 1u);
            const unsigned tg = og / nx;
            if (og + 1u == (tg + 1u) * nx) xb_add(&bar[XB_TOPGEN], 1u);
            else XB_SPIN(xb_ld(&bar[XB_TOPGEN]) == tg, bar);
            __builtin_amdgcn_fence(__ATOMIC_ACQUIRE, "agent");
            xb_add(&bar[XB_XGEN(b.x)], 1u);
            asm volatile("s_waitcnt vmcnt(0)" ::: "memory");
        } else {
            XB_SPIN(xb_ld(&bar[XB_XGEN(b.x)]) == gen, bar);
            __builtin_amdgcn_fence(__ATOMIC_ACQUIRE, "agent");
            asm volatile("s_waitcnt vmcnt(0)" ::: "memory");
        }
    }
    __syncthreads();
}

struct Args { const float* in[13]; float* out; unsigned char* ws; int ph_lo, ph_hi, pad0, pad1; };
struct Frame {
    LAS unsigned char* lds;
    int vcu, G, wv;
    unsigned char* ws;
};
__device__ __forceinline__ int lane_id() { int l; asm volatile("v_mbcnt_lo_u32_b32 %0, -1, 0\n\tv_mbcnt_hi_u32_b32 %0, -1, %0" : "=v"(l)); return l; }
__device__ __forceinline__ unsigned char* launder_ptr(unsigned char* p) {
    unsigned lo = (unsigned)(unsigned long long)p, hi = (unsigned)((unsigned long long)p >> 32);
    asm volatile("" : "+s"(lo), "+s"(hi));
    return (unsigned char*)(((unsigned long long)hi << 32) | lo);
}
#define PHASE_IDS() int tid = F.wv * 64 + lane_id(); asm volatile("" : "+v"(tid)); const int lane = tid & 63, wave = __builtin_amdgcn_readfirstlane(tid >> 6); (void)lane; (void)wave; \
    unsigned char* ws = launder_ptr(F.ws); (void)ws
#define LDS_WAIT() asm volatile("s_waitcnt lgkmcnt(0)" ::: "memory")

__device__ __forceinline__ int qk_pos(int d) { const int half = d >> 7, n = (d >> 6) & 1, i = d & 63; return 128 * half + 8 * (i >> 2) + 4 * n + (i & 3); }
template <int MODE>
__device__ __forceinline__ void transpose_item(const float* W, int K, int N, int n_begin, bf16_t* WT, LAS float* scr, int item, int nblk, int lane) {
    const int kb = item / nblk, nb = item % nblk, k0 = 64 * kb, n0 = n_begin + 64 * nb;
    const GAS f32x4* src = (const GAS f32x4*)(W + (size_t)(k0 + (lane >> 4)) * N + n0 + 4 * (lane & 15));
    f32x4 v[16];
#pragma unroll
    for (int i = 0; i < 16; ++i) v[i] = src[(size_t)i * N];
#pragma unroll
    for (int i = 0; i < 16; ++i) *(LAS f32x4*)(scr + (4 * i + (lane >> 4)) * 68 + 4 * (lane & 15)) = v[i];
    LDS_WAIT(); asm volatile("" ::: "memory");
    const int na = n0 + lane; int nn = na - n_begin;
    if (MODE == 1) nn = (na < 2048) ? ((na & ~255) + qk_pos(na & 255)) : na;
    GAS u32x4* dst = (GAS u32x4*)(WT + (size_t)nn * K + k0);
#pragma unroll
    for (int c = 0; c < 8; ++c) { const LAS float* sp = scr + (8 * c) * 68 + lane;
        u32x4 o; o.x = pk2(sp[0 * 68], sp[1 * 68]); o.y = pk2(sp[2 * 68], sp[3 * 68]); o.z = pk2(sp[4 * 68], sp[5 * 68]); o.w = pk2(sp[6 * 68], sp[7 * 68]);
        dst[c] = o; }
    LDS_WAIT(); asm volatile("" ::: "memory");
}
__device__ __forceinline__ void fold_task(const float* Win  , const LAS float* ctab  , bf16_t* WfT, int t, int lane) {
    const int g = t >> 8, p0 = ((t >> 5) & 7) * 32, kk0 = (t & 31) * 32, s = lane >> 5, li = lane & 31;
    f32x16 acc;
#pragma unroll
    for (int i = 0; i < 16; ++i) acc[i] = 0.f;
    const float* wrow = Win + (size_t)(kk0 + li) * 4096 + g * 256 + 4 * s;
    const int pcol = p0 + li;
    const int pmul = pcol < 128 ? pcol : pcol - 128, poff = pcol < 128 ? 0 : -64; const bool nyq = pcol == 128;
    f32x4 wvv[32];
#pragma unroll
    for (int tp = 0; tp < 32; ++tp) wvv[tp] = *(const GAS f32x4*)((const GAS float*)wrow + 8 * tp);
#pragma unroll
    for (int tp = 0; tp < 32; ++tp) {
        const f32x4 wv = wvv[tp];
#pragma unroll
        for (int uu = 0; uu < 4; ++uu) { const int cc = 8 * tp + 4 * s + uu; float a;
            a = ctab[(pmul * cc + poff) & 255]; if (nyq) a = (cc & 1) ? -0.0625f : 0.0625f;
            acc = __builtin_amdgcn_mfma_f32_32x32x2f32(a, wv[uu], acc, 0, 0, 0); }
    }
#pragma unroll
    for (int i = 0; i < 16; ++i) { const int row = (i & 3) + 8 * (i >> 2) + 4 * s; WfT[(size_t)(g * 256 + p0 + row) * 1024 + kk0 + li] = (bf16_t)f2bf(acc[i]); }
}

__device__ __forceinline__ void p0_phase(Frame& F, const Args& a) {
    PHASE_IDS();
    float* ADA = (float*)(ws + WS_ADA);
    const float* c = a.in[1]; const float* cctx = a.in[3]; const float* ada_w = a.in[5]; const float* ada_b = a.in[6];
    LAS float* sl = (LAS float*)F.lds;
    LAS float* part = (LAS float*)(F.lds + 36864);
    bool loaded = false;
    for (int u = F.vcu; u < 192; u += F.G) {
        if (!loaded) { for (int idx = tid; idx < 9 * 1024; idx += 512) { const int r = idx >> 10, k = idx & 1023; const float x = r < 8 ? c[r * 1024 + k] : cctx[k]; sl[idx] = x / (1.f + expf(-x)); } loaded = true; }
        __syncthreads();
        const int i = u / 48, n0 = (u % 48) * 64;
        f32x4 acc[9];
#pragma unroll
        for (int r = 0; r < 9; ++r) acc[r] = (f32x4){0.f, 0.f, 0.f, 0.f};
        const int ks4 = lane >> 4, c4 = 4 * (lane & 15);
        const float* wp = ada_w + ((size_t)i * 1024 + wave * 128 + ks4) * 3072 + n0 + c4;
#pragma unroll 8
        for (int kk = 0; kk < 32; ++kk) { const f32x4 wv = *(const f32x4*)(wp + (size_t)kk * 4 * 3072); const int k = wave * 128 + 4 * kk + ks4;
#pragma unroll
            for (int r = 0; r < 9; ++r) acc[r] += wv * sl[r * 1024 + k]; }
#pragma unroll
        for (int r = 0; r < 9; ++r) *(LAS f32x4*)(part + ((wave * 4 + ks4) * 9 + r) * 64 + c4) = acc[r];
        __syncthreads();
        for (int idx = tid; idx < 576; idx += 512) { const int r = idx >> 6, l = idx & 63; float s = 0.f;
#pragma unroll
            for (int w = 0; w < 32; ++w) s += part[(w * 9 + r) * 64 + l];
            ADA[(i * 9 + r) * 3072 + n0 + l] = s + ada_b[i * 3072 + n0 + l]; }
    }
    const int gt = F.vcu * 512 + tid, NT = F.G * 512;
    float* RC = (float*)(ws + WS_ROPE); float* RS = RC + 4096;
    for (int idx = gt; idx < 4096; idx += NT) { const int pos = idx >> 6, i = idx & 63; const float freq = powf(10000.0f, -(float)i / 64.0f); const float ang = (float)pos * freq;
        RC[idx] = cosf(ang); RS[idx] = sinf(ang); }
    bf16_t* CS256 = (bf16_t*)(ws + WS_CS256);
    for (int idx = gt; idx < 512 * 256; idx += NT) { const int row = idx >> 8, l = idx & 255, kt = row >> 8, hf = (row >> 7) & 1, k = kt * 128 + (row & 127);
        const float x = (float)((k * l) & 255) * (1.f / 128.f); const float v = (hf ? sinpif(x) : cospif(x)) * 0.0625f; CS256[idx] = (bf16_t)f2bf(v); }
}

__device__ __forceinline__ void norm_row(const float* xrow, const float* ng, const float* adar  , bf16_t* orow, int lane) {
    const f32x4* xr = (const f32x4*)xrow + lane;
    f32x4 v[4]; float s = 0.f;
#pragma unroll
    for (int j = 0; j < 4; ++j) { v[j] = xr[64 * j]; s += (v[j].x * v[j].x + v[j].y * v[j].y) + (v[j].z * v[j].z + v[j].w * v[j].w); }
    const float rinv = rsqrtf(wave_sum(s, lane) * (1.f / DM) + EPS);
    unsigned long long* o8 = (unsigned long long*)orow + lane;
#pragma unroll
    for (int j = 0; j < 4; ++j) { const int col = 4 * lane + 256 * j; const f32x4 g = *(const f32x4*)(ng + col), sh = *(const f32x4*)(adar + col), sc = *(const f32x4*)(adar + 1024 + col);
        const f32x4 y = v[j] * rinv * g * (sc + 1.0f) + sh;
        o8[64 * j] = (unsigned long long)pk2(y.x, y.y) | ((unsigned long long)pk2(y.z, y.w) << 32); }
}
template <int NR>
__device__ __forceinline__ void norm_batch(const float* const (&xrow)[NR], bf16_t* const (&hrow)[NR], int nrows, const f32x4 (&gm)[4], const f32x4 (&sh)[4], int lane) {
    f32x4 v[NR][4]; float ss[NR];
#pragma unroll
    for (int t = 0; t < NR; ++t) { const f32x4* xr = (const f32x4*)xrow[t] + lane;
#pragma unroll
        for (int j = 0; j < 4; ++j) v[t][j] = xr[64 * j]; }
#pragma unroll
    for (int t = 0; t < NR; ++t) { float s = 0.f;
#pragma unroll
        for (int j = 0; j < 4; ++j) s += (v[t][j].x * v[t][j].x + v[t][j].y * v[t][j].y) + (v[t][j].z * v[t][j].z + v[t][j].w * v[t][j].w);
        ss[t] = s; }
#pragma unroll
    for (int o = 1; o < 64; o <<= 1) {
#pragma unroll
        for (int t = 0; t < NR; ++t) ss[t] += shx(ss[t], o, lane); }
#pragma unroll
    for (int t = 0; t < NR; ++t) if (t < nrows) { const float rinv = rsqrtf(ss[t] * (1.f / DM) + EPS);
        unsigned long long* o8 = (unsigned long long*)hrow[t] + lane;
#pragma unroll
        for (int j = 0; j < 4; ++j) { const f32x4 y = v[t][j] * rinv * gm[j] + sh[j];
            o8[64 * j] = (unsigned long long)pk2(y.x, y.y) | ((unsigned long long)pk2(y.z, y.w) << 32); } }
}
template <bool ADDP>
__device__ __forceinline__ void norm_rows(Frame& F, const Args& a, int layer, bf16_t* H, int wsub = 8) {
    PHASE_IDS();
    const float* xl = layer == 0 ? a.in[0] : a.out; const float* xc = (layer == 0 || (ADDP && layer == 1)) ? a.in[2] : (const float*)(ws + WS_XCTX);
    const float* ng = a.in[4] + layer * DM; const float* ADA = (const float*)(ws + WS_ADA) + layer * 9 * 3072;
    const int gw = F.vcu * wsub + wave, NGW = F.G * wsub;
    const int wpb = NGW >> 3;
    if (wpb > 0 && (NGW & 7) == 0) {
        const int b = gw / wpb, wi = gw - b * wpb; const float* adar = ADA + b * 3072;
        f32x4 gm[4], sh[4];
#pragma unroll
        for (int j = 0; j < 4; ++j) { const int col = 4 * lane + 256 * j; gm[j] = *(const f32x4*)(ng + col) * (*(const f32x4*)(adar + 1024 + col) + 1.0f); sh[j] = *(const f32x4*)(adar + col); }
        for (int l0 = wi; l0 < SEQ; l0 += 8 * wpb) {
            const float* xr[8]; bf16_t* hr[8]; int n = 0;
#pragma unroll
            for (int t = 0; t < 8; ++t) { const int l = l0 + t * wpb; const int ll = l < SEQ ? l : wi; if (l < SEQ) n = t + 1; xr[t] = xl + (size_t)(b * SEQ + ll) * DM; hr[t] = H + (size_t)(b * SEQ + ll) * DM; }
            norm_batch<8>(xr, hr, n, gm, sh, lane);
        }
        const float* adac = ADA + 8 * 3072;
#pragma unroll
        for (int j = 0; j < 4; ++j) { const int col = 4 * lane + 256 * j; gm[j] = *(const f32x4*)(ng + col) * (*(const f32x4*)(adac + 1024 + col) + 1.0f); sh[j] = *(const f32x4*)(adac + col); }
        for (int m = gw; m < NCTX; m += NGW) {
            f32x4 xv[4];
#pragma unroll
            for (int j = 0; j < 4; ++j) xv[j] = *((const f32x4*)(xc + (size_t)m * DM) + lane + 64 * j);
            if (ADDP && layer >= 1) {
                const float* part = (const float*)(ws + WS_PART); const float* gprev = (const float*)(ws + WS_ADA) + (layer - 1) * 9 * 3072 + 8 * 3072 + 2048;
                float* xw = (float*)(ws + WS_XCTX) + (size_t)m * DM;
#pragma unroll
                for (int j = 0; j < 4; ++j) { const f32x4* pr = (const f32x4*)(part + (size_t)m * DM) + lane + 64 * j;
                    const f32x4 ps = (pr[0] + pr[(size_t)NCTX * DM / 4]) + (pr[(size_t)2 * NCTX * DM / 4] + pr[(size_t)3 * NCTX * DM / 4]);
                    xv[j] = xv[j] + *(const f32x4*)(gprev + 4 * lane + 256 * j) * ps;
                    *((f32x4*)xw + lane + 64 * j) = xv[j]; }
            }
            float s_ = 0.f;
#pragma unroll
            for (int j = 0; j < 4; ++j) s_ += (xv[j].x * xv[j].x + xv[j].y * xv[j].y) + (xv[j].z * xv[j].z + xv[j].w * xv[j].w);
            const float rinv = rsqrtf(wave_sum(s_, lane) * (1.f / DM) + EPS);
            unsigned long long* o8 = (unsigned long long*)(H + (size_t)(NLAT + m) * DM) + lane;
#pragma unroll
            for (int j = 0; j < 4; ++j) { const f32x4 y = xv[j] * rinv * gm[j] + sh[j];
                o8[64 * j] = (unsigned long long)pk2(y.x, y.y) | ((unsigned long long)pk2(y.z, y.w) << 32); }
        }
        return;
    }
    for (int m = gw; m < NTOK; m += NGW) {
        const bool lat = m < NLAT; const int r = lat ? (m >> 11) : 8; const float* adar = ADA + r * 3072;
        f32x4 gm[4], sh[4];
#pragma unroll
        for (int j = 0; j < 4; ++j) { const int col = 4 * lane + 256 * j; gm[j] = *(const f32x4*)(ng + col) * (*(const f32x4*)(adar + 1024 + col) + 1.0f); sh[j] = *(const f32x4*)(adar + col); }
        const float* xr[1] = {lat ? xl + (size_t)m * DM : xc + (size_t)(m - NLAT) * DM}; bf16_t* hr[1] = {H + (size_t)m * DM};
        norm_batch<1>(xr, hr, 1, gm, sh, lane);
    }
}
__device__ __forceinline__ void cf_prep(Frame& F, int wave, int lane) {
    LAS float* ctab = (LAS float*)(F.lds + 139264);
    { const int tt = wave * 64 + lane; if (tt < 256) ctab[tt] = cospif((float)tt * (1.f / 128.f)) * 0.0625f; }
    __syncthreads();
}
__device__ __forceinline__ void cf_main(Frame& F, const Args& a, int j, int gw, int NGW, unsigned char* ws, int wave, int lane) {
    LAS float* scr = (LAS float*)(F.lds + wave * 17408); const LAS float* ctab = (const LAS float*)(F.lds + 139264);
    bf16_t* W1 = (bf16_t*)(ws + WS_WF);
    const float* win = a.in[7] + (size_t)j * 1024 * 4096; const float* wout = a.in[8] + (size_t)j * 2048 * 1024;
    bf16_t* WfoT = W1 + (size_t)4096 * 1024;
    for (int t = gw; t < 2048; t += NGW) fold_task(win, ctab, W1, t, lane);
    for (int it = gw; it < 16 * 32; it += NGW) transpose_item<0>(win, 1024, 4096, 2048, W1 + (size_t)2048 * 1024, scr, it, 32, lane);
    for (int it = gw; it < 32 * 16; it += NGW) transpose_item<0>(wout, 2048, 1024, 0, WfoT, scr, it, 16, lane);
}
__device__ __forceinline__ void cf_cs(Frame& F, int gt, int NT, unsigned char* ws, int wave, int lane) {
    bf16_t* CS = (bf16_t*)(ws + WS_CS);
    __syncthreads();
    LAS float* ctab2 = (LAS float*)F.lds;
    for (int n = wave * 64 + lane; n < 2048; n += 512) ctab2[n] = cospif((float)n * (1.f / 1024.f)) * 0.022097087f;
    __syncthreads();
    for (int ch = gt; ch < 2048 * 128; ch += NT) { const int row = ch >> 7, l0 = (ch & 127) * 8, kt = row >> 8, hf = (row >> 7) & 1, k = kt * 128 + (row & 127);
        const int off = hf ? -512 : 0;
        unsigned w[4];
#pragma unroll
        for (int e = 0; e < 4; ++e) { float v[2];
#pragma unroll
            for (int q = 0; q < 2; ++q) { const int l = l0 + 2 * e + q; v[q] = ctab2[(k * l + off) & 2047]; }
            w[e] = pk2(v[0], v[1]); }
        *(u32x4*)(CS + (size_t)row * 1024 + l0) = (u32x4){w[0], w[1], w[2], w[3]}; }
    __syncthreads();
}
__device__ __forceinline__ void conv_fourier(Frame& F, const Args& a, int j, int gw, int NGW, int gt, int NT, unsigned char* ws, int wave, int lane) {
    cf_prep(F, wave, lane); cf_main(F, a, j, gw, NGW, ws, wave, lane); cf_cs(F, gt, NT, ws, wave, lane);
}
__device__ __forceinline__ void conv_ret(Frame& F, const Args& a, int j, int gw, int NGW, unsigned char* ws, int wave, int lane, int lo = 0, int hi = 2048) {
    LAS float* scr = (LAS float*)(F.lds + wave * 17408);
    bf16_t* W1 = (bf16_t*)(ws + WS_W);
    const float* win = a.in[9] + (size_t)j * 1024 * 6144; const float* wout = a.in[10] + (size_t)j * 2048 * 1024;
    bf16_t* WroT = W1 + (size_t)6144 * 1024;
    for (int it = lo + gw; it < hi; it += NGW) {
        if (it < 1536) transpose_item<1>(win, 1024, 6144, 0, W1, scr, it, 96, lane);
        else transpose_item<0>(wout, 2048, 1024, 0, WroT, scr, it - 1536, 16, lane);
    }
}
__device__ __forceinline__ void bg_conv_ret(Frame& F, const Args& a, int layer, int cu_lo, int lo, int hi) {
    PHASE_IDS();
    const int cu = (int)blockIdx.x - cu_lo;
    if (layer + 1 >= NLAYER || F.G != 256 || cu < 0 || cu >= 128) return;
    conv_ret(F, a, (layer + 1) >> 1, cu * 8 + wave, 1024, ws, wave, lane, lo, hi);
}
__device__ __forceinline__ void p0_conv(Frame& F, const Args& a) {
    PHASE_IDS();
    __syncthreads();
    conv_fourier(F, a, 0, F.vcu * 8 + wave, F.G * 8, F.vcu * 512 + tid, F.G * 512, ws, wave, lane);
}
__device__ __forceinline__ void n_phase(Frame& F, const Args& a, int layer) {
    PHASE_IDS();
    const bool fourier = (layer & 1) == 0;
    if (fourier && layer >= 1) {
        cf_prep(F, wave, lane);
        if (wave < 4) norm_rows<true>(F, a, layer, (bf16_t*)(ws + WS_H), 4); else cf_main(F, a, layer >> 1, F.vcu * 4 + wave - 4, F.G * 4, ws, wave, lane);
        cf_cs(F, F.vcu * 512 + tid, F.G * 512, ws, wave, lane);
        return;
    }
    norm_rows<true>(F, a, layer, (bf16_t*)(ws + (fourier ? WS_H : WS_OF)));
    if (layer >= 1) {
        if (fourier) conv_fourier(F, a, layer >> 1, F.vcu * 8 + wave, F.G * 8, F.vcu * 512 + tid, F.G * 512, ws, wave, lane);
        else if (F.G != 256) conv_ret(F, a, layer >> 1, F.vcu * 8 + wave, F.G * 8, ws, wave, lane);
    }
}
__device__ __forceinline__ void nyq_row_phase(Frame& F) {
    PHASE_IDS();
    const bf16_t* UTF = (const bf16_t*)(ws + WS_UTL); const float* AH = (const float*)(ws + WS_RINV); bf16_t* Z = (bf16_t*)(ws + WS_Z);
    const int gw = F.vcu * 8 + wave, NGW = F.G * 8;
    for (int t = gw; t < 64 * 129; t += NGW) {
        const int bg = t / 129, mt = t - bg * 129, b = bg >> 3, g = bg & 7; const int row = b * 2048 + g * 256 + mt;
        const GAS u32x4* src = (const GAS u32x4*)(UTF + (size_t)row * 1024);
        float s = 0.f;
#pragma unroll
        for (int i = 0; i < 2; ++i) { const u32x4 v = src[lane + 64 * i]; s += (bflo(v.x) - bfhi(v.x)) + (bflo(v.y) - bfhi(v.y)) + (bflo(v.z) - bfhi(v.z)) + (bflo(v.w) - bfhi(v.w)); }
        s = wave_sum(s, lane);
        const float y = (s + AH[row]) * 0.022097087f;
        bf16_t* zrow = Z + (size_t)(b * 2048 + 1024) * 2048 + g * 256;
        if (lane == 0) zrow[mt] = (bf16_t)f2bf(y * bf1(zrow[mt]));
        if (lane == 1 && mt >= 1 && mt <= 127) zrow[256 - mt] = (bf16_t)f2bf(y * bf1(zrow[256 - mt]));
    }
}
__device__ __forceinline__ bf16_t* s_chunk(unsigned char* ws, int h, int rc) {
    return rc < 56 ? (bf16_t*)(ws + WS_SA) + ((size_t)(h * 56 + rc) << 14) : (bf16_t*)(ws + WS_SB) + ((size_t)(h * 88 + rc - 56) << 14);
}
struct DiagOrder {
    int G, c;
    __device__ bool next(int i, pg8::Unit& u) const { const int L = i * G + c; if (L >= 288) return false; u.aux = L / 72; u.pm = L - 72 * u.aux; u.pn = u.pm; return true; }
    __device__ __forceinline__ const char* a_ptr(const pg8::Gemm& g, const pg8::Unit& u) const { return (const char*)(g.A + ((size_t)(2 * u.pm) * 4 + u.aux) * 32768); }
    __device__ __forceinline__ const char* b_ptr(const pg8::Gemm& g, const pg8::Unit& u, int half) const { return (const char*)(g.Bt + ((size_t)(2 * u.pm + half) * 4 + u.aux) * 32768); }
    __device__ __forceinline__ bool b_mirror(const pg8::Unit&) const { return false; }
    __device__ __forceinline__ bool b_fix(const pg8::Unit&) const { return false; }
    __device__ __forceinline__ int ktiles(const pg8::Gemm& g, const pg8::Unit&) const { return g.K / pg8::BK; }
};
struct EpiS {
    static constexpr bool PERM = true;
    unsigned char* ws;
    __device__ __forceinline__ void operator()(AccRef acc, const pg8::Unit& u, int wr, int wc, int fr, int fq) const {
#pragma unroll
        for (int ai = 0; ai < 2; ++ai) { bf16_t* sp = s_chunk(ws, u.aux, 2 * u.pm + ai);
#pragma unroll
            for (int m = 0; m < 4; ++m) { const f32x4 v0 = acc[ai][ai][m][0], v1 = acc[ai][ai][m][1]; u32x4 w;
                w.x = cvt_pk_bf16(v0[0], v0[1]); w.y = cvt_pk_bf16(v0[2], v0[3]); w.z = cvt_pk_bf16(v1[0], v1[1]); w.w = cvt_pk_bf16(v1[2], v1[3]);
                *(u32x4*)(sp + ((((wr * 4 + m) * 4 + wc) * 64 + fq * 16 + fr) << 3)) = w; } }
    }
};
struct QKVOrder : pg8::TileOrder {
    int i0, i1;
    __device__ void init2(int G_, int c_, int i0_, int i1_) { nM = 72; nN = 16; nwg = 1152; G = G_; c = c_; i0 = i0_; i1 = i1_; }
    __device__ bool next(int i, pg8::Unit& u) const {
        const int ii = i + i0; if (ii >= i1) return false;
        const int L = ii * G + c; if (L >= 1152) return false;
        if (L < 576) { map(L, 72, 8, u); } else if (L < 1008) { map(L - 576, 72, 6, u); u.pn += 8; } else { map(L - 1008, 72, 2, u); u.pn += 14; }
        return true;
    }
};
#define XQ_SUB(l, j) (3584 + 64 * ((l) * 16 + (j)))
#define XQ_TOP(l)    (8768 + 64 * (l))
__device__ __forceinline__ void xq_arrive(const XcdBarrier& b, int layer) {
    asm volatile("s_waitcnt vmcnt(0)" ::: "memory");
    __syncthreads();
    if (threadIdx.x == 0) {
        unsigned nloc = b.st[0], nx = b.st[1];
        if (nloc == 0u) { xcd_barrier_complete(b.bar, b.x, nloc, nx); b.st[0] = nloc; b.st[1] = nx; }
        const unsigned old = xb_add(&b.bar[XQ_SUB(layer, b.x)], 1u);
        if (old + 1u == nloc) { __builtin_amdgcn_fence(__ATOMIC_RELEASE, "agent"); asm volatile("s_waitcnt vmcnt(0)" ::: "memory"); xb_add(&b.bar[XQ_TOP(layer)], 1u); }
    }
}
__device__ __forceinline__ void xq_wait(const XcdBarrier& b, int layer) {
    if (threadIdx.x == 0) {
        const unsigned nx = b.st[1];
        XB_SPIN(xb_ld(&b.bar[XQ_TOP(layer)]) < nx, b.bar);
        __builtin_amdgcn_fence(__ATOMIC_ACQUIRE, "agent");
        asm volatile("s_waitcnt vmcnt(0)" ::: "memory");
    }
    __syncthreads();
}
typedef short bf16x4 __attribute__((ext_vector_type(4)));
typedef short v4i16_t __attribute__((ext_vector_type(4)));
__device__ __forceinline__ bf16x8 ldtr2(const LAS unsigned char* p0, const LAS unsigned char* p1) {
    const bf16x4 lo = __builtin_bit_cast(bf16x4, __builtin_amdgcn_ds_read_tr16_b64_v4i16((LAS v4i16_t*)p0));
    const bf16x4 hi = __builtin_bit_cast(bf16x4, __builtin_amdgcn_ds_read_tr16_b64_v4i16((LAS v4i16_t*)p1));
    return __builtin_shufflevector(lo, hi, 0, 1, 2, 3, 4, 5, 6, 7);
}
__device__ __forceinline__ int blk_perm(int rb) { return (rb & ~3) | ((rb >> 1) & 1) | ((rb & 1) << 1); }
__device__ __forceinline__ int scan_t0(int dir, int b, int s) {
    return dir == 0 ? ((s < 2) ? (NLAT + b * CTXL + s * 128) : (b * SEQ + (s - 2) * 128)) : ((s < 2) ? (NLAT + b * CTXL + (1 - s) * 128) : (b * SEQ + (17 - s) * 128));
}
__device__ __forceinline__ int scan_rc(int dir, int b, int s) {
    return dir == 0 ? ((s < 2) ? (128 + b * 2 + s) : (b * 16 + (s - 2))) : ((s < 2) ? (128 + b * 2 + (1 - s)) : (b * 16 + (17 - s)));
}
__device__ __forceinline__ u32x4 ldg16(const void* ub, unsigned voff) { return *(const GAS u32x4*)((const GAS unsigned char*)ub + voff); }
__device__ __forceinline__ void scan_load_s(u32x4 (&sf)[4], unsigned char* ws, int h, int rc, int w, int r, int q) {
    const bf16_t* ub = s_chunk(ws, h, rc) + w * 2048; const unsigned vo = (unsigned)(16 * q + r) * 16u;
#pragma unroll
    for (int ks = 0; ks < 4; ++ks) sf[ks] = ldg16(ub, vo + 1024u * ks);
}
__device__ __forceinline__ void scan_load_q(u32x4 (&qf)[8], const bf16_t* Qg, int h, int t0, int w, int r, int q) {
    const bf16_t* ub = Qg + (((size_t)(t0 >> 7) * 4 + h) * 8 + w) * 4096; const unsigned vo = (unsigned)(16 * q + r) * 16u;
#pragma unroll
    for (int ks = 0; ks < 8; ++ks) qf[ks] = ldg16(ub, vo + 1024u * ks);
}
__device__ __forceinline__ void scan_load_kv(u32x4 (&kr)[8], u32x4 (&vr)[2], const bf16_t* Kg, const bf16_t* Vg, int h, int sl, int t0, int w, int lane, int tid) {
    const bf16_t* kb = Kg + (((size_t)(t0 >> 7) * 4 + h) * 8 + w) * 4096; const unsigned ko = (unsigned)lane * 16u;
#pragma unroll
    for (int it = 0; it < 8; ++it) kr[it] = ldg16(kb, ko + 1024u * it);
    const bf16_t* vb = Vg + (size_t)t0 * 2048 + h * 512 + sl * 64; const unsigned vo = (unsigned)((tid >> 3) * 2048 + 8 * (tid & 7)) * 2u;
#pragma unroll
    for (int i = 0; i < 2; ++i) vr[i] = ldg16(vb + (size_t)i * 64 * 2048, vo);
}
#ifndef DBG_SEG
#define DBG_SEG -1
#endif
#define SEG_MARK(k) do { if (DBG_SEG >= 0) { __builtin_amdgcn_sched_barrier(0); const unsigned long long t_ = __builtin_amdgcn_s_memtime(); if (DBG_SEG == (k)) segacc += t_ - segt; segt = t_; __builtin_amdgcn_sched_barrier(0); } } while (0)
template <int DIR>
__device__ __forceinline__ void scan_step(unsigned long long& segacc, unsigned long long& segt, LAS unsigned char* lds, u32x4 (&sf)[4], u32x4 (&qf)[8], u32x4 (&kr)[8], u32x4 (&vr)[2], f32x4 (&Rb)[2][4], const float (&wm)[2], float rsc, float g128,
                                          int t0, int t0n, int rcn, unsigned char* ws, int h, int sl, int w, int lane_in, int tid_in, const bf16_t* Qg, const bf16_t* Kg, const bf16_t* Vg, bf16_t* OF, float* SSP) {
    int lane = lane_in; asm volatile("" : "+v"(lane));
    const int tid = (tid_in & ~63) | lane;
    const int r = lane & 15, q = lane >> 4;
    LAS unsigned char* VI = lds + SC_V_OFF; LAS unsigned char* RT = lds + SC_RT_OFF; LAS unsigned char* KI = lds + SC_K_OFF + w * 8192;
    SEG_MARK(5);
#pragma unroll
    for (int i = 0; i < 2; ++i) { const int m = (tid >> 3) + 64 * i, e0 = 8 * (tid & 7); const float sc = wm[i]; const u32x4 v = vr[i]; u32x4 o;
        o.x = cvt_pk_bf16(bflo(v.x) * sc, bfhi(v.x) * sc); o.y = cvt_pk_bf16(bflo(v.y) * sc, bfhi(v.y) * sc); o.z = cvt_pk_bf16(bflo(v.z) * sc, bfhi(v.z) * sc); o.w = cvt_pk_bf16(bflo(v.w) * sc, bfhi(v.w) * sc);
        *(LAS u32x4*)(VI + 128 * ((e0 >> 4) * 32 + blk_perm(m >> 2)) + (m & 3) * 32 + (e0 & 15) * 2) = o; }
#pragma unroll
    for (int it = 0; it < 8; ++it) { const int m = it * 16 + (lane >> 2), dc = lane & 3;
        *(LAS u32x4*)(KI + 128 * ((dc >> 1) * 32 + blk_perm(m >> 2)) + (m & 3) * 32 + (dc & 1) * 16) = kr[it]; }
    SEG_MARK(0);
    asm volatile("s_waitcnt lgkmcnt(0)" ::: "memory"); __builtin_amdgcn_s_barrier(); asm volatile("" ::: "memory");
    SEG_MARK(1);
    const int jl = 16 * w + r;
    { const bf16_t* vb = Vg + (size_t)t0n * 2048 + h * 512 + sl * 64; const unsigned vo = (unsigned)((tid >> 3) * 2048 + 8 * (tid & 7)) * 2u;
#pragma unroll
      for (int i = 0; i < 2; ++i) vr[i] = ldg16(vb + (size_t)i * 64 * 2048, vo); }
    GAS unsigned char* ob = (GAS unsigned char*)(OF + ((size_t)((((t0 >> 7) * 4 + h) * 8 + sl) * 8 + w) << 10)); const unsigned oo = (unsigned)lane * 8u;
    f32x4 O[4];
#pragma unroll
    for (int eb = 0; eb < 4; ++eb) O[eb] = (f32x4){0.f, 0.f, 0.f, 0.f};
    const LAS unsigned char* rtb = RT + r * 528 + q * 16;
    const bf16_t* qub = Qg + (((size_t)(t0n >> 7) * 4 + h) * 8 + w) * 4096; const unsigned qvo = (unsigned)(16 * q + r) * 16u;
    const bf16_t* kub = Kg + (((size_t)(t0n >> 7) * 4 + h) * 8 + w) * 4096; const unsigned kvo = (unsigned)lane * 16u;
    bf16x8 avp[2][4];
#pragma unroll
    for (int eb = 0; eb < 4; ++eb) avp[0][eb] = *(const LAS bf16x8*)(rtb + (16 * eb * 528));
#pragma unroll
    for (int ks = 0; ks < 8; ++ks) { const bf16x8 qv = __builtin_bit_cast(bf16x8, qf[ks]);
        if (ks < 7) {
#pragma unroll
            for (int eb = 0; eb < 4; ++eb) avp[(ks + 1) & 1][eb] = *(const LAS bf16x8*)(rtb + (16 * eb * 528 + 64 * (ks + 1)));
            asm volatile("s_waitcnt lgkmcnt(4)" ::: "memory"); }
        else asm volatile("s_waitcnt lgkmcnt(0)" ::: "memory");
        __builtin_amdgcn_sched_barrier(0);
#pragma unroll
        for (int eb = 0; eb < 4; ++eb) O[eb] = __builtin_amdgcn_mfma_f32_16x16x32_bf16(avp[ks & 1][eb], qv, O[eb], 0, 0, 0);
        if (w < 4) { qf[ks] = ldg16(qub, qvo + 1024u * ks); kr[ks] = ldg16(kub, kvo + 1024u * ks); }
        __builtin_amdgcn_sched_barrier(0); }
    u32x2 pvf[4];
    if (DIR == 1) {
#pragma unroll
        for (int eb = 0; eb < 4; ++eb) pvf[eb] = *(const GAS u32x2*)(ob + oo + 512 * eb); }
    SEG_MARK(2);
    const int lofs = 128 * (4 * (q >> 1) + (q & 1)) + 8 * r;
    const LAS unsigned char* vtb = VI + lofs; const LAS unsigned char* ktb = KI + lofs;
#pragma unroll
    for (int ks = 0; ks < 4; ++ks) {
        bf16x8 vb[4], ka[2];
#pragma unroll
        for (int eb = 0; eb < 4; ++eb) vb[eb] = ldtr2(vtb + 128 * (eb * 32 + 8 * ks), vtb + 128 * (eb * 32 + 8 * ks + 2));
#pragma unroll
        for (int db = 0; db < 2; ++db) ka[db] = ldtr2(ktb + 128 * (db * 32 + 8 * ks), ktb + 128 * (db * 32 + 8 * ks + 2));
        __builtin_amdgcn_sched_barrier(0);
        bf16x8 sfm;
        { unsigned wd[4] = {sf[ks].x, sf[ks].y, sf[ks].z, sf[ks].w};
#pragma unroll
          for (int i = 0; i < 4; ++i) { const int m0 = 32 * ks + 8 * q + 2 * i; const bool k0 = DIR == 0 ? (m0 <= jl) : (m0 >= jl), k1 = DIR == 0 ? (m0 + 1 <= jl) : (m0 + 1 >= jl);
              wd[i] &= (k0 ? 0xffffu : 0u) | (k1 ? 0xffff0000u : 0u); }
          sfm = __builtin_bit_cast(bf16x8, (u32x4){wd[0], wd[1], wd[2], wd[3]}); }
#pragma unroll
        for (int eb = 0; eb < 4; ++eb) O[eb] = __builtin_amdgcn_mfma_f32_16x16x32_bf16(vb[eb], sfm, O[eb], 0, 0, 0);
#pragma unroll
        for (int db = 0; db < 2; ++db)
#pragma unroll
            for (int eb = 0; eb < 4; ++eb) Rb[db][eb] = __builtin_amdgcn_mfma_f32_16x16x32_bf16(ka[db], vb[eb], Rb[db][eb], 0, 0, 0);
        if (w >= 4) {
            qf[2 * ks] = ldg16(qub, qvo + 1024u * (2 * ks)); qf[2 * ks + 1] = ldg16(qub, qvo + 1024u * (2 * ks + 1));
            kr[2 * ks] = ldg16(kub, kvo + 1024u * (2 * ks)); kr[2 * ks + 1] = ldg16(kub, kvo + 1024u * (2 * ks + 1)); }
    }
    SEG_MARK(3);
    scan_load_s(sf, ws, h, rcn, w, r, q);
    {
        float ss = 0.f;
#pragma unroll
        for (int eb = 0; eb < 4; ++eb) { f32x4 v = O[eb] * rsc;
            if (DIR == 1) { const u32x2 pv = pvf[eb]; v[0] += bflo(pv.x); v[1] += bfhi(pv.x); v[2] += bflo(pv.y); v[3] += bfhi(pv.y);
                ss += (v[0] * v[0] + v[1] * v[1]) + (v[2] * v[2] + v[3] * v[3]); }
            u32x2 o; o.x = cvt_pk_bf16(v[0], v[1]); o.y = cvt_pk_bf16(v[2], v[3]); *(GAS u32x2*)(ob + oo + 512 * eb) = o; }
        if (DIR == 1) { ss += shx(ss, 16, lane); ss += shx(ss, 32, lane); if (q == 0) *(GAS float*)((GAS unsigned char*)(SSP + (size_t)(t0 + 16 * w) * 32 + h * 8 + sl) + (unsigned)r * 128u) = ss; }
    }
#pragma unroll
    for (int db = 0; db < 2; ++db)
#pragma unroll
        for (int eb = 0; eb < 4; ++eb) Rb[db][eb] = Rb[db][eb] * g128;
    SEG_MARK(4);
    asm volatile("s_waitcnt lgkmcnt(0)" ::: "memory"); __builtin_amdgcn_s_barrier(); asm volatile("" ::: "memory");
    SEG_MARK(6);
#pragma unroll
    for (int db = 0; db < 2; ++db)
#pragma unroll
        for (int eb = 0; eb < 4; ++eb) { u32x2 o; o.x = cvt_pk_bf16(Rb[db][eb][0], Rb[db][eb][1]); o.y = cvt_pk_bf16(Rb[db][eb][2], Rb[db][eb][3]);
            *(LAS u32x2*)(RT + (16 * eb + r) * 528 + (32 * w + 16 * db + 4 * q) * 2) = o; }
}
template <int DIR>
__device__ __forceinline__ void scan_unit(Frame& F, int tid, unsigned char* ws, int b, int h, int sl, float lg, const bf16_t* Qg, const bf16_t* Kg, const bf16_t* Vg, bf16_t* OF, float* SSP) {
    const int lane = tid & 63, w = __builtin_amdgcn_readfirstlane(tid >> 6), r = lane & 15, q = lane >> 4;
    const float g128 = __expf(128.f * lg);
    float wm[2];
#pragma unroll
    for (int i = 0; i < 2; ++i) { const int m = (tid >> 3) + 64 * i; wm[i] = __expf(lg * (float)(DIR == 0 ? 127 - m : m)); }
    const int jl = 16 * w + r; const float rsc = __expf(lg * (float)(DIR == 0 ? jl - 127 : -jl));
    f32x4 Rb[2][4];
#pragma unroll
    for (int db = 0; db < 2; ++db)
#pragma unroll
        for (int eb = 0; eb < 4; ++eb) Rb[db][eb] = (f32x4){0.f, 0.f, 0.f, 0.f};
    {
        LAS unsigned char* RT = F.lds + SC_RT_OFF;
#pragma unroll
        for (int db = 0; db < 2; ++db)
#pragma unroll
            for (int eb = 0; eb < 4; ++eb) *(LAS u32x2*)(RT + (16 * eb + r) * 528 + (32 * w + 16 * db + 4 * q) * 2) = (u32x2){0u, 0u};
    }
    u32x4 sf[4], qf[8], kr[8], vr[2];
    unsigned long long segacc = 0ull, segt = (DBG_SEG >= 0) ? __builtin_amdgcn_s_memtime() : 0ull;
    scan_load_s(sf, ws, h, scan_rc(DIR, b, 0), w, r, q);
    scan_load_q(qf, Qg, h, scan_t0(DIR, b, 0), w, r, q);
    scan_load_kv(kr, vr, Kg, Vg, h, sl, scan_t0(DIR, b, 0), w, lane, tid);
    for (int s = 0; s < 18; ++s) {
        const int sn = (s + 1 < 18) ? s + 1 : 17;
        scan_step<DIR>(segacc, segt, F.lds, sf, qf, kr, vr, Rb, wm, rsc, g128, scan_t0(DIR, b, s), scan_t0(DIR, b, sn), scan_rc(DIR, b, sn), ws, h, sl, w, lane, tid, Qg, Kg, Vg, OF, SSP);
    }
    if (DBG_SEG >= 0) { const unsigned long long te_ = __builtin_amdgcn_s_memtime() + segacc; while (__builtin_amdgcn_s_memtime() < te_) __builtin_amdgcn_s_sleep(4); }
    __syncthreads();
}
__device__ __forceinline__ void scan_phase(Frame& F, const Args& a, int layer, int dir) {
    PHASE_IDS();
    const int j = layer >> 1; const float* dec = a.in[11] + j * 8 + dir * 4;
    for (int u = F.vcu; u < 256; u += F.G) {
        const int b = u >> 5, h = (u >> 3) & 3, sl = u & 7;
        const float lg = log1pf(-exp2f(dec[h]));
        if (dir == 0) scan_unit<0>(F, tid, ws, b, h, sl, lg, (const bf16_t*)(ws + WS_Q), (const bf16_t*)(ws + WS_K), (const bf16_t*)(ws + WS_V), (bf16_t*)(ws + WS_OF), (float*)(ws + WS_SSP));
        else scan_unit<1>(F, tid, ws, b, h, sl, lg, (const bf16_t*)(ws + WS_Q), (const bf16_t*)(ws + WS_K), (const bf16_t*)(ws + WS_V), (bf16_t*)(ws + WS_OF), (float*)(ws + WS_SSP));
    }
}
__device__ __forceinline__ void n2_phase(Frame& F, const Args& a, int layer) {
    PHASE_IDS();
    norm_rows<false>(F, a, layer, (bf16_t*)(ws + WS_Q));
    const float* SSP = (const float*)(ws + WS_SSP); float* RINV = (float*)(ws + WS_RINV);
    const int gt = F.vcu * 512 + tid, NT = F.G * 512;
    for (int idx = gt; idx < NTOK * 4; idx += NT) { const f32x4 p0 = *(const f32x4*)(SSP + (size_t)idx * 8), p1 = *(const f32x4*)(SSP + (size_t)idx * 8 + 4);
        const float ss = ((p0.x + p0.y) + (p0.z + p0.w)) + ((p1.x + p1.y) + (p1.z + p1.w)); RINV[idx] = rsqrtf(ss * (1.f / 512.f) + EPS); }
}
__device__ __forceinline__ void final_phase(Frame& F, const Args& a) {
    PHASE_IDS();
    const float* fg = a.in[12]; const int gw = F.vcu * 8 + wave, NGW = F.G * 8;
    f32x4 g[4];
#pragma unroll
    for (int jj = 0; jj < 4; ++jj) g[jj] = *(const f32x4*)(fg + 4 * lane + 256 * jj);
    for (int m0 = gw; m0 < NLAT; m0 += 4 * NGW) {
        f32x4 v[4][4]; float ss[4];
#pragma unroll
        for (int t = 0; t < 4; ++t) { const int m = (m0 + t * NGW) < NLAT ? (m0 + t * NGW) : gw; const f32x4* xr = (const f32x4*)(a.out + (size_t)m * DM) + lane;
#pragma unroll
            for (int jj = 0; jj < 4; ++jj) v[t][jj] = xr[64 * jj]; }
#pragma unroll
        for (int t = 0; t < 4; ++t) { float s = 0.f;
#pragma unroll
            for (int jj = 0; jj < 4; ++jj) s += (v[t][jj].x * v[t][jj].x + v[t][jj].y * v[t][jj].y) + (v[t][jj].z * v[t][jj].z + v[t][jj].w * v[t][jj].w);
            ss[t] = s; }
#pragma unroll
        for (int o = 1; o < 64; o <<= 1) {
#pragma unroll
            for (int t = 0; t < 4; ++t) ss[t] += shx(ss[t], o, lane); }
#pragma unroll
        for (int t = 0; t < 4; ++t) { const int m = m0 + t * NGW; if (m < NLAT) { const float rinv = rsqrtf(ss[t] * (1.f / DM) + EPS); f32x4* xw = (f32x4*)(a.out + (size_t)m * DM) + lane;
#pragma unroll
            for (int jj = 0; jj < 4; ++jj) xw[64 * jj] = v[t][jj] * rinv * g[jj]; } }
    }
}

constexpr int N_PHASES = 34;
__global__ void __launch_bounds__(512, 2) trunk_fwd(Args args) {
    extern __shared__ __attribute__((aligned(16))) unsigned char lds_raw[];
    Frame F;
    F.lds = (LAS unsigned char*)lds_raw;
    F.G = gridDim.x; F.wv = __builtin_amdgcn_readfirstlane((int)threadIdx.x >> 6); { const int bx = blockIdx.x; F.vcu = (F.G % 8 == 0) ? (bx % 8) * (F.G / 8) + bx / 8 : bx; }
    F.ws = args.ws;
    volatile LAS unsigned* MISC = (volatile LAS unsigned*)(F.lds + MISC_OFF);
    for (int u = threadIdx.x; u < 128; u += 512) MISC[u] = 0u;
    __syncthreads();
    const int lo = args.ph_lo, hi = args.ph_hi;
    XcdBarrier bar; bar.bar = (unsigned*)(args.ws + WS_CTL) + 4096; bar.x = 0; bar.st = nullptr;
    const bool multi = (hi - lo) > 1;
    if (multi) bar = xcd_barrier_post((unsigned*)(args.ws + WS_CTL) + 4096, MISC + 8);
#ifndef KINDS
#define KINDS 0xFFFF
#endif
#define KON(b) (((KINDS) >> (b)) & 1)
#define IN(k) (lo <= (k) && (k) < hi)
#ifndef DBG_PROBE
#define DBG_PROBE -1
#endif
    unsigned long long tph0 = (DBG_PROBE >= 0) ? __builtin_amdgcn_s_memrealtime() : 0ull; int cur_layer = -1;
#ifndef DBG_PLAYER
#define DBG_PLAYER -1
#endif
#define PROBE(kind) do { if (DBG_PROBE == (kind) && (DBG_PLAYER < 0 || DBG_PLAYER == cur_layer)) { const unsigned long long t1_ = __builtin_amdgcn_s_memrealtime(); const unsigned long long te_ = t1_ + (t1_ - tph0); while (__builtin_amdgcn_s_memrealtime() < te_) __builtin_amdgcn_s_sleep(8); } } while (0)
#define SEAM(k) do { if (multi && (k) + 1 < hi) xcd_barrier(bar); if (DBG_PROBE >= 0) tph0 = __builtin_amdgcn_s_memrealtime(); } while (0)
    const int bx = (int)blockIdx.x, G = F.G;
    const bool mergeS = multi && G == 256 && lo == 0;
    const bool mergeP0 = mergeS && hi > 1 && KON(0) && KON(1);
    if (KON(0) && IN(0)) { p0_phase(F, args); if (mergeP0) xq_arrive(bar, 4); p0_conv(F, args); if (mergeP0) xq_wait(bar, 4); PROBE(0); if (!mergeP0) SEAM(0); }
    for (int layer = 0; layer < NLAYER; ++layer) {
        const int pb = 1 + 8 * layer; const bool fourier = (layer & 1) == 0; cur_layer = layer;
        unsigned char* ws = launder_ptr(args.ws);
#define MAKE_ER() const EpiResid ER{layer == 0 ? args.in[0] : args.out, args.out, (const float*)(ws + WS_ADA) + layer * 9 * 3072 + 2048, (float*)(ws + WS_PART)}
        if (KON(1) && IN(pb)) { n_phase(F, args, layer); PROBE(1); SEAM(pb); }
        if (fourier) {
            bf16_t* W1 = (bf16_t*)(ws + WS_WF);
            if (KON(2) && IN(pb + 1)) {
                { pg8::Gemm g{(const bf16_t*)(ws + WS_H), W1 + (size_t)2048 * 1024, 1024, 1024, 1024}; pg8::TileOrder S; S.init(72, 8, G, bx);
                  EpiSilu E{(bf16_t*)(ws + WS_Z), 2048}; pg8::gemm_phase(F.lds, F.wv, g, S, E); }
                { pg8::Gemm g{W1, (const bf16_t*)(ws + WS_H), 1024, 1024, 1024}; UOrder S; S.init(8, 72, G, (bx + 64) % G);
                  EpiUTF E{(bf16_t*)(ws + WS_UTL), (bf16_t*)(ws + WS_UTC), (float*)(ws + WS_RINV)}; pg8::gemm_phase<EpiUTF, UOrder, true>(F.lds, F.wv, g, S, E); }
                bg_conv_ret(F, args, layer, 64, 0, 1024);
                PROBE(2); SEAM(pb + 1);
            }
            if (KON(3) && IN(pb + 2)) {
                { pg8::Gemm g{(const bf16_t*)(ws + WS_CS), (const bf16_t*)(ws + WS_UTL), 1024, 1024, 1024}; pg8::TileOrder S; S.init(8, 64, G, bx);
                  EpiDft<true> E{(bf16_t*)(ws + WS_Z), 2048, 0, (const float*)(ws + WS_RINV)}; pg8::gemm_phase(F.lds, F.wv, g, S, E); }
                { pg8::Gemm g{(const bf16_t*)(ws + WS_CS256), (const bf16_t*)(ws + WS_UTC), 256, 256, 256}; pg8::TileOrder S; S.init(2, 64, G, bx);
                  EpiDft<false> E{(bf16_t*)(ws + WS_Z), 256, NLAT, nullptr}; pg8::gemm_phase(F.lds, F.wv, g, S, E); }
                nyq_row_phase(F);
                bg_conv_ret(F, args, layer, 128, 1024, 1536);
                PROBE(3); SEAM(pb + 2);
            }
            if (KON(4) && IN(pb + 3)) {
                pg8::Gemm g{(const bf16_t*)(ws + WS_Z), W1 + (size_t)4096 * 1024, 2048, 2048, 2048}; OutOrder S; S.init(G, bx, true); MAKE_ER();
                pg8::gemm_phase(F.lds, F.wv, g, S, ER);
                bg_conv_ret(F, args, layer, 128, 1536, 2048);
                PROBE(4); SEAM(pb + 3);
            }
        } else {
            bf16_t* W1 = (bf16_t*)(ws + WS_W);
            if (KON(5) && IN(pb + 1)) {
                pg8::Gemm g{(const bf16_t*)(ws + WS_OF), W1, 1024, 1024, 1024};
                EpiQKV E{(bf16_t*)(ws + WS_Q), (bf16_t*)(ws + WS_K), (bf16_t*)(ws + WS_V), (const float*)(ws + WS_ROPE), (const float*)(ws + WS_ROPE) + 4096};
                if (mergeS) {
                    { QKVOrder S; S.init2(G, bx, 0, 4); pg8::gemm_phase(F.lds, F.wv, g, S, E); }
                    xq_arrive(bar, layer);
                    if (bx < 128) { QKVOrder S; S.init2(G, bx, 4, 5); pg8::gemm_phase(F.lds, F.wv, g, S, E); }
                    else { xq_wait(bar, layer);
                        pg8::Gemm gs{(const bf16_t*)(ws + WS_Q), (const bf16_t*)(ws + WS_K), 1024, 1024, 256}; DiagOrder S{128, bx - 128};
                        EpiS ES{ws}; pg8::gemm_phase<EpiS, DiagOrder, false, true>(F.lds, F.wv, gs, S, ES); }
                } else { pg8::TileOrder S; S.init(72, 16, G, bx); pg8::gemm_phase(F.lds, F.wv, g, S, E); }
                PROBE(5); SEAM(pb + 1);
            }
            if (KON(6) && IN(pb + 2)) {
                if (!mergeS) {
                    { pg8::Gemm g{(const bf16_t*)(ws + WS_Q), (const bf16_t*)(ws + WS_K), 1024, 1024, 256}; DiagOrder S{G, bx};
                      EpiS E{ws}; pg8::gemm_phase<EpiS, DiagOrder, false, true>(F.lds, F.wv, g, S, E); }
                    PROBE(11); if (multi) xcd_barrier(bar); if (DBG_PROBE >= 0) tph0 = __builtin_amdgcn_s_memrealtime(); }
                scan_phase(F, args, layer, 0); PROBE(6);
            }
            if (KON(6) && IN(pb + 3)) {
                if (multi) { asm volatile("s_waitcnt vmcnt(0)" ::: "memory"); __syncthreads();
                    if (threadIdx.x == 0) { __builtin_amdgcn_fence(__ATOMIC_ACQUIRE, "agent"); asm volatile("s_waitcnt vmcnt(0)" ::: "memory"); }
                    __syncthreads(); if (DBG_PROBE >= 0) tph0 = __builtin_amdgcn_s_memrealtime(); }
                scan_phase(F, args, layer, 1); PROBE(12); SEAM(pb + 3); }
            if (KON(7) && IN(pb + 4)) { n2_phase(F, args, layer); PROBE(7); SEAM(pb + 4); }
            if (KON(8) && IN(pb + 5)) {
                pg8::Gemm g{(const bf16_t*)(ws + WS_Q), W1 + (size_t)4096 * 1024, 1024, 1024, 1024}; pg8::TileOrder S; S.init(layer == NLAYER - 1 ? 64 : 72, 8, G, bx);
                EpiZGate E{(const bf16_t*)(ws + WS_OF), (const float*)(ws + WS_RINV), (bf16_t*)(ws + WS_V)};
                pg8::gemm_phase(F.lds, F.wv, g, S, E);
                PROBE(8); SEAM(pb + 5);
            }
            if (KON(9) && IN(pb + 6)) {
                pg8::Gemm g{(const bf16_t*)(ws + WS_V), W1 + (size_t)6144 * 1024, 2048, 2048, 2048}; OutOrder S; S.init(G, bx, layer != NLAYER - 1); MAKE_ER();
                pg8::gemm_phase(F.lds, F.wv, g, S, ER);
                PROBE(9); SEAM(pb + 6);
            }
        }
    }
    if (KON(10) && IN(33)) { final_phase(F, args); PROBE(10); }
#undef IN
#undef SEAM
}

extern "C" void kernel_launch(void* const* d_in, const int* in_sizes, int n_in, void* d_out, int out_size, void* d_ws, size_t ws_size, hipStream_t stream) {
    static int grid = 0;
    if (grid == 0) {
        if (n_in != 13 || out_size != NLAT * DM || ws_size < WS_END) { fprintf(stderr, "kernel_launch: unexpected problem (n_in %d, out %d, ws %zu)\n", n_in, out_size, ws_size); grid = -1; return; }
        int dev = 0, cus = 0;
        if (hipGetDevice(&dev) != hipSuccess || hipDeviceGetAttribute(&cus, hipDeviceAttributeMultiprocessorCount, dev) != hipSuccess) { grid = -1; return; }
        if (hipFuncSetAttribute((const void*)trunk_fwd, hipFuncAttributeMaxDynamicSharedMemorySize, LDS_BYTES) != hipSuccess) { fprintf(stderr, "kernel_launch: hipFuncSetAttribute failed\n"); grid = -1; return; }
        (void)hipGetLastError();
        grid = cus;
    }
    if (grid < 0) return;
    if (hipMemsetAsync((char*)d_ws + WS_CTL, 0, CTL_ZERO_BYTES, stream) != hipSuccess) return;
    Args a{};
    for (int i = 0; i < 13; ++i) a.in[i] = (const float*)d_in[i];
    a.out = (float*)d_out; a.ws = (unsigned char*)d_ws;
    a.ph_lo = 0; a.ph_hi = N_PHASES;
    hipLaunchKernelGGL(trunk_fwd, dim3(grid), dim3(512), LDS_BYTES, stream, a);
}
```

```cpp
#include <hip/hip_runtime.h>
#include <cstdio>
#include <cstdint>

#define LAS __attribute__((address_space(3)))
#define GAS __attribute__((address_space(1)))
typedef unsigned short bf16_t;
typedef short bf16x8 __attribute__((ext_vector_type(8)));
typedef float f32x4 __attribute__((ext_vector_type(4)));
typedef float f32x16 __attribute__((ext_vector_type(16)));
typedef unsigned u32x4 __attribute__((ext_vector_type(4)));
typedef unsigned u32x2 __attribute__((ext_vector_type(2)));

constexpr int DM = 1024, NB = 8, SEQ = 2048, CTXL = 256, DBR = 2048, NLAYER = 4;
constexpr int NLAT = NB * SEQ, NCTX = NB * CTXL, NTOK = NLAT + NCTX;
constexpr float EPS = 1e-6f;

constexpr size_t MiB = 1u << 20;
constexpr size_t KiB = 1024;
constexpr size_t WS_CTL = 0, CTL_ZERO_BYTES = 64 * KiB;
constexpr size_t WS_ADA = 256 * KiB;
constexpr size_t WS_TC = 768 * KiB;
constexpr size_t WS_ROPE = 1024 * KiB;
constexpr size_t WS_CS256 = 1088 * KiB;
constexpr size_t WS_RINV = 1344 * KiB;
constexpr size_t WS_XCTX = 2 * MiB;
constexpr size_t WS_W = 10 * MiB;
constexpr size_t WS_R = 26 * MiB;
constexpr size_t WS_H = WS_R;
constexpr size_t WS_Z = WS_R + 36 * MiB;
constexpr size_t WS_UTL = WS_R + 108 * MiB;
constexpr size_t WS_UTC = WS_R + 172 * MiB;
constexpr size_t WS_CS = WS_R + 180 * MiB;
constexpr size_t WS_WF = WS_R + 144 * MiB;
constexpr size_t WS_Q = WS_R;
constexpr size_t WS_K = WS_R + 36 * MiB;
constexpr size_t WS_V = WS_R + 72 * MiB;
constexpr size_t WS_OF = WS_R + 144 * MiB;
constexpr size_t WS_PART = WS_R + 184 * MiB;
constexpr size_t WS_SSP = WS_R + 216 * MiB;
constexpr size_t WS_SA = WS_W;
constexpr size_t WS_SB = WS_R + 219 * MiB;
constexpr size_t WS_END = 256 * MiB;
static_assert(WS_SSP + (size_t)NTOK * 32 * 4 <= WS_SB && WS_SB + 11 * MiB <= WS_END && WS_CS + 16 * MiB <= WS_END && WS_RINV + 288 * KiB <= WS_XCTX, "ws map");

constexpr int LDS_BYTES = 147456;
constexpr int RING_BYTES = 131072;
constexpr int SC_V_OFF = 0;
constexpr int SC_RT_OFF = 16384;
constexpr int SC_K_OFF = 16384 + 33792;
constexpr int MISC_OFF = 145408;
static_assert(SC_K_OFF + 65536 <= MISC_OFF && MISC_OFF + 512 <= LDS_BYTES, "lds map");

__device__ __forceinline__ unsigned f2bf(float f) { unsigned u = __builtin_bit_cast(unsigned, f); return (u + 0x7fffu + ((u >> 16) & 1u)) >> 16; }
__device__ __forceinline__ unsigned pk2(float lo, float hi) { return f2bf(lo) | (f2bf(hi) << 16); }
__device__ __forceinline__ float bflo(unsigned w) { return __builtin_bit_cast(float, w << 16); }
__device__ __forceinline__ float bfhi(unsigned w) { return __builtin_bit_cast(float, w & 0xffff0000u); }
__device__ __forceinline__ float bf1(bf16_t h) { return __builtin_bit_cast(float, (unsigned)h << 16); }
__device__ __forceinline__ float silu_f(float x) { return x * __builtin_amdgcn_rcpf(1.f + __expf(-x)); }
__device__ __forceinline__ float shx(float v, int o, int lane) { return __builtin_bit_cast(float, __builtin_amdgcn_ds_bpermute((lane ^ o) << 2, __builtin_bit_cast(int, v))); }
__device__ __forceinline__ float wave_sum(float v, int lane) {
#pragma unroll
    for (int o = 1; o < 64; o <<= 1) v += shx(v, o, lane);
    return v;
}

namespace pg8 {
constexpr int BM = 256, BK = 64, HALF = 128, HTB = HALF * BK * 2, STAGE_BYTES = 8 * HTB, NXCD = 8, WGM = 8;
__host__ __device__ __forceinline__ int lds_byte(int r, int c) { const int st = (r >> 4) * 2 + (c >> 5), rr = r & 15, cc = c & 31, ob = rr * 64 + cc * 2; return st * 1024 + (ob ^ (((ob >> 9) & 1) << 5)); }
__host__ __device__ __forceinline__ void stage_rc(int b, int& R, int& C) { const int st = b / 1024, sb = b % 1024, swz = sb ^ (((sb >> 9) & 1) << 5); R = (st >> 1) * 16 + swz / 64; C = (st & 1) * 32 + (swz % 64) / 2; }
__host__ __device__ __forceinline__ int perm32(int rho) { const int n = rho >> 4, i = rho & 15; return 8 * (i >> 2) + 4 * n + (i & 3); }
struct Unit { int pm, pn, aux; };
struct Gemm { const bf16_t* A; const bf16_t* Bt; int lda, ldb, K; };
struct TileOrder {
    int nM, nN, nwg, G, c;
    __device__ void init(int nM_, int nN_, int G_, int c_) { nM = nM_; nN = nN_; nwg = nM * nN; G = G_; c = c_; }
    __device__ static void map(int wgid, int nM, int nN, Unit& u) {
        const int nwg = nM * nN;
        { const int q = nwg / NXCD, r = nwg % NXCD, xcd = wgid % NXCD, off = wgid / NXCD; wgid = (xcd < r ? xcd * (q + 1) : r * (q + 1) + (xcd - r) * q) + off; }
        const int nig = WGM * nN, gid = wgid / nig, fm = gid * WGM, gsz = (nM - fm) < WGM ? (nM - fm) : WGM;
        u.pm = fm + ((wgid % nig) % gsz); u.pn = (wgid % nig) / gsz; u.aux = 0;
    }
    __device__ bool next(int i, Unit& u) const {
        const long L = (long)i * G + c; if (L >= nwg) return false;
        map((int)L, nM, nN, u); return true;
    }
    __device__ __forceinline__ const char* a_ptr(const Gemm& g, const Unit& u) const { return (const char*)g.A + (size_t)u.pm * 256 * g.lda * 2; }
    __device__ __forceinline__ const char* b_ptr(const Gemm& g, const Unit& u, int half) const { return (const char*)g.Bt + (size_t)(u.pn * 256 + 128 * half) * g.ldb * 2; }
    __device__ __forceinline__ bool b_mirror(const Unit&) const { return false; }
    __device__ __forceinline__ bool b_fix(const Unit&) const { return false; }
    __device__ __forceinline__ int ktiles(const Gemm& g, const Unit&) const { return g.K / BK; }
};
__device__ __forceinline__ unsigned cvt_pk_bf16(float lo, float hi) { unsigned r; asm volatile("v_cvt_pk_bf16_f32 %0, %1, %2" : "=v"(r) : "v"(lo), "v"(hi)); return r; }

template <class Epi, class Sched, bool MIRB = false, bool TILED = false>
__device__ __forceinline__ void gemm_phase(LAS unsigned char* lds, int wv, const Gemm g, const Sched& S, const Epi& E) {
    int tid; { int l_; asm volatile("v_mbcnt_lo_u32_b32 %0, -1, 0\n\tv_mbcnt_hi_u32_b32 %0, -1, %0" : "=v"(l_)); tid = wv * 64 + l_; }
    const int wid = __builtin_amdgcn_readfirstlane(tid >> 6), lane = tid & 63, wr = wid >> 2, wc = wid & 3, fr = lane & 15, fq = lane >> 4;
    unsigned voffA[2], voffB[2], voffM[2], fixd[2];
#pragma unroll
    for (int i = 0; i < 2; ++i) { int R, C; stage_rc(tid * 16 + i * 8192, R, C); const int Rb = Epi::PERM ? ((R & ~31) + perm32(R & 31)) : R;
        voffA[i] = (unsigned)(R * g.lda + C) * 2u; voffB[i] = (unsigned)(Rb * g.ldb + C) * 2u; voffM[i] = (unsigned)((1024 - Rb) * g.ldb + C) * 2u; fixd[i] = (Rb == 0) ? (unsigned)(1024 * g.ldb) * 2u : 0u;
        if (TILED) { voffA[i] = (unsigned)(((R >> 4) & 7) * 8192 + (C >> 5) * 1024 + (16 * ((C >> 3) & 3) + (R & 15)) * 16);
                     voffB[i] = (unsigned)(((Rb & 127) >> 4) * 1024 + (4 * (Rb & 15) + ((C >> 3) & 3)) * 16 + (C >> 5) * 8192); } }
    const size_t kstepA = TILED ? (size_t)2048 : (size_t)(BK * 2), kstepB = TILED ? (size_t)16384 : (size_t)(BK * 2);
    const size_t hstepA = TILED ? (size_t)262144 : (size_t)HALF * g.lda * 2;
    const unsigned ldsw = (unsigned)wid * 1024u;
    const int aoff = lds_byte(wr * 64 + fr, fq * 8), boff = lds_byte(wc * 32 + fr, fq * 8);
#define PG8_SA(b, h) (((b) * 2 + (h)) * HTB)
#define PG8_SB(b, h) ((4 + (b) * 2 + (h)) * HTB)
#define PG8_STAGE(bufoff, gbase, voff) do { _Pragma("unroll") for (int _i = 0; _i < 2; ++_i) \
        __builtin_amdgcn_global_load_lds((const unsigned*)((const char*)(gbase) + (voff)[_i]), (LAS unsigned*)(lds + (bufoff) + ldsw + _i * 8192), 16, 0, 0); } while (0)
#define PG8_LDA(dst, b, h) do { _Pragma("unroll") for (int m = 0; m < 4; ++m) _Pragma("unroll") for (int k = 0; k < 2; ++k) dst[m][k] = *(const LAS bf16x8*)(lds + PG8_SA(b, h) + aoff + m * 2048 + k * 1024); } while (0)
#define PG8_LDB(dst, b, h) do { _Pragma("unroll") for (int n = 0; n < 2; ++n) _Pragma("unroll") for (int k = 0; k < 2; ++k) dst[n][k] = *(const LAS bf16x8*)(lds + PG8_SB(b, h) + boff + n * 2048 + k * 1024); } while (0)
#define PG8_MMA(ai, bj, At, Bt) do { __builtin_amdgcn_s_setprio(1); _Pragma("unroll") for (int m = 0; m < 4; ++m) _Pragma("unroll") for (int n = 0; n < 2; ++n) _Pragma("unroll") for (int k = 0; k < 2; ++k) \
        acc[ai][bj][m][n] = __builtin_amdgcn_mfma_f32_16x16x32_bf16(Bt[n][k], At[m][k], acc[ai][bj][m][n], 0, 0, 0); __builtin_amdgcn_s_setprio(0); } while (0)
#define PG8_WAIT_V(n) asm volatile("s_waitcnt vmcnt(" #n ")" ::: "memory")
#define PG8_WAIT_L(n) asm volatile("s_waitcnt lgkmcnt(" #n ")" ::: "memory")
#define PG8_BAR __builtin_amdgcn_s_barrier()
#define PG8_SCHED __builtin_amdgcn_sched_barrier(0)
#define PG8_VB1(dst, u) do { if (MIRB && S.b_mirror(u)) { const bool fx_ = S.b_fix(u); dst[0] = voffM[0] - (fx_ ? fixd[0] : 0u); dst[1] = voffM[1] - (fx_ ? fixd[1] : 0u); } else { dst[0] = voffB[0]; dst[1] = voffB[1]; } } while (0)
    Unit cur, nxt; int ui = 0;
    if (!S.next(0, cur)) return;
    f32x4 acc[2][2][4][2];
#pragma unroll
    for (int a = 0; a < 2; ++a)
#pragma unroll
        for (int b = 0; b < 2; ++b)
#pragma unroll
            for (int m = 0; m < 4; ++m)
#pragma unroll
                for (int n = 0; n < 2; ++n) acc[a][b][m][n] = (f32x4){0.f, 0.f, 0.f, 0.f};
    bf16x8 At[4][2], B0[2][2], B1[2][2];
    const char* cA = S.a_ptr(g, cur); const char* cB0 = S.b_ptr(g, cur, 0); const char* cB1 = S.b_ptr(g, cur, 1);
    unsigned vc1[2]; PG8_VB1(vc1, cur);
    PG8_STAGE(PG8_SB(0, 0), cB0, voffB); PG8_STAGE(PG8_SB(0, 1), cB1, vc1); PG8_STAGE(PG8_SA(0, 0), cA, voffA); PG8_STAGE(PG8_SA(0, 1), cA + hstepA, voffA);
    if (wr == 1) PG8_BAR;
    PG8_WAIT_V(2); PG8_BAR;
    PG8_STAGE(PG8_SB(1, 0), cB0 + kstepB, voffB); PG8_STAGE(PG8_SA(1, 0), cA + kstepA, voffA); PG8_STAGE(PG8_SB(1, 1), cB1 + kstepB, vc1);
    PG8_WAIT_V(6); PG8_BAR;
    for (;;) {
        const bool has_next = S.next(ui + 1, nxt);
        const int nt = S.ktiles(g, cur);
        const char* nA = cA; const char* nB0 = cB0; const char* nB1 = cB1; unsigned vn1[2] = {vc1[0], vc1[1]};
        if (has_next) { nA = S.a_ptr(g, nxt); nB0 = S.b_ptr(g, nxt, 0); nB1 = S.b_ptr(g, nxt, 1); PG8_VB1(vn1, nxt); }
        for (int t = 0; t < nt; t += 2) {
            const bool last = (t == nt - 2);
            const char* a1 = cA + (size_t)(t + 1) * kstepA;
            const char* a2 = last ? nA : cA + (size_t)(t + 2) * kstepA; const char* b20 = last ? nB0 : cB0 + (size_t)(t + 2) * kstepB; const char* b21 = last ? nB1 : cB1 + (size_t)(t + 2) * kstepB;
            const char* a3 = a2 + kstepA; const char* b30 = b20 + kstepB; const char* b31 = b21 + kstepB;
            unsigned v21[2]; v21[0] = (MIRB && last) ? vn1[0] : vc1[0]; v21[1] = (MIRB && last) ? vn1[1] : vc1[1];
            PG8_LDB(B0, 0, 0); PG8_LDB(B1, 0, 1); PG8_SCHED; PG8_LDA(At, 0, 0); PG8_STAGE(PG8_SA(1, 1), a1 + hstepA, voffA);
            PG8_WAIT_V(8); PG8_WAIT_L(0); PG8_BAR; PG8_MMA(0, 0, At, B0); PG8_MMA(0, 1, At, B1); PG8_BAR; PG8_SCHED;
            PG8_LDA(At, 0, 1); PG8_STAGE(PG8_SB(0, 0), b20, voffB); PG8_STAGE(PG8_SB(0, 1), b21, v21); PG8_STAGE(PG8_SA(0, 0), a2, voffA);
            PG8_WAIT_V(8); PG8_WAIT_L(0); PG8_BAR; PG8_MMA(1, 0, At, B0); PG8_MMA(1, 1, At, B1); PG8_BAR; PG8_SCHED;
            PG8_LDB(B0, 1, 0); PG8_LDB(B1, 1, 1); PG8_SCHED; PG8_LDA(At, 1, 0); PG8_STAGE(PG8_SA(0, 1), a2 + hstepA, voffA);
            PG8_WAIT_V(8); PG8_WAIT_L(0); PG8_BAR; PG8_MMA(0, 0, At, B0); PG8_MMA(0, 1, At, B1); PG8_BAR; PG8_SCHED;
            PG8_LDA(At, 1, 1); PG8_STAGE(PG8_SB(1, 0), b30, voffB); PG8_STAGE(PG8_SB(1, 1), b31, v21); PG8_STAGE(PG8_SA(1, 0), a3, voffA);
            PG8_WAIT_V(8); PG8_WAIT_L(0); PG8_BAR; PG8_MMA(1, 0, At, B0); PG8_MMA(1, 1, At, B1); PG8_BAR; PG8_SCHED;
        }
        if (wr == 0) PG8_BAR;
        { int l2 = lane; asm volatile("" : "+v"(l2)); E(acc, cur, wr, wc, l2 & 15, l2 >> 4); }
        if (!has_next) break;
#pragma unroll
        for (int a = 0; a < 2; ++a)
#pragma unroll
            for (int b = 0; b < 2; ++b)
#pragma unroll
                for (int m = 0; m < 4; ++m)
#pragma unroll
                    for (int n = 0; n < 2; ++n) acc[a][b][m][n] = (f32x4){0.f, 0.f, 0.f, 0.f};
        cur = nxt; cA = nA; cB0 = nB0; cB1 = nB1; vc1[0] = vn1[0]; vc1[1] = vn1[1]; ++ui;
        if (wr == 1) PG8_BAR;
    }
    PG8_WAIT_V(0);
    PG8_BAR;
#undef PG8_SA
#undef PG8_SB
#undef PG8_STAGE
#undef PG8_LDA
#undef PG8_LDB
#undef PG8_MMA
#undef PG8_WAIT_V
#undef PG8_WAIT_L
#undef PG8_BAR
#undef PG8_SCHED
#undef PG8_VB1
}
}
using pg8::cvt_pk_bf16;
__device__ __forceinline__ void stg16(void* ub, unsigned vo, u32x4 v) { *(GAS u32x4*)((GAS unsigned char*)ub + vo) = v; }
__device__ __forceinline__ u32x4 ldg16u(const void* ub, unsigned vo) { return *(const GAS u32x4*)((const GAS unsigned char*)ub + vo); }
__device__ __forceinline__ void stg16f(void* ub, unsigned vo, f32x4 v) { *(GAS f32x4*)((GAS unsigned char*)ub + vo) = v; }
__device__ __forceinline__ f32x4 ldg16f(const void* ub, unsigned vo) { return *(const GAS f32x4*)((const GAS unsigned char*)ub + vo); }
typedef const f32x4 (&AccRef)[2][2][4][2];

struct EpiSilu {
    static constexpr bool PERM = true;
    bf16_t* O; int ldc;
    __device__ __forceinline__ void operator()(AccRef acc, const pg8::Unit& u, int wr, int wc, int fr, int fq) const {
        bf16_t* ub = O + (size_t)u.pm * 256 * ldc + u.pn * 256; const unsigned vo = (unsigned)((wr * 64 + fr) * ldc + wc * 32 + 8 * fq) * 2u;
#pragma unroll
        for (int ai = 0; ai < 2; ++ai)
#pragma unroll
            for (int m = 0; m < 4; ++m)
#pragma unroll
                for (int bj = 0; bj < 2; ++bj) { const f32x4 v0 = acc[ai][bj][m][0], v1 = acc[ai][bj][m][1]; u32x4 w;
                    w.x = cvt_pk_bf16(silu_f(v0[0]), silu_f(v0[1])); w.y = cvt_pk_bf16(silu_f(v0[2]), silu_f(v0[3]));
                    w.z = cvt_pk_bf16(silu_f(v1[0]), silu_f(v1[1])); w.w = cvt_pk_bf16(silu_f(v1[2]), silu_f(v1[3]));
                    stg16(ub + (size_t)(ai * 128 + m * 16) * ldc, vo + (unsigned)(bj * 256), w); }
    }
};
struct UOrder : pg8::TileOrder {
    __device__ __forceinline__ const char* b_ptr(const pg8::Gemm& g, const pg8::Unit& u, int half) const {
        if (u.pn < 64) { const int b = u.pn >> 3, tp = u.pn & 7; return (const char*)(g.Bt + (size_t)(b * 2048 + (half ? 1024 - 128 * tp : 128 * tp)) * 1024); }
        return (const char*)(g.Bt + (size_t)(NLAT + (u.pn - 64) * 256 + 128 * half) * 1024);
    }
    __device__ __forceinline__ bool b_mirror(const pg8::Unit& u) const { return u.pn < 64; }
    __device__ __forceinline__ bool b_fix(const pg8::Unit& u) const { return (u.pn & 7) == 0; }
};
struct EpiUTF {
    static constexpr bool PERM = true;
    bf16_t* UTF; bf16_t* UTc; float* AH;
    __device__ __forceinline__ void operator()(AccRef acc, const pg8::Unit& u, int wr, int wc, int fr, int fq) const {
        const int feat0 = u.pm * 256 + wr * 64 + fr, col0 = wc * 32 + 8 * fq;
        if (u.pn >= 64) { bf16_t* ub = UTc + (size_t)(u.pn - 64) * 2048 * 256 + (size_t)u.pm * 256 * 256; const unsigned vo = (unsigned)((wr * 64 + fr) * 256 + col0) * 2u;
#pragma unroll
            for (int ai = 0; ai < 2; ++ai)
#pragma unroll
                for (int m = 0; m < 4; ++m)
#pragma unroll
                    for (int bj = 0; bj < 2; ++bj) { const f32x4 v0 = acc[ai][bj][m][0], v1 = acc[ai][bj][m][1]; u32x4 w;
                        w.x = cvt_pk_bf16(v0[0], v0[1]); w.y = cvt_pk_bf16(v0[2], v0[3]); w.z = cvt_pk_bf16(v1[0], v1[1]); w.w = cvt_pk_bf16(v1[2], v1[3]);
                        stg16(ub + (size_t)(ai * 128 + m * 16) * 256, vo + (unsigned)(bj * 256), w); }
            return; }
        const int b = u.pn >> 3, tp = u.pn & 7; const bool first = (tp == 0) && (col0 == 0);
        bf16_t* ub = UTF + ((size_t)b * 2048 + u.pm * 256) * 1024 + 128 * tp; const unsigned vo = (unsigned)((wr * 64 + fr) * 1024 + col0) * 2u;
#pragma unroll
        for (int ai = 0; ai < 2; ++ai)
#pragma unroll
            for (int m = 0; m < 4; ++m) { const int feat = feat0 + ai * 128 + m * 16; const float sg = ((feat & 255) <= 128) ? 1.f : -1.f;
                f32x4 v0 = acc[ai][0][m][0] + acc[ai][1][m][0] * sg; const f32x4 v1 = acc[ai][0][m][1] + acc[ai][1][m][1] * sg;
                if (first) { v0[0] = acc[ai][0][m][0][0]; AH[(size_t)b * 2048 + feat] = acc[ai][1][m][0][0]; }
                u32x4 w; w.x = cvt_pk_bf16(v0[0], v0[1]); w.y = cvt_pk_bf16(v0[2], v0[3]); w.z = cvt_pk_bf16(v1[0], v1[1]); w.w = cvt_pk_bf16(v1[2], v1[3]);
                stg16(ub + (size_t)(ai * 128 + m * 16) * 1024, vo, w); }
    }
};
__device__ __forceinline__ int fpos(int f) { return f <= 128 ? f : 384 - f; }
struct DftZ { u32x4 zd, zm; };
__device__ __forceinline__ DftZ dft_row_ld(const bf16_t* zrow, int mi0) { DftZ z; z.zd = *(const u32x4*)(zrow + mi0); z.zm = *(const u32x4*)(zrow + 128 + mi0); return z; }
__device__ __forceinline__ void dft_row_st(bf16_t* zrow, int mi0, const DftZ& z, const float (&d)[8], const float (&mr)[8]) {
    const u32x4 zd = z.zd, zm = z.zm;
    u32x4 o; o.x = cvt_pk_bf16(d[0] * bflo(zd.x), d[1] * bfhi(zd.x)); o.y = cvt_pk_bf16(d[2] * bflo(zd.y), d[3] * bfhi(zd.y));
    o.z = cvt_pk_bf16(d[4] * bflo(zd.z), d[5] * bfhi(zd.z)); o.w = cvt_pk_bf16(d[6] * bflo(zd.w), d[7] * bfhi(zd.w));
    *(u32x4*)(zrow + mi0) = o;
    u32x4 q; q.x = cvt_pk_bf16(mr[0] * bflo(zm.x), mr[1] * bfhi(zm.x)); q.y = cvt_pk_bf16(mr[2] * bflo(zm.y), mr[3] * bfhi(zm.y));
    q.z = cvt_pk_bf16(mr[4] * bflo(zm.z), mr[5] * bfhi(zm.z)); q.w = cvt_pk_bf16(mr[6] * bflo(zm.w), mr[7] * bfhi(zm.w));
    *(u32x4*)(zrow + 128 + mi0) = q;
}
template <bool FOLD> struct EpiDft {
    static constexpr bool PERM = true;
    bf16_t* Z; int L; int tok_base; const float* AH;
    __device__ __forceinline__ void operator()(AccRef acc, const pg8::Unit& u, int wr, int wc, int fr, int fq) const {
        const int b = u.pn >> 3, g = u.pn & 7, k0 = u.pm * 128 + wr * 64 + fr, mi0 = wc * 32 + 8 * fq;
        f32x4 ah[2] = {(f32x4){0.f, 0.f, 0.f, 0.f}, (f32x4){0.f, 0.f, 0.f, 0.f}}; float ahn = 0.f;
        if (FOLD) { const float* ap = AH + (size_t)b * 2048 + g * 256; ah[0] = *(const f32x4*)(ap + mi0) * 0.022097087f; ah[1] = *(const f32x4*)(ap + mi0 + 4) * 0.022097087f; ahn = ap[128] * 0.022097087f; }
        const bool nyq = (wc == 0 && fq == 0);
        DftZ zr[4], zq[4];
#pragma unroll
        for (int m = 0; m < 4; ++m) { const int k = k0 + 16 * m; const bf16_t* zrow = Z + (size_t)(tok_base + b * L + k) * 2048 + g * 256;
            const bf16_t* zmir = Z + (size_t)(tok_base + b * L + ((FOLD && k >= 1) ? (L - k) : k)) * 2048 + g * 256;
            zr[m] = dft_row_ld(zrow, mi0); if (FOLD) zq[m] = dft_row_ld(zmir, mi0); }
#pragma unroll
        for (int m = 0; m < 4; ++m) { const int k = k0 + 16 * m; bf16_t* zrow = Z + (size_t)(tok_base + b * L + k) * 2048 + g * 256;
            bf16_t* zmir = Z + (size_t)(tok_base + b * L + (L - k)) * 2048 + g * 256;
            const float sg = (k & 1) ? -1.f : 1.f;
            float dm[8], sm[8], p0 = 0.f;
#pragma unroll
            for (int n = 0; n < 2; ++n) { f32x4 P = acc[0][0][m][n]; const f32x4 Q = acc[1][1][m][n]; if (FOLD) P = P + ah[n] * sg;
                if (n == 0) p0 = P[0];
#pragma unroll
                for (int e = 0; e < 4; ++e) { dm[4 * n + e] = P[e] - Q[e]; sm[4 * n + e] = P[e] + Q[e]; } }
            if (nyq) {
                const float yn = acc[0][1][m][0][0] + (FOLD ? ahn * sg : 0.f);
                float d2[8], s2[8];
#pragma unroll
                for (int j = 0; j < 8; ++j) { d2[j] = dm[j]; s2[j] = sm[j]; }
                dm[0] = p0; sm[0] = yn; d2[0] = yn; s2[0] = p0;
                dft_row_st(zrow, mi0, zr[m], dm, sm);
                if (FOLD && k >= 1) dft_row_st(zmir, mi0, zq[m], s2, d2);
            } else {
                dft_row_st(zrow, mi0, zr[m], dm, sm);
                if (FOLD && k >= 1) dft_row_st(zmir, mi0, zq[m], sm, dm); } }
    }
};
struct OutOrder {
    pg8::TileOrder T; int G, c; bool with_ctx;
    __device__ void init(int G_, int c_, bool with_ctx_) { T.init(64, 4, G_, c_); G = G_; c = c_; with_ctx = with_ctx_; }
    __device__ bool next(int i, pg8::Unit& u) const {
        const int L = i * G + c;
        if (L < 256) return T.next(i, u);
        if (!with_ctx || L >= 384) return false;
        const int idx = L - 256, tile = idx >> 2; u.pm = 64 + (tile >> 2); u.pn = tile & 3; u.aux = 1 + (idx & 3); return true;
    }
    __device__ __forceinline__ int koff(const pg8::Unit& u) const { return u.aux ? 512 * (u.aux - 1) : 0; }
    __device__ __forceinline__ const char* a_ptr(const pg8::Gemm& g, const pg8::Unit& u) const { return (const char*)(g.A + (size_t)u.pm * 256 * g.lda + koff(u)); }
    __device__ __forceinline__ const char* b_ptr(const pg8::Gemm& g, const pg8::Unit& u, int half) const { return (const char*)(g.Bt + (size_t)(u.pn * 256 + 128 * half) * g.ldb + koff(u)); }
    __device__ __forceinline__ bool b_mirror(const pg8::Unit&) const { return false; }
    __device__ __forceinline__ bool b_fix(const pg8::Unit&) const { return false; }
    __device__ __forceinline__ int ktiles(const pg8::Gemm& g, const pg8::Unit& u) const { return u.aux ? 8 : g.K / pg8::BK; }
};
struct EpiResid {
    static constexpr bool PERM = false;
    const float* xin_lat; float* xout_lat; const float* gate; float* part;
    __device__ __forceinline__ void operator()(AccRef acc, const pg8::Unit& u, int wr, int wc, int fr, int fq) const {
        const int row0 = u.pm * 256 + wr * 64 + fr, col0 = u.pn * 256 + wc * 32 + 4 * fq;
        if (u.aux) {
            float* pp = part + (size_t)(u.aux - 1) * NCTX * DM + (size_t)(row0 - NLAT) * DM + col0;
#pragma unroll
            for (int ai = 0; ai < 2; ++ai)
#pragma unroll
                for (int m = 0; m < 4; ++m)
#pragma unroll
                    for (int bj = 0; bj < 2; ++bj)
#pragma unroll
                        for (int n = 0; n < 2; ++n) *(f32x4*)(pp + (size_t)(ai * 128 + m * 16) * DM + bj * 128 + n * 16) = acc[ai][bj][m][n];
            return;
        }
        const float* gp = gate + (u.pm >> 3) * 3072 + col0;
        f32x4 gv[2][2];
#pragma unroll
        for (int bj = 0; bj < 2; ++bj)
#pragma unroll
            for (int n = 0; n < 2; ++n) gv[bj][n] = *(const f32x4*)(gp + bj * 128 + n * 16);
#pragma unroll
        for (int ai = 0; ai < 2; ++ai) {
            f32x4 xv[4][2][2];
#pragma unroll
            for (int m = 0; m < 4; ++m) { const size_t off = (size_t)(row0 + ai * 128 + m * 16) * DM + col0;
#pragma unroll
                for (int bj = 0; bj < 2; ++bj)
#pragma unroll
                    for (int n = 0; n < 2; ++n) xv[m][bj][n] = *(const f32x4*)(xin_lat + off + bj * 128 + n * 16); }
#pragma unroll
            for (int m = 0; m < 4; ++m) { const size_t off = (size_t)(row0 + ai * 128 + m * 16) * DM + col0;
#pragma unroll
                for (int bj = 0; bj < 2; ++bj)
#pragma unroll
                    for (int n = 0; n < 2; ++n) *(f32x4*)(xout_lat + off + bj * 128 + n * 16) = xv[m][bj][n] + gv[bj][n] * acc[ai][bj][m][n]; }
            asm volatile("" ::: "memory"); }
    }
};
struct EpiQKV {
    static constexpr bool PERM = true;
    bf16_t* Q; bf16_t* K; bf16_t* V; const float* rcos; const float* rsin;
    __device__ __forceinline__ void operator()(AccRef acc, const pg8::Unit& u, int wr, int wc, int fr, int fq) const {
        const int row0 = u.pm * 256 + wr * 64 + fr, c0 = wc * 32 + 8 * fq;
        if (u.pn >= 8) {
#pragma unroll
            for (int ai = 0; ai < 2; ++ai)
#pragma unroll
                for (int m = 0; m < 4; ++m) { bf16_t* rowp = V + (size_t)(row0 + ai * 128 + m * 16) * 2048 + (u.pn - 8) * 256 + c0;
#pragma unroll
                    for (int bj = 0; bj < 2; ++bj) { const f32x4 v0 = acc[ai][bj][m][0], v1 = acc[ai][bj][m][1]; u32x4 w;
                        w.x = cvt_pk_bf16(v0[0], v0[1]); w.y = cvt_pk_bf16(v0[2], v0[3]); w.z = cvt_pk_bf16(v1[0], v1[1]); w.w = cvt_pk_bf16(v1[2], v1[3]);
                        *(u32x4*)(rowp + bj * 128) = w; } }
            return;
        }
        const bool isk = u.pn >= 4, lat = u.pm < 64; const int h = u.pn & 3; bf16_t* dst = isk ? K : Q; const float sc = isk ? 0.0625f : 1.0f;
        const int i0 = 16 * wc + 4 * fq;
#pragma unroll
        for (int ai = 0; ai < 2; ++ai) {
            f32x4 cv[4][2], sv[4][2];
            if (lat) {
#pragma unroll
                for (int m = 0; m < 4; ++m) { const int l = (row0 + ai * 128 + m * 16) & 2047;
#pragma unroll
                    for (int bj = 0; bj < 2; ++bj) { const int pos = bj == 0 ? (l >> 6) : (l & 63); cv[m][bj] = *(const f32x4*)(rcos + pos * 64 + i0); sv[m][bj] = *(const f32x4*)(rsin + pos * 64 + i0); } } }
#pragma unroll
            for (int m = 0; m < 4; ++m) { const int row = row0 + ai * 128 + m * 16;
                bf16_t* chp = dst + ((size_t)(row >> 7) * 4 + h) * 32768;
#pragma unroll
                for (int bj = 0; bj < 2; ++bj) { f32x4 x1 = acc[ai][bj][m][0], x2 = acc[ai][bj][m][1];
                    if (lat) { const f32x4 o1 = x1 * cv[m][bj] - x2 * sv[m][bj], o2 = x1 * sv[m][bj] + x2 * cv[m][bj]; x1 = o1; x2 = o2; }
                    x1 = x1 * sc; x2 = x2 * sc; u32x4 w;
                    w.x = cvt_pk_bf16(x1[0], x1[1]); w.y = cvt_pk_bf16(x1[2], x1[3]); w.z = cvt_pk_bf16(x2[0], x2[1]); w.w = cvt_pk_bf16(x2[2], x2[3]);
                    const int s32 = 4 * bj + wc;
                    const int off = isk ? ((s32 * 8 + ((row & 127) >> 4)) * 512 + (4 * (row & 15) + fq) * 8)
                                        : (((((row >> 4) & 7) * 8) + s32) * 512 + (16 * fq + (row & 15)) * 8);
                    *(u32x4*)(chp + off) = w; } }
            asm volatile("" ::: "memory"); }
    }
};
struct EpiZGate {
    static constexpr bool PERM = true;
    const bf16_t* O; const float* rinv; bf16_t* AO;
    __device__ __forceinline__ void operator()(AccRef acc, const pg8::Unit& u, int wr, int wc, int fr, int fq) const {
        const int row0 = u.pm * 256 + wr * 64 + fr, col0 = u.pn * 256 + wc * 32 + 8 * fq, head = u.pn >> 1;
#pragma unroll
        for (int ai = 0; ai < 2; ++ai) {
            u32x4 ov[4][2]; float rv[4];
#pragma unroll
            for (int m = 0; m < 4; ++m) { const int row = row0 + ai * 128 + m * 16; rv[m] = rinv[row * 4 + head];
#pragma unroll
                for (int bj = 0; bj < 2; ++bj) { const int c = col0 + bj * 128, e0 = c & 63;
                    const bf16_t* op = O + ((size_t)((((row >> 7) * 4 + (c >> 9)) * 8 + ((c >> 6) & 7)) * 8 + ((row >> 4) & 7)) << 10) + (e0 >> 4) * 256 + (16 * ((e0 >> 2) & 3) + (row & 15)) * 4;
                    const u32x2 lo = *(const u32x2*)op, hi = *(const u32x2*)(op + 64); ov[m][bj] = (u32x4){lo.x, lo.y, hi.x, hi.y}; } }
#pragma unroll
            for (int m = 0; m < 4; ++m) { const int row = row0 + ai * 128 + m * 16; const float r_ = rv[m];
#pragma unroll
                for (int bj = 0; bj < 2; ++bj) { const u32x4 o = ov[m][bj]; const f32x4 v0 = acc[ai][bj][m][0], v1 = acc[ai][bj][m][1]; u32x4 w;
                    w.x = cvt_pk_bf16(bflo(o.x) * r_ * silu_f(v0[0]), bfhi(o.x) * r_ * silu_f(v0[1])); w.y = cvt_pk_bf16(bflo(o.y) * r_ * silu_f(v0[2]), bfhi(o.y) * r_ * silu_f(v0[3]));
                    w.z = cvt_pk_bf16(bflo(o.z) * r_ * silu_f(v1[0]), bfhi(o.z) * r_ * silu_f(v1[1])); w.w = cvt_pk_bf16(bflo(o.w) * r_ * silu_f(v1[2]), bfhi(o.w) * r_ * silu_f(v1[3]));
                    *(u32x4*)(AO + (size_t)row * 2048 + col0 + bj * 128) = w; } }
            asm volatile("" ::: "memory"); }
    }
};

#define XB_TMO      128
#define XB_XCNT(j)  (256  + 64 * (j))
#define XB_XSUB(j)  (1280 + 64 * (j))
#define XB_XGEN(j)  (2304 + 64 * (j))
#define XB_TOP      3328
#define XB_TOPGEN   3392
#define XCD_BAR_WORDS 3456
#define XB_SPIN_CAP (1u << 18)
__device__ __forceinline__ unsigned xb_ld(unsigned* p)              { return __hip_atomic_load(p, __ATOMIC_RELAXED, __HIP_MEMORY_SCOPE_AGENT); }
__device__ __forceinline__ unsigned xb_add(unsigned* p, unsigned v) { return __hip_atomic_fetch_add(p, v, __ATOMIC_RELAXED, __HIP_MEMORY_SCOPE_AGENT); }
__device__ __forceinline__ unsigned xb_xcc_id() { return (unsigned)__builtin_amdgcn_s_getreg((3 << 11) | 20) & 0xFu; }
#define XB_SPIN(cond, bar) do { unsigned _sp = 0; while (cond) { __builtin_amdgcn_s_sleep(1); \
    if ((++_sp & 255u) == 0u) { if (xb_ld(&(bar)[XB_TMO])) break; if (_sp > XB_SPIN_CAP) { atomicAdd(&(bar)[XB_TMO], 1u); break; } } } } while (0)
struct XcdBarrier { unsigned* bar; unsigned x; volatile LAS unsigned* st; };
__device__ __forceinline__ XcdBarrier xcd_barrier_post(unsigned* bar, volatile LAS unsigned* st) {
    XcdBarrier b; b.bar = bar; b.x = xb_xcc_id(); b.st = st;
    if (threadIdx.x == 0) (void)xb_add(&bar[XB_XCNT(b.x)], 1u);
    return b;
}
__device__ __forceinline__ void xcd_barrier_complete(unsigned* bar, unsigned x, unsigned& nloc, unsigned& nx) {
    const unsigned G = gridDim.x * gridDim.y * gridDim.z;
    unsigned sum, cnt, mine, sp = 0u;
    for (;;) {
        sum = 0u; cnt = 0u; mine = 0u;
#pragma unroll 1
        for (unsigned j = 0; j < 16; ++j) { const unsigned c = xb_ld(&bar[XB_XCNT(j)]); sum += c; cnt += (c > 0u) ? 1u : 0u; mine = (j == x) ? c : mine; }
        if (sum == G) break;
        __builtin_amdgcn_s_sleep(1);
        if ((++sp & 255u) == 0u) { if (xb_ld(&bar[XB_TMO])) break; if (sp > XB_SPIN_CAP) { atomicAdd(&bar[XB_TMO], 1u); break; } }
    }
    nloc = mine > 0u ? mine : 1u; nx = cnt > 0u ? cnt : 1u;
}
__device__ __forceinline__ void xcd_barrier(const XcdBarrier& b) {
    asm volatile("s_waitcnt vmcnt(0)" ::: "memory");
    __syncthreads();
    if (threadIdx.x == 0) {
        unsigned* bar = b.bar;
        __builtin_amdgcn_s_waitcnt(0);
        unsigned nloc = b.st[0], nx = b.st[1];
        if (nloc == 0u) { xcd_barrier_complete(bar, b.x, nloc, nx); b.st[0] = nloc; b.st[1] = nx; }
        const unsigned old = xb_add(&bar[XB_XSUB(b.x)], 1u);
        const unsigned gen = old / nloc;
        if (old + 1u == (gen + 1u) * nloc) {
            __builtin_amdgcn_fence(__ATOMIC_RELEASE, "agent");
            asm volatile("s_waitcnt vmcnt(0)" ::: "memory");
            const unsigned og = xb_add(&bar[XB_TOP], 1u);
            const unsigned tg = og / nx;
            if (og + 1u == (tg + 1u) * nx) xb_add(&bar[XB_TOPGEN], 1u);
            else XB_SPIN(xb_ld(&bar[XB_TOPGEN]) == tg, bar);
            __builtin_amdgcn_fence(__ATOMIC_ACQUIRE, "agent");
            xb_add(&bar[XB_XGEN(b.x)], 1u);
            asm volatile("s_waitcnt vmcnt(0)" ::: "memory");
        } else {
            XB_SPIN(xb_ld(&bar[XB_XGEN(b.x)]) == gen, bar);
            __builtin_amdgcn_fence(__ATOMIC_ACQUIRE, "agent");
            asm volatile("s_waitcnt vmcnt(0)" ::: "memory");
        }
    }
    __syncthreads();
}

struct Args { const float* in[13]; float* out; unsigned char* ws; int ph_lo, ph_hi, pad0, pad1; };
struct Frame {
    LAS unsigned char* lds;
    int vcu, G, wv;
    unsigned char* ws;
};
__device__ __forceinline__ int lane_id() { int l; asm volatile("v_mbcnt_lo_u32_b32 %0, -1, 0\n\tv_mbcnt_hi_u32_b32 %0, -1, %0" : "=v"(l)); return l; }
__device__ __forceinline__ unsigned char* launder_ptr(unsigned char* p) {
    unsigned lo = (unsigned)(unsigned long long)p, hi = (unsigned)((unsigned long long)p >> 32);
    asm volatile("" : "+s"(lo), "+s"(hi));
    return (unsigned char*)(((unsigned long long)hi << 32) | lo);
}
#define PHASE_IDS() int tid = F.wv * 64 + lane_id(); asm volatile("" : "+v"(tid)); const int lane = tid & 63, wave = __builtin_amdgcn_readfirstlane(tid >> 6); (void)lane; (void)wave; \
    unsigned char* ws = launder_ptr(F.ws); (void)ws
#define LDS_WAIT() asm volatile("s_waitcnt lgkmcnt(0)" ::: "memory")

__device__ __forceinline__ int qk_pos(int d) { const int half = d >> 7, n = (d >> 6) & 1, i = d & 63; return 128 * half + 8 * (i >> 2) + 4 * n + (i & 3); }
template <int MODE>
__device__ __forceinline__ void transpose_item(const float* W, int K, int N, int n_begin, bf16_t* WT, LAS float* scr, int item, int nblk, int lane) {
    const int kb = item / nblk, nb = item % nblk, k0 = 64 * kb, n0 = n_begin + 64 * nb;
    const GAS f32x4* src = (const GAS f32x4*)(W + (size_t)(k0 + (lane >> 4)) * N + n0 + 4 * (lane & 15));
    f32x4 v[16];
#pragma unroll
    for (int i = 0; i < 16; ++i) {
        if (MODE == 3) { const int kr = k0 + 4 * i + (lane >> 4), ks = (kr & ~255) + fpos(kr & 255); v[i] = *(const GAS f32x4*)(W + (size_t)ks * N + n0 + 4 * (lane & 15)); }
        else v[i] = src[(size_t)i * N]; }
#pragma unroll
    for (int i = 0; i < 16; ++i) *(LAS f32x4*)(scr + (4 * i + (lane >> 4)) * 68 + 4 * (lane & 15)) = v[i];
    LDS_WAIT(); asm volatile("" ::: "memory");
    const int na = n0 + lane; int nn = na - n_begin;
    if (MODE == 1) nn = (na < 2048) ? ((na & ~255) + qk_pos(na & 255)) : na;
    if (MODE == 2) nn = (nn & ~255) + fpos(nn & 255);
    GAS u32x4* dst = (GAS u32x4*)(WT + (size_t)nn * K + k0);
#pragma unroll
    for (int c = 0; c < 8; ++c) { const LAS float* sp = scr + (8 * c) * 68 + lane;
        u32x4 o; o.x = pk2(sp[0 * 68], sp[1 * 68]); o.y = pk2(sp[2 * 68], sp[3 * 68]); o.z = pk2(sp[4 * 68], sp[5 * 68]); o.w = pk2(sp[6 * 68], sp[7 * 68]);
        dst[c] = o; }
    LDS_WAIT(); asm volatile("" ::: "memory");
}
__device__ __forceinline__ void fold_task(const float* Win  , const LAS float* ctab  , bf16_t* WfT, int t, int lane) {
    const int g = t >> 8, p0 = ((t >> 5) & 7) * 32, kk0 = (t & 31) * 32, s = lane >> 5, li = lane & 31;
    f32x16 acc;
#pragma unroll
    for (int i = 0; i < 16; ++i) acc[i] = 0.f;
    const float* wrow = Win + (size_t)(kk0 + li) * 4096 + g * 256 + 4 * s;
    const int pcol = p0 + li;
    const int pmul = pcol < 128 ? pcol : pcol - 128, poff = pcol < 128 ? 0 : -64; const bool nyq = pcol == 128;
    f32x4 wvv[32];
#pragma unroll
    for (int tp = 0; tp < 32; ++tp) wvv[tp] = *(const GAS f32x4*)((const GAS float*)wrow + 8 * tp);
#pragma unroll
    for (int tp = 0; tp < 32; ++tp) {
        const f32x4 wv = wvv[tp];
#pragma unroll
        for (int uu = 0; uu < 4; ++uu) { const int cc = 8 * tp + 4 * s + uu; float a;
            a = ctab[(pmul * cc + poff) & 255]; if (nyq) a = (cc & 1) ? -0.0625f : 0.0625f;
            acc = __builtin_amdgcn_mfma_f32_32x32x2f32(a, wv[uu], acc, 0, 0, 0); }
    }
#pragma unroll
    for (int i = 0; i < 16; ++i) { const int row = (i & 3) + 8 * (i >> 2) + 4 * s; WfT[(size_t)(g * 256 + p0 + row) * 1024 + kk0 + li] = (bf16_t)f2bf(acc[i]); }
}

__device__ __forceinline__ void p0_phase(Frame& F, const Args& a) {
    PHASE_IDS();
    float* ADA = (float*)(ws + WS_ADA);
    const float* c = a.in[1]; const float* cctx = a.in[3]; const float* ada_w = a.in[5]; const float* ada_b = a.in[6];
    LAS float* sl = (LAS float*)F.lds;
    LAS float* part = (LAS float*)(F.lds + 36864);
    bool loaded = false;
    for (int u = F.vcu; u < 192; u += F.G) {
        if (!loaded) { for (int idx = tid; idx < 9 * 1024; idx += 512) { const int r = idx >> 10, k = idx & 1023; const float x = r < 8 ? c[r * 1024 + k] : cctx[k]; sl[idx] = x / (1.f + expf(-x)); } loaded = true; }
        __syncthreads();
        const int i = u / 48, n0 = (u % 48) * 64;
        f32x4 acc[9];
#pragma unroll
        for (int r = 0; r < 9; ++r) acc[r] = (f32x4){0.f, 0.f, 0.f, 0.f};
        const int ks4 = lane >> 4, c4 = 4 * (lane & 15);
        const float* wp = ada_w + ((size_t)i * 1024 + wave * 128 + ks4) * 3072 + n0 + c4;
#pragma unroll 8
        for (int kk = 0; kk < 32; ++kk) { const f32x4 wv = *(const f32x4*)(wp + (size_t)kk * 4 * 3072); const int k = wave * 128 + 4 * kk + ks4;
#pragma unroll
            for (int r = 0; r < 9; ++r) acc[r] += wv * sl[r * 1024 + k]; }
#pragma unroll
        for (int r = 0; r < 9; ++r) *(LAS f32x4*)(part + ((wave * 4 + ks4) * 9 + r) * 64 + c4) = acc[r];
        __syncthreads();
        for (int idx = tid; idx < 576; idx += 512) { const int r = idx >> 6, l = idx & 63; float s = 0.f;
#pragma unroll
            for (int w = 0; w < 32; ++w) s += part[(w * 9 + r) * 64 + l];
            ADA[(i * 9 + r) * 3072 + n0 + l] = s + ada_b[i * 3072 + n0 + l]; }
    }
    const int gt = F.vcu * 512 + tid, NT = F.G * 512;
    float* RC = (float*)(ws + WS_ROPE); float* RS = RC + 4096;
    for (int idx = gt; idx < 4096; idx += NT) { const int pos = idx >> 6, i = idx & 63; const float freq = powf(10000.0f, -(float)i / 64.0f); const float ang = (float)pos * freq;
        RC[idx] = cosf(ang); RS[idx] = sinf(ang); }
    bf16_t* CS256 = (bf16_t*)(ws + WS_CS256);
    for (int idx = gt; idx < 512 * 256; idx += NT) { const int row = idx >> 8, l = idx & 255, kt = row >> 8, hf = (row >> 7) & 1, k = kt * 128 + (row & 127);
        const float x = (float)((k * l) & 255) * (1.f / 128.f); const float v = (hf ? sinpif(x) : cospif(x)) * 0.0625f; CS256[idx] = (bf16_t)f2bf(v); }
}

__device__ __forceinline__ void norm_row(const float* xrow, const float* ng, const float* adar  , bf16_t* orow, int lane) {
    const f32x4* xr = (const f32x4*)xrow + lane;
    f32x4 v[4]; float s = 0.f;
#pragma unroll
    for (int j = 0; j < 4; ++j) { v[j] = xr[64 * j]; s += (v[j].x * v[j].x + v[j].y * v[j].y) + (v[j].z * v[j].z + v[j].w * v[j].w); }
    const float rinv = rsqrtf(wave_sum(s, lane) * (1.f / DM) + EPS);
    unsigned long long* o8 = (unsigned long long*)orow + lane;
#pragma unroll
    for (int j = 0; j < 4; ++j) { const int col = 4 * lane + 256 * j; const f32x4 g = *(const f32x4*)(ng + col), sh = *(const f32x4*)(adar + col), sc = *(const f32x4*)(adar + 1024 + col);
        const f32x4 y = v[j] * rinv * g * (sc + 1.0f) + sh;
        o8[64 * j] = (unsigned long long)pk2(y.x, y.y) | ((unsigned long long)pk2(y.z, y.w) << 32); }
}
template <int NR>
__device__ __forceinline__ void norm_batch(const float* const (&xrow)[NR], bf16_t* const (&hrow)[NR], int nrows, const f32x4 (&gm)[4], const f32x4 (&sh)[4], int lane) {
    f32x4 v[NR][4]; float ss[NR];
#pragma unroll
    for (int t = 0; t < NR; ++t) { const f32x4* xr = (const f32x4*)xrow[t] + lane;
#pragma unroll
        for (int j = 0; j < 4; ++j) v[t][j] = xr[64 * j]; }
#pragma unroll
    for (int t = 0; t < NR; ++t) { float s = 0.f;
#pragma unroll
        for (int j = 0; j < 4; ++j) s += (v[t][j].x * v[t][j].x + v[t][j].y * v[t][j].y) + (v[t][j].z * v[t][j].z + v[t][j].w * v[t][j].w);
        ss[t] = s; }
#pragma unroll
    for (int o = 1; o < 64; o <<= 1) {
#pragma unroll
        for (int t = 0; t < NR; ++t) ss[t] += shx(ss[t], o, lane); }
#pragma unroll
    for (int t = 0; t < NR; ++t) if (t < nrows) { const float rinv = rsqrtf(ss[t] * (1.f / DM) + EPS);
        unsigned long long* o8 = (unsigned long long*)hrow[t] + lane;
#pragma unroll
        for (int j = 0; j < 4; ++j) { const f32x4 y = v[t][j] * rinv * gm[j] + sh[j];
            o8[64 * j] = (unsigned long long)pk2(y.x, y.y) | ((unsigned long long)pk2(y.z, y.w) << 32); } }
}
template <bool ADDP>
__device__ __forceinline__ void norm_rows(Frame& F, const Args& a, int layer, bf16_t* H, int wsub = 8) {
    PHASE_IDS();
    const float* xl = layer == 0 ? a.in[0] : a.out; const float* xc = (layer == 0 || (ADDP && layer == 1)) ? a.in[2] : (const float*)(ws + WS_XCTX);
    const float* ng = a.in[4] + layer * DM; const float* ADA = (const float*)(ws + WS_ADA) + layer * 9 * 3072;
    const int gw = F.vcu * wsub + wave, NGW = F.G * wsub;
    const int wpb = NGW >> 3;
    if (wpb > 0 && (NGW & 7) == 0) {
        const int b = gw / wpb, wi = gw - b * wpb; const float* adar = ADA + b * 3072;
        f32x4 gm[4], sh[4];
#pragma unroll
        for (int j = 0; j < 4; ++j) { const int col = 4 * lane + 256 * j; gm[j] = *(const f32x4*)(ng + col) * (*(const f32x4*)(adar + 1024 + col) + 1.0f); sh[j] = *(const f32x4*)(adar + col); }
        for (int l0 = wi; l0 < SEQ; l0 += 8 * wpb) {
            const float* xr[8]; bf16_t* hr[8]; int n = 0;
#pragma unroll
            for (int t = 0; t < 8; ++t) { const int l = l0 + t * wpb; const int ll = l < SEQ ? l : wi; if (l < SEQ) n = t + 1; xr[t] = xl + (size_t)(b * SEQ + ll) * DM; hr[t] = H + (size_t)(b * SEQ + ll) * DM; }
            norm_batch<8>(xr, hr, n, gm, sh, lane);
        }
        const float* adac = ADA + 8 * 3072;
#pragma unroll
        for (int j = 0; j < 4; ++j) { const int col = 4 * lane + 256 * j; gm[j] = *(const f32x4*)(ng + col) * (*(const f32x4*)(adac + 1024 + col) + 1.0f); sh[j] = *(const f32x4*)(adac + col); }
        for (int m = gw; m < NCTX; m += NGW) {
            f32x4 xv[4];
#pragma unroll
            for (int j = 0; j < 4; ++j) xv[j] = *((const f32x4*)(xc + (size_t)m * DM) + lane + 64 * j);
            if (ADDP && layer >= 1) {
                const float* part = (const float*)(ws + WS_PART); const float* gprev = (const float*)(ws + WS_ADA) + (layer - 1) * 9 * 3072 + 8 * 3072 + 2048;
                float* xw = (float*)(ws + WS_XCTX) + (size_t)m * DM;
#pragma unroll
                for (int j = 0; j < 4; ++j) { const f32x4* pr = (const f32x4*)(part + (size_t)m * DM) + lane + 64 * j;
                    const f32x4 ps = (pr[0] + pr[(size_t)NCTX * DM / 4]) + (pr[(size_t)2 * NCTX * DM / 4] + pr[(size_t)3 * NCTX * DM / 4]);
                    xv[j] = xv[j] + *(const f32x4*)(gprev + 4 * lane + 256 * j) * ps;
                    *((f32x4*)xw + lane + 64 * j) = xv[j]; }
            }
            float s_ = 0.f;
#pragma unroll
            for (int j = 0; j < 4; ++j) s_ += (xv[j].x * xv[j].x + xv[j].y * xv[j].y) + (xv[j].z * xv[j].z + xv[j].w * xv[j].w);
            const float rinv = rsqrtf(wave_sum(s_, lane) * (1.f / DM) + EPS);
            unsigned long long* o8 = (unsigned long long*)(H + (size_t)(NLAT + m) * DM) + lane;
#pragma unroll
            for (int j = 0; j < 4; ++j) { const f32x4 y = xv[j] * rinv * gm[j] + sh[j];
                o8[64 * j] = (unsigned long long)pk2(y.x, y.y) | ((unsigned long long)pk2(y.z, y.w) << 32); }
        }
        return;
    }
    for (int m = gw; m < NTOK; m += NGW) {
        const bool lat = m < NLAT; const int r = lat ? (m >> 11) : 8; const float* adar = ADA + r * 3072;
        f32x4 gm[4], sh[4];
#pragma unroll
        for (int j = 0; j < 4; ++j) { const int col = 4 * lane + 256 * j; gm[j] = *(const f32x4*)(ng + col) * (*(const f32x4*)(adar + 1024 + col) + 1.0f); sh[j] = *(const f32x4*)(adar + col); }
        const float* xr[1] = {lat ? xl + (size_t)m * DM : xc + (size_t)(m - NLAT) * DM}; bf16_t* hr[1] = {H + (size_t)m * DM};
        norm_batch<1>(xr, hr, 1, gm, sh, lane);
    }
}
__device__ __forceinline__ void cf_prep(Frame& F, int wave, int lane) {
    LAS float* ctab = (LAS float*)(F.lds + 139264);
    { const int tt = wave * 64 + lane; if (tt < 256) ctab[tt] = cospif((float)tt * (1.f / 128.f)) * 0.0625f; }
    __syncthreads();
}
__device__ __forceinline__ void cf_main(Frame& F, const Args& a, int j, int gw, int NGW, unsigned char* ws, int wave, int lane) {
    LAS float* scr = (LAS float*)(F.lds + wave * 17408); const LAS float* ctab = (const LAS float*)(F.lds + 139264);
    bf16_t* W1 = (bf16_t*)(ws + WS_WF);
    const float* win = a.in[7] + (size_t)j * 1024 * 4096; const float* wout = a.in[8] + (size_t)j * 2048 * 1024;
    bf16_t* WfoT = W1 + (size_t)4096 * 1024;
    for (int t = gw; t < 2048; t += NGW) fold_task(win, ctab, W1, t, lane);
    for (int it = gw; it < 16 * 32; it += NGW) transpose_item<2>(win, 1024, 4096, 2048, W1 + (size_t)2048 * 1024, scr, it, 32, lane);
    for (int it = gw; it < 32 * 16; it += NGW) transpose_item<3>(wout, 2048, 1024, 0, WfoT, scr, it, 16, lane);
}
__device__ __forceinline__ void cf_cs(Frame& F, int gt, int NT, unsigned char* ws, int wave, int lane) {
    bf16_t* CS = (bf16_t*)(ws + WS_CS);
    __syncthreads();
    LAS float* ctab2 = (LAS float*)F.lds;
    for (int n = wave * 64 + lane; n < 2048; n += 512) ctab2[n] = cospif((float)n * (1.f / 1024.f)) * 0.022097087f;
    __syncthreads();
    for (int ch = gt; ch < 2048 * 128; ch += NT) { const int row = ch >> 7, l0 = (ch & 127) * 8, kt = row >> 8, hf = (row >> 7) & 1, k = kt * 128 + (row & 127);
        const int off = hf ? -512 : 0;
        unsigned w[4];
#pragma unroll
        for (int e = 0; e < 4; ++e) { float v[2];
#pragma unroll
            for (int q = 0; q < 2; ++q) { const int l = l0 + 2 * e + q; v[q] = ctab2[(k * l + off) & 2047]; }
            w[e] = pk2(v[0], v[1]); }
        *(u32x4*)(CS + (size_t)row * 1024 + l0) = (u32x4){w[0], w[1], w[2], w[3]}; }
    __syncthreads();
}
__device__ __forceinline__ void conv_fourier(Frame& F, const Args& a, int j, int gw, int NGW, int gt, int NT, unsigned char* ws, int wave, int lane) {
    cf_prep(F, wave, lane); cf_main(F, a, j, gw, NGW, ws, wave, lane); cf_cs(F, gt, NT, ws, wave, lane);
}
__device__ __forceinline__ void conv_ret(Frame& F, const Args& a, int j, int gw, int NGW, unsigned char* ws, int wave, int lane, int lo = 0, int hi = 2048) {
    LAS float* scr = (LAS float*)(F.lds + wave * 17408);
    bf16_t* W1 = (bf16_t*)(ws + WS_W);
    const float* win = a.in[9] + (size_t)j * 1024 * 6144; const float* wout = a.in[10] + (size_t)j * 2048 * 1024;
    bf16_t* WroT = W1 + (size_t)6144 * 1024;
    for (int it = lo + gw; it < hi; it += NGW) {
        if (it < 1536) transpose_item<1>(win, 1024, 6144, 0, W1, scr, it, 96, lane);
        else transpose_item<0>(wout, 2048, 1024, 0, WroT, scr, it - 1536, 16, lane);
    }
}
__device__ __forceinline__ void bg_conv_ret(Frame& F, const Args& a, int layer, int cu_lo, int lo, int hi) {
    PHASE_IDS();
    const int cu = (int)blockIdx.x - cu_lo;
    if (layer + 1 >= NLAYER || F.G != 256 || cu < 0 || cu >= 128) return;
    conv_ret(F, a, (layer + 1) >> 1, cu * 8 + wave, 1024, ws, wave, lane, lo, hi);
}
__device__ __forceinline__ void p0_conv(Frame& F, const Args& a) {
    PHASE_IDS();
    __syncthreads();
    conv_fourier(F, a, 0, F.vcu * 8 + wave, F.G * 8, F.vcu * 512 + tid, F.G * 512, ws, wave, lane);
}
__device__ __forceinline__ void n_phase(Frame& F, const Args& a, int layer) {
    PHASE_IDS();
    const bool fourier = (layer & 1) == 0;
    if (fourier && layer >= 1) {
        cf_prep(F, wave, lane);
        if (wave < 4) norm_rows<true>(F, a, layer, (bf16_t*)(ws + WS_H), 4); else cf_main(F, a, layer >> 1, F.vcu * 4 + wave - 4, F.G * 4, ws, wave, lane);
        cf_cs(F, F.vcu * 512 + tid, F.G * 512, ws, wave, lane);
        return;
    }
    norm_rows<true>(F, a, layer, (bf16_t*)(ws + (fourier ? WS_H : WS_OF)));
    if (layer >= 1) {
        if (fourier) conv_fourier(F, a, layer >> 1, F.vcu * 8 + wave, F.G * 8, F.vcu * 512 + tid, F.G * 512, ws, wave, lane);
        else if (F.G != 256) conv_ret(F, a, layer >> 1, F.vcu * 8 + wave, F.G * 8, ws, wave, lane);
    }
}
__device__ __forceinline__ void nyq_row_phase(Frame& F) {
    PHASE_IDS();
    const bf16_t* UTF = (const bf16_t*)(ws + WS_UTL); const float* AH = (const float*)(ws + WS_RINV); bf16_t* Z = (bf16_t*)(ws + WS_Z);
    const int gw = F.vcu * 8 + wave, NGW = F.G * 8;
    for (int t = gw; t < 64 * 129; t += NGW) {
        const int bg = t / 129, mt = t - bg * 129, b = bg >> 3, g = bg & 7; const int row = b * 2048 + g * 256 + mt;
        const GAS u32x4* src = (const GAS u32x4*)(UTF + (size_t)row * 1024);
        float s = 0.f;
#pragma unroll
        for (int i = 0; i < 2; ++i) { const u32x4 v = src[lane + 64 * i]; s += (bflo(v.x) - bfhi(v.x)) + (bflo(v.y) - bfhi(v.y)) + (bflo(v.z) - bfhi(v.z)) + (bflo(v.w) - bfhi(v.w)); }
        s = wave_sum(s, lane);
        const float y = (s + AH[row]) * 0.022097087f;
        bf16_t* zrow = Z + (size_t)(b * 2048 + 1024) * 2048 + g * 256;
        if (lane == 0) zrow[mt] = (bf16_t)f2bf(y * bf1(zrow[mt]));
        if (lane == 1 && mt >= 1 && mt <= 127) zrow[128 + mt] = (bf16_t)f2bf(y * bf1(zrow[128 + mt]));
    }
}
__device__ __forceinline__ bf16_t* s_chunk(unsigned char* ws, int h, int rc) {
    return rc < 56 ? (bf16_t*)(ws + WS_SA) + ((size_t)(h * 56 + rc) << 14) : (bf16_t*)(ws + WS_SB) + ((size_t)(h * 88 + rc - 56) << 14);
}
struct DiagOrder {
    int G, c;
    __device__ bool next(int i, pg8::Unit& u) const { const int L = i * G + c; if (L >= 288) return false; u.aux = L / 72; u.pm = L - 72 * u.aux; u.pn = u.pm; return true; }
    __device__ __forceinline__ const char* a_ptr(const pg8::Gemm& g, const pg8::Unit& u) const { return (const char*)(g.A + ((size_t)(2 * u.pm) * 4 + u.aux) * 32768); }
    __device__ __forceinline__ const char* b_ptr(const pg8::Gemm& g, const pg8::Unit& u, int half) const { return (const char*)(g.Bt + ((size_t)(2 * u.pm + half) * 4 + u.aux) * 32768); }
    __device__ __forceinline__ bool b_mirror(const pg8::Unit&) const { return false; }
    __device__ __forceinline__ bool b_fix(const pg8::Unit&) const { return false; }
    __device__ __forceinline__ int ktiles(const pg8::Gemm& g, const pg8::Unit&) const { return g.K / pg8::BK; }
};
struct EpiS {
    static constexpr bool PERM = true;
    unsigned char* ws;
    __device__ __forceinline__ void operator()(AccRef acc, const pg8::Unit& u, int wr, int wc, int fr, int fq) const {
#pragma unroll
        for (int ai = 0; ai < 2; ++ai) { bf16_t* sp = s_chunk(ws, u.aux, 2 * u.pm + ai);
#pragma unroll
            for (int m = 0; m < 4; ++m) { const f32x4 v0 = acc[ai][ai][m][0], v1 = acc[ai][ai][m][1]; u32x4 w;
                w.x = cvt_pk_bf16(v0[0], v0[1]); w.y = cvt_pk_bf16(v0[2], v0[3]); w.z = cvt_pk_bf16(v1[0], v1[1]); w.w = cvt_pk_bf16(v1[2], v1[3]);
                *(u32x4*)(sp + ((((wr * 4 + m) * 4 + wc) * 64 + fq * 16 + fr) << 3)) = w; } }
    }
};
struct QKVOrder : pg8::TileOrder {
    int i0, i1;
    __device__ void init2(int G_, int c_, int i0_, int i1_) { nM = 72; nN = 16; nwg = 1152; G = G_; c = c_; i0 = i0_; i1 = i1_; }
    __device__ bool next(int i, pg8::Unit& u) const {
        const int ii = i + i0; if (ii >= i1) return false;
        const int L = ii * G + c; if (L >= 1152) return false;
        if (L < 576) { map(L, 72, 8, u); } else if (L < 1008) { map(L - 576, 72, 6, u); u.pn += 8; } else { map(L - 1008, 72, 2, u); u.pn += 14; }
        return true;
    }
};
#define XQ_SUB(l, j) (3584 + 64 * ((l) * 16 + (j)))
#define XQ_TOP(l)    (8768 + 64 * (l))
__device__ __forceinline__ void xq_arrive(const XcdBarrier& b, int layer) {
    asm volatile("s_waitcnt vmcnt(0)" ::: "memory");
    __syncthreads();
    if (threadIdx.x == 0) {
        unsigned nloc = b.st[0], nx = b.st[1];
        if (nloc == 0u) { xcd_barrier_complete(b.bar, b.x, nloc, nx); b.st[0] = nloc; b.st[1] = nx; }
        const unsigned old = xb_add(&b.bar[XQ_SUB(layer, b.x)], 1u);
        if (old + 1u == nloc) { __builtin_amdgcn_fence(__ATOMIC_RELEASE, "agent"); asm volatile("s_waitcnt vmcnt(0)" ::: "memory"); xb_add(&b.bar[XQ_TOP(layer)], 1u); }
    }
}
__device__ __forceinline__ void xq_wait(const XcdBarrier& b, int layer) {
    if (threadIdx.x == 0) {
        const unsigned nx = b.st[1];
        XB_SPIN(xb_ld(&b.bar[XQ_TOP(layer)]) < nx, b.bar);
        __builtin_amdgcn_fence(__ATOMIC_ACQUIRE, "agent");
        asm volatile("s_waitcnt vmcnt(0)" ::: "memory");
    }
    __syncthreads();
}
typedef short bf16x4 __attribute__((ext_vector_type(4)));
typedef short v4i16_t __attribute__((ext_vector_type(4)));
__device__ __forceinline__ bf16x8 ldtr2(const LAS unsigned char* p0, const LAS unsigned char* p1) {
    const bf16x4 lo = __builtin_bit_cast(bf16x4, __builtin_amdgcn_ds_read_tr16_b64_v4i16((LAS v4i16_t*)p0));
    const bf16x4 hi = __builtin_bit_cast(bf16x4, __builtin_amdgcn_ds_read_tr16_b64_v4i16((LAS v4i16_t*)p1));
    return __builtin_shufflevector(lo, hi, 0, 1, 2, 3, 4, 5, 6, 7);
}
__device__ __forceinline__ int blk_perm(int rb) { return (rb & ~3) | ((rb >> 1) & 1) | ((rb & 1) << 1); }
__device__ __forceinline__ int scan_t0(int dir, int b, int s) {
    return dir == 0 ? ((s < 2) ? (NLAT + b * CTXL + s * 128) : (b * SEQ + (s - 2) * 128)) : ((s < 2) ? (NLAT + b * CTXL + (1 - s) * 128) : (b * SEQ + (17 - s) * 128));
}
__device__ __forceinline__ int scan_rc(int dir, int b, int s) {
    return dir == 0 ? ((s < 2) ? (128 + b * 2 + s) : (b * 16 + (s - 2))) : ((s < 2) ? (128 + b * 2 + (1 - s)) : (b * 16 + (17 - s)));
}
__device__ __forceinline__ u32x4 ldg16(const void* ub, unsigned voff) { return *(const GAS u32x4*)((const GAS unsigned char*)ub + voff); }
__device__ __forceinline__ void scan_load_s(u32x4 (&sf)[4], unsigned char* ws, int h, int rc, int w, int r, int q) {
    const bf16_t* ub = s_chunk(ws, h, rc) + w * 2048; const unsigned vo = (unsigned)(16 * q + r) * 16u;
#pragma unroll
    for (int ks = 0; ks < 4; ++ks) sf[ks] = ldg16(ub, vo + 1024u * ks);
}
__device__ __forceinline__ void scan_load_q(u32x4 (&qf)[8], const bf16_t* Qg, int h, int t0, int w, int r, int q) {
    const bf16_t* ub = Qg + (((size_t)(t0 >> 7) * 4 + h) * 8 + w) * 4096; const unsigned vo = (unsigned)(16 * q + r) * 16u;
#pragma unroll
    for (int ks = 0; ks < 8; ++ks) qf[ks] = ldg16(ub, vo + 1024u * ks);
}
__device__ __forceinline__ void scan_load_kv(u32x4 (&kr)[8], u32x4 (&vr)[2], const bf16_t* Kg, const bf16_t* Vg, int h, int sl, int t0, int w, int lane, int tid) {
    const bf16_t* kb = Kg + (((size_t)(t0 >> 7) * 4 + h) * 8 + w) * 4096; const unsigned ko = (unsigned)lane * 16u;
#pragma unroll
    for (int it = 0; it < 8; ++it) kr[it] = ldg16(kb, ko + 1024u * it);
    const bf16_t* vb = Vg + (size_t)t0 * 2048 + h * 512 + sl * 64; const unsigned vo = (unsigned)((tid >> 3) * 2048 + 8 * (tid & 7)) * 2u;
#pragma unroll
    for (int i = 0; i < 2; ++i) vr[i] = ldg16(vb + (size_t)i * 64 * 2048, vo);
}
#ifndef DBG_SEG
#define DBG_SEG -1
#endif
#define SEG_MARK(k) do { if (DBG_SEG >= 0) { __builtin_amdgcn_sched_barrier(0); const unsigned long long t_ = __builtin_amdgcn_s_memtime(); if (DBG_SEG == (k)) segacc += t_ - segt; segt = t_; __builtin_amdgcn_sched_barrier(0); } } while (0)
template <int DIR>
__device__ __forceinline__ void scan_step(unsigned long long& segacc, unsigned long long& segt, LAS unsigned char* lds, u32x4 (&sf)[4], u32x4 (&qf)[8], u32x4 (&kr)[8], u32x4 (&vr)[2], f32x4 (&Rb)[2][4], const float (&wm)[2], float rsc, float g128,
                                          int t0, int t0n, int rcn, unsigned char* ws, int h, int sl, int w, int lane_in, int tid_in, const bf16_t* Qg, const bf16_t* Kg, const bf16_t* Vg, bf16_t* OF, float* SSP) {
    int lane = lane_in; asm volatile("" : "+v"(lane));
    const int tid = (tid_in & ~63) | lane;
    const int r = lane & 15, q = lane >> 4;
    LAS unsigned char* VI = lds + SC_V_OFF; LAS unsigned char* RT = lds + SC_RT_OFF; LAS unsigned char* KI = lds + SC_K_OFF + w * 8192;
    SEG_MARK(5);
#pragma unroll
    for (int i = 0; i < 2; ++i) { const int m = (tid >> 3) + 64 * i, e0 = 8 * (tid & 7); const float sc = wm[i]; const u32x4 v = vr[i]; u32x4 o;
        o.x = cvt_pk_bf16(bflo(v.x) * sc, bfhi(v.x) * sc); o.y = cvt_pk_bf16(bflo(v.y) * sc, bfhi(v.y) * sc); o.z = cvt_pk_bf16(bflo(v.z) * sc, bfhi(v.z) * sc); o.w = cvt_pk_bf16(bflo(v.w) * sc, bfhi(v.w) * sc);
        *(LAS u32x4*)(VI + 128 * ((e0 >> 4) * 32 + blk_perm(m >> 2)) + (m & 3) * 32 + (e0 & 15) * 2) = o; }
#pragma unroll
    for (int it = 0; it < 8; ++it) { const int m = it * 16 + (lane >> 2), dc = lane & 3;
        *(LAS u32x4*)(KI + 128 * ((dc >> 1) * 32 + blk_perm(m >> 2)) + (m & 3) * 32 + (dc & 1) * 16) = kr[it]; }
    SEG_MARK(0);
    asm volatile("s_waitcnt lgkmcnt(0)" ::: "memory"); __builtin_amdgcn_s_barrier(); asm volatile("" ::: "memory");
    SEG_MARK(1);
    const int jl = 16 * w + r;
    { const bf16_t* vb = Vg + (size_t)t0n * 2048 + h * 512 + sl * 64; const unsigned vo = (unsigned)((tid >> 3) * 2048 + 8 * (tid & 7)) * 2u;
#pragma unroll
      for (int i = 0; i < 2; ++i) vr[i] = ldg16(vb + (size_t)i * 64 * 2048, vo); }
    GAS unsigned char* ob = (GAS unsigned char*)(OF + ((size_t)((((t0 >> 7) * 4 + h) * 8 + sl) * 8 + w) << 10)); const unsigned oo = (unsigned)lane * 8u;
    f32x4 O[4];
#pragma unroll
    for (int eb = 0; eb < 4; ++eb) O[eb] = (f32x4){0.f, 0.f, 0.f, 0.f};
    const LAS unsigned char* rtb = RT + r * 528 + q * 16;
    const bf16_t* qub = Qg + (((size_t)(t0n >> 7) * 4 + h) * 8 + w) * 4096; const unsigned qvo = (unsigned)(16 * q + r) * 16u;
    const bf16_t* kub = Kg + (((size_t)(t0n >> 7) * 4 + h) * 8 + w) * 4096; const unsigned kvo = (unsigned)lane * 16u;
    bf16x8 avp[2][4];
#pragma unroll
    for (int eb = 0; eb < 4; ++eb) avp[0][eb] = *(const LAS bf16x8*)(rtb + (16 * eb * 528));
#pragma unroll
    for (int ks = 0; ks < 8; ++ks) { const bf16x8 qv = __builtin_bit_cast(bf16x8, qf[ks]);
        if (ks < 7) {
#pragma unroll
            for (int eb = 0; eb < 4; ++eb) avp[(ks + 1) & 1][eb] = *(const LAS bf16x8*)(rtb + (16 * eb * 528 + 64 * (ks + 1)));
            asm volatile("s_waitcnt lgkmcnt(4)" ::: "memory"); }
        else asm volatile("s_waitcnt lgkmcnt(0)" ::: "memory");
        __builtin_amdgcn_sched_barrier(0);
#pragma unroll
        for (int eb = 0; eb < 4; ++eb) O[eb] = __builtin_amdgcn_mfma_f32_16x16x32_bf16(avp[ks & 1][eb], qv, O[eb], 0, 0, 0);
        if (w < 4) { qf[ks] = ldg16(qub, qvo + 1024u * ks); kr[ks] = ldg16(kub, kvo + 1024u * ks); }
        __builtin_amdgcn_sched_barrier(0); }
    u32x2 pvf[4];
    if (DIR == 1) {
#pragma unroll
        for (int eb = 0; eb < 4; ++eb) pvf[eb] = *(const GAS u32x2*)(ob + oo + 512 * eb); }
    SEG_MARK(2);
    const int lofs = 128 * (4 * (q >> 1) + (q & 1)) + 8 * r;
    const LAS unsigned char* vtb = VI + lofs; const LAS unsigned char* ktb = KI + lofs;
#pragma unroll
    for (int ks = 0; ks < 4; ++ks) {
        bf16x8 vb[4], ka[2];
#pragma unroll
        for (int eb = 0; eb < 4; ++eb) vb[eb] = ldtr2(vtb + 128 * (eb * 32 + 8 * ks), vtb + 128 * (eb * 32 + 8 * ks + 2));
#pragma unroll
        for (int db = 0; db < 2; ++db) ka[db] = ldtr2(ktb + 128 * (db * 32 + 8 * ks), ktb + 128 * (db * 32 + 8 * ks + 2));
        __builtin_amdgcn_sched_barrier(0);
        bf16x8 sfm;
        { unsigned wd[4] = {sf[ks].x, sf[ks].y, sf[ks].z, sf[ks].w};
#pragma unroll
          for (int i = 0; i < 4; ++i) { const int m0 = 32 * ks + 8 * q + 2 * i; const bool k0 = DIR == 0 ? (m0 <= jl) : (m0 >= jl), k1 = DIR == 0 ? (m0 + 1 <= jl) : (m0 + 1 >= jl);
              wd[i] &= (k0 ? 0xffffu : 0u) | (k1 ? 0xffff0000u : 0u); }
          sfm = __builtin_bit_cast(bf16x8, (u32x4){wd[0], wd[1], wd[2], wd[3]}); }
#pragma unroll
        for (int eb = 0; eb < 4; ++eb) O[eb] = __builtin_amdgcn_mfma_f32_16x16x32_bf16(vb[eb], sfm, O[eb], 0, 0, 0);
#pragma unroll
        for (int db = 0; db < 2; ++db)
#pragma unroll
            for (int eb = 0; eb < 4; ++eb) Rb[db][eb] = __builtin_amdgcn_mfma_f32_16x16x32_bf16(ka[db], vb[eb], Rb[db][eb], 0, 0, 0);
        if (w >= 4) {
            qf[2 * ks] = ldg16(qub, qvo + 1024u * (2 * ks)); qf[2 * ks + 1] = ldg16(qub, qvo + 1024u * (2 * ks + 1));
            kr[2 * ks] = ldg16(kub, kvo + 1024u * (2 * ks)); kr[2 * ks + 1] = ldg16(kub, kvo + 1024u * (2 * ks + 1)); }
    }
    SEG_MARK(3);
    scan_load_s(sf, ws, h, rcn, w, r, q);
    {
        float ss = 0.f;
#pragma unroll
        for (int eb = 0; eb < 4; ++eb) { f32x4 v = O[eb] * rsc;
            if (DIR == 1) { const u32x2 pv = pvf[eb]; v[0] += bflo(pv.x); v[1] += bfhi(pv.x); v[2] += bflo(pv.y); v[3] += bfhi(pv.y);
                ss += (v[0] * v[0] + v[1] * v[1]) + (v[2] * v[2] + v[3] * v[3]); }
            u32x2 o; o.x = cvt_pk_bf16(v[0], v[1]); o.y = cvt_pk_bf16(v[2], v[3]); *(GAS u32x2*)(ob + oo + 512 * eb) = o; }
        if (DIR == 1) { ss += shx(ss, 16, lane); ss += shx(ss, 32, lane); if (q == 0) *(GAS float*)((GAS unsigned char*)(SSP + (size_t)(t0 + 16 * w) * 32 + h * 8 + sl) + (unsigned)r * 128u) = ss; }
    }
#pragma unroll
    for (int db = 0; db < 2; ++db)
#pragma unroll
        for (int eb = 0; eb < 4; ++eb) Rb[db][eb] = Rb[db][eb] * g128;
    SEG_MARK(4);
    asm volatile("s_waitcnt lgkmcnt(0)" ::: "memory"); __builtin_amdgcn_s_barrier(); asm volatile("" ::: "memory");
    SEG_MARK(6);
#pragma unroll
    for (int db = 0; db < 2; ++db)
#pragma unroll
        for (int eb = 0; eb < 4; ++eb) { u32x2 o; o.x = cvt_pk_bf16(Rb[db][eb][0], Rb[db][eb][1]); o.y = cvt_pk_bf16(Rb[db][eb][2], Rb[db][eb][3]);
            *(LAS u32x2*)(RT + (16 * eb + r) * 528 + (32 * w + 16 * db + 4 * q) * 2) = o; }
}
template <int DIR>
__device__ __forceinline__ void scan_unit(Frame& F, int tid, unsigned char* ws, int b, int h, int sl, float lg, const bf16_t* Qg, const bf16_t* Kg, const bf16_t* Vg, bf16_t* OF, float* SSP) {
    const int lane = tid & 63, w = __builtin_amdgcn_readfirstlane(tid >> 6), r = lane & 15, q = lane >> 4;
    const float g128 = __expf(128.f * lg);
    float wm[2];
#pragma unroll
    for (int i = 0; i < 2; ++i) { const int m = (tid >> 3) + 64 * i; wm[i] = __expf(lg * (float)(DIR == 0 ? 127 - m : m)); }
    const int jl = 16 * w + r; const float rsc = __expf(lg * (float)(DIR == 0 ? jl - 127 : -jl));
    f32x4 Rb[2][4];
#pragma unroll
    for (int db = 0; db < 2; ++db)
#pragma unroll
        for (int eb = 0; eb < 4; ++eb) Rb[db][eb] = (f32x4){0.f, 0.f, 0.f, 0.f};
    {
        LAS unsigned char* RT = F.lds + SC_RT_OFF;
#pragma unroll
        for (int db = 0; db < 2; ++db)
#pragma unroll
            for (int eb = 0; eb < 4; ++eb) *(LAS u32x2*)(RT + (16 * eb + r) * 528 + (32 * w + 16 * db + 4 * q) * 2) = (u32x2){0u, 0u};
    }
    u32x4 sf[4], qf[8], kr[8], vr[2];
    unsigned long long segacc = 0ull, segt = (DBG_SEG >= 0) ? __builtin_amdgcn_s_memtime() : 0ull;
    scan_load_s(sf, ws, h, scan_rc(DIR, b, 0), w, r, q);
    scan_load_q(qf, Qg, h, scan_t0(DIR, b, 0), w, r, q);
    scan_load_kv(kr, vr, Kg, Vg, h, sl, scan_t0(DIR, b, 0), w, lane, tid);
    for (int s = 0; s < 18; ++s) {
        const int sn = (s + 1 < 18) ? s + 1 : 17;
        scan_step<DIR>(segacc, segt, F.lds, sf, qf, kr, vr, Rb, wm, rsc, g128, scan_t0(DIR, b, s), scan_t0(DIR, b, sn), scan_rc(DIR, b, sn), ws, h, sl, w, lane, tid, Qg, Kg, Vg, OF, SSP);
    }
    if (DBG_SEG >= 0) { const unsigned long long te_ = __builtin_amdgcn_s_memtime() + segacc; while (__builtin_amdgcn_s_memtime() < te_) __builtin_amdgcn_s_sleep(4); }
    __syncthreads();
}
__device__ __forceinline__ void scan_phase(Frame& F, const Args& a, int layer, int dir) {
    PHASE_IDS();
    const int j = layer >> 1; const float* dec = a.in[11] + j * 8 + dir * 4;
    for (int u = F.vcu; u < 256; u += F.G) {
        const int b = u >> 5, h = (u >> 3) & 3, sl = u & 7;
        const float lg = log1pf(-exp2f(dec[h]));
        if (dir == 0) scan_unit<0>(F, tid, ws, b, h, sl, lg, (const bf16_t*)(ws + WS_Q), (const bf16_t*)(ws + WS_K), (const bf16_t*)(ws + WS_V), (bf16_t*)(ws + WS_OF), (float*)(ws + WS_SSP));
        else scan_unit<1>(F, tid, ws, b, h, sl, lg, (const bf16_t*)(ws + WS_Q), (const bf16_t*)(ws + WS_K), (const bf16_t*)(ws + WS_V), (bf16_t*)(ws + WS_OF), (float*)(ws + WS_SSP));
    }
}
__device__ __forceinline__ void n2_phase(Frame& F, const Args& a, int layer) {
    PHASE_IDS();
    norm_rows<false>(F, a, layer, (bf16_t*)(ws + WS_Q));
    const float* SSP = (const float*)(ws + WS_SSP); float* RINV = (float*)(ws + WS_RINV);
    const int gt = F.vcu * 512 + tid, NT = F.G * 512;
    for (int idx = gt; idx < NTOK * 4; idx += NT) { const f32x4 p0 = *(const f32x4*)(SSP + (size_t)idx * 8), p1 = *(const f32x4*)(SSP + (size_t)idx * 8 + 4);
        const float ss = ((p0.x + p0.y) + (p0.z + p0.w)) + ((p1.x + p1.y) + (p1.z + p1.w)); RINV[idx] = rsqrtf(ss * (1.f / 512.f) + EPS); }
}
__device__ __forceinline__ void final_phase(Frame& F, const Args& a) {
    PHASE_IDS();
    const float* fg = a.in[12]; const int gw = F.vcu * 8 + wave, NGW = F.G * 8;
    f32x4 g[4];
#pragma unroll
    for (int jj = 0; jj < 4; ++jj) g[jj] = *(const f32x4*)(fg + 4 * lane + 256 * jj);
    for (int m0 = gw; m0 < NLAT; m0 += 4 * NGW) {
        f32x4 v[4][4]; float ss[4];
#pragma unroll
        for (int t = 0; t < 4; ++t) { const int m = (m0 + t * NGW) < NLAT ? (m0 + t * NGW) : gw; const f32x4* xr = (const f32x4*)(a.out + (size_t)m * DM) + lane;
#pragma unroll
            for (int jj = 0; jj < 4; ++jj) v[t][jj] = xr[64 * jj]; }
#pragma unroll
        for (int t = 0; t < 4; ++t) { float s = 0.f;
#pragma unroll
            for (int jj = 0; jj < 4; ++jj) s += (v[t][jj].x * v[t][jj].x + v[t][jj].y * v[t][jj].y) + (v[t][jj].z * v[t][jj].z + v[t][jj].w * v[t][jj].w);
            ss[t] = s; }
#pragma unroll
        for (int o = 1; o < 64; o <<= 1) {
#pragma unroll
            for (int t = 0; t < 4; ++t) ss[t] += shx(ss[t], o, lane); }
#pragma unroll
        for (int t = 0; t < 4; ++t) { const int m = m0 + t * NGW; if (m < NLAT) { const float rinv = rsqrtf(ss[t] * (1.f / DM) + EPS); f32x4* xw = (f32x4*)(a.out + (size_t)m * DM) + lane;
#pragma unroll
            for (int jj = 0; jj < 4; ++jj) xw[64 * jj] = v[t][jj] * rinv * g[jj]; } }
    }
}

constexpr int N_PHASES = 34;
__global__ void __launch_bounds__(512, 2) trunk_fwd(Args args) {
    extern __shared__ __attribute__((aligned(16))) unsigned char lds_raw[];
    Frame F;
    F.lds = (LAS unsigned char*)lds_raw;
    F.G = gridDim.x; F.wv = __builtin_amdgcn_readfirstlane((int)threadIdx.x >> 6); { const int bx = blockIdx.x; F.vcu = (F.G % 8 == 0) ? (bx % 8) * (F.G / 8) + bx / 8 : bx; }
    F.ws = args.ws;
    volatile LAS unsigned* MISC = (volatile LAS unsigned*)(F.lds + MISC_OFF);
    for (int u = threadIdx.x; u < 128; u += 512) MISC[u] = 0u;
    __syncthreads();
    const int lo = args.ph_lo, hi = args.ph_hi;
    XcdBarrier bar; bar.bar = (unsigned*)(args.ws + WS_CTL) + 4096; bar.x = 0; bar.st = nullptr;
    const bool multi = (hi - lo) > 1;
    if (multi) bar = xcd_barrier_post((unsigned*)(args.ws + WS_CTL) + 4096, MISC + 8);
#ifndef KINDS
#define KINDS 0xFFFF
#endif
#define KON(b) (((KINDS) >> (b)) & 1)
#define IN(k) (lo <= (k) && (k) < hi)
#ifndef DBG_PROBE
#define DBG_PROBE -1
#endif
    unsigned long long tph0 = (DBG_PROBE >= 0) ? __builtin_amdgcn_s_memrealtime() : 0ull; int cur_layer = -1;
#ifndef DBG_PLAYER
#define DBG_PLAYER -1
#endif
#define PROBE(kind) do { if (DBG_PROBE == (kind) && (DBG_PLAYER < 0 || DBG_PLAYER == cur_layer)) { const unsigned long long t1_ = __builtin_amdgcn_s_memrealtime(); const unsigned long long te_ = t1_ + (t1_ - tph0); while (__builtin_amdgcn_s_memrealtime() < te_) __builtin_amdgcn_s_sleep(8); } } while (0)
#define SEAM(k) do { if (multi && (k) + 1 < hi) xcd_barrier(bar); if (DBG_PROBE >= 0) tph0 = __builtin_amdgcn_s_memrealtime(); } while (0)
    const int bx = (int)blockIdx.x, G = F.G;
    const bool mergeS = multi && G == 256 && lo == 0;
    const bool mergeP0 = mergeS && hi > 1 && KON(0) && KON(1);
    if (KON(0) && IN(0)) { p0_phase(F, args); if (mergeP0) xq_arrive(bar, 4); p0_conv(F, args); if (mergeP0) xq_wait(bar, 4); PROBE(0); if (!mergeP0) SEAM(0); }
    for (int layer = 0; layer < NLAYER; ++layer) {
        const int pb = 1 + 8 * layer; const bool fourier = (layer & 1) == 0; cur_layer = layer;
        unsigned char* ws = launder_ptr(args.ws);
#define MAKE_ER() const EpiResid ER{layer == 0 ? args.in[0] : args.out, args.out, (const float*)(ws + WS_ADA) + layer * 9 * 3072 + 2048, (float*)(ws + WS_PART)}
        if (KON(1) && IN(pb)) { n_phase(F, args, layer); PROBE(1); SEAM(pb); }
        if (fourier) {
            bf16_t* W1 = (bf16_t*)(ws + WS_WF);
            if (KON(2) && IN(pb + 1)) {
                { pg8::Gemm g{(const bf16_t*)(ws + WS_H), W1 + (size_t)2048 * 1024, 1024, 1024, 1024}; pg8::TileOrder S; S.init(72, 8, G, bx);
                  EpiSilu E{(bf16_t*)(ws + WS_Z), 2048}; pg8::gemm_phase(F.lds, F.wv, g, S, E); }
                { pg8::Gemm g{W1, (const bf16_t*)(ws + WS_H), 1024, 1024, 1024}; UOrder S; S.init(8, 72, G, (bx + 64) % G);
                  EpiUTF E{(bf16_t*)(ws + WS_UTL), (bf16_t*)(ws + WS_UTC), (float*)(ws + WS_RINV)}; pg8::gemm_phase<EpiUTF, UOrder, true>(F.lds, F.wv, g, S, E); }
                bg_conv_ret(F, args, layer, 64, 0, 1024);
                PROBE(2); SEAM(pb + 1);
            }
            if (KON(3) && IN(pb + 2)) {
                { pg8::Gemm g{(const bf16_t*)(ws + WS_CS), (const bf16_t*)(ws + WS_UTL), 1024, 1024, 1024}; pg8::TileOrder S; S.init(8, 64, G, bx);
                  EpiDft<true> E{(bf16_t*)(ws + WS_Z), 2048, 0, (const float*)(ws + WS_RINV)}; pg8::gemm_phase(F.lds, F.wv, g, S, E); }
                { pg8::Gemm g{(const bf16_t*)(ws + WS_CS256), (const bf16_t*)(ws + WS_UTC), 256, 256, 256}; pg8::TileOrder S; S.init(2, 64, G, bx);
                  EpiDft<false> E{(bf16_t*)(ws + WS_Z), 256, NLAT, nullptr}; pg8::gemm_phase(F.lds, F.wv, g, S, E); }
                nyq_row_phase(F);
                bg_conv_ret(F, args, layer, 128, 1024, 1536);
                PROBE(3); SEAM(pb + 2);
            }
            if (KON(4) && IN(pb + 3)) {
                pg8::Gemm g{(const bf16_t*)(ws + WS_Z), W1 + (size_t)4096 * 1024, 2048, 2048, 2048}; OutOrder S; S.init(G, bx, true); MAKE_ER();
                pg8::gemm_phase(F.lds, F.wv, g, S, ER);
                bg_conv_ret(F, args, layer, 128, 1536, 2048);
                PROBE(4); SEAM(pb + 3);
            }
        } else {
            bf16_t* W1 = (bf16_t*)(ws + WS_W);
            if (KON(5) && IN(pb + 1)) {
                pg8::Gemm g{(const bf16_t*)(ws + WS_OF), W1, 1024, 1024, 1024};
                EpiQKV E{(bf16_t*)(ws + WS_Q), (bf16_t*)(ws + WS_K), (bf16_t*)(ws + WS_V), (const float*)(ws + WS_ROPE), (const float*)(ws + WS_ROPE) + 4096};
                if (mergeS) {
                    { QKVOrder S; S.init2(G, bx, 0, 4); pg8::gemm_phase(F.lds, F.wv, g, S, E); }
                    xq_arrive(bar, layer);
                    if (bx < 128) { QKVOrder S; S.init2(G, bx, 4, 5); pg8::gemm_phase(F.lds, F.wv, g, S, E); }
                    else { xq_wait(bar, layer);
                        pg8::Gemm gs{(const bf16_t*)(ws + WS_Q), (const bf16_t*)(ws + WS_K), 1024, 1024, 256}; DiagOrder S{128, bx - 128};
                        EpiS ES{ws}; pg8::gemm_phase<EpiS, DiagOrder, false, true>(F.lds, F.wv, gs, S, ES); }
                } else { pg8::TileOrder S; S.init(72, 16, G, bx); pg8::gemm_phase(F.lds, F.wv, g, S, E); }
                PROBE(5); SEAM(pb + 1);
            }
            if (KON(6) && IN(pb + 2)) {
                if (!mergeS) {
                    { pg8::Gemm g{(const bf16_t*)(ws + WS_Q), (const bf16_t*)(ws + WS_K), 1024, 1024, 256}; DiagOrder S{G, bx};
                      EpiS E{ws}; pg8::gemm_phase<EpiS, DiagOrder, false, true>(F.lds, F.wv, g, S, E); }
                    PROBE(11); if (multi) xcd_barrier(bar); if (DBG_PROBE >= 0) tph0 = __builtin_amdgcn_s_memrealtime(); }
                scan_phase(F, args, layer, 0); PROBE(6);
            }
            if (KON(6) && IN(pb + 3)) {
                if (multi) { asm volatile("s_waitcnt vmcnt(0)" ::: "memory"); __syncthreads();
                    if (threadIdx.x == 0) { __builtin_amdgcn_fence(__ATOMIC_ACQUIRE, "agent"); asm volatile("s_waitcnt vmcnt(0)" ::: "memory"); }
                    __syncthreads(); if (DBG_PROBE >= 0) tph0 = __builtin_amdgcn_s_memrealtime(); }
                scan_phase(F, args, layer, 1); PROBE(12); SEAM(pb + 3); }
            if (KON(7) && IN(pb + 4)) { n2_phase(F, args, layer); PROBE(7); SEAM(pb + 4); }
            if (KON(8) && IN(pb + 5)) {
                pg8::Gemm g{(const bf16_t*)(ws + WS_Q), W1 + (size_t)4096 * 1024, 1024, 1024, 1024}; pg8::TileOrder S; S.init(layer == NLAYER - 1 ? 64 : 72, 8, G, bx);
                EpiZGate E{(const bf16_t*)(ws + WS_OF), (const float*)(ws + WS_RINV), (bf16_t*)(ws + WS_V)};
                pg8::gemm_phase(F.lds, F.wv, g, S, E);
                PROBE(8); SEAM(pb + 5);
            }
            if (KON(9) && IN(pb + 6)) {
                pg8::Gemm g{(const bf16_t*)(ws + WS_V), W1 + (size_t)6144 * 1024, 2048, 2048, 2048}; OutOrder S; S.init(G, bx, layer != NLAYER - 1); MAKE_ER();
                pg8::gemm_phase(F.lds, F.wv, g, S, ER);
                PROBE(9); SEAM(pb + 6);
            }
        }
    }
    if (KON(10) && IN(33)) { final_phase(F, args); PROBE(10); }
#undef IN
#undef SEAM
}

extern "C" void kernel_launch(void* const* d_in, const int* in_sizes, int n_in, void* d_out, int out_size, void* d_ws, size_t ws_size, hipStream_t stream) {
    static int grid = 0;
    if (grid == 0) {
        if (n_in != 13 || out_size != NLAT * DM || ws_size < WS_END) { fprintf(stderr, "kernel_launch: unexpected problem (n_in %d, out %d, ws %zu)\n", n_in, out_size, ws_size); grid = -1; return; }
        int dev = 0, cus = 0;
        if (hipGetDevice(&dev) != hipSuccess || hipDeviceGetAttribute(&cus, hipDeviceAttributeMultiprocessorCount, dev) != hipSuccess) { grid = -1; return; }
        if (hipFuncSetAttribute((const void*)trunk_fwd, hipFuncAttributeMaxDynamicSharedMemorySize, LDS_BYTES) != hipSuccess) { fprintf(stderr, "kernel_launch: hipFuncSetAttribute failed\n"); grid = -1; return; }
        (void)hipGetLastError();
        grid = cus;
    }
    if (grid < 0) return;
    if (hipMemsetAsync((char*)d_ws + WS_CTL, 0, CTL_ZERO_BYTES, stream) != hipSuccess) return;
    Args a{};
    for (int i = 0; i < 13; ++i) a.in[i] = (const float*)d_in[i];
    a.out = (float*)d_out; a.ws = (unsigned char*)d_ws;
    a.ph_lo = 0; a.ph_hi = N_PHASES;
    hipLaunchKernelGGL(trunk_fwd, dim3(grid), dim3(512), LDS_BYTES, stream, a);
}
```

```cpp
#include <hip/hip_runtime.h>
#include <cstdio>
#include <cstdint>

#define LAS __attribute__((address_space(3)))
#define GAS __attribute__((address_space(1)))
typedef unsigned short bf16_t;
typedef short bf16x8 __attribute__((ext_vector_type(8)));
typedef float f32x4 __attribute__((ext_vector_type(4)));
typedef float f32x16 __attribute__((ext_vector_type(16)));
typedef unsigned u32x4 __attribute__((ext_vector_type(4)));
typedef unsigned u32x2 __attribute__((ext_vector_type(2)));

constexpr int DM = 1024, NB = 8, SEQ = 2048, CTXL = 256, DBR = 2048, NLAYER = 4;
constexpr int NLAT = NB * SEQ, NCTX = NB * CTXL, NTOK = NLAT + NCTX;
constexpr float EPS = 1e-6f;

constexpr size_t MiB = 1u << 20;
constexpr size_t KiB = 1024;
constexpr size_t WS_CTL = 0, CTL_ZERO_BYTES = 64 * KiB;
constexpr size_t WS_ADA = 256 * KiB;
constexpr size_t WS_TC = 768 * KiB;
constexpr size_t WS_ROPE = 1024 * KiB;
constexpr size_t WS_CS256 = 1088 * KiB;
constexpr size_t WS_RINV = 1344 * KiB;
constexpr size_t WS_XCTX = 2 * MiB;
constexpr size_t WS_W = 10 * MiB;
constexpr size_t WS_R = 26 * MiB;
constexpr size_t WS_H = WS_R;
constexpr size_t WS_Z = WS_R + 36 * MiB;
constexpr size_t WS_UTL = WS_R + 108 * MiB;
constexpr size_t WS_UTC = WS_R + 172 * MiB;
constexpr size_t WS_CS = WS_R + 180 * MiB;
constexpr size_t WS_WF = WS_R + 144 * MiB;
constexpr size_t WS_Q = WS_R;
constexpr size_t WS_K = WS_R + 36 * MiB;
constexpr size_t WS_V = WS_R + 72 * MiB;
constexpr size_t WS_OF = WS_R + 144 * MiB;
constexpr size_t WS_PART = WS_R + 184 * MiB;
constexpr size_t WS_SSP = WS_R + 216 * MiB;
constexpr size_t WS_SA = WS_W;
constexpr size_t WS_SB = WS_R + 219 * MiB;
constexpr size_t WS_END = 256 * MiB;
static_assert(WS_SSP + (size_t)NTOK * 32 * 4 <= WS_SB && WS_SB + 11 * MiB <= WS_END && WS_CS + 16 * MiB <= WS_END && WS_RINV + 288 * KiB <= WS_XCTX, "ws map");

constexpr int LDS_BYTES = 147456;
constexpr int RING_BYTES = 131072;
constexpr int SC_V_OFF = 0;
constexpr int SC_RT_OFF = 16384;
constexpr int SC_K_OFF = 16384 + 33792;
constexpr int MISC_OFF = 145408;
static_assert(SC_K_OFF + 65536 <= MISC_OFF && MISC_OFF + 512 <= LDS_BYTES, "lds map");

__device__ __forceinline__ unsigned f2bf(float f) { unsigned u = __builtin_bit_cast(unsigned, f); return (u + 0x7fffu + ((u >> 16) & 1u)) >> 16; }
__device__ __forceinline__ unsigned pk2(float lo, float hi) { return f2bf(lo) | (f2bf(hi) << 16); }
__device__ __forceinline__ float bflo(unsigned w) { return __builtin_bit_cast(float, w << 16); }
__device__ __forceinline__ float bfhi(unsigned w) { return __builtin_bit_cast(float, w & 0xffff0000u); }
__device__ __forceinline__ float bf1(bf16_t h) { return __builtin_bit_cast(float, (unsigned)h << 16); }
__device__ __forceinline__ float silu_f(float x) { return x * __builtin_amdgcn_rcpf(1.f + __expf(-x)); }
__device__ __forceinline__ float shx(float v, int o, int lane) { return __builtin_bit_cast(float, __builtin_amdgcn_ds_bpermute((lane ^ o) << 2, __builtin_bit_cast(int, v))); }
__device__ __forceinline__ float wave_sum(float v, int lane) {
#pragma unroll
    for (int o = 1; o < 64; o <<= 1) v += shx(v, o, lane);
    return v;
}

namespace pg8 {
constexpr int BM = 256, BK = 64, HALF = 128, HTB = HALF * BK * 2, STAGE_BYTES = 8 * HTB, NXCD = 8, WGM = 8;
__host__ __device__ __forceinline__ int lds_byte(int r, int c) { const int st = (r >> 4) * 2 + (c >> 5), rr = r & 15, cc = c & 31, ob = rr * 64 + cc * 2; return st * 1024 + (ob ^ (((ob >> 9) & 1) << 5)); }
__host__ __device__ __forceinline__ void stage_rc(int b, int& R, int& C) { const int st = b / 1024, sb = b % 1024, swz = sb ^ (((sb >> 9) & 1) << 5); R = (st >> 1) * 16 + swz / 64; C = (st & 1) * 32 + (swz % 64) / 2; }
__host__ __device__ __forceinline__ int perm32(int rho) { const int n = rho >> 4, i = rho & 15; return 8 * (i >> 2) + 4 * n + (i & 3); }
struct Unit { int pm, pn, aux; };
struct Gemm { const bf16_t* A; const bf16_t* Bt; int lda, ldb, K; };
struct TileOrder {
    int nM, nN, nwg, G, c;
    __device__ void init(int nM_, int nN_, int G_, int c_) { nM = nM_; nN = nN_; nwg = nM * nN; G = G_; c = c_; }
    __device__ static void map(int wgid, int nM, int nN, Unit& u) {
        const int nwg = nM * nN;
        { const int q = nwg / NXCD, r = nwg % NXCD, xcd = wgid % NXCD, off = wgid / NXCD; wgid = (xcd < r ? xcd * (q + 1) : r * (q + 1) + (xcd - r) * q) + off; }
        const int nig = WGM * nN, gid = wgid / nig, fm = gid * WGM, gsz = (nM - fm) < WGM ? (nM - fm) : WGM;
        u.pm = fm + ((wgid % nig) % gsz); u.pn = (wgid % nig) / gsz; u.aux = 0;
    }
    __device__ bool next(int i, Unit& u) const {
        const long L = (long)i * G + c; if (L >= nwg) return false;
        map((int)L, nM, nN, u); return true;
    }
    __device__ __forceinline__ const char* a_ptr(const Gemm& g, const Unit& u) const { return (const char*)g.A + (size_t)u.pm * 256 * g.lda * 2; }
    __device__ __forceinline__ const char* b_ptr(const Gemm& g, const Unit& u, int half) const { return (const char*)g.Bt + (size_t)(u.pn * 256 + 128 * half) * g.ldb * 2; }
    __device__ __forceinline__ bool b_mirror(const Unit&) const { return false; }
    __device__ __forceinline__ bool b_fix(const Unit&) const { return false; }
    __device__ __forceinline__ int ktiles(const Gemm& g, const Unit&) const { return g.K / BK; }
};
__device__ __forceinline__ unsigned cvt_pk_bf16(float lo, float hi) { unsigned r; asm volatile("v_cvt_pk_bf16_f32 %0, %1, %2" : "=v"(r) : "v"(lo), "v"(hi)); return r; }

template <class Epi, class Sched, bool MIRB = false, bool TILED = false>
__device__ __forceinline__ void gemm_phase(LAS unsigned char* lds, int wv, const Gemm g, const Sched& S, const Epi& E) {
    int tid; { int l_; asm volatile("v_mbcnt_lo_u32_b32 %0, -1, 0\n\tv_mbcnt_hi_u32_b32 %0, -1, %0" : "=v"(l_)); tid = wv * 64 + l_; }
    const int wid = __builtin_amdgcn_readfirstlane(tid >> 6), lane = tid & 63, wr = wid >> 2, wc = wid & 3, fr = lane & 15, fq = lane >> 4;
    unsigned voffA[2], voffB[2], voffM[2], fixd[2];
#pragma unroll
    for (int i = 0; i < 2; ++i) { int R, C; stage_rc(tid * 16 + i * 8192, R, C); const int Rb = Epi::PERM ? ((R & ~31) + perm32(R & 31)) : R;
        voffA[i] = (unsigned)(R * g.lda + C) * 2u; voffB[i] = (unsigned)(Rb * g.ldb + C) * 2u; voffM[i] = (unsigned)((1024 - Rb) * g.ldb + C) * 2u; fixd[i] = (Rb == 0) ? (unsigned)(1024 * g.ldb) * 2u : 0u;
        if (TILED) { voffA[i] = (unsigned)(((R >> 4) & 7) * 8192 + (C >> 5) * 1024 + (16 * ((C >> 3) & 3) + (R & 15)) * 16);
                     voffB[i] = (unsigned)(((Rb & 127) >> 4) * 1024 + (4 * (Rb & 15) + ((C >> 3) & 3)) * 16 + (C >> 5) * 8192); } }
    const size_t kstepA = TILED ? (size_t)2048 : (size_t)(BK * 2), kstepB = TILED ? (size_t)16384 : (size_t)(BK * 2);
    const size_t hstepA = TILED ? (size_t)262144 : (size_t)HALF * g.lda * 2;
    const unsigned ldsw = (unsigned)wid * 1024u;
    const int aoff = lds_byte(wr * 64 + fr, fq * 8), boff = lds_byte(wc * 32 + fr, fq * 8);
#define PG8_SA(b, h) (((b) * 2 + (h)) * HTB)
#define PG8_SB(b, h) ((4 + (b) * 2 + (h)) * HTB)
#define PG8_STAGE(bufoff, gbase, voff) do { _Pragma("unroll") for (int _i = 0; _i < 2; ++_i) \
        __builtin_amdgcn_global_load_lds((const unsigned*)((const char*)(gbase) + (voff)[_i]), (LAS unsigned*)(lds + (bufoff) + ldsw + _i * 8192), 16, 0, 0); } while (0)
#define PG8_LDA(dst, b, h) do { _Pragma("unroll") for (int m = 0; m < 4; ++m) _Pragma("unroll") for (int k = 0; k < 2; ++k) dst[m][k] = *(const LAS bf16x8*)(lds + PG8_SA(b, h) + aoff + m * 2048 + k * 1024); } while (0)
#define PG8_LDB(dst, b, h) do { _Pragma("unroll") for (int n = 0; n < 2; ++n) _Pragma("unroll") for (int k = 0; k < 2; ++k) dst[n][k] = *(const LAS bf16x8*)(lds + PG8_SB(b, h) + boff + n * 2048 + k * 1024); } while (0)
#define PG8_MMA(ai, bj, At, Bt) do { __builtin_amdgcn_s_setprio(1); _Pragma("unroll") for (int m = 0; m < 4; ++m) _Pragma("unroll") for (int n = 0; n < 2; ++n) _Pragma("unroll") for (int k = 0; k < 2; ++k) \
        acc[ai][bj][m][n] = __builtin_amdgcn_mfma_f32_16x16x32_bf16(Bt[n][k], At[m][k], acc[ai][bj][m][n], 0, 0, 0); __builtin_amdgcn_s_setprio(0); } while (0)
#define PG8_WAIT_V(n) asm volatile("s_waitcnt vmcnt(" #n ")" ::: "memory")
#define PG8_WAIT_L(n) asm volatile("s_waitcnt lgkmcnt(" #n ")" ::: "memory")
#define PG8_BAR __builtin_amdgcn_s_barrier()
#define PG8_SCHED __builtin_amdgcn_sched_barrier(0)
#define PG8_VB1(dst, u) do { if (MIRB && S.b_mirror(u)) { const bool fx_ = S.b_fix(u); dst[0] = voffM[0] - (fx_ ? fixd[0] : 0u); dst[1] = voffM[1] - (fx_ ? fixd[1] : 0u); } else { dst[0] = voffB[0]; dst[1] = voffB[1]; } } while (0)
    Unit cur, nxt; int ui = 0;
    if (!S.next(0, cur)) return;
    f32x4 acc[2][2][4][2];
#pragma unroll
    for (int a = 0; a < 2; ++a)
#pragma unroll
        for (int b = 0; b < 2; ++b)
#pragma unroll
            for (int m = 0; m < 4; ++m)
#pragma unroll
                for (int n = 0; n < 2; ++n) acc[a][b][m][n] = (f32x4){0.f, 0.f, 0.f, 0.f};
    bf16x8 At[4][2], B0[2][2], B1[2][2];
    const char* cA = S.a_ptr(g, cur); const char* cB0 = S.b_ptr(g, cur, 0); const char* cB1 = S.b_ptr(g, cur, 1);
    unsigned vc1[2]; PG8_VB1(vc1, cur);
    PG8_STAGE(PG8_SB(0, 0), cB0, voffB); PG8_STAGE(PG8_SB(0, 1), cB1, vc1); PG8_STAGE(PG8_SA(0, 0), cA, voffA); PG8_STAGE(PG8_SA(0, 1), cA + hstepA, voffA);
    if (wr == 1) PG8_BAR;
    PG8_WAIT_V(2); PG8_BAR;
    PG8_STAGE(PG8_SB(1, 0), cB0 + kstepB, voffB); PG8_STAGE(PG8_SA(1, 0), cA + kstepA, voffA); PG8_STAGE(PG8_SB(1, 1), cB1 + kstepB, vc1);
    PG8_WAIT_V(6); PG8_BAR;
    for (;;) {
        const bool has_next = S.next(ui + 1, nxt);
        const int nt = S.ktiles(g, cur);
        const char* nA = cA; const char* nB0 = cB0; const char* nB1 = cB1; unsigned vn1[2] = {vc1[0], vc1[1]};
        if (has_next) { nA = S.a_ptr(g, nxt); nB0 = S.b_ptr(g, nxt, 0); nB1 = S.b_ptr(g, nxt, 1); PG8_VB1(vn1, nxt); }
        for (int t = 0; t < nt; t += 2) {
            const bool last = (t == nt - 2);
            const char* a1 = cA + (size_t)(t + 1) * kstepA;
            const char* a2 = last ? nA : cA + (size_t)(t + 2) * kstepA; const char* b20 = last ? nB0 : cB0 + (size_t)(t + 2) * kstepB; const char* b21 = last ? nB1 : cB1 + (size_t)(t + 2) * kstepB;
            const char* a3 = a2 + kstepA; const char* b30 = b20 + kstepB; const char* b31 = b21 + kstepB;
            unsigned v21[2]; v21[0] = (MIRB && last) ? vn1[0] : vc1[0]; v21[1] = (MIRB && last) ? vn1[1] : vc1[1];
            PG8_LDB(B0, 0, 0); PG8_LDB(B1, 0, 1); PG8_SCHED; PG8_LDA(At, 0, 0); PG8_STAGE(PG8_SA(1, 1), a1 + hstepA, voffA);
            PG8_WAIT_V(8); PG8_WAIT_L(0); PG8_BAR; PG8_MMA(0, 0, At, B0); PG8_MMA(0, 1, At, B1); PG8_BAR; PG8_SCHED;
            PG8_LDA(At, 0, 1); PG8_STAGE(PG8_SB(0, 0), b20, voffB); PG8_STAGE(PG8_SB(0, 1), b21, v21); PG8_STAGE(PG8_SA(0, 0), a2, voffA);
            PG8_WAIT_V(8); PG8_WAIT_L(0); PG8_BAR; PG8_MMA(1, 0, At, B0); PG8_MMA(1, 1, At, B1); PG8_BAR; PG8_SCHED;
            PG8_LDB(B0, 1, 0); PG8_LDB(B1, 1, 1); PG8_SCHED; PG8_LDA(At, 1, 0); PG8_STAGE(PG8_SA(0, 1), a2 + hstepA, voffA);
            PG8_WAIT_V(8); PG8_WAIT_L(0); PG8_BAR; PG8_MMA(0, 0, At, B0); PG8_MMA(0, 1, At, B1); PG8_BAR; PG8_SCHED;
            PG8_LDA(At, 1, 1); PG8_STAGE(PG8_SB(1, 0), b30, voffB); PG8_STAGE(PG8_SB(1, 1), b31, v21); PG8_STAGE(PG8_SA(1, 0), a3, voffA);
            PG8_WAIT_V(8); PG8_WAIT_L(0); PG8_BAR; PG8_MMA(1, 0, At, B0); PG8_MMA(1, 1, At, B1); PG8_BAR; PG8_SCHED;
        }
        if (wr == 0) PG8_BAR;
        { int l2 = lane; asm volatile("" : "+v"(l2)); E(acc, cur, wr, wc, l2 & 15, l2 >> 4); }
        if (!has_next) break;
#pragma unroll
        for (int a = 0; a < 2; ++a)
#pragma unroll
            for (int b = 0; b < 2; ++b)
#pragma unroll
                for (int m = 0; m < 4; ++m)
#pragma unroll
                    for (int n = 0; n < 2; ++n) acc[a][b][m][n] = (f32x4){0.f, 0.f, 0.f, 0.f};
        cur = nxt; cA = nA; cB0 = nB0; cB1 = nB1; vc1[0] = vn1[0]; vc1[1] = vn1[1]; ++ui;
        if (wr == 1) PG8_BAR;
    }
    PG8_WAIT_V(0);
    PG8_BAR;
#undef PG8_SA
#undef PG8_SB
#undef PG8_STAGE
#undef PG8_LDA
#undef PG8_LDB
#undef PG8_MMA
#undef PG8_WAIT_V
#undef PG8_WAIT_L
#undef PG8_BAR
#undef PG8_SCHED
#undef PG8_VB1
}
}
using pg8::cvt_pk_bf16;
__device__ __forceinline__ void stg16(void* ub, unsigned vo, u32x4 v) { *(GAS u32x4*)((GAS unsigned char*)ub + vo) = v; }
__device__ __forceinline__ u32x4 ldg16u(const void* ub, unsigned vo) { return *(const GAS u32x4*)((const GAS unsigned char*)ub + vo); }
__device__ __forceinline__ void stg16f(void* ub, unsigned vo, f32x4 v) { *(GAS f32x4*)((GAS unsigned char*)ub + vo) = v; }
__device__ __forceinline__ f32x4 ldg16f(const void* ub, unsigned vo) { return *(const GAS f32x4*)((const GAS unsigned char*)ub + vo); }
typedef const f32x4 (&AccRef)[2][2][4][2];

struct EpiSilu {
    static constexpr bool PERM = true;
    bf16_t* O; int ldc;
    __device__ __forceinline__ void operator()(AccRef acc, const pg8::Unit& u, int wr, int wc, int fr, int fq) const {
        bf16_t* ub = O + (size_t)u.pm * 256 * ldc + u.pn * 256; const unsigned vo = (unsigned)((wr * 64 + fr) * ldc + wc * 32 + 8 * fq) * 2u;
#pragma unroll
        for (int ai = 0; ai < 2; ++ai)
#pragma unroll
            for (int m = 0; m < 4; ++m)
#pragma unroll
                for (int bj = 0; bj < 2; ++bj) { const f32x4 v0 = acc[ai][bj][m][0], v1 = acc[ai][bj][m][1]; u32x4 w;
                    w.x = cvt_pk_bf16(silu_f(v0[0]), silu_f(v0[1])); w.y = cvt_pk_bf16(silu_f(v0[2]), silu_f(v0[3]));
                    w.z = cvt_pk_bf16(silu_f(v1[0]), silu_f(v1[1])); w.w = cvt_pk_bf16(silu_f(v1[2]), silu_f(v1[3]));
                    stg16(ub + (size_t)(ai * 128 + m * 16) * ldc, vo + (unsigned)(bj * 256), w); }
    }
};
struct UOrder : pg8::TileOrder {
    __device__ __forceinline__ const char* b_ptr(const pg8::Gemm& g, const pg8::Unit& u, int half) const {
        if (u.pn < 64) { const int b = u.pn >> 3, tp = u.pn & 7; return (const char*)(g.Bt + (size_t)(b * 2048 + (half ? 1024 - 128 * tp : 128 * tp)) * 1024); }
        return (const char*)(g.Bt + (size_t)(NLAT + (u.pn - 64) * 256 + 128 * half) * 1024);
    }
    __device__ __forceinline__ bool b_mirror(const pg8::Unit& u) const { return u.pn < 64; }
    __device__ __forceinline__ bool b_fix(const pg8::Unit& u) const { return (u.pn & 7) == 0; }
};
struct EpiUTF {
    static constexpr bool PERM = true;
    bf16_t* UTF; bf16_t* UTc; float* AH;
    __device__ __forceinline__ void operator()(AccRef acc, const pg8::Unit& u, int wr, int wc, int fr, int fq) const {
        const int feat0 = u.pm * 256 + wr * 64 + fr, col0 = wc * 32 + 8 * fq;
        if (u.pn >= 64) { bf16_t* ub = UTc + (size_t)(u.pn - 64) * 2048 * 256 + (size_t)u.pm * 256 * 256; const unsigned vo = (unsigned)((wr * 64 + fr) * 256 + col0) * 2u;
#pragma unroll
            for (int ai = 0; ai < 2; ++ai)
#pragma unroll
                for (int m = 0; m < 4; ++m)
#pragma unroll
                    for (int bj = 0; bj < 2; ++bj) { const f32x4 v0 = acc[ai][bj][m][0], v1 = acc[ai][bj][m][1]; u32x4 w;
                        w.x = cvt_pk_bf16(v0[0], v0[1]); w.y = cvt_pk_bf16(v0[2], v0[3]); w.z = cvt_pk_bf16(v1[0], v1[1]); w.w = cvt_pk_bf16(v1[2], v1[3]);
                        stg16(ub + (size_t)(ai * 128 + m * 16) * 256, vo + (unsigned)(bj * 256), w); }
            return; }
        const int b = u.pn >> 3, tp = u.pn & 7; const bool first = (tp == 0) && (col0 == 0);
        bf16_t* ub = UTF + ((size_t)b * 2048 + u.pm * 256) * 1024 + 128 * tp; const unsigned vo = (unsigned)((wr * 64 + fr) * 1024 + col0) * 2u;
#pragma unroll
        for (int ai = 0; ai < 2; ++ai)
#pragma unroll
            for (int m = 0; m < 4; ++m) { const int feat = feat0 + ai * 128 + m * 16; const float sg = ((feat & 255) <= 128) ? 1.f : -1.f;
                f32x4 v0 = acc[ai][0][m][0] + acc[ai][1][m][0] * sg; const f32x4 v1 = acc[ai][0][m][1] + acc[ai][1][m][1] * sg;
                if (first) { v0[0] = acc[ai][0][m][0][0]; AH[(size_t)b * 2048 + feat] = acc[ai][1][m][0][0]; }
                u32x4 w; w.x = cvt_pk_bf16(v0[0], v0[1]); w.y = cvt_pk_bf16(v0[2], v0[3]); w.z = cvt_pk_bf16(v1[0], v1[1]); w.w = cvt_pk_bf16(v1[2], v1[3]);
                stg16(ub + (size_t)(ai * 128 + m * 16) * 1024, vo, w); }
    }
};
__device__ __forceinline__ int fpos(int f) { return f <= 128 ? f : 384 - f; }
struct DftZ { u32x4 zd, zm; };
__device__ __forceinline__ DftZ dft_row_ld(const bf16_t* zrow, int mi0) { DftZ z; z.zd = *(const u32x4*)(zrow + mi0); z.zm = *(const u32x4*)(zrow + 128 + mi0); return z; }
__device__ __forceinline__ void dft_row_st(bf16_t* zrow, int mi0, const DftZ& z, const float (&d)[8], const float (&mr)[8]) {
    const u32x4 zd = z.zd, zm = z.zm;
    u32x4 o; o.x = cvt_pk_bf16(d[0] * bflo(zd.x), d[1] * bfhi(zd.x)); o.y = cvt_pk_bf16(d[2] * bflo(zd.y), d[3] * bfhi(zd.y));
    o.z = cvt_pk_bf16(d[4] * bflo(zd.z), d[5] * bfhi(zd.z)); o.w = cvt_pk_bf16(d[6] * bflo(zd.w), d[7] * bfhi(zd.w));
    *(u32x4*)(zrow + mi0) = o;
    u32x4 q; q.x = cvt_pk_bf16(mr[0] * bflo(zm.x), mr[1] * bfhi(zm.x)); q.y = cvt_pk_bf16(mr[2] * bflo(zm.y), mr[3] * bfhi(zm.y));
    q.z = cvt_pk_bf16(mr[4] * bflo(zm.z), mr[5] * bfhi(zm.z)); q.w = cvt_pk_bf16(mr[6] * bflo(zm.w), mr[7] * bfhi(zm.w));
    *(u32x4*)(zrow + 128 + mi0) = q;
}
template <bool FOLD> struct EpiDft {
    static constexpr bool PERM = true;
    bf16_t* Z; int L; int tok_base; const float* AH;
    __device__ __forceinline__ void operator()(AccRef acc, const pg8::Unit& u, int wr, int wc, int fr, int fq) const {
        const int b = u.pn >> 3, g = u.pn & 7, k0 = u.pm * 128 + wr * 64 + fr, mi0 = wc * 32 + 8 * fq;
        f32x4 ah[2] = {(f32x4){0.f, 0.f, 0.f, 0.f}, (f32x4){0.f, 0.f, 0.f, 0.f}}; float ahn = 0.f;
        if (FOLD) { const float* ap = AH + (size_t)b * 2048 + g * 256; ah[0] = *(const f32x4*)(ap + mi0) * 0.022097087f; ah[1] = *(const f32x4*)(ap + mi0 + 4) * 0.022097087f; ahn = ap[128] * 0.022097087f; }
        const bool nyq = (wc == 0 && fq == 0);
        DftZ zr[4], zq[4];
#pragma unroll
        for (int m = 0; m < 4; ++m) { const int k = k0 + 16 * m; const bf16_t* zrow = Z + (size_t)(tok_base + b * L + k) * 2048 + g * 256;
            const bf16_t* zmir = Z + (size_t)(tok_base + b * L + ((FOLD && k >= 1) ? (L - k) : k)) * 2048 + g * 256;
            zr[m] = dft_row_ld(zrow, mi0); if (FOLD) zq[m] = dft_row_ld(zmir, mi0); }
#pragma unroll
        for (int m = 0; m < 4; ++m) { const int k = k0 + 16 * m; bf16_t* zrow = Z + (size_t)(tok_base + b * L + k) * 2048 + g * 256;
            bf16_t* zmir = Z + (size_t)(tok_base + b * L + (L - k)) * 2048 + g * 256;
            const float sg = (k & 1) ? -1.f : 1.f;
            float dm[8], sm[8], p0 = 0.f;
#pragma unroll
            for (int n = 0; n < 2; ++n) { f32x4 P = acc[0][0][m][n]; const f32x4 Q = acc[1][1][m][n]; if (FOLD) P = P + ah[n] * sg;
                if (n == 0) p0 = P[0];
#pragma unroll
                for (int e = 0; e < 4; ++e) { dm[4 * n + e] = P[e] - Q[e]; sm[4 * n + e] = P[e] + Q[e]; } }
            if (nyq) {
                const float yn = acc[0][1][m][0][0] + (FOLD ? ahn * sg : 0.f);
                float d2[8], s2[8];
#pragma unroll
                for (int j = 0; j < 8; ++j) { d2[j] = dm[j]; s2[j] = sm[j]; }
                dm[0] = p0; sm[0] = yn; d2[0] = yn; s2[0] = p0;
                dft_row_st(zrow, mi0, zr[m], dm, sm);
                if (FOLD && k >= 1) dft_row_st(zmir, mi0, zq[m], s2, d2);
            } else {
                dft_row_st(zrow, mi0, zr[m], dm, sm);
                if (FOLD && k >= 1) dft_row_st(zmir, mi0, zq[m], sm, dm); } }
    }
};
struct OutOrder {
    pg8::TileOrder T; int G, c; bool with_ctx;
    __device__ void init(int G_, int c_, bool with_ctx_) { T.init(64, 4, G_, c_); G = G_; c = c_; with_ctx = with_ctx_; }
    __device__ bool next(int i, pg8::Unit& u) const {
        const int L = i * G + c;
        if (L < 256) return T.next(i, u);
        if (!with_ctx || L >= 384) return false;
        const int idx = L - 256, tile = idx >> 2; u.pm = 64 + (tile >> 2); u.pn = tile & 3; u.aux = 1 + (idx & 3); return true;
    }
    __device__ __forceinline__ int koff(const pg8::Unit& u) const { return u.aux ? 512 * (u.aux - 1) : 0; }
    __device__ __forceinline__ const char* a_ptr(const pg8::Gemm& g, const pg8::Unit& u) const { return (const char*)(g.A + (size_t)u.pm * 256 * g.lda + koff(u)); }
    __device__ __forceinline__ const char* b_ptr(const pg8::Gemm& g, const pg8::Unit& u, int half) const { return (const char*)(g.Bt + (size_t)(u.pn * 256 + 128 * half) * g.ldb + koff(u)); }
    __device__ __forceinline__ bool b_mirror(const pg8::Unit&) const { return false; }
    __device__ __forceinline__ bool b_fix(const pg8::Unit&) const { return false; }
    __device__ __forceinline__ int ktiles(const pg8::Gemm& g, const pg8::Unit& u) const { return u.aux ? 8 : g.K / pg8::BK; }
};
struct EpiResid {
    static constexpr bool PERM = false;
    const float* xin_lat; float* xout_lat; const float* gate; float* part;
    __device__ __forceinline__ void operator()(AccRef acc, const pg8::Unit& u, int wr, int wc, int fr, int fq) const {
        const int row0 = u.pm * 256 + wr * 64 + fr, col0 = u.pn * 256 + wc * 32 + 4 * fq;
        if (u.aux) {
            float* pp = part + (size_t)(u.aux - 1) * NCTX * DM + (size_t)(row0 - NLAT) * DM + col0;
#pragma unroll
            for (int ai = 0; ai < 2; ++ai)
#pragma unroll
                for (int m = 0; m < 4; ++m)
#pragma unroll
                    for (int bj = 0; bj < 2; ++bj)
#pragma unroll
                        for (int n = 0; n < 2; ++n) *(f32x4*)(pp + (size_t)(ai * 128 + m * 16) * DM + bj * 128 + n * 16) = acc[ai][bj][m][n];
            return;
        }
        const float* gp = gate + (u.pm >> 3) * 3072 + col0;
        f32x4 gv[2][2];
#pragma unroll
        for (int bj = 0; bj < 2; ++bj)
#pragma unroll
            for (int n = 0; n < 2; ++n) gv[bj][n] = *(const f32x4*)(gp + bj * 128 + n * 16);
#pragma unroll
        for (int ai = 0; ai < 2; ++ai) {
            f32x4 xv[4][2][2];
#pragma unroll
            for (int m = 0; m < 4; ++m) { const size_t off = (size_t)(row0 + ai * 128 + m * 16) * DM + col0;
#pragma unroll
                for (int bj = 0; bj < 2; ++bj)
#pragma unroll
                    for (int n = 0; n < 2; ++n) xv[m][bj][n] = *(const f32x4*)(xin_lat + off + bj * 128 + n * 16); }
#pragma unroll
            for (int m = 0; m < 4; ++m) { const size_t off = (size_t)(row0 + ai * 128 + m * 16) * DM + col0;
#pragma unroll
                for (int bj = 0; bj < 2; ++bj)
#pragma unroll
                    for (int n = 0; n < 2; ++n) *(f32x4*)(xout_lat + off + bj * 128 + n * 16) = xv[m][bj][n] + gv[bj][n] * acc[ai][bj][m][n]; }
            asm volatile("" ::: "memory"); }
    }
};
struct EpiQKV {
    static constexpr bool PERM = true;
    bf16_t* Q; bf16_t* K; bf16_t* V; const float* rcos; const float* rsin;
    __device__ __forceinline__ void operator()(AccRef acc, const pg8::Unit& u, int wr, int wc, int fr, int fq) const {
        const int row0 = u.pm * 256 + wr * 64 + fr, c0 = wc * 32 + 8 * fq;
        if (u.pn >= 8) {
#pragma unroll
            for (int ai = 0; ai < 2; ++ai)
#pragma unroll
                for (int m = 0; m < 4; ++m) { bf16_t* rowp = V + (size_t)(row0 + ai * 128 + m * 16) * 2048 + (u.pn - 8) * 256 + c0;
#pragma unroll
                    for (int bj = 0; bj < 2; ++bj) { const f32x4 v0 = acc[ai][bj][m][0], v1 = acc[ai][bj][m][1]; u32x4 w;
                        w.x = cvt_pk_bf16(v0[0], v0[1]); w.y = cvt_pk_bf16(v0[2], v0[3]); w.z = cvt_pk_bf16(v1[0], v1[1]); w.w = cvt_pk_bf16(v1[2], v1[3]);
                        *(u32x4*)(rowp + bj * 128) = w; } }
            return;
        }
        const bool isk = u.pn >= 4, lat = u.pm < 64; const int h = u.pn & 3; bf16_t* dst = isk ? K : Q; const float sc = isk ? 0.0625f : 1.0f;
        const int i0 = 16 * wc + 4 * fq;
#pragma unroll
        for (int ai = 0; ai < 2; ++ai) {
            f32x4 cv[4][2], sv[4][2];
            if (lat) {
#pragma unroll
                for (int m = 0; m < 4; ++m) { const int l = (row0 + ai * 128 + m * 16) & 2047;
#pragma unroll
                    for (int bj = 0; bj < 2; ++bj) { const int pos = bj == 0 ? (l >> 6) : (l & 63); cv[m][bj] = *(const f32x4*)(rcos + pos * 64 + i0); sv[m][bj] = *(const f32x4*)(rsin + pos * 64 + i0); } } }
#pragma unroll
            for (int m = 0; m < 4; ++m) { const int row = row0 + ai * 128 + m * 16;
                bf16_t* chp = dst + ((size_t)(row >> 7) * 4 + h) * 32768;
#pragma unroll
                for (int bj = 0; bj < 2; ++bj) { f32x4 x1 = acc[ai][bj][m][0], x2 = acc[ai][bj][m][1];
                    if (lat) { const f32x4 o1 = x1 * cv[m][bj] - x2 * sv[m][bj], o2 = x1 * sv[m][bj] + x2 * cv[m][bj]; x1 = o1; x2 = o2; }
                    x1 = x1 * sc; x2 = x2 * sc; u32x4 w;
                    w.x = cvt_pk_bf16(x1[0], x1[1]); w.y = cvt_pk_bf16(x1[2], x1[3]); w.z = cvt_pk_bf16(x2[0], x2[1]); w.w = cvt_pk_bf16(x2[2], x2[3]);
                    const int s32 = 4 * bj + wc;
                    const int off = isk ? ((s32 * 8 + ((row & 127) >> 4)) * 512 + (4 * (row & 15) + fq) * 8)
                                        : (((((row >> 4) & 7) * 8) + s32) * 512 + (16 * fq + (row & 15)) * 8);
                    *(u32x4*)(chp + off) = w; } }
            asm volatile("" ::: "memory"); }
    }
};
struct EpiZGate {
    static constexpr bool PERM = true;
    const bf16_t* O; const float* rinv; bf16_t* AO;
    __device__ __forceinline__ void operator()(AccRef acc, const pg8::Unit& u, int wr, int wc, int fr, int fq) const {
        const int head = u.pn >> 1;
        const unsigned vo_o = (unsigned)((fq >> 1) * 256 + (32 * (fq & 1) + fr) * 4) * 2u, vo_r = (unsigned)fr * 16u, vo_a = (unsigned)(fr * 2048 + 8 * fq) * 2u;
        u32x4 ov[2][4][2]; float rv[2][4];
#pragma unroll
        for (int ai = 0; ai < 2; ++ai)
#pragma unroll
            for (int m = 0; m < 4; ++m) { const int rowu = u.pm * 256 + wr * 64 + ai * 128 + m * 16;
                rv[ai][m] = *(const GAS float*)((const GAS unsigned char*)(rinv + (size_t)rowu * 4 + head) + vo_r);
#pragma unroll
                for (int bj = 0; bj < 2; ++bj) { const int sl = (u.pn & 1) * 4 + bj * 2 + (wc >> 1);
                    const bf16_t* ob = O + ((size_t)((((2 * u.pm + ai) * 4 + head) * 8 + sl) * 8 + (wr * 4 + m)) << 10) + (wc & 1) * 512;
                    const u32x2 lo = *(const GAS u32x2*)((const GAS unsigned char*)ob + vo_o), hi = *(const GAS u32x2*)((const GAS unsigned char*)(ob + 64) + vo_o); ov[ai][m][bj] = (u32x4){lo.x, lo.y, hi.x, hi.y}; } }
#pragma unroll
        for (int ai = 0; ai < 2; ++ai)
#pragma unroll
            for (int m = 0; m < 4; ++m) { const int rowu = u.pm * 256 + wr * 64 + ai * 128 + m * 16; const float r_ = rv[ai][m];
#pragma unroll
                for (int bj = 0; bj < 2; ++bj) { const u32x4 o = ov[ai][m][bj]; const f32x4 v0 = acc[ai][bj][m][0], v1 = acc[ai][bj][m][1]; u32x4 w;
                    w.x = cvt_pk_bf16(bflo(o.x) * r_ * silu_f(v0[0]), bfhi(o.x) * r_ * silu_f(v0[1])); w.y = cvt_pk_bf16(bflo(o.y) * r_ * silu_f(v0[2]), bfhi(o.y) * r_ * silu_f(v0[3]));
                    w.z = cvt_pk_bf16(bflo(o.z) * r_ * silu_f(v1[0]), bfhi(o.z) * r_ * silu_f(v1[1])); w.w = cvt_pk_bf16(bflo(o.w) * r_ * silu_f(v1[2]), bfhi(o.w) * r_ * silu_f(v1[3]));
                    stg16(AO + (size_t)rowu * 2048 + u.pn * 256 + wc * 32 + bj * 128, vo_a, w); } }
    }
};

#define XB_TMO      128
#define XB_XCNT(j)  (256  + 64 * (j))
#define XB_XSUB(j)  (1280 + 64 * (j))
#define XB_XGEN(j)  (2304 + 64 * (j))
#define XB_TOP      3328
#define XB_TOPGEN   3392
#define XCD_BAR_WORDS 3456
#define XB_SPIN_CAP (1u << 18)
__device__ __forceinline__ unsigned xb_ld(unsigned* p)              { return __hip_atomic_load(p, __ATOMIC_RELAXED, __HIP_MEMORY_SCOPE_AGENT); }
__device__ __forceinline__ unsigned xb_add(unsigned* p, unsigned v) { return __hip_atomic_fetch_add(p, v, __ATOMIC_RELAXED, __HIP_MEMORY_SCOPE_AGENT); }
__device__ __forceinline__ unsigned xb_xcc_id() { return (unsigned)__builtin_amdgcn_s_getreg((3 << 11) | 20) & 0xFu; }
#define XB_SPIN(cond, bar) do { unsigned _sp = 0; while (cond) { __builtin_amdgcn_s_sleep(1); \
    if ((++_sp & 255u) == 0u) { if (xb_ld(&(bar)[XB_TMO])) break; if (_sp > XB_SPIN_CAP) { atomicAdd(&(bar)[XB_TMO], 1u); break; } } } } while (0)
struct XcdBarrier { unsigned* bar; unsigned x; volatile LAS unsigned* st; };
__device__ __forceinline__ XcdBarrier xcd_barrier_post(unsigned* bar, volatile LAS unsigned* st) {
    XcdBarrier b; b.bar = bar; b.x = xb_xcc_id(); b.st = st;
    if (threadIdx.x == 0) (void)xb_add(&bar[XB_XCNT(b.x)], 1u);
    return b;
}
__device__ __forceinline__ void xcd_barrier_complete(unsigned* bar, unsigned x, unsigned& nloc, unsigned& nx) {
    const unsigned G = gridDim.x * gridDim.y * gridDim.z;
    unsigned sum, cnt, mine, sp = 0u;
    for (;;) {
        sum = 0u; cnt = 0u; mine = 0u;
#pragma unroll 1
        for (unsigned j = 0; j < 16; ++j) { const unsigned c = xb_ld(&bar[XB_XCNT(j)]); sum += c; cnt += (c > 0u) ? 1u : 0u; mine = (j == x) ? c : mine; }
        if (sum == G) break;
        __builtin_amdgcn_s_sleep(1);
        if ((++sp & 255u) == 0u) { if (xb_ld(&bar[XB_TMO])) break; if (sp > XB_SPIN_CAP) { atomicAdd(&bar[XB_TMO], 1u); break; } }
    }
    nloc = mine > 0u ? mine : 1u; nx = cnt > 0u ? cnt : 1u;
}
__device__ __forceinline__ void xcd_barrier(const XcdBarrier& b) {
    asm volatile("s_waitcnt vmcnt(0)" ::: "memory");
    __syncthreads();
    if (threadIdx.x == 0) {
        unsigned* bar = b.bar;
        __builtin_amdgcn_s_waitcnt(0);
        unsigned nloc = b.st[0], nx = b.st[1];
        if (nloc == 0u) { xcd_barrier_complete(bar, b.x, nloc, nx); b.st[0] = nloc; b.st[1] = nx; }
        const unsigned old = xb_add(&bar[XB_XSUB(b.x)], 1u);
        const unsigned gen = old / nloc;
        if (old + 1u == (gen + 1u) * nloc) {
            __builtin_amdgcn_fence(__ATOMIC_RELEASE, "agent");
            asm volatile("s_waitcnt vmcnt(0)" ::: "memory");
            const unsigned og = xb_add(&bar[XB_TOP], 1u);
            const unsigned tg = og / nx;
            if (og + 1u == (tg + 1u) * nx) xb_add(&bar[XB_TOPGEN], 1u);
            else XB_SPIN(xb_ld(&bar[XB_TOPGEN]) == tg, bar);
            __builtin_amdgcn_fence(__ATOMIC_ACQUIRE, "agent");
            xb_add(&bar[XB_XGEN(b.x)], 1u);
            asm volatile("s_waitcnt vmcnt(0)" ::: "memory");
        } else {
            XB_SPIN(xb_ld(&bar[XB_XGEN(b.x)]) == gen, bar);
            __builtin_amdgcn_fence(__ATOMIC_ACQUIRE, "agent");
            asm volatile("s_waitcnt vmcnt(0)" ::: "memory");
        }
    }
    __syncthreads();
}

struct Args { const float* in[13]; float* out; unsigned char* ws; int ph_lo, ph_hi, pad0, pad1; };
struct Frame {
    LAS unsigned char* lds;
    int vcu, G, wv;
    unsigned char* ws;
};
__device__ __forceinline__ int lane_id() { int l; asm volatile("v_mbcnt_lo_u32_b32 %0, -1, 0\n\tv_mbcnt_hi_u32_b32 %0, -1, %0" : "=v"(l)); return l; }
__device__ __forceinline__ unsigned char* launder_ptr(unsigned char* p) {
    unsigned lo = (unsigned)(unsigned long long)p, hi = (unsigned)((unsigned long long)p >> 32);
    asm volatile("" : "+s"(lo), "+s"(hi));
    return (unsigned char*)(((unsigned long long)hi << 32) | lo);
}
#define PHASE_IDS() int tid = F.wv * 64 + lane_id(); asm volatile("" : "+v"(tid)); const int lane = tid & 63, wave = __builtin_amdgcn_readfirstlane(tid >> 6); (void)lane; (void)wave; \
    unsigned char* ws = launder_ptr(F.ws); (void)ws
#define LDS_WAIT() asm volatile("s_waitcnt lgkmcnt(0)" ::: "memory")

__device__ __forceinline__ int qk_pos(int d) { const int half = d >> 7, n = (d >> 6) & 1, i = d & 63; return 128 * half + 8 * (i >> 2) + 4 * n + (i & 3); }
template <int MODE>
__device__ __forceinline__ void transpose_item(const float* W, int K, int N, int n_begin, bf16_t* WT, LAS float* scr, int item, int nblk, int lane) {
    const int kb = item / nblk, nb = item % nblk, k0 = 64 * kb, n0 = n_begin + 64 * nb;
    const GAS f32x4* src = (const GAS f32x4*)(W + (size_t)(k0 + (lane >> 4)) * N + n0 + 4 * (lane & 15));
    f32x4 v[16];
#pragma unroll
    for (int i = 0; i < 16; ++i) {
        if (MODE == 3) { const int kr = k0 + 4 * i + (lane >> 4), ks = (kr & ~255) + fpos(kr & 255); v[i] = *(const GAS f32x4*)(W + (size_t)ks * N + n0 + 4 * (lane & 15)); }
        else v[i] = src[(size_t)i * N]; }
#pragma unroll
    for (int i = 0; i < 16; ++i) *(LAS f32x4*)(scr + (4 * i + (lane >> 4)) * 68 + 4 * (lane & 15)) = v[i];
    LDS_WAIT(); asm volatile("" ::: "memory");
    const int na = n0 + lane; int nn = na - n_begin;
    if (MODE == 1) nn = (na < 2048) ? ((na & ~255) + qk_pos(na & 255)) : na;
    if (MODE == 2) nn = (nn & ~255) + fpos(nn & 255);
    GAS u32x4* dst = (GAS u32x4*)(WT + (size_t)nn * K + k0);
#pragma unroll
    for (int c = 0; c < 8; ++c) { const LAS float* sp = scr + (8 * c) * 68 + lane;
        u32x4 o; o.x = pk2(sp[0 * 68], sp[1 * 68]); o.y = pk2(sp[2 * 68], sp[3 * 68]); o.z = pk2(sp[4 * 68], sp[5 * 68]); o.w = pk2(sp[6 * 68], sp[7 * 68]);
        dst[c] = o; }
    LDS_WAIT(); asm volatile("" ::: "memory");
}
__device__ __forceinline__ void fold_task(const float* Win  , const LAS float* ctab  , bf16_t* WfT, int t, int lane) {
    const int g = t >> 8, p0 = ((t >> 5) & 7) * 32, kk0 = (t & 31) * 32, s = lane >> 5, li = lane & 31;
    f32x16 acc;
#pragma unroll
    for (int i = 0; i < 16; ++i) acc[i] = 0.f;
    const float* wrow = Win + (size_t)(kk0 + li) * 4096 + g * 256 + 4 * s;
    const int pcol = p0 + li;
    const int pmul = pcol < 128 ? pcol : pcol - 128, poff = pcol < 128 ? 0 : -64; const bool nyq = pcol == 128;
    f32x4 wvv[32];
#pragma unroll
    for (int tp = 0; tp < 32; ++tp) wvv[tp] = *(const GAS f32x4*)((const GAS float*)wrow + 8 * tp);
#pragma unroll
    for (int tp = 0; tp < 32; ++tp) {
        const f32x4 wv = wvv[tp];
#pragma unroll
        for (int uu = 0; uu < 4; ++uu) { const int cc = 8 * tp + 4 * s + uu; float a;
            a = ctab[(pmul * cc + poff) & 255]; if (nyq) a = (cc & 1) ? -0.0625f : 0.0625f;
            acc = __builtin_amdgcn_mfma_f32_32x32x2f32(a, wv[uu], acc, 0, 0, 0); }
    }
#pragma unroll
    for (int i = 0; i < 16; ++i) { const int row = (i & 3) + 8 * (i >> 2) + 4 * s; WfT[(size_t)(g * 256 + p0 + row) * 1024 + kk0 + li] = (bf16_t)f2bf(acc[i]); }
}

__device__ __forceinline__ void p0_phase(Frame& F, const Args& a) {
    PHASE_IDS();
    float* ADA = (float*)(ws + WS_ADA);
    const float* c = a.in[1]; const float* cctx = a.in[3]; const float* ada_w = a.in[5]; const float* ada_b = a.in[6];
    LAS float* sl = (LAS float*)F.lds;
    LAS float* part = (LAS float*)(F.lds + 36864);
    bool loaded = false;
    for (int u = F.vcu; u < 192; u += F.G) {
        if (!loaded) { for (int idx = tid; idx < 9 * 1024; idx += 512) { const int r = idx >> 10, k = idx & 1023; const float x = r < 8 ? c[r * 1024 + k] : cctx[k]; sl[idx] = x / (1.f + expf(-x)); } loaded = true; }
        __syncthreads();
        const int i = u / 48, n0 = (u % 48) * 64;
        f32x4 acc[9];
#pragma unroll
        for (int r = 0; r < 9; ++r) acc[r] = (f32x4){0.f, 0.f, 0.f, 0.f};
        const int ks4 = lane >> 4, c4 = 4 * (lane & 15);
        const float* wp = ada_w + ((size_t)i * 1024 + wave * 128 + ks4) * 3072 + n0 + c4;
#pragma unroll 8
        for (int kk = 0; kk < 32; ++kk) { const f32x4 wv = *(const f32x4*)(wp + (size_t)kk * 4 * 3072); const int k = wave * 128 + 4 * kk + ks4;
#pragma unroll
            for (int r = 0; r < 9; ++r) acc[r] += wv * sl[r * 1024 + k]; }
#pragma unroll
        for (int r = 0; r < 9; ++r) *(LAS f32x4*)(part + ((wave * 4 + ks4) * 9 + r) * 64 + c4) = acc[r];
        __syncthreads();
        for (int idx = tid; idx < 576; idx += 512) { const int r = idx >> 6, l = idx & 63; float s = 0.f;
#pragma unroll
            for (int w = 0; w < 32; ++w) s += part[(w * 9 + r) * 64 + l];
            ADA[(i * 9 + r) * 3072 + n0 + l] = s + ada_b[i * 3072 + n0 + l]; }
    }
    const int gt = F.vcu * 512 + tid, NT = F.G * 512;
    float* RC = (float*)(ws + WS_ROPE); float* RS = RC + 4096;
    for (int idx = gt; idx < 4096; idx += NT) { const int pos = idx >> 6, i = idx & 63; const float freq = powf(10000.0f, -(float)i / 64.0f); const float ang = (float)pos * freq;
        RC[idx] = cosf(ang); RS[idx] = sinf(ang); }
    bf16_t* CS256 = (bf16_t*)(ws + WS_CS256);
    for (int idx = gt; idx < 512 * 256; idx += NT) { const int row = idx >> 8, l = idx & 255, kt = row >> 8, hf = (row >> 7) & 1, k = kt * 128 + (row & 127);
        const float x = (float)((k * l) & 255) * (1.f / 128.f); const float v = (hf ? sinpif(x) : cospif(x)) * 0.0625f; CS256[idx] = (bf16_t)f2bf(v); }
}

__device__ __forceinline__ void norm_row(const float* xrow, const float* ng, const float* adar  , bf16_t* orow, int lane) {
    const f32x4* xr = (const f32x4*)xrow + lane;
    f32x4 v[4]; float s = 0.f;
#pragma unroll
    for (int j = 0; j < 4; ++j) { v[j] = xr[64 * j]; s += (v[j].x * v[j].x + v[j].y * v[j].y) + (v[j].z * v[j].z + v[j].w * v[j].w); }
    const float rinv = rsqrtf(wave_sum(s, lane) * (1.f / DM) + EPS);
    unsigned long long* o8 = (unsigned long long*)orow + lane;
#pragma unroll
    for (int j = 0; j < 4; ++j) { const int col = 4 * lane + 256 * j; const f32x4 g = *(const f32x4*)(ng + col), sh = *(const f32x4*)(adar + col), sc = *(const f32x4*)(adar + 1024 + col);
        const f32x4 y = v[j] * rinv * g * (sc + 1.0f) + sh;
        o8[64 * j] = (unsigned long long)pk2(y.x, y.y) | ((unsigned long long)pk2(y.z, y.w) << 32); }
}
template <int NR>
__device__ __forceinline__ void norm_batch(const float* const (&xrow)[NR], bf16_t* const (&hrow)[NR], int nrows, const f32x4 (&gm)[4], const f32x4 (&sh)[4], int lane) {
    f32x4 v[NR][4]; float ss[NR];
#pragma unroll
    for (int t = 0; t < NR; ++t) { const f32x4* xr = (const f32x4*)xrow[t] + lane;
#pragma unroll
        for (int j = 0; j < 4; ++j) v[t][j] = xr[64 * j]; }
#pragma unroll
    for (int t = 0; t < NR; ++t) { float s = 0.f;
#pragma unroll
        for (int j = 0; j < 4; ++j) s += (v[t][j].x * v[t][j].x + v[t][j].y * v[t][j].y) + (v[t][j].z * v[t][j].z + v[t][j].w * v[t][j].w);
        ss[t] = s; }
#pragma unroll
    for (int o = 1; o < 64; o <<= 1) {
#pragma unroll
        for (int t = 0; t < NR; ++t) ss[t] += shx(ss[t], o, lane); }
#pragma unroll
    for (int t = 0; t < NR; ++t) if (t < nrows) { const float rinv = rsqrtf(ss[t] * (1.f / DM) + EPS);
        unsigned long long* o8 = (unsigned long long*)hrow[t] + lane;
#pragma unroll
        for (int j = 0; j < 4; ++j) { const f32x4 y = v[t][j] * rinv * gm[j] + sh[j];
            o8[64 * j] = (unsigned long long)pk2(y.x, y.y) | ((unsigned long long)pk2(y.z, y.w) << 32); } }
}
template <bool ADDP>
__device__ __forceinline__ void norm_rows(Frame& F, const Args& a, int layer, bf16_t* H, int wsub = 8) {
    PHASE_IDS();
    const float* xl = layer == 0 ? a.in[0] : a.out; const float* xc = (layer == 0 || (ADDP && layer == 1)) ? a.in[2] : (const float*)(ws + WS_XCTX);
    const float* ng = a.in[4] + layer * DM; const float* ADA = (const float*)(ws + WS_ADA) + layer * 9 * 3072;
    const int gw = F.vcu * wsub + wave, NGW = F.G * wsub;
    const int wpb = NGW >> 3;
    if (wpb > 0 && (NGW & 7) == 0) {
        const int b = gw / wpb, wi = gw - b * wpb; const float* adar = ADA + b * 3072;
        f32x4 gm[4], sh[4];
#pragma unroll
        for (int j = 0; j < 4; ++j) { const int col = 4 * lane + 256 * j; gm[j] = *(const f32x4*)(ng + col) * (*(const f32x4*)(adar + 1024 + col) + 1.0f); sh[j] = *(const f32x4*)(adar + col); }
        for (int l0 = wi; l0 < SEQ; l0 += 8 * wpb) {
            const float* xr[8]; bf16_t* hr[8]; int n = 0;
#pragma unroll
            for (int t = 0; t < 8; ++t) { const int l = l0 + t * wpb; const int ll = l < SEQ ? l : wi; if (l < SEQ) n = t + 1; xr[t] = xl + (size_t)(b * SEQ + ll) * DM; hr[t] = H + (size_t)(b * SEQ + ll) * DM; }
            norm_batch<8>(xr, hr, n, gm, sh, lane);
        }
        const float* adac = ADA + 8 * 3072;
#pragma unroll
        for (int j = 0; j < 4; ++j) { const int col = 4 * lane + 256 * j; gm[j] = *(const f32x4*)(ng + col) * (*(const f32x4*)(adac + 1024 + col) + 1.0f); sh[j] = *(const f32x4*)(adac + col); }
        for (int m = gw; m < NCTX; m += NGW) {
            f32x4 xv[4];
#pragma unroll
            for (int j = 0; j < 4; ++j) xv[j] = *((const f32x4*)(xc + (size_t)m * DM) + lane + 64 * j);
            if (ADDP && layer >= 1) {
                const float* part = (const float*)(ws + WS_PART); const float* gprev = (const float*)(ws + WS_ADA) + (layer - 1) * 9 * 3072 + 8 * 3072 + 2048;
                float* xw = (float*)(ws + WS_XCTX) + (size_t)m * DM;
#pragma unroll
                for (int j = 0; j < 4; ++j) { const f32x4* pr = (const f32x4*)(part + (size_t)m * DM) + lane + 64 * j;
                    const f32x4 ps = (pr[0] + pr[(size_t)NCTX * DM / 4]) + (pr[(size_t)2 * NCTX * DM / 4] + pr[(size_t)3 * NCTX * DM / 4]);
                    xv[j] = xv[j] + *(const f32x4*)(gprev + 4 * lane + 256 * j) * ps;
                    *((f32x4*)xw + lane + 64 * j) = xv[j]; }
            }
            float s_ = 0.f;
#pragma unroll
            for (int j = 0; j < 4; ++j) s_ += (xv[j].x * xv[j].x + xv[j].y * xv[j].y) + (xv[j].z * xv[j].z + xv[j].w * xv[j].w);
            const float rinv = rsqrtf(wave_sum(s_, lane) * (1.f / DM) + EPS);
            unsigned long long* o8 = (unsigned long long*)(H + (size_t)(NLAT + m) * DM) + lane;
#pragma unroll
            for (int j = 0; j < 4; ++j) { const f32x4 y = xv[j] * rinv * gm[j] + sh[j];
                o8[64 * j] = (unsigned long long)pk2(y.x, y.y) | ((unsigned long long)pk2(y.z, y.w) << 32); }
        }
        return;
    }
    for (int m = gw; m < NTOK; m += NGW) {
        const bool lat = m < NLAT; const int r = lat ? (m >> 11) : 8; const float* adar = ADA + r * 3072;
        f32x4 gm[4], sh[4];
#pragma unroll
        for (int j = 0; j < 4; ++j) { const int col = 4 * lane + 256 * j; gm[j] = *(const f32x4*)(ng + col) * (*(const f32x4*)(adar + 1024 + col) + 1.0f); sh[j] = *(const f32x4*)(adar + col); }
        const float* xr[1] = {lat ? xl + (size_t)m * DM : xc + (size_t)(m - NLAT) * DM}; bf16_t* hr[1] = {H + (size_t)m * DM};
        norm_batch<1>(xr, hr, 1, gm, sh, lane);
    }
}
__device__ __forceinline__ void cf_prep(Frame& F, int wave, int lane) {
    LAS float* ctab = (LAS float*)(F.lds + 139264);
    { const int tt = wave * 64 + lane; if (tt < 256) ctab[tt] = cospif((float)tt * (1.f / 128.f)) * 0.0625f; }
    __syncthreads();
}
__device__ __forceinline__ void cf_main(Frame& F, const Args& a, int j, int gw, int NGW, unsigned char* ws, int wave, int lane) {
    LAS float* scr = (LAS float*)(F.lds + wave * 17408); const LAS float* ctab = (const LAS float*)(F.lds + 139264);
    bf16_t* W1 = (bf16_t*)(ws + WS_WF);
    const float* win = a.in[7] + (size_t)j * 1024 * 4096; const float* wout = a.in[8] + (size_t)j * 2048 * 1024;
    bf16_t* WfoT = W1 + (size_t)4096 * 1024;
    for (int t = gw; t < 2048; t += NGW) fold_task(win, ctab, W1, t, lane);
    for (int it = gw; it < 16 * 32; it += NGW) transpose_item<2>(win, 1024, 4096, 2048, W1 + (size_t)2048 * 1024, scr, it, 32, lane);
    for (int it = gw; it < 32 * 16; it += NGW) transpose_item<3>(wout, 2048, 1024, 0, WfoT, scr, it, 16, lane);
}
__device__ __forceinline__ void cf_cs(Frame& F, int gt, int NT, unsigned char* ws, int wave, int lane) {
    bf16_t* CS = (bf16_t*)(ws + WS_CS);
    __syncthreads();
    LAS float* ctab2 = (LAS float*)F.lds;
    for (int n = wave * 64 + lane; n < 2048; n += 512) ctab2[n] = cospif((float)n * (1.f / 1024.f)) * 0.022097087f;
    __syncthreads();
    for (int ch = gt; ch < 2048 * 128; ch += NT) { const int row = ch >> 7, l0 = (ch & 127) * 8, kt = row >> 8, hf = (row >> 7) & 1, k = kt * 128 + (row & 127);
        const int off = hf ? -512 : 0;
        unsigned w[4];
#pragma unroll
        for (int e = 0; e < 4; ++e) { float v[2];
#pragma unroll
            for (int q = 0; q < 2; ++q) { const int l = l0 + 2 * e + q; v[q] = ctab2[(k * l + off) & 2047]; }
            w[e] = pk2(v[0], v[1]); }
        *(u32x4*)(CS + (size_t)row * 1024 + l0) = (u32x4){w[0], w[1], w[2], w[3]}; }
    __syncthreads();
}
__device__ __forceinline__ void conv_fourier(Frame& F, const Args& a, int j, int gw, int NGW, int gt, int NT, unsigned char* ws, int wave, int lane) {
    cf_prep(F, wave, lane); cf_main(F, a, j, gw, NGW, ws, wave, lane); cf_cs(F, gt, NT, ws, wave, lane);
}
__device__ __forceinline__ void conv_ret(Frame& F, const Args& a, int j, int gw, int NGW, unsigned char* ws, int wave, int lane, int lo = 0, int hi = 2048) {
    LAS float* scr = (LAS float*)(F.lds + wave * 17408);
    bf16_t* W1 = (bf16_t*)(ws + WS_W);
    const float* win = a.in[9] + (size_t)j * 1024 * 6144; const float* wout = a.in[10] + (size_t)j * 2048 * 1024;
    bf16_t* WroT = W1 + (size_t)6144 * 1024;
    for (int it = lo + gw; it < hi; it += NGW) {
        if (it < 1536) transpose_item<1>(win, 1024, 6144, 0, W1, scr, it, 96, lane);
        else transpose_item<0>(wout, 2048, 1024, 0, WroT, scr, it - 1536, 16, lane);
    }
}
__device__ __forceinline__ void bg_conv_ret(Frame& F, const Args& a, int layer, int cu_lo, int lo, int hi) {
    PHASE_IDS();
    const int cu = (int)blockIdx.x - cu_lo;
    if (layer + 1 >= NLAYER || F.G != 256 || cu < 0 || cu >= 128) return;
    conv_ret(F, a, (layer + 1) >> 1, cu * 8 + wave, 1024, ws, wave, lane, lo, hi);
}
__device__ __forceinline__ void p0_conv(Frame& F, const Args& a) {
    PHASE_IDS();
    __syncthreads();
    conv_fourier(F, a, 0, F.vcu * 8 + wave, F.G * 8, F.vcu * 512 + tid, F.G * 512, ws, wave, lane);
}
__device__ __forceinline__ void n_phase(Frame& F, const Args& a, int layer) {
    PHASE_IDS();
    const bool fourier = (layer & 1) == 0;
    if (fourier && layer >= 1) {
        cf_prep(F, wave, lane);
        if (wave < 4) norm_rows<true>(F, a, layer, (bf16_t*)(ws + WS_H), 4); else cf_main(F, a, layer >> 1, F.vcu * 4 + wave - 4, F.G * 4, ws, wave, lane);
        cf_cs(F, F.vcu * 512 + tid, F.G * 512, ws, wave, lane);
        return;
    }
    norm_rows<true>(F, a, layer, (bf16_t*)(ws + (fourier ? WS_H : WS_OF)));
    if (layer >= 1) {
        if (fourier) conv_fourier(F, a, layer >> 1, F.vcu * 8 + wave, F.G * 8, F.vcu * 512 + tid, F.G * 512, ws, wave, lane);
        else if (F.G != 256) conv_ret(F, a, layer >> 1, F.vcu * 8 + wave, F.G * 8, ws, wave, lane);
    }
}
__device__ __forceinline__ void nyq_row_phase(Frame& F) {
    PHASE_IDS();
    const bf16_t* UTF = (const bf16_t*)(ws + WS_UTL); const float* AH = (const float*)(ws + WS_RINV); bf16_t* Z = (bf16_t*)(ws + WS_Z);
    const int gw = F.vcu * 8 + wave, NGW = F.G * 8;
    for (int t = gw; t < 64 * 129; t += NGW) {
        const int bg = t / 129, mt = t - bg * 129, b = bg >> 3, g = bg & 7; const int row = b * 2048 + g * 256 + mt;
        const GAS u32x4* src = (const GAS u32x4*)(UTF + (size_t)row * 1024);
        float s = 0.f;
#pragma unroll
        for (int i = 0; i < 2; ++i) { const u32x4 v = src[lane + 64 * i]; s += (bflo(v.x) - bfhi(v.x)) + (bflo(v.y) - bfhi(v.y)) + (bflo(v.z) - bfhi(v.z)) + (bflo(v.w) - bfhi(v.w)); }
        s = wave_sum(s, lane);
        const float y = (s + AH[row]) * 0.022097087f;
        bf16_t* zrow = Z + (size_t)(b * 2048 + 1024) * 2048 + g * 256;
        if (lane == 0) zrow[mt] = (bf16_t)f2bf(y * bf1(zrow[mt]));
        if (lane == 1 && mt >= 1 && mt <= 127) zrow[128 + mt] = (bf16_t)f2bf(y * bf1(zrow[128 + mt]));
    }
}
__device__ __forceinline__ bf16_t* s_chunk(unsigned char* ws, int h, int rc) {
    return rc < 56 ? (bf16_t*)(ws + WS_SA) + ((size_t)(h * 56 + rc) << 14) : (bf16_t*)(ws + WS_SB) + ((size_t)(h * 88 + rc - 56) << 14);
}
struct DiagOrder {
    int G, c;
    __device__ bool next(int i, pg8::Unit& u) const { const int L = i * G + c; if (L >= 288) return false; u.aux = L / 72; u.pm = L - 72 * u.aux; u.pn = u.pm; return true; }
    __device__ __forceinline__ const char* a_ptr(const pg8::Gemm& g, const pg8::Unit& u) const { return (const char*)(g.A + ((size_t)(2 * u.pm) * 4 + u.aux) * 32768); }
    __device__ __forceinline__ const char* b_ptr(const pg8::Gemm& g, const pg8::Unit& u, int half) const { return (const char*)(g.Bt + ((size_t)(2 * u.pm + half) * 4 + u.aux) * 32768); }
    __device__ __forceinline__ bool b_mirror(const pg8::Unit&) const { return false; }
    __device__ __forceinline__ bool b_fix(const pg8::Unit&) const { return false; }
    __device__ __forceinline__ int ktiles(const pg8::Gemm& g, const pg8::Unit&) const { return g.K / pg8::BK; }
};
struct EpiS {
    static constexpr bool PERM = true;
    unsigned char* ws;
    __device__ __forceinline__ void operator()(AccRef acc, const pg8::Unit& u, int wr, int wc, int fr, int fq) const {
#pragma unroll
        for (int ai = 0; ai < 2; ++ai) { bf16_t* sp = s_chunk(ws, u.aux, 2 * u.pm + ai);
#pragma unroll
            for (int m = 0; m < 4; ++m) { const f32x4 v0 = acc[ai][ai][m][0], v1 = acc[ai][ai][m][1]; u32x4 w;
                w.x = cvt_pk_bf16(v0[0], v0[1]); w.y = cvt_pk_bf16(v0[2], v0[3]); w.z = cvt_pk_bf16(v1[0], v1[1]); w.w = cvt_pk_bf16(v1[2], v1[3]);
                *(u32x4*)(sp + ((((wr * 4 + m) * 4 + wc) * 64 + fq * 16 + fr) << 3)) = w; } }
    }
};
struct QKVOrder : pg8::TileOrder {
    int i0, i1;
    __device__ void init2(int G_, int c_, int i0_, int i1_) { nM = 72; nN = 16; nwg = 1152; G = G_; c = c_; i0 = i0_; i1 = i1_; }
    __device__ bool next(int i, pg8::Unit& u) const {
        const int ii = i + i0; if (ii >= i1) return false;
        const int L = ii * G + c; if (L >= 1152) return false;
        if (L < 576) { map(L, 72, 8, u); } else if (L < 1008) { map(L - 576, 72, 6, u); u.pn += 8; } else { map(L - 1008, 72, 2, u); u.pn += 14; }
        return true;
    }
};
#define XQ_SUB(l, j) (3584 + 64 * ((l) * 16 + (j)))
#define XQ_TOP(l)    (8768 + 64 * (l))
__device__ __forceinline__ void xq_arrive(const XcdBarrier& b, int layer) {
    asm volatile("s_waitcnt vmcnt(0)" ::: "memory");
    __syncthreads();
    if (threadIdx.x == 0) {
        unsigned nloc = b.st[0], nx = b.st[1];
        if (nloc == 0u) { xcd_barrier_complete(b.bar, b.x, nloc, nx); b.st[0] = nloc; b.st[1] = nx; }
        const unsigned old = xb_add(&b.bar[XQ_SUB(layer, b.x)], 1u);
        if (old + 1u == nloc) { __builtin_amdgcn_fence(__ATOMIC_RELEASE, "agent"); asm volatile("s_waitcnt vmcnt(0)" ::: "memory"); xb_add(&b.bar[XQ_TOP(layer)], 1u); }
    }
}
__device__ __forceinline__ void xq_wait(const XcdBarrier& b, int layer) {
    if (threadIdx.x == 0) {
        const unsigned nx = b.st[1];
        XB_SPIN(xb_ld(&b.bar[XQ_TOP(layer)]) < nx, b.bar);
        __builtin_amdgcn_fence(__ATOMIC_ACQUIRE, "agent");
        asm volatile("s_waitcnt vmcnt(0)" ::: "memory");
    }
    __syncthreads();
}
typedef short bf16x4 __attribute__((ext_vector_type(4)));
typedef short v4i16_t __attribute__((ext_vector_type(4)));
__device__ __forceinline__ bf16x8 ldtr2(const LAS unsigned char* p0, const LAS unsigned char* p1) {
    const bf16x4 lo = __builtin_bit_cast(bf16x4, __builtin_amdgcn_ds_read_tr16_b64_v4i16((LAS v4i16_t*)p0));
    const bf16x4 hi = __builtin_bit_cast(bf16x4, __builtin_amdgcn_ds_read_tr16_b64_v4i16((LAS v4i16_t*)p1));
    return __builtin_shufflevector(lo, hi, 0, 1, 2, 3, 4, 5, 6, 7);
}
__device__ __forceinline__ int blk_perm(int rb) { return (rb & ~3) | ((rb >> 1) & 1) | ((rb & 1) << 1); }
__device__ __forceinline__ int scan_t0(int dir, int b, int s) {
    return dir == 0 ? ((s < 2) ? (NLAT + b * CTXL + s * 128) : (b * SEQ + (s - 2) * 128)) : ((s < 2) ? (NLAT + b * CTXL + (1 - s) * 128) : (b * SEQ + (17 - s) * 128));
}
__device__ __forceinline__ int scan_rc(int dir, int b, int s) {
    return dir == 0 ? ((s < 2) ? (128 + b * 2 + s) : (b * 16 + (s - 2))) : ((s < 2) ? (128 + b * 2 + (1 - s)) : (b * 16 + (17 - s)));
}
__device__ __forceinline__ u32x4 ldg16(const void* ub, unsigned voff) { return *(const GAS u32x4*)((const GAS unsigned char*)ub + voff); }
__device__ __forceinline__ void scan_load_s(u32x4 (&sf)[4], unsigned char* ws, int h, int rc, int w, int r, int q) {
    const bf16_t* ub = s_chunk(ws, h, rc) + w * 2048; const unsigned vo = (unsigned)(16 * q + r) * 16u;
#pragma unroll
    for (int ks = 0; ks < 4; ++ks) sf[ks] = ldg16(ub, vo + 1024u * ks);
}
__device__ __forceinline__ void scan_load_q(u32x4 (&qf)[8], const bf16_t* Qg, int h, int t0, int w, int r, int q) {
    const bf16_t* ub = Qg + (((size_t)(t0 >> 7) * 4 + h) * 8 + w) * 4096; const unsigned vo = (unsigned)(16 * q + r) * 16u;
#pragma unroll
    for (int ks = 0; ks < 8; ++ks) qf[ks] = ldg16(ub, vo + 1024u * ks);
}
__device__ __forceinline__ void scan_load_kv(u32x4 (&kr)[8], u32x4 (&vr)[2], const bf16_t* Kg, const bf16_t* Vg, int h, int sl, int t0, int w, int lane, int tid) {
    const bf16_t* kb = Kg + (((size_t)(t0 >> 7) * 4 + h) * 8 + w) * 4096; const unsigned ko = (unsigned)lane * 16u;
#pragma unroll
    for (int it = 0; it < 8; ++it) kr[it] = ldg16(kb, ko + 1024u * it);
    const bf16_t* vb = Vg + (size_t)t0 * 2048 + h * 512 + sl * 64; const unsigned vo = (unsigned)((tid >> 3) * 2048 + 8 * (tid & 7)) * 2u;
#pragma unroll
    for (int i = 0; i < 2; ++i) vr[i] = ldg16(vb + (size_t)i * 64 * 2048, vo);
}
#ifndef DBG_SEG
#define DBG_SEG -1
#endif
#define SEG_MARK(k) do { if (DBG_SEG >= 0) { __builtin_amdgcn_sched_barrier(0); const unsigned long long t_ = __builtin_amdgcn_s_memtime(); if (DBG_SEG == (k)) segacc += t_ - segt; segt = t_; __builtin_amdgcn_sched_barrier(0); } } while (0)
template <int DIR>
__device__ __forceinline__ void scan_step(unsigned long long& segacc, unsigned long long& segt, LAS unsigned char* lds, u32x4 (&sf)[4], u32x4 (&qf)[8], u32x4 (&kr)[8], u32x4 (&vr)[2], f32x4 (&Rb)[2][4], const float (&wm)[2], float rsc, float g128,
                                          int t0, int t0n, int rcn, unsigned char* ws, int h, int sl, int w, int lane_in, int tid_in, const bf16_t* Qg, const bf16_t* Kg, const bf16_t* Vg, bf16_t* OF, float* SSP) {
    int lane = lane_in; asm volatile("" : "+v"(lane));
    const int tid = (tid_in & ~63) | lane;
    const int r = lane & 15, q = lane >> 4;
    LAS unsigned char* VI = lds + SC_V_OFF; LAS unsigned char* RT = lds + SC_RT_OFF; LAS unsigned char* KI = lds + SC_K_OFF + w * 8192;
    SEG_MARK(5);
#pragma unroll
    for (int i = 0; i < 2; ++i) { const int m = (tid >> 3) + 64 * i, e0 = 8 * (tid & 7); const float sc = wm[i]; const u32x4 v = vr[i]; u32x4 o;
        o.x = cvt_pk_bf16(bflo(v.x) * sc, bfhi(v.x) * sc); o.y = cvt_pk_bf16(bflo(v.y) * sc, bfhi(v.y) * sc); o.z = cvt_pk_bf16(bflo(v.z) * sc, bfhi(v.z) * sc); o.w = cvt_pk_bf16(bflo(v.w) * sc, bfhi(v.w) * sc);
        *(LAS u32x4*)(VI + 128 * ((e0 >> 4) * 32 + blk_perm(m >> 2)) + (m & 3) * 32 + (e0 & 15) * 2) = o; }
#pragma unroll
    for (int it = 0; it < 8; ++it) { const int m = it * 16 + (lane >> 2), dc = lane & 3;
        *(LAS u32x4*)(KI + 128 * ((dc >> 1) * 32 + blk_perm(m >> 2)) + (m & 3) * 32 + (dc & 1) * 16) = kr[it]; }
    SEG_MARK(0);
    asm volatile("s_waitcnt lgkmcnt(0)" ::: "memory"); __builtin_amdgcn_s_barrier(); asm volatile("" ::: "memory");
    SEG_MARK(1);
    const int jl = 16 * w + r;
    { const bf16_t* vb = Vg + (size_t)t0n * 2048 + h * 512 + sl * 64; const unsigned vo = (unsigned)((tid >> 3) * 2048 + 8 * (tid & 7)) * 2u;
#pragma unroll
      for (int i = 0; i < 2; ++i) vr[i] = ldg16(vb + (size_t)i * 64 * 2048, vo); }
    GAS unsigned char* ob = (GAS unsigned char*)(OF + ((size_t)((((t0 >> 7) * 4 + h) * 8 + sl) * 8 + w) << 10)); const unsigned oo = (unsigned)lane * 8u;
    f32x4 O[4];
#pragma unroll
    for (int eb = 0; eb < 4; ++eb) O[eb] = (f32x4){0.f, 0.f, 0.f, 0.f};
    const LAS unsigned char* rtb = RT + r * 528 + q * 16;
    const bf16_t* qub = Qg + (((size_t)(t0n >> 7) * 4 + h) * 8 + w) * 4096; const unsigned qvo = (unsigned)(16 * q + r) * 16u;
    const bf16_t* kub = Kg + (((size_t)(t0n >> 7) * 4 + h) * 8 + w) * 4096; const unsigned kvo = (unsigned)lane * 16u;
    bf16x8 avp[2][4];
#pragma unroll
    for (int eb = 0; eb < 4; ++eb) avp[0][eb] = *(const LAS bf16x8*)(rtb + (16 * eb * 528));
#pragma unroll
    for (int ks = 0; ks < 8; ++ks) { const bf16x8 qv = __builtin_bit_cast(bf16x8, qf[ks]);
        if (ks < 7) {
#pragma unroll
            for (int eb = 0; eb < 4; ++eb) avp[(ks + 1) & 1][eb] = *(const LAS bf16x8*)(rtb + (16 * eb * 528 + 64 * (ks + 1)));
            asm volatile("s_waitcnt lgkmcnt(4)" ::: "memory"); }
        else asm volatile("s_waitcnt lgkmcnt(0)" ::: "memory");
        __builtin_amdgcn_sched_barrier(0);
#pragma unroll
        for (int eb = 0; eb < 4; ++eb) O[eb] = __builtin_amdgcn_mfma_f32_16x16x32_bf16(avp[ks & 1][eb], qv, O[eb], 0, 0, 0);
        if (w < 4) { qf[ks] = ldg16(qub, qvo + 1024u * ks); kr[ks] = ldg16(kub, kvo + 1024u * ks); }
        __builtin_amdgcn_sched_barrier(0); }
    u32x2 pvf[4];
    if (DIR == 1) {
#pragma unroll
        for (int eb = 0; eb < 4; ++eb) pvf[eb] = *(const GAS u32x2*)(ob + oo + 512 * eb); }
    SEG_MARK(2);
    const int lofs = 128 * (4 * (q >> 1) + (q & 1)) + 8 * r;
    const LAS unsigned char* vtb = VI + lofs; const LAS unsigned char* ktb = KI + lofs;
#pragma unroll
    for (int ks = 0; ks < 4; ++ks) {
        bf16x8 vb[4], ka[2];
#pragma unroll
        for (int eb = 0; eb < 4; ++eb) vb[eb] = ldtr2(vtb + 128 * (eb * 32 + 8 * ks), vtb + 128 * (eb * 32 + 8 * ks + 2));
#pragma unroll
        for (int db = 0; db < 2; ++db) ka[db] = ldtr2(ktb + 128 * (db * 32 + 8 * ks), ktb + 128 * (db * 32 + 8 * ks + 2));
        __builtin_amdgcn_sched_barrier(0);
        bf16x8 sfm;
        { unsigned wd[4] = {sf[ks].x, sf[ks].y, sf[ks].z, sf[ks].w};
#pragma unroll
          for (int i = 0; i < 4; ++i) { const int m0 = 32 * ks + 8 * q + 2 * i; const bool k0 = DIR == 0 ? (m0 <= jl) : (m0 >= jl), k1 = DIR == 0 ? (m0 + 1 <= jl) : (m0 + 1 >= jl);
              wd[i] &= (k0 ? 0xffffu : 0u) | (k1 ? 0xffff0000u : 0u); }
          sfm = __builtin_bit_cast(bf16x8, (u32x4){wd[0], wd[1], wd[2], wd[3]}); }
#pragma unroll
        for (int eb = 0; eb < 4; ++eb) O[eb] = __builtin_amdgcn_mfma_f32_16x16x32_bf16(vb[eb], sfm, O[eb], 0, 0, 0);
#pragma unroll
        for (int db = 0; db < 2; ++db)
#pragma unroll
            for (int eb = 0; eb < 4; ++eb) Rb[db][eb] = __builtin_amdgcn_mfma_f32_16x16x32_bf16(ka[db], vb[eb], Rb[db][eb], 0, 0, 0);
        if (w >= 4) {
            qf[2 * ks] = ldg16(qub, qvo + 1024u * (2 * ks)); qf[2 * ks + 1] = ldg16(qub, qvo + 1024u * (2 * ks + 1));
            kr[2 * ks] = ldg16(kub, kvo + 1024u * (2 * ks)); kr[2 * ks + 1] = ldg16(kub, kvo + 1024u * (2 * ks + 1)); }
    }
    SEG_MARK(3);
    scan_load_s(sf, ws, h, rcn, w, r, q);
    {
        float ss = 0.f;
#pragma unroll
        for (int eb = 0; eb < 4; ++eb) { f32x4 v = O[eb] * rsc;
            if (DIR == 1) { const u32x2 pv = pvf[eb]; v[0] += bflo(pv.x); v[1] += bfhi(pv.x); v[2] += bflo(pv.y); v[3] += bfhi(pv.y);
                ss += (v[0] * v[0] + v[1] * v[1]) + (v[2] * v[2] + v[3] * v[3]); }
            u32x2 o; o.x = cvt_pk_bf16(v[0], v[1]); o.y = cvt_pk_bf16(v[2], v[3]); *(GAS u32x2*)(ob + oo + 512 * eb) = o; }
        if (DIR == 1) { ss += shx(ss, 16, lane); ss += shx(ss, 32, lane); if (q == 0) *(GAS float*)((GAS unsigned char*)(SSP + (size_t)(t0 + 16 * w) * 32 + h * 8 + sl) + (unsigned)r * 128u) = ss; }
    }
#pragma unroll
    for (int db = 0; db < 2; ++db)
#pragma unroll
        for (int eb = 0; eb < 4; ++eb) Rb[db][eb] = Rb[db][eb] * g128;
    SEG_MARK(4);
    asm volatile("s_waitcnt lgkmcnt(0)" ::: "memory"); __builtin_amdgcn_s_barrier(); asm volatile("" ::: "memory");
    SEG_MARK(6);
#pragma unroll
    for (int db = 0; db < 2; ++db)
#pragma unroll
        for (int eb = 0; eb < 4; ++eb) { u32x2 o; o.x = cvt_pk_bf16(Rb[db][eb][0], Rb[db][eb][1]); o.y = cvt_pk_bf16(Rb[db][eb][2], Rb[db][eb][3]);
            *(LAS u32x2*)(RT + (16 * eb + r) * 528 + (32 * w + 16 * db + 4 * q) * 2) = o; }
}
template <int DIR>
__device__ __forceinline__ void scan_unit(Frame& F, int tid, unsigned char* ws, int b, int h, int sl, float lg, const bf16_t* Qg, const bf16_t* Kg, const bf16_t* Vg, bf16_t* OF, float* SSP) {
    const int lane = tid & 63, w = __builtin_amdgcn_readfirstlane(tid >> 6), r = lane & 15, q = lane >> 4;
    const float g128 = __expf(128.f * lg);
    float wm[2];
#pragma unroll
    for (int i = 0; i < 2; ++i) { const int m = (tid >> 3) + 64 * i; wm[i] = __expf(lg * (float)(DIR == 0 ? 127 - m : m)); }
    const int jl = 16 * w + r; const float rsc = __expf(lg * (float)(DIR == 0 ? jl - 127 : -jl));
    f32x4 Rb[2][4];
#pragma unroll
    for (int db = 0; db < 2; ++db)
#pragma unroll
        for (int eb = 0; eb < 4; ++eb) Rb[db][eb] = (f32x4){0.f, 0.f, 0.f, 0.f};
    {
        LAS unsigned char* RT = F.lds + SC_RT_OFF;
#pragma unroll
        for (int db = 0; db < 2; ++db)
#pragma unroll
            for (int eb = 0; eb < 4; ++eb) *(LAS u32x2*)(RT + (16 * eb + r) * 528 + (32 * w + 16 * db + 4 * q) * 2) = (u32x2){0u, 0u};
    }
    u32x4 sf[4], qf[8], kr[8], vr[2];
    unsigned long long segacc = 0ull, segt = (DBG_SEG >= 0) ? __builtin_amdgcn_s_memtime() : 0ull;
    scan_load_s(sf, ws, h, scan_rc(DIR, b, 0), w, r, q);
    scan_load_q(qf, Qg, h, scan_t0(DIR, b, 0), w, r, q);
    scan_load_kv(kr, vr, Kg, Vg, h, sl, scan_t0(DIR, b, 0), w, lane, tid);
    for (int s = 0; s < 18; ++s) {
        const int sn = (s + 1 < 18) ? s + 1 : 17;
        scan_step<DIR>(segacc, segt, F.lds, sf, qf, kr, vr, Rb, wm, rsc, g128, scan_t0(DIR, b, s), scan_t0(DIR, b, sn), scan_rc(DIR, b, sn), ws, h, sl, w, lane, tid, Qg, Kg, Vg, OF, SSP);
    }
    if (DBG_SEG >= 0) { const unsigned long long te_ = __builtin_amdgcn_s_memtime() + segacc; while (__builtin_amdgcn_s_memtime() < te_) __builtin_amdgcn_s_sleep(4); }
    __syncthreads();
}
__device__ __forceinline__ void scan_phase(Frame& F, const Args& a, int layer, int dir) {
    PHASE_IDS();
    const int j = layer >> 1; const float* dec = a.in[11] + j * 8 + dir * 4;
    for (int u = F.vcu; u < 256; u += F.G) {
        const int b = u >> 5, h = (u >> 3) & 3, sl = u & 7;
        const float lg = log1pf(-exp2f(dec[h]));
        if (dir == 0) scan_unit<0>(F, tid, ws, b, h, sl, lg, (const bf16_t*)(ws + WS_Q), (const bf16_t*)(ws + WS_K), (const bf16_t*)(ws + WS_V), (bf16_t*)(ws + WS_OF), (float*)(ws + WS_SSP));
        else scan_unit<1>(F, tid, ws, b, h, sl, lg, (const bf16_t*)(ws + WS_Q), (const bf16_t*)(ws + WS_K), (const bf16_t*)(ws + WS_V), (bf16_t*)(ws + WS_OF), (float*)(ws + WS_SSP));
    }
}
__device__ __forceinline__ void n2_phase(Frame& F, const Args& a, int layer) {
    PHASE_IDS();
    norm_rows<false>(F, a, layer, (bf16_t*)(ws + WS_Q));
    const float* SSP = (const float*)(ws + WS_SSP); float* RINV = (float*)(ws + WS_RINV);
    const int gt = F.vcu * 512 + tid, NT = F.G * 512;
    for (int idx = gt; idx < NTOK * 4; idx += NT) { const f32x4 p0 = *(const f32x4*)(SSP + (size_t)idx * 8), p1 = *(const f32x4*)(SSP + (size_t)idx * 8 + 4);
        const float ss = ((p0.x + p0.y) + (p0.z + p0.w)) + ((p1.x + p1.y) + (p1.z + p1.w)); RINV[idx] = rsqrtf(ss * (1.f / 512.f) + EPS); }
}
__device__ __forceinline__ void final_phase(Frame& F, const Args& a) {
    PHASE_IDS();
    const float* fg = a.in[12]; const int gw = F.vcu * 8 + wave, NGW = F.G * 8;
    f32x4 g[4];
#pragma unroll
    for (int jj = 0; jj < 4; ++jj) g[jj] = *(const f32x4*)(fg + 4 * lane + 256 * jj);
    for (int m0 = gw; m0 < NLAT; m0 += 4 * NGW) {
        f32x4 v[4][4]; float ss[4];
#pragma unroll
        for (int t = 0; t < 4; ++t) { const int m = (m0 + t * NGW) < NLAT ? (m0 + t * NGW) : gw; const f32x4* xr = (const f32x4*)(a.out + (size_t)m * DM) + lane;
#pragma unroll
            for (int jj = 0; jj < 4; ++jj) v[t][jj] = xr[64 * jj]; }
#pragma unroll
        for (int t = 0; t < 4; ++t) { float s = 0.f;
#pragma unroll
            for (int jj = 0; jj < 4; ++jj) s += (v[t][jj].x * v[t][jj].x + v[t][jj].y * v[t][jj].y) + (v[t][jj].z * v[t][jj].z + v[t][jj].w * v[t][jj].w);
            ss[t] = s; }
#pragma unroll
        for (int o = 1; o < 64; o <<= 1) {
#pragma unroll
            for (int t = 0; t < 4; ++t) ss[t] += shx(ss[t], o, lane); }
#pragma unroll
        for (int t = 0; t < 4; ++t) { const int m = m0 + t * NGW; if (m < NLAT) { const float rinv = rsqrtf(ss[t] * (1.f / DM) + EPS); f32x4* xw = (f32x4*)(a.out + (size_t)m * DM) + lane;
#pragma unroll
            for (int jj = 0; jj < 4; ++jj) xw[64 * jj] = v[t][jj] * rinv * g[jj]; } }
    }
}

constexpr int N_PHASES = 34;
__global__ void __launch_bounds__(512, 2) trunk_fwd(Args args) {
    extern __shared__ __attribute__((aligned(16))) unsigned char lds_raw[];
    Frame F;
    F.lds = (LAS unsigned char*)lds_raw;
    F.G = gridDim.x; F.wv = __builtin_amdgcn_readfirstlane((int)threadIdx.x >> 6); { const int bx = blockIdx.x; F.vcu = (F.G % 8 == 0) ? (bx % 8) * (F.G / 8) + bx / 8 : bx; }
    F.ws = args.ws;
    volatile LAS unsigned* MISC = (volatile LAS unsigned*)(F.lds + MISC_OFF);
    for (int u = threadIdx.x; u < 128; u += 512) MISC[u] = 0u;
    __syncthreads();
    const int lo = args.ph_lo, hi = args.ph_hi;
    XcdBarrier bar; bar.bar = (unsigned*)(args.ws + WS_CTL) + 4096; bar.x = 0; bar.st = nullptr;
    const bool multi = (hi - lo) > 1;
    if (multi) bar = xcd_barrier_post((unsigned*)(args.ws + WS_CTL) + 4096, MISC + 8);
#ifndef KINDS
#define KINDS 0xFFFF
#endif
#define KON(b) (((KINDS) >> (b)) & 1)
#define IN(k) (lo <= (k) && (k) < hi)
#ifndef DBG_PROBE
#define DBG_PROBE -1
#endif
    unsigned long long tph0 = (DBG_PROBE >= 0) ? __builtin_amdgcn_s_memrealtime() : 0ull; int cur_layer = -1;
#ifndef DBG_PLAYER
#define DBG_PLAYER -1
#endif
#define PROBE(kind) do { if (DBG_PROBE == (kind) && (DBG_PLAYER < 0 || DBG_PLAYER == cur_layer)) { const unsigned long long t1_ = __builtin_amdgcn_s_memrealtime(); const unsigned long long te_ = t1_ + (t1_ - tph0); while (__builtin_amdgcn_s_memrealtime() < te_) __builtin_amdgcn_s_sleep(8); } } while (0)
#define SEAM(k) do { if (multi && (k) + 1 < hi) xcd_barrier(bar); if (DBG_PROBE >= 0) tph0 = __builtin_amdgcn_s_memrealtime(); } while (0)
    const int bx = (int)blockIdx.x, G = F.G;
    const bool mergeS = multi && G == 256 && lo == 0;
    const bool mergeP0 = mergeS && hi > 1 && KON(0) && KON(1);
    if (KON(0) && IN(0)) { p0_phase(F, args); if (mergeP0) xq_arrive(bar, 4); p0_conv(F, args); if (mergeP0) xq_wait(bar, 4); PROBE(0); if (!mergeP0) SEAM(0); }
    for (int layer = 0; layer < NLAYER; ++layer) {
        const int pb = 1 + 8 * layer; const bool fourier = (layer & 1) == 0; cur_layer = layer;
        unsigned char* ws = launder_ptr(args.ws);
#define MAKE_ER() const EpiResid ER{layer == 0 ? args.in[0] : args.out, args.out, (const float*)(ws + WS_ADA) + layer * 9 * 3072 + 2048, (float*)(ws + WS_PART)}
        if (KON(1) && IN(pb)) { n_phase(F, args, layer); PROBE(1); SEAM(pb); }
        if (fourier) {
            bf16_t* W1 = (bf16_t*)(ws + WS_WF);
            if (KON(2) && IN(pb + 1)) {
                { pg8::Gemm g{(const bf16_t*)(ws + WS_H), W1 + (size_t)2048 * 1024, 1024, 1024, 1024}; pg8::TileOrder S; S.init(72, 8, G, bx);
                  EpiSilu E{(bf16_t*)(ws + WS_Z), 2048}; pg8::gemm_phase(F.lds, F.wv, g, S, E); }
                { pg8::Gemm g{W1, (const bf16_t*)(ws + WS_H), 1024, 1024, 1024}; UOrder S; S.init(8, 72, G, (bx + 64) % G);
                  EpiUTF E{(bf16_t*)(ws + WS_UTL), (bf16_t*)(ws + WS_UTC), (float*)(ws + WS_RINV)}; pg8::gemm_phase<EpiUTF, UOrder, true>(F.lds, F.wv, g, S, E); }
                bg_conv_ret(F, args, layer, 64, 0, 1024);
                PROBE(2); SEAM(pb + 1);
            }
            if (KON(3) && IN(pb + 2)) {
                { pg8::Gemm g{(const bf16_t*)(ws + WS_CS), (const bf16_t*)(ws + WS_UTL), 1024, 1024, 1024}; pg8::TileOrder S; S.init(8, 64, G, bx);
                  EpiDft<true> E{(bf16_t*)(ws + WS_Z), 2048, 0, (const float*)(ws + WS_RINV)}; pg8::gemm_phase(F.lds, F.wv, g, S, E); }
                { pg8::Gemm g{(const bf16_t*)(ws + WS_CS256), (const bf16_t*)(ws + WS_UTC), 256, 256, 256}; pg8::TileOrder S; S.init(2, 64, G, bx);
                  EpiDft<false> E{(bf16_t*)(ws + WS_Z), 256, NLAT, nullptr}; pg8::gemm_phase(F.lds, F.wv, g, S, E); }
                nyq_row_phase(F);
                bg_conv_ret(F, args, layer, 128, 1024, 1536);
                PROBE(3); SEAM(pb + 2);
            }
            if (KON(4) && IN(pb + 3)) {
                pg8::Gemm g{(const bf16_t*)(ws + WS_Z), W1 + (size_t)4096 * 1024, 2048, 2048, 2048}; OutOrder S; S.init(G, bx, true); MAKE_ER();
                pg8::gemm_phase(F.lds, F.wv, g, S, ER);
                bg_conv_ret(F, args, layer, 128, 1536, 2048);
                PROBE(4); SEAM(pb + 3);
            }
        } else {
            bf16_t* W1 = (bf16_t*)(ws + WS_W);
            if (KON(5) && IN(pb + 1)) {
                pg8::Gemm g{(const bf16_t*)(ws + WS_OF), W1, 1024, 1024, 1024};
                EpiQKV E{(bf16_t*)(ws + WS_Q), (bf16_t*)(ws + WS_K), (bf16_t*)(ws + WS_V), (const float*)(ws + WS_ROPE), (const float*)(ws + WS_ROPE) + 4096};
                if (mergeS) {
                    { QKVOrder S; S.init2(G, bx, 0, 4); pg8::gemm_phase(F.lds, F.wv, g, S, E); }
                    xq_arrive(bar, layer);
                    if (bx < 128) { QKVOrder S; S.init2(G, bx, 4, 5); pg8::gemm_phase(F.lds, F.wv, g, S, E); }
                    else { xq_wait(bar, layer);
                        pg8::Gemm gs{(const bf16_t*)(ws + WS_Q), (const bf16_t*)(ws + WS_K), 1024, 1024, 256}; DiagOrder S{128, bx - 128};
                        EpiS ES{ws}; pg8::gemm_phase<EpiS, DiagOrder, false, true>(F.lds, F.wv, gs, S, ES); }
                } else { pg8::TileOrder S; S.init(72, 16, G, bx); pg8::gemm_phase(F.lds, F.wv, g, S, E); }
                PROBE(5); SEAM(pb + 1);
            }
            if (KON(6) && IN(pb + 2)) {
                if (!mergeS) {
                    { pg8::Gemm g{(const bf16_t*)(ws + WS_Q), (const bf16_t*)(ws + WS_K), 1024, 1024, 256}; DiagOrder S{G, bx};
                      EpiS E{ws}; pg8::gemm_phase<EpiS, DiagOrder, false, true>(F.lds, F.wv, g, S, E); }
                    PROBE(11); if (multi) xcd_barrier(bar); if (DBG_PROBE >= 0) tph0 = __builtin_amdgcn_s_memrealtime(); }
                scan_phase(F, args, layer, 0); PROBE(6);
            }
            if (KON(6) && IN(pb + 3)) {
                if (multi) { asm volatile("s_waitcnt vmcnt(0)" ::: "memory"); __syncthreads();
                    if (threadIdx.x == 0) { __builtin_amdgcn_fence(__ATOMIC_ACQUIRE, "agent"); asm volatile("s_waitcnt vmcnt(0)" ::: "memory"); }
                    __syncthreads(); if (DBG_PROBE >= 0) tph0 = __builtin_amdgcn_s_memrealtime(); }
                scan_phase(F, args, layer, 1); PROBE(12); SEAM(pb + 3); }
            if (KON(7) && IN(pb + 4)) { n2_phase(F, args, layer); PROBE(7); SEAM(pb + 4); }
            if (KON(8) && IN(pb + 5)) {
                pg8::Gemm g{(const bf16_t*)(ws + WS_Q), W1 + (size_t)4096 * 1024, 1024, 1024, 1024}; pg8::TileOrder S; S.init(layer == NLAYER - 1 ? 64 : 72, 8, G, bx);
                EpiZGate E{(const bf16_t*)(ws + WS_OF), (const float*)(ws + WS_RINV), (bf16_t*)(ws + WS_V)};
                pg8::gemm_phase(F.lds, F.wv, g, S, E);
                PROBE(8); SEAM(pb + 5);
            }
            if (KON(9) && IN(pb + 6)) {
                pg8::Gemm g{(const bf16_t*)(ws + WS_V), W1 + (size_t)6144 * 1024, 2048, 2048, 2048}; OutOrder S; S.init(G, bx, layer != NLAYER - 1); MAKE_ER();
                pg8::gemm_phase(F.lds, F.wv, g, S, ER);
                PROBE(9); SEAM(pb + 6);
            }
        }
    }
    if (KON(10) && IN(33)) { final_phase(F, args); PROBE(10); }
#undef IN
#undef SEAM
}

extern "C" void kernel_launch(void* const* d_in, const int* in_sizes, int n_in, void* d_out, int out_size, void* d_ws, size_t ws_size, hipStream_t stream) {
    static int grid = 0;
    if (grid == 0) {
        if (n_in != 13 || out_size != NLAT * DM || ws_size < WS_END) { fprintf(stderr, "kernel_launch: unexpected problem (n_in %d, out %d, ws %zu)\n", n_in, out_size, ws_size); grid = -1; return; }
        int dev = 0, cus = 0;
        if (hipGetDevice(&dev) != hipSuccess || hipDeviceGetAttribute(&cus, hipDeviceAttributeMultiprocessorCount, dev) != hipSuccess) { grid = -1; return; }
        if (hipFuncSetAttribute((const void*)trunk_fwd, hipFuncAttributeMaxDynamicSharedMemorySize, LDS_BYTES) != hipSuccess) { fprintf(stderr, "kernel_launch: hipFuncSetAttribute failed\n"); grid = -1; return; }
        (void)hipGetLastError();
        grid = cus;
    }
    if (grid < 0) return;
    if (hipMemsetAsync((char*)d_ws + WS_CTL, 0, CTL_ZERO_BYTES, stream) != hipSuccess) return;
    Args a{};
    for (int i = 0; i < 13; ++i) a.in[i] = (const float*)d_in[i];
    a.out = (float*)d_out; a.ws = (unsigned char*)d_ws;
    a.ph_lo = 0; a.ph_hi = N_PHASES;
    hipLaunchKernelGGL(trunk_fwd, dim3(grid), dim3(512), LDS_BYTES, stream, a);
}
```

```cpp
#include <hip/hip_runtime.h>
#include <cstdio>
#include <cstdint>

#define LAS __attribute__((address_space(3)))
#define GAS __attribute__((address_space(1)))
typedef unsigned short bf16_t;
typedef short bf16x8 __attribute__((ext_vector_type(8)));
typedef float f32x4 __attribute__((ext_vector_type(4)));
typedef float f32x16 __attribute__((ext_vector_type(16)));
typedef unsigned u32x4 __attribute__((ext_vector_type(4)));
typedef unsigned u32x2 __attribute__((ext_vector_type(2)));

constexpr int DM = 1024, NB = 8, SEQ = 2048, CTXL = 256, DBR = 2048, NLAYER = 4;
constexpr int NLAT = NB * SEQ, NCTX = NB * CTXL, NTOK = NLAT + NCTX;
constexpr float EPS = 1e-6f;

constexpr size_t MiB = 1u << 20;
constexpr size_t KiB = 1024;
constexpr size_t WS_CTL = 0, CTL_ZERO_BYTES = 64 * KiB;
constexpr size_t WS_ADA = 256 * KiB;
constexpr size_t WS_TC = 768 * KiB;
constexpr size_t WS_ROPE = 1024 * KiB;
constexpr size_t WS_CS256 = 1088 * KiB;
constexpr size_t WS_RINV = 1344 * KiB;
constexpr size_t WS_XCTX = 2 * MiB;
constexpr size_t WS_W = 10 * MiB;
constexpr size_t WS_R = 26 * MiB;
constexpr size_t WS_H = WS_R;
constexpr size_t WS_Z = WS_R + 36 * MiB;
constexpr size_t WS_UTL = WS_R + 108 * MiB;
constexpr size_t WS_UTC = WS_R + 172 * MiB;
constexpr size_t WS_CS = WS_R + 180 * MiB;
constexpr size_t WS_HP = WS_R + 156 * MiB;
constexpr size_t WS_HM = WS_R + 216 * MiB;
constexpr size_t WS_HM7 = WS_R + 140 * MiB;
constexpr size_t WS_WF = WS_R + 144 * MiB;
constexpr size_t WS_Q = WS_R;
constexpr size_t WS_K = WS_R + 36 * MiB;
constexpr size_t WS_V = WS_R + 72 * MiB;
constexpr size_t WS_OF = WS_R + 144 * MiB;
constexpr size_t WS_PART = WS_R + 184 * MiB;
constexpr size_t WS_SSP = WS_R + 216 * MiB;
constexpr size_t WS_SA = WS_W;
constexpr size_t WS_SB = WS_R + 219 * MiB;
constexpr size_t WS_END = 256 * MiB;
static_assert(WS_SSP + (size_t)NTOK * 32 * 4 <= WS_SB && WS_SB + 11 * MiB <= WS_END && WS_CS + 16 * MiB <= WS_END && WS_RINV + 288 * KiB <= WS_XCTX, "ws map");

constexpr int LDS_BYTES = 163840;
constexpr int RING_BYTES = 131072;
constexpr int SC_V_OFF = 0;
constexpr int SC_RT_OFF = 32768;
constexpr int SC_K_OFF = 98304;
static_assert(SC_K_OFF + 65536 <= LDS_BYTES, "lds map");

__device__ __forceinline__ unsigned f2bf(float f) { unsigned u = __builtin_bit_cast(unsigned, f); return (u + 0x7fffu + ((u >> 16) & 1u)) >> 16; }
__device__ __forceinline__ unsigned pk2(float lo, float hi) { return f2bf(lo) | (f2bf(hi) << 16); }
__device__ __forceinline__ float bflo(unsigned w) { return __builtin_bit_cast(float, w << 16); }
__device__ __forceinline__ float bfhi(unsigned w) { return __builtin_bit_cast(float, w & 0xffff0000u); }
__device__ __forceinline__ float bf1(bf16_t h) { return __builtin_bit_cast(float, (unsigned)h << 16); }
__device__ __forceinline__ float silu_f(float x) { return x * __builtin_amdgcn_rcpf(1.f + __expf(-x)); }
__device__ __forceinline__ float shx(float v, int o, int lane) { return __builtin_bit_cast(float, __builtin_amdgcn_ds_bpermute((lane ^ o) << 2, __builtin_bit_cast(int, v))); }
__device__ __forceinline__ float wave_sum(float v, int lane) {
#pragma unroll
    for (int o = 1; o < 64; o <<= 1) v += shx(v, o, lane);
    return v;
}

namespace pg8 {
constexpr int BM = 256, BK = 64, HALF = 128, HTB = HALF * BK * 2, STAGE_BYTES = 8 * HTB, NXCD = 8, WGM = 4;
__host__ __device__ __forceinline__ int lds_byte(int r, int c) { const int st = (r >> 4) * 2 + (c >> 5), rr = r & 15, cc = c & 31, ob = rr * 64 + cc * 2; return st * 1024 + (ob ^ (((ob >> 9) & 1) << 5)); }
__host__ __device__ __forceinline__ void stage_rc(int b, int& R, int& C) { const int st = b / 1024, sb = b % 1024, swz = sb ^ (((sb >> 9) & 1) << 5); R = (st >> 1) * 16 + swz / 64; C = (st & 1) * 32 + (swz % 64) / 2; }
__host__ __device__ __forceinline__ int perm32(int rho) { const int n = rho >> 4, i = rho & 15; return 8 * (i >> 2) + 4 * n + (i & 3); }
struct Unit { int pm, pn, aux; };
struct Gemm { const bf16_t* A; const bf16_t* Bt; int lda, ldb, K; };
struct TileOrder {
    int nM, nN, nwg, G, c;
    __device__ void init(int nM_, int nN_, int G_, int c_) { nM = nM_; nN = nN_; nwg = nM * nN; G = G_; c = c_; }
    __device__ static void map(int wgid, int nM, int nN, Unit& u) {
        const int nwg = nM * nN;
        { const int q = nwg / NXCD, r = nwg % NXCD, xcd = wgid % NXCD, off = wgid / NXCD; wgid = (xcd < r ? xcd * (q + 1) : r * (q + 1) + (xcd - r) * q) + off; }
        const int nig = WGM * nN, gid = wgid / nig, fm = gid * WGM, gsz = (nM - fm) < WGM ? (nM - fm) : WGM;
        u.pm = fm + ((wgid % nig) % gsz); u.pn = (wgid % nig) / gsz; u.aux = 0;
    }
    __device__ bool next(int i, Unit& u) const {
        const long L = (long)i * G + c; if (L >= nwg) return false;
        map((int)L, nM, nN, u); return true;
    }
    __device__ __forceinline__ const char* a_ptr(const Gemm& g, const Unit& u) const { return (const char*)g.A + (size_t)u.pm * 256 * g.lda * 2; }
    __device__ __forceinline__ const char* b_ptr(const Gemm& g, const Unit& u, int half) const { return (const char*)g.Bt + (size_t)(u.pn * 256 + 128 * half) * g.ldb * 2; }
    __device__ __forceinline__ bool b_mirror(const Unit&) const { return false; }
    __device__ __forceinline__ bool b_fix(const Unit&) const { return false; }
    __device__ __forceinline__ int ktiles(const Gemm& g, const Unit&) const { return g.K / BK; }
    __device__ __forceinline__ int a_half_rows() const { return HALF; }
};
__device__ __forceinline__ unsigned cvt_pk_bf16(float lo, float hi) { unsigned r; asm volatile("v_cvt_pk_bf16_f32 %0, %1, %2" : "=v"(r) : "v"(lo), "v"(hi)); return r; }

template <class Epi, class Sched, bool MIRB = false, bool TILED = false>
__device__ __forceinline__ void gemm_phase(LAS unsigned char* lds, int wv, const Gemm g, const Sched& S, const Epi& E) {
    int tid; { int l_; asm volatile("v_mbcnt_lo_u32_b32 %0, -1, 0\n\tv_mbcnt_hi_u32_b32 %0, -1, %0" : "=v"(l_)); tid = wv * 64 + l_; }
    const int wid = __builtin_amdgcn_readfirstlane(tid >> 6), lane = tid & 63, wr = wid >> 2, wc = wid & 3, fr = lane & 15, fq = lane >> 4;
    unsigned voffA[2], voffB[2], voffM[2], fixd[2];
#pragma unroll
    for (int i = 0; i < 2; ++i) { int R, C; stage_rc(tid * 16 + i * 8192, R, C); const int Rb = Epi::PERM ? ((R & ~31) + perm32(R & 31)) : R;
        voffA[i] = (unsigned)(R * g.lda + C) * 2u; voffB[i] = (unsigned)(Rb * g.ldb + C) * 2u; voffM[i] = (unsigned)((1024 - Rb) * g.ldb + C) * 2u; fixd[i] = (Rb == 0) ? (unsigned)(1024 * g.ldb) * 2u : 0u;
        if (TILED) { voffA[i] = (unsigned)(((R >> 4) & 7) * 8192 + (C >> 5) * 1024 + (16 * ((C >> 3) & 3) + (R & 15)) * 16);
                     voffB[i] = (unsigned)(((Rb & 127) >> 4) * 1024 + (4 * (Rb & 15) + ((C >> 3) & 3)) * 16 + (C >> 5) * 8192); } }
    const size_t kstepA = TILED ? (size_t)2048 : (size_t)(BK * 2), kstepB = TILED ? (size_t)16384 : (size_t)(BK * 2);
    const size_t hstepA = TILED ? (size_t)262144 : (size_t)S.a_half_rows() * g.lda * 2;
    const unsigned ldsw = (unsigned)wid * 1024u;
    const int aoff = lds_byte(wr * 64 + fr, fq * 8), boff = lds_byte(wc * 32 + fr, fq * 8);
#define PG8_SA(b, h) (((b) * 2 + (h)) * HTB)
#define PG8_SB(b, h) ((4 + (b) * 2 + (h)) * HTB)
#define PG8_STAGE(bufoff, gbase, voff) do { _Pragma("unroll") for (int _i = 0; _i < 2; ++_i) \
        __builtin_amdgcn_global_load_lds((const unsigned*)((const char*)(gbase) + (voff)[_i]), (LAS unsigned*)(lds + (bufoff) + ldsw + _i * 8192), 16, 0, 0); } while (0)
#define PG8_LDA(dst, b, h) do { _Pragma("unroll") for (int m = 0; m < 4; ++m) _Pragma("unroll") for (int k = 0; k < 2; ++k) dst[m][k] = *(const LAS bf16x8*)(lds + PG8_SA(b, h) + aoff + m * 2048 + k * 1024); } while (0)
#define PG8_LDB(dst, b, h) do { _Pragma("unroll") for (int n = 0; n < 2; ++n) _Pragma("unroll") for (int k = 0; k < 2; ++k) dst[n][k] = *(const LAS bf16x8*)(lds + PG8_SB(b, h) + boff + n * 2048 + k * 1024); } while (0)
#define PG8_MMA(ai, bj, At, Bt) do { __builtin_amdgcn_s_setprio(1); _Pragma("unroll") for (int m = 0; m < 4; ++m) _Pragma("unroll") for (int n = 0; n < 2; ++n) _Pragma("unroll") for (int k = 0; k < 2; ++k) \
        acc[ai][bj][m][n] = __builtin_amdgcn_mfma_f32_16x16x32_bf16(Bt[n][k], At[m][k], acc[ai][bj][m][n], 0, 0, 0); __builtin_amdgcn_s_setprio(0); } while (0)
#define PG8_WAIT_V(n) asm volatile("s_waitcnt vmcnt(" #n ")" ::: "memory")
#define PG8_WAIT_L(n) asm volatile("s_waitcnt lgkmcnt(" #n ")" ::: "memory")
#define PG8_BAR __builtin_amdgcn_s_barrier()
#define PG8_SCHED __builtin_amdgcn_sched_barrier(0)
#define PG8_VB1(dst, u) do { if (MIRB && S.b_mirror(u)) { const bool fx_ = S.b_fix(u); dst[0] = voffM[0] - (fx_ ? fixd[0] : 0u); dst[1] = voffM[1] - (fx_ ? fixd[1] : 0u); } else { dst[0] = voffB[0]; dst[1] = voffB[1]; } } while (0)
    Unit cur, nxt; int ui = 0;
    if (!S.next(0, cur)) return;
    f32x4 acc[2][2][4][2];
#pragma unroll
    for (int a = 0; a < 2; ++a)
#pragma unroll
        for (int b = 0; b < 2; ++b)
#pragma unroll
            for (int m = 0; m < 4; ++m)
#pragma unroll
                for (int n = 0; n < 2; ++n) acc[a][b][m][n] = (f32x4){0.f, 0.f, 0.f, 0.f};
    bf16x8 At[4][2], B0[2][2], B1[2][2];
    const char* cA = S.a_ptr(g, cur); const char* cB0 = S.b_ptr(g, cur, 0); const char* cB1 = S.b_ptr(g, cur, 1);
    unsigned vc1[2]; PG8_VB1(vc1, cur);
    PG8_STAGE(PG8_SB(0, 0), cB0, voffB); PG8_STAGE(PG8_SB(0, 1), cB1, vc1); PG8_STAGE(PG8_SA(0, 0), cA, voffA); PG8_STAGE(PG8_SA(0, 1), cA + hstepA, voffA);
    if (wr == 1) PG8_BAR;
    PG8_WAIT_V(2); PG8_BAR;
    PG8_STAGE(PG8_SB(1, 0), cB0 + kstepB, voffB); PG8_STAGE(PG8_SA(1, 0), cA + kstepA, voffA); PG8_STAGE(PG8_SB(1, 1), cB1 + kstepB, vc1);
    PG8_WAIT_V(6); PG8_BAR;
    for (;;) {
        const bool has_next = S.next(ui + 1, nxt);
        const int nt = S.ktiles(g, cur);
        const char* nA = cA; const char* nB0 = cB0; const char* nB1 = cB1; unsigned vn1[2] = {vc1[0], vc1[1]};
        if (has_next) { nA = S.a_ptr(g, nxt); nB0 = S.b_ptr(g, nxt, 0); nB1 = S.b_ptr(g, nxt, 1); PG8_VB1(vn1, nxt); }
        for (int t = 0; t < nt; t += 2) {
            const bool last = (t == nt - 2);
            const char* a1 = cA + (size_t)(t + 1) * kstepA;
            const char* a2 = last ? nA : cA + (size_t)(t + 2) * kstepA; const char* b20 = last ? nB0 : cB0 + (size_t)(t + 2) * kstepB; const char* b21 = last ? nB1 : cB1 + (size_t)(t + 2) * kstepB;
            const char* a3 = a2 + kstepA; const char* b30 = b20 + kstepB; const char* b31 = b21 + kstepB;
            unsigned v21[2]; v21[0] = (MIRB && last) ? vn1[0] : vc1[0]; v21[1] = (MIRB && last) ? vn1[1] : vc1[1];
            PG8_LDB(B0, 0, 0); PG8_LDB(B1, 0, 1); PG8_SCHED; PG8_LDA(At, 0, 0); PG8_STAGE(PG8_SA(1, 1), a1 + hstepA, voffA);
            PG8_WAIT_V(8); PG8_WAIT_L(0); PG8_BAR; PG8_MMA(0, 0, At, B0); PG8_MMA(0, 1, At, B1); PG8_BAR; PG8_SCHED;
            PG8_LDA(At, 0, 1); PG8_STAGE(PG8_SB(0, 0), b20, voffB); PG8_STAGE(PG8_SB(0, 1), b21, v21); PG8_STAGE(PG8_SA(0, 0), a2, voffA);
            PG8_WAIT_V(8); PG8_WAIT_L(0); PG8_BAR; PG8_MMA(1, 0, At, B0); PG8_MMA(1, 1, At, B1); PG8_BAR; PG8_SCHED;
            PG8_LDB(B0, 1, 0); PG8_LDB(B1, 1, 1); PG8_SCHED; PG8_LDA(At, 1, 0); PG8_STAGE(PG8_SA(0, 1), a2 + hstepA, voffA);
            PG8_WAIT_V(8); PG8_WAIT_L(0); PG8_BAR; PG8_MMA(0, 0, At, B0); PG8_MMA(0, 1, At, B1); PG8_BAR; PG8_SCHED;
            PG8_LDA(At, 1, 1); PG8_STAGE(PG8_SB(1, 0), b30, voffB); PG8_STAGE(PG8_SB(1, 1), b31, v21); PG8_STAGE(PG8_SA(1, 0), a3, voffA);
            PG8_WAIT_V(8); PG8_WAIT_L(0); PG8_BAR; PG8_MMA(1, 0, At, B0); PG8_MMA(1, 1, At, B1); PG8_BAR; PG8_SCHED;
        }
        if (wr == 0) PG8_BAR;
        { int l2 = lane; asm volatile("" : "+v"(l2)); E(acc, cur, wr, wc, l2 & 15, l2 >> 4); }
        if (!has_next) break;
#pragma unroll
        for (int a = 0; a < 2; ++a)
#pragma unroll
            for (int b = 0; b < 2; ++b)
#pragma unroll
                for (int m = 0; m < 4; ++m)
#pragma unroll
                    for (int n = 0; n < 2; ++n) acc[a][b][m][n] = (f32x4){0.f, 0.f, 0.f, 0.f};
        cur = nxt; cA = nA; cB0 = nB0; cB1 = nB1; vc1[0] = vn1[0]; vc1[1] = vn1[1]; ++ui;
        if (wr == 1) PG8_BAR;
    }
    PG8_WAIT_V(0);
    PG8_BAR;
#undef PG8_SA
#undef PG8_SB
#undef PG8_STAGE
#undef PG8_LDA
#undef PG8_LDB
#undef PG8_MMA
#undef PG8_WAIT_V
#undef PG8_WAIT_L
#undef PG8_BAR
#undef PG8_SCHED
#undef PG8_VB1
}
}
using pg8::cvt_pk_bf16;
__device__ __forceinline__ void stg16(void* ub, unsigned vo, u32x4 v) { *(GAS u32x4*)((GAS unsigned char*)ub + vo) = v; }
__device__ __forceinline__ u32x4 ldg16u(const void* ub, unsigned vo) { return *(const GAS u32x4*)((const GAS unsigned char*)ub + vo); }
__device__ __forceinline__ void stg16f(void* ub, unsigned vo, f32x4 v) { *(GAS f32x4*)((GAS unsigned char*)ub + vo) = v; }
__device__ __forceinline__ f32x4 ldg16f(const void* ub, unsigned vo) { return *(const GAS f32x4*)((const GAS unsigned char*)ub + vo); }
typedef const f32x4 (&AccRef)[2][2][4][2];

struct EpiSilu {
    static constexpr bool PERM = true;
    bf16_t* O; int ldc;
    __device__ __forceinline__ void operator()(AccRef acc, const pg8::Unit& u, int wr, int wc, int fr, int fq) const {
        bf16_t* ub = O + (size_t)u.pm * 256 * ldc + u.pn * 256; const unsigned vo = (unsigned)((wr * 64 + fr) * ldc + wc * 32 + 8 * fq) * 2u;
#pragma unroll
        for (int ai = 0; ai < 2; ++ai)
#pragma unroll
            for (int m = 0; m < 4; ++m)
#pragma unroll
                for (int bj = 0; bj < 2; ++bj) { const f32x4 v0 = acc[ai][bj][m][0], v1 = acc[ai][bj][m][1]; u32x4 w;
                    w.x = cvt_pk_bf16(silu_f(v0[0]), silu_f(v0[1])); w.y = cvt_pk_bf16(silu_f(v0[2]), silu_f(v0[3]));
                    w.z = cvt_pk_bf16(silu_f(v1[0]), silu_f(v1[1])); w.w = cvt_pk_bf16(silu_f(v1[2]), silu_f(v1[3]));
                    stg16(ub + (size_t)(ai * 128 + m * 16) * ldc, vo + (unsigned)(bj * 256), w); }
    }
};
struct UOrder : pg8::TileOrder {
    __device__ __forceinline__ const char* b_ptr(const pg8::Gemm& g, const pg8::Unit& u, int half) const {
        if (u.pn < 64) { const int b = u.pn >> 3, tp = u.pn & 7; return (const char*)(g.Bt + (size_t)(b * 2048 + (half ? 1024 - 128 * tp : 128 * tp)) * 1024); }
        return (const char*)(g.Bt + (size_t)(NLAT + (u.pn - 64) * 256 + 128 * half) * 1024);
    }
    __device__ __forceinline__ bool b_mirror(const pg8::Unit& u) const { return u.pn < 64; }
    __device__ __forceinline__ bool b_fix(const pg8::Unit& u) const { return (u.pn & 7) == 0; }
};
struct EpiUTF {
    static constexpr bool PERM = true;
    bf16_t* UTF; bf16_t* UTc; float* AH;
    __device__ __forceinline__ void operator()(AccRef acc, const pg8::Unit& u, int wr, int wc, int fr, int fq) const {
        const int feat0 = u.pm * 256 + wr * 64 + fr, col0 = wc * 32 + 8 * fq;
        if (u.pn >= 64) { bf16_t* ub = UTc + (size_t)(u.pn - 64) * 2048 * 256 + (size_t)u.pm * 256 * 256; const unsigned vo = (unsigned)((wr * 64 + fr) * 256 + col0) * 2u;
#pragma unroll
            for (int ai = 0; ai < 2; ++ai)
#pragma unroll
                for (int m = 0; m < 4; ++m)
#pragma unroll
                    for (int bj = 0; bj < 2; ++bj) { const f32x4 v0 = acc[ai][bj][m][0], v1 = acc[ai][bj][m][1]; u32x4 w;
                        w.x = cvt_pk_bf16(v0[0], v0[1]); w.y = cvt_pk_bf16(v0[2], v0[3]); w.z = cvt_pk_bf16(v1[0], v1[1]); w.w = cvt_pk_bf16(v1[2], v1[3]);
                        stg16(ub + (size_t)(ai * 128 + m * 16) * 256, vo + (unsigned)(bj * 256), w); }
            return; }
        const int b = u.pn >> 3, tp = u.pn & 7; const bool first = (tp == 0) && (col0 == 0);
        bf16_t* ub = UTF + ((size_t)b * 2048 + u.pm * 256) * 1024 + 128 * tp; const unsigned vo = (unsigned)((wr * 64 + fr) * 1024 + col0) * 2u;
#pragma unroll
        for (int ai = 0; ai < 2; ++ai)
#pragma unroll
            for (int m = 0; m < 4; ++m) { const int feat = feat0 + ai * 128 + m * 16; const float sg = ((feat & 255) <= 128) ? 1.f : -1.f;
                f32x4 v0 = acc[ai][0][m][0] + acc[ai][1][m][0] * sg; const f32x4 v1 = acc[ai][0][m][1] + acc[ai][1][m][1] * sg;
                if (first) { v0[0] = acc[ai][0][m][0][0]; AH[(size_t)b * 2048 + feat] = acc[ai][1][m][0][0]; }
                u32x4 w; w.x = cvt_pk_bf16(v0[0], v0[1]); w.y = cvt_pk_bf16(v0[2], v0[3]); w.z = cvt_pk_bf16(v1[0], v1[1]); w.w = cvt_pk_bf16(v1[2], v1[3]);
                stg16(ub + (size_t)(ai * 128 + m * 16) * 1024, vo, w); }
    }
};
__device__ __forceinline__ const bf16_t* hm_rows(const unsigned char* ws, int b) { return (const bf16_t*)(b < 7 ? ws + WS_HM + (size_t)b * 2 * MiB : ws + WS_HM7); }
struct UFoldOrder : pg8::TileOrder {
    const unsigned char* ws;
    __device__ bool next(int i, pg8::Unit& u) const {
        const int L = i * G + c; if (L >= 320) return false;
        if (L < 256) { u.pn = L & 31; u.pm = (L >> 5) & 3; u.aux = L >> 7; }
        else { const int q = L - 256; u.pn = 32 + (q & 7); u.pm = (q >> 3) & 3; u.aux = q >> 5; }
        return true;
    }
    __device__ __forceinline__ const char* a_ptr(const pg8::Gemm& g, const pg8::Unit& u) const { return (const char*)(g.A + (size_t)(u.pm * 512 + u.aux * 128) * 1024); }
    __device__ __forceinline__ const char* b_ptr(const pg8::Gemm& g, const pg8::Unit& u, int half) const {
        if (u.pn >= 32) return (const char*)(g.Bt + (size_t)(NLAT + (u.pn - 32) * 256 + 128 * half) * 1024);
        const int b = u.pn >> 2, tn = u.pn & 3;
        const bf16_t* base = u.aux ? hm_rows(ws, b) : (const bf16_t*)(ws + WS_HP) + (size_t)b * 1024 * 1024;
        return (const char*)(base + (size_t)(256 * tn + 128 * half) * 1024);
    }
    __device__ __forceinline__ int a_half_rows() const { return 256; }
};
struct EpiUTF2 {
    static constexpr bool PERM = true; static constexpr bool PREFETCH = false;
    bf16_t* UTF; bf16_t* UTc;
    __device__ __forceinline__ void operator()(AccRef acc, const pg8::Unit& u, int wr, int wc, int fr, int fq) const {
        const int rb0 = wr * 64 + fr;
        const bool ctx = u.pn >= 32;
        const int b = u.pn >> 2, tn = u.pn & 3;
#pragma unroll
        for (int ai = 0; ai < 2; ++ai) { const int R0 = (2 * u.pm + ai) * 256 + u.aux * 128;
            bf16_t* ub = ctx ? UTc + ((size_t)(u.pn - 32) * 2048 + R0) * 256 + wc * 32 : UTF + ((size_t)b * 2048 + R0) * 1024 + 256 * tn + wc * 32;
            const unsigned ld_ = ctx ? 256u : 1024u;
#pragma unroll
            for (int m = 0; m < 4; ++m) { const int rb = rb0 + 16 * m; const bool skip = !ctx && u.aux == 1 && rb == 0;
#pragma unroll
                for (int bj = 0; bj < 2; ++bj) { const f32x4 v0 = acc[ai][bj][m][0], v1 = acc[ai][bj][m][1]; u32x4 w;
                    w.x = cvt_pk_bf16(v0[0], v0[1]); w.y = cvt_pk_bf16(v0[2], v0[3]); w.z = cvt_pk_bf16(v1[0], v1[1]); w.w = cvt_pk_bf16(v1[2], v1[3]);
                    if (!skip) stg16(ub + bj * 128, (unsigned)((unsigned)rb * ld_ + 8u * fq) * 2u, w); } } }
    }
};
__device__ __forceinline__ f32x4 skinny16x8(const bf16_t* A16, const bf16_t* Bt, size_t bstride, int lane) {
    const int r = lane & 15, q = lane >> 4;
    const GAS u32x4* ap = (const GAS u32x4*)(A16 + (size_t)r * 1024 + 8 * q);
    const GAS u32x4* bp = (const GAS u32x4*)(Bt + (size_t)(r & 7) * bstride + 8 * q);
    f32x4 d = (f32x4){0.f, 0.f, 0.f, 0.f};
#pragma unroll 8
    for (int ks = 0; ks < 32; ++ks) { const u32x4 av = ap[4 * ks]; u32x4 bv = bp[4 * ks]; if (r >= 8) bv = (u32x4){0u, 0u, 0u, 0u};
        d = __builtin_amdgcn_mfma_f32_16x16x32_bf16(__builtin_bit_cast(bf16x8, av), __builtin_bit_cast(bf16x8, bv), d, 0, 0, 0); }
    return d;
}
__device__ __forceinline__ int fpos(int f) { return f <= 128 ? f : 384 - f; }
struct DftZ { u32x4 zd, zm; };
__device__ __forceinline__ DftZ dft_row_ld(const bf16_t* zrow, int mi0) { DftZ z; z.zd = *(const u32x4*)(zrow + mi0); z.zm = *(const u32x4*)(zrow + 128 + mi0); return z; }
__device__ __forceinline__ void dft_row_st(bf16_t* zrow, int mi0, const DftZ& z, const float (&d)[8], const float (&mr)[8]) {
    const u32x4 zd = z.zd, zm = z.zm;
    u32x4 o; o.x = cvt_pk_bf16(d[0] * bflo(zd.x), d[1] * bfhi(zd.x)); o.y = cvt_pk_bf16(d[2] * bflo(zd.y), d[3] * bfhi(zd.y));
    o.z = cvt_pk_bf16(d[4] * bflo(zd.z), d[5] * bfhi(zd.z)); o.w = cvt_pk_bf16(d[6] * bflo(zd.w), d[7] * bfhi(zd.w));
    *(u32x4*)(zrow + mi0) = o;
    u32x4 q; q.x = cvt_pk_bf16(mr[0] * bflo(zm.x), mr[1] * bfhi(zm.x)); q.y = cvt_pk_bf16(mr[2] * bflo(zm.y), mr[3] * bfhi(zm.y));
    q.z = cvt_pk_bf16(mr[4] * bflo(zm.z), mr[5] * bfhi(zm.z)); q.w = cvt_pk_bf16(mr[6] * bflo(zm.w), mr[7] * bfhi(zm.w));
    *(u32x4*)(zrow + 128 + mi0) = q;
}
template <bool FOLD> struct EpiDft {
    static constexpr bool PERM = true;
    bf16_t* Z; int L; int tok_base; const float* AH;
    __device__ __forceinline__ void operator()(AccRef acc, const pg8::Unit& u, int wr, int wc, int fr, int fq) const {
        const int b = u.pn >> 3, g = u.pn & 7, k0 = u.pm * 128 + wr * 64 + fr, mi0 = wc * 32 + 8 * fq;
        f32x4 ah[2] = {(f32x4){0.f, 0.f, 0.f, 0.f}, (f32x4){0.f, 0.f, 0.f, 0.f}}; float ahn = 0.f;
        if (FOLD) { const float* ap = AH + (size_t)b * 2048 + g * 256; ah[0] = *(const f32x4*)(ap + mi0) * 0.022097087f; ah[1] = *(const f32x4*)(ap + mi0 + 4) * 0.022097087f; ahn = ap[128] * 0.022097087f; }
        const bool nyq = (wc == 0 && fq == 0);
        DftZ zr[4], zq[4];
#pragma unroll
        for (int m = 0; m < 4; ++m) { const int k = k0 + 16 * m; const bf16_t* zrow = Z + (size_t)(tok_base + b * L + k) * 2048 + g * 256;
            const bf16_t* zmir = Z + (size_t)(tok_base + b * L + ((FOLD && k >= 1) ? (L - k) : k)) * 2048 + g * 256;
            zr[m] = dft_row_ld(zrow, mi0); if (FOLD) zq[m] = dft_row_ld(zmir, mi0); }
#pragma unroll
        for (int m = 0; m < 4; ++m) { const int k = k0 + 16 * m; bf16_t* zrow = Z + (size_t)(tok_base + b * L + k) * 2048 + g * 256;
            bf16_t* zmir = Z + (size_t)(tok_base + b * L + (L - k)) * 2048 + g * 256;
            const float sg = (k & 1) ? -1.f : 1.f;
            float dm[8], sm[8], p0 = 0.f;
#pragma unroll
            for (int n = 0; n < 2; ++n) { f32x4 P = acc[0][0][m][n]; const f32x4 Q = acc[1][1][m][n]; if (FOLD) P = P + ah[n] * sg;
                if (n == 0) p0 = P[0];
#pragma unroll
                for (int e = 0; e < 4; ++e) { dm[4 * n + e] = P[e] - Q[e]; sm[4 * n + e] = P[e] + Q[e]; } }
            if (nyq) {
                const float yn = acc[0][1][m][0][0] + (FOLD ? ahn * sg : 0.f);
                float d2[8], s2[8];
#pragma unroll
                for (int j = 0; j < 8; ++j) { d2[j] = dm[j]; s2[j] = sm[j]; }
                dm[0] = p0; sm[0] = yn; d2[0] = yn; s2[0] = p0;
                dft_row_st(zrow, mi0, zr[m], dm, sm);
                if (FOLD && k >= 1) dft_row_st(zmir, mi0, zq[m], s2, d2);
            } else {
                dft_row_st(zrow, mi0, zr[m], dm, sm);
                if (FOLD && k >= 1) dft_row_st(zmir, mi0, zq[m], sm, dm); } }
    }
};
struct OutOrder {
    pg8::TileOrder T; int G, c; bool with_ctx;
    __device__ void init(int G_, int c_, bool with_ctx_) { T.init(64, 4, G_, c_); G = G_; c = c_; with_ctx = with_ctx_; }
    __device__ bool next(int i, pg8::Unit& u) const {
        const int L = i * G + c;
        if (L < 256) return T.next(i, u);
        if (!with_ctx || L >= 384) return false;
        const int idx = L - 256, tile = idx >> 2; u.pm = 64 + (tile >> 2); u.pn = tile & 3; u.aux = 1 + (idx & 3); return true;
    }
    __device__ __forceinline__ int koff(const pg8::Unit& u) const { return u.aux ? 512 * (u.aux - 1) : 0; }
    __device__ __forceinline__ const char* a_ptr(const pg8::Gemm& g, const pg8::Unit& u) const { return (const char*)(g.A + (size_t)u.pm * 256 * g.lda + koff(u)); }
    __device__ __forceinline__ const char* b_ptr(const pg8::Gemm& g, const pg8::Unit& u, int half) const { return (const char*)(g.Bt + (size_t)(u.pn * 256 + 128 * half) * g.ldb + koff(u)); }
    __device__ __forceinline__ bool b_mirror(const pg8::Unit&) const { return false; }
    __device__ __forceinline__ bool b_fix(const pg8::Unit&) const { return false; }
    __device__ __forceinline__ int ktiles(const pg8::Gemm& g, const pg8::Unit& u) const { return u.aux ? 8 : g.K / pg8::BK; }
    __device__ __forceinline__ int a_half_rows() const { return pg8::HALF; }
};
struct EpiResid {
    static constexpr bool PERM = false;
    const float* xin_lat; float* xout_lat; const float* gate; float* part;
    __device__ __forceinline__ void operator()(AccRef acc, const pg8::Unit& u, int wr, int wc, int fr, int fq) const {
        const int row0 = u.pm * 256 + wr * 64 + fr, col0 = u.pn * 256 + wc * 32 + 4 * fq;
        if (u.aux) {
            float* pp = part + (size_t)(u.aux - 1) * NCTX * DM + (size_t)(row0 - NLAT) * DM + col0;
#pragma unroll
            for (int ai = 0; ai < 2; ++ai)
#pragma unroll
                for (int m = 0; m < 4; ++m)
#pragma unroll
                    for (int bj = 0; bj < 2; ++bj)
#pragma unroll
                        for (int n = 0; n < 2; ++n) *(f32x4*)(pp + (size_t)(ai * 128 + m * 16) * DM + bj * 128 + n * 16) = acc[ai][bj][m][n];
            return;
        }
        const float* gp = gate + (u.pm >> 3) * 3072 + col0;
        f32x4 gv[2][2];
#pragma unroll
        for (int bj = 0; bj < 2; ++bj)
#pragma unroll
            for (int n = 0; n < 2; ++n) gv[bj][n] = *(const f32x4*)(gp + bj * 128 + n * 16);
#pragma unroll
        for (int ai = 0; ai < 2; ++ai) {
            f32x4 xv[4][2][2];
#pragma unroll
            for (int m = 0; m < 4; ++m) { const size_t off = (size_t)(row0 + ai * 128 + m * 16) * DM + col0;
#pragma unroll
                for (int bj = 0; bj < 2; ++bj)
#pragma unroll
                    for (int n = 0; n < 2; ++n) xv[m][bj][n] = *(const f32x4*)(xin_lat + off + bj * 128 + n * 16); }
#pragma unroll
            for (int m = 0; m < 4; ++m) { const size_t off = (size_t)(row0 + ai * 128 + m * 16) * DM + col0;
#pragma unroll
                for (int bj = 0; bj < 2; ++bj)
#pragma unroll
                    for (int n = 0; n < 2; ++n) *(f32x4*)(xout_lat + off + bj * 128 + n * 16) = xv[m][bj][n] + gv[bj][n] * acc[ai][bj][m][n]; }
            asm volatile("" ::: "memory"); }
    }
};
struct EpiQKV {
    static constexpr bool PERM = true;
    bf16_t* Q; bf16_t* K; bf16_t* V; const float* rcos; const float* rsin;
    __device__ __forceinline__ void operator()(AccRef acc, const pg8::Unit& u, int wr, int wc, int fr, int fq) const {
        const int row0 = u.pm * 256 + wr * 64 + fr, c0 = wc * 32 + 8 * fq;
        if (u.pn >= 8) {
            const int hv = (u.pn - 8) >> 1;
#pragma unroll
            for (int ai = 0; ai < 2; ++ai)
#pragma unroll
                for (int bj = 0; bj < 2; ++bj) { const int slv = ((u.pn - 8) & 1) * 4 + ai * 2 + wr;
                    bf16_t* blk = V + ((size_t)((((2 * u.pm + bj) * 4 + hv) * 8 + slv)) << 13) + wc * 32;
#pragma unroll
                    for (int m = 0; m < 4; ++m) { const f32x4 v0 = acc[ai][bj][m][0], v1 = acc[ai][bj][m][1]; u32x4 w;
                        w.x = cvt_pk_bf16(v0[0], v0[1]); w.y = cvt_pk_bf16(v0[2], v0[3]); w.z = cvt_pk_bf16(v1[0], v1[1]); w.w = cvt_pk_bf16(v1[2], v1[3]);
                        stg16(blk + m * 16 * 128, (unsigned)(fr * 128 + 8 * fq) * 2u, w); } }
            return;
        }
        const bool isk = u.pn >= 4, lat = u.pm < 64; const int h = u.pn & 3; bf16_t* dst = isk ? K : Q; const float sc = isk ? 0.0625f : 1.0f;
        const int i0 = 16 * wc + 4 * fq;
#pragma unroll
        for (int ai = 0; ai < 2; ++ai) {
            f32x4 cv[4][2], sv[4][2];
            if (lat) {
#pragma unroll
                for (int m = 0; m < 4; ++m) { const int l = (row0 + ai * 128 + m * 16) & 2047;
#pragma unroll
                    for (int bj = 0; bj < 2; ++bj) { const int pos = bj == 0 ? (l >> 6) : (l & 63); cv[m][bj] = *(const f32x4*)(rcos + pos * 64 + i0); sv[m][bj] = *(const f32x4*)(rsin + pos * 64 + i0); } } }
#pragma unroll
            for (int m = 0; m < 4; ++m) { const int row = row0 + ai * 128 + m * 16;
                bf16_t* chp = dst + ((size_t)(row >> 7) * 4 + h) * 32768;
#pragma unroll
                for (int bj = 0; bj < 2; ++bj) { f32x4 x1 = acc[ai][bj][m][0], x2 = acc[ai][bj][m][1];
                    if (lat) { const f32x4 o1 = x1 * cv[m][bj] - x2 * sv[m][bj], o2 = x1 * sv[m][bj] + x2 * cv[m][bj]; x1 = o1; x2 = o2; }
                    x1 = x1 * sc; x2 = x2 * sc; u32x4 w;
                    w.x = cvt_pk_bf16(x1[0], x1[1]); w.y = cvt_pk_bf16(x1[2], x1[3]); w.z = cvt_pk_bf16(x2[0], x2[1]); w.w = cvt_pk_bf16(x2[2], x2[3]);
                    const int s32 = 4 * bj + wc;
                    const int off = isk ? ((s32 * 8 + ((row & 127) >> 4)) * 512 + (4 * (row & 15) + fq) * 8)
                                        : (((((row >> 4) & 7) * 8) + s32) * 512 + (16 * fq + (row & 15)) * 8);
                    *(u32x4*)(chp + off) = w; } }
            asm volatile("" ::: "memory"); }
    }
};
struct EpiZGate {
    static constexpr bool PERM = true;
    const bf16_t* O; const float* rinv; bf16_t* AO;
    __device__ __forceinline__ void operator()(AccRef acc, const pg8::Unit& u, int wr, int wc, int fr, int fq) const {
        const int head = u.pn >> 1;
        const unsigned vo_o = (unsigned)((fq >> 1) * 256 + (32 * (fq & 1) + fr) * 4) * 2u, vo_r = (unsigned)fr * 16u, vo_a = (unsigned)(fr * 2048 + 8 * fq) * 2u;
        u32x4 ov[2][4][2]; float rv[2][4];
#pragma unroll
        for (int ai = 0; ai < 2; ++ai)
#pragma unroll
            for (int m = 0; m < 4; ++m) { const int rowu = u.pm * 256 + wr * 64 + ai * 128 + m * 16;
                rv[ai][m] = *(const GAS float*)((const GAS unsigned char*)(rinv + (size_t)rowu * 4 + head) + vo_r);
#pragma unroll
                for (int bj = 0; bj < 2; ++bj) { const int sl = (u.pn & 1) * 4 + bj * 2 + (wc >> 1);
                    const bf16_t* ob = O + ((size_t)((((2 * u.pm + ai) * 4 + head) * 8 + sl) * 8 + (wr * 4 + m)) << 10) + (wc & 1) * 512;
                    const u32x2 lo = *(const GAS u32x2*)((const GAS unsigned char*)ob + vo_o), hi = *(const GAS u32x2*)((const GAS unsigned char*)(ob + 64) + vo_o); ov[ai][m][bj] = (u32x4){lo.x, lo.y, hi.x, hi.y}; } }
#pragma unroll
        for (int ai = 0; ai < 2; ++ai)
#pragma unroll
            for (int m = 0; m < 4; ++m) { const int rowu = u.pm * 256 + wr * 64 + ai * 128 + m * 16; const float r_ = rv[ai][m];
#pragma unroll
                for (int bj = 0; bj < 2; ++bj) { const u32x4 o = ov[ai][m][bj]; const f32x4 v0 = acc[ai][bj][m][0], v1 = acc[ai][bj][m][1]; u32x4 w;
                    w.x = cvt_pk_bf16(bflo(o.x) * r_ * silu_f(v0[0]), bfhi(o.x) * r_ * silu_f(v0[1])); w.y = cvt_pk_bf16(bflo(o.y) * r_ * silu_f(v0[2]), bfhi(o.y) * r_ * silu_f(v0[3]));
                    w.z = cvt_pk_bf16(bflo(o.z) * r_ * silu_f(v1[0]), bfhi(o.z) * r_ * silu_f(v1[1])); w.w = cvt_pk_bf16(bflo(o.w) * r_ * silu_f(v1[2]), bfhi(o.w) * r_ * silu_f(v1[3]));
                    stg16(AO + (size_t)rowu * 2048 + u.pn * 256 + wc * 32 + bj * 128, vo_a, w); } }
    }
};

#define XB_TMO      128
#define XB_XCNT(j)  (256  + 64 * (j))
#define XB_XSUB(j)  (1280 + 64 * (j))
#define XB_XGEN(j)  (2304 + 64 * (j))
#define XB_TOP      3328
#define XB_TOPGEN   3392
#define XCD_BAR_WORDS 3456
#define XB_SPIN_CAP (1u << 18)
__device__ __forceinline__ unsigned xb_ld(unsigned* p)              { return __hip_atomic_load(p, __ATOMIC_RELAXED, __HIP_MEMORY_SCOPE_AGENT); }
__device__ __forceinline__ unsigned xb_add(unsigned* p, unsigned v) { return __hip_atomic_fetch_add(p, v, __ATOMIC_RELAXED, __HIP_MEMORY_SCOPE_AGENT); }
__device__ __forceinline__ unsigned xb_xcc_id() { return (unsigned)__builtin_amdgcn_s_getreg((3 << 11) | 20) & 0xFu; }
#define XB_SPIN(cond, bar) do { unsigned _sp = 0; while (cond) { __builtin_amdgcn_s_sleep(1); \
    if ((++_sp & 255u) == 0u) { if (xb_ld(&(bar)[XB_TMO])) break; if (_sp > XB_SPIN_CAP) { atomicAdd(&(bar)[XB_TMO], 1u); break; } } } } while (0)
struct XcdBarrier { unsigned* bar; unsigned x, nloc, nx; };
__device__ __forceinline__ XcdBarrier xcd_barrier_post(unsigned* bar) {
    XcdBarrier b; b.bar = bar; b.x = xb_xcc_id(); b.nloc = 0u; b.nx = 0u;
    if (threadIdx.x == 0) (void)xb_add(&bar[XB_XCNT(b.x)], 1u);
    return b;
}
__device__ __forceinline__ void xcd_barrier_complete(unsigned* bar, unsigned x, unsigned& nloc, unsigned& nx) {
    const unsigned G = gridDim.x * gridDim.y * gridDim.z;
    unsigned sum, cnt, mine, sp = 0u;
    for (;;) {
        sum = 0u; cnt = 0u; mine = 0u;
#pragma unroll 1
        for (unsigned j = 0; j < 16; ++j) { const unsigned c = xb_ld(&bar[XB_XCNT(j)]); sum += c; cnt += (c > 0u) ? 1u : 0u; mine = (j == x) ? c : mine; }
        if (sum == G) break;
        __builtin_amdgcn_s_sleep(1);
        if ((++sp & 255u) == 0u) { if (xb_ld(&bar[XB_TMO])) break; if (sp > XB_SPIN_CAP) { atomicAdd(&bar[XB_TMO], 1u); break; } }
    }
    nloc = mine > 0u ? mine : 1u; nx = cnt > 0u ? cnt : 1u;
}
__device__ __forceinline__ void xcd_census(XcdBarrier& b, volatile LAS unsigned* tmp) {
    if (threadIdx.x == 0) { unsigned nloc, nx; xcd_barrier_complete(b.bar, b.x, nloc, nx); tmp[0] = nloc; tmp[1] = nx; }
    __syncthreads();
    b.nloc = (unsigned)__builtin_amdgcn_readfirstlane((int)tmp[0]); b.nx = (unsigned)__builtin_amdgcn_readfirstlane((int)tmp[1]);
    __syncthreads();
}
__device__ __forceinline__ void xcd_barrier(const XcdBarrier& b) {
    asm volatile("s_waitcnt vmcnt(0)" ::: "memory");
    __syncthreads();
    if (threadIdx.x == 0) {
        unsigned* bar = b.bar;
        __builtin_amdgcn_s_waitcnt(0);
        unsigned nloc = b.nloc, nx = b.nx; asm volatile("" : "+s"(nloc), "+s"(nx));
        const unsigned old = xb_add(&bar[XB_XSUB(b.x)], 1u);
        const unsigned gen = old / nloc;
        if (old + 1u == (gen + 1u) * nloc) {
            __builtin_amdgcn_fence(__ATOMIC_RELEASE, "agent");
            asm volatile("s_waitcnt vmcnt(0)" ::: "memory");
            const unsigned og = xb_add(&bar[XB_TOP], 1u);
            const unsigned tg = og / nx;
            if (og + 1u == (tg + 1u) * nx) xb_add(&bar[XB_TOPGEN], 1u);
            else XB_SPIN(xb_ld(&bar[XB_TOPGEN]) == tg, bar);
            __builtin_amdgcn_fence(__ATOMIC_ACQUIRE, "agent");
            xb_add(&bar[XB_XGEN(b.x)], 1u);
            asm volatile("s_waitcnt vmcnt(0)" ::: "memory");
        } else {
            XB_SPIN(xb_ld(&bar[XB_XGEN(b.x)]) == gen, bar);
            __builtin_amdgcn_fence(__ATOMIC_ACQUIRE, "agent");
            asm volatile("s_waitcnt vmcnt(0)" ::: "memory");
        }
    }
    __syncthreads();
}

struct Args { const float* in[13]; float* out; unsigned char* ws; int ph_lo, ph_hi, pad0, pad1; };
struct Frame {
    LAS unsigned char* lds;
    int vcu, G, wv;
    unsigned char* ws;
};
__device__ __forceinline__ int lane_id() { int l; asm volatile("v_mbcnt_lo_u32_b32 %0, -1, 0\n\tv_mbcnt_hi_u32_b32 %0, -1, %0" : "=v"(l)); return l; }
__device__ __forceinline__ unsigned char* launder_ptr(unsigned char* p) {
    unsigned lo = (unsigned)(unsigned long long)p, hi = (unsigned)((unsigned long long)p >> 32);
    asm volatile("" : "+s"(lo), "+s"(hi));
    return (unsigned char*)(((unsigned long long)hi << 32) | lo);
}
#define PHASE_IDS() int tid = F.wv * 64 + lane_id(); asm volatile("" : "+v"(tid)); const int lane = tid & 63, wave = __builtin_amdgcn_readfirstlane(tid >> 6); (void)lane; (void)wave; \
    unsigned char* ws = launder_ptr(F.ws); (void)ws
#define LDS_WAIT() asm volatile("s_waitcnt lgkmcnt(0)" ::: "memory")

__device__ __forceinline__ int qk_pos(int d) { const int half = d >> 7, n = (d >> 6) & 1, i = d & 63; return 128 * half + 8 * (i >> 2) + 4 * n + (i & 3); }
template <int MODE>
__device__ __forceinline__ void transpose_item(const float* W, int K, int N, int n_begin, bf16_t* WT, LAS float* scr, int item, int nblk, int lane) {
    const int kb = item / nblk, nb = item % nblk, k0 = 64 * kb, n0 = n_begin + 64 * nb;
    const GAS f32x4* src = (const GAS f32x4*)(W + (size_t)(k0 + (lane >> 4)) * N + n0 + 4 * (lane & 15));
    f32x4 v[16];
#pragma unroll
    for (int i = 0; i < 16; ++i) {
        if (MODE == 3) { const int kr = k0 + 4 * i + (lane >> 4), ks = (kr & ~255) + fpos(kr & 255); v[i] = *(const GAS f32x4*)(W + (size_t)ks * N + n0 + 4 * (lane & 15)); }
        else v[i] = src[(size_t)i * N]; }
#pragma unroll
    for (int i = 0; i < 16; ++i) *(LAS f32x4*)(scr + (4 * i + (lane >> 4)) * 68 + 4 * (lane & 15)) = v[i];
    LDS_WAIT(); asm volatile("" ::: "memory");
    const int na = n0 + lane; int nn = na - n_begin;
    if (MODE == 1) nn = (na < 2048) ? ((na & ~255) + qk_pos(na & 255)) : na;
    if (MODE == 2) nn = (nn & ~255) + fpos(nn & 255);
    GAS u32x4* dst = (GAS u32x4*)(WT + (size_t)nn * K + k0);
#pragma unroll
    for (int c = 0; c < 8; ++c) { const LAS float* sp = scr + (8 * c) * 68 + lane;
        u32x4 o; o.x = pk2(sp[0 * 68], sp[1 * 68]); o.y = pk2(sp[2 * 68], sp[3 * 68]); o.z = pk2(sp[4 * 68], sp[5 * 68]); o.w = pk2(sp[6 * 68], sp[7 * 68]);
        dst[c] = o; }
    LDS_WAIT(); asm volatile("" ::: "memory");
}
__device__ __forceinline__ void fold_task(const float* Win  , const LAS float* ctab  , bf16_t* WfT, int t, int lane) {
    const int g = t >> 8, p0 = ((t >> 5) & 7) * 32, kk0 = (t & 31) * 32, s = lane >> 5, li = lane & 31;
    f32x16 acc;
#pragma unroll
    for (int i = 0; i < 16; ++i) acc[i] = 0.f;
    const float* wrow = Win + (size_t)(kk0 + li) * 4096 + g * 256 + 4 * s;
    const int pcol = p0 + li;
    const int pmul = pcol < 128 ? pcol : pcol - 128, poff = pcol < 128 ? 0 : -64; const bool nyq = pcol == 128;
    f32x4 wvv[32];
#pragma unroll
    for (int tp = 0; tp < 32; ++tp) wvv[tp] = *(const GAS f32x4*)((const GAS float*)wrow + 8 * tp);
#pragma unroll
    for (int tp = 0; tp < 32; ++tp) {
        const f32x4 wv = wvv[tp];
#pragma unroll
        for (int uu = 0; uu < 4; ++uu) { const int cc = 8 * tp + 4 * s + uu; float a;
            a = ctab[(pmul * cc + poff) & 255]; if (nyq) a = (cc & 1) ? -0.0625f : 0.0625f;
            acc = __builtin_amdgcn_mfma_f32_32x32x2f32(a, wv[uu], acc, 0, 0, 0); }
    }
#pragma unroll
    for (int i = 0; i < 16; ++i) { const int row = (i & 3) + 8 * (i >> 2) + 4 * s; WfT[(size_t)(g * 256 + p0 + row) * 1024 + kk0 + li] = (bf16_t)f2bf(acc[i]); }
}

__device__ __forceinline__ void p0_phase(Frame& F, const Args& a) {
    PHASE_IDS();
    float* ADA = (float*)(ws + WS_ADA);
    const float* c = a.in[1]; const float* cctx = a.in[3]; const float* ada_w = a.in[5]; const float* ada_b = a.in[6];
    LAS float* sl = (LAS float*)F.lds;
    LAS float* part = (LAS float*)(F.lds + 36864);
    bool loaded = false;
    for (int u = F.vcu; u < 192; u += F.G) {
        if (!loaded) { for (int idx = tid; idx < 9 * 1024; idx += 512) { const int r = idx >> 10, k = idx & 1023; const float x = r < 8 ? c[r * 1024 + k] : cctx[k]; sl[idx] = x / (1.f + expf(-x)); } loaded = true; }
        __syncthreads();
        const int i = u / 48, n0 = (u % 48) * 64;
        f32x4 acc[9];
#pragma unroll
        for (int r = 0; r < 9; ++r) acc[r] = (f32x4){0.f, 0.f, 0.f, 0.f};
        const int ks4 = lane >> 4, c4 = 4 * (lane & 15);
        const float* wp = ada_w + ((size_t)i * 1024 + wave * 128 + ks4) * 3072 + n0 + c4;
#pragma unroll 8
        for (int kk = 0; kk < 32; ++kk) { const f32x4 wv = *(const f32x4*)(wp + (size_t)kk * 4 * 3072); const int k = wave * 128 + 4 * kk + ks4;
#pragma unroll
            for (int r = 0; r < 9; ++r) acc[r] += wv * sl[r * 1024 + k]; }
#pragma unroll
        for (int r = 0; r < 9; ++r) *(LAS f32x4*)(part + ((wave * 4 + ks4) * 9 + r) * 64 + c4) = acc[r];
        __syncthreads();
        for (int idx = tid; idx < 576; idx += 512) { const int r = idx >> 6, l = idx & 63; float s = 0.f;
#pragma unroll
            for (int w = 0; w < 32; ++w) s += part[(w * 9 + r) * 64 + l];
            ADA[(i * 9 + r) * 3072 + n0 + l] = s + ada_b[i * 3072 + n0 + l]; }
    }
    const int gt = F.vcu * 512 + tid, NT = F.G * 512;
    float* RC = (float*)(ws + WS_ROPE); float* RS = RC + 4096;
    for (int idx = gt; idx < 4096; idx += NT) { const int pos = idx >> 6, i = idx & 63; const float freq = powf(10000.0f, -(float)i / 64.0f); const float ang = (float)pos * freq;
        RC[idx] = cosf(ang); RS[idx] = sinf(ang); }
    bf16_t* CS256 = (bf16_t*)(ws + WS_CS256);
    for (int idx = gt; idx < 512 * 256; idx += NT) { const int row = idx >> 8, l = idx & 255, kt = row >> 8, hf = (row >> 7) & 1, k = kt * 128 + (row & 127);
        const float x = (float)((k * l) & 255) * (1.f / 128.f); const float v = (hf ? sinpif(x) : cospif(x)) * 0.0625f; CS256[idx] = (bf16_t)f2bf(v); }
}

__device__ __forceinline__ void norm_row(const float* xrow, const float* ng, const float* adar  , bf16_t* orow, int lane) {
    const f32x4* xr = (const f32x4*)xrow + lane;
    f32x4 v[4]; float s = 0.f;
#pragma unroll
    for (int j = 0; j < 4; ++j) { v[j] = xr[64 * j]; s += (v[j].x * v[j].x + v[j].y * v[j].y) + (v[j].z * v[j].z + v[j].w * v[j].w); }
    const float rinv = rsqrtf(wave_sum(s, lane) * (1.f / DM) + EPS);
    unsigned long long* o8 = (unsigned long long*)orow + lane;
#pragma unroll
    for (int j = 0; j < 4; ++j) { const int col = 4 * lane + 256 * j; const f32x4 g = *(const f32x4*)(ng + col), sh = *(const f32x4*)(adar + col), sc = *(const f32x4*)(adar + 1024 + col);
        const f32x4 y = v[j] * rinv * g * (sc + 1.0f) + sh;
        o8[64 * j] = (unsigned long long)pk2(y.x, y.y) | ((unsigned long long)pk2(y.z, y.w) << 32); }
}
template <int NR>
__device__ __forceinline__ void norm_batch(const float* const (&xrow)[NR], bf16_t* const (&hrow)[NR], int nrows, const f32x4 (&gm)[4], const f32x4 (&sh)[4], int lane) {
    f32x4 v[NR][4]; float ss[NR];
#pragma unroll
    for (int t = 0; t < NR; ++t) { const f32x4* xr = (const f32x4*)xrow[t] + lane;
#pragma unroll
        for (int j = 0; j < 4; ++j) v[t][j] = xr[64 * j]; }
#pragma unroll
    for (int t = 0; t < NR; ++t) { float s = 0.f;
#pragma unroll
        for (int j = 0; j < 4; ++j) s += (v[t][j].x * v[t][j].x + v[t][j].y * v[t][j].y) + (v[t][j].z * v[t][j].z + v[t][j].w * v[t][j].w);
        ss[t] = s; }
#pragma unroll
    for (int o = 1; o < 64; o <<= 1) {
#pragma unroll
        for (int t = 0; t < NR; ++t) ss[t] += shx(ss[t], o, lane); }
#pragma unroll
    for (int t = 0; t < NR; ++t) if (t < nrows) { const float rinv = rsqrtf(ss[t] * (1.f / DM) + EPS);
        unsigned long long* o8 = (unsigned long long*)hrow[t] + lane;
#pragma unroll
        for (int j = 0; j < 4; ++j) { const f32x4 y = v[t][j] * rinv * gm[j] + sh[j];
            o8[64 * j] = (unsigned long long)pk2(y.x, y.y) | ((unsigned long long)pk2(y.z, y.w) << 32); } }
}
__device__ __forceinline__ void norm_batch_fold(const float* const (&xrow)[8], bf16_t* const (&hrow)[8], bf16_t* const (&hp)[4], bf16_t* const (&hm)[4], bool lone, const f32x4 (&gm)[4], const f32x4 (&sh)[4], int lane) {
    f32x4 v[8][4]; float ss[8];
#pragma unroll
    for (int t = 0; t < 8; ++t) { const f32x4* xr = (const f32x4*)xrow[t] + lane;
#pragma unroll
        for (int j = 0; j < 4; ++j) v[t][j] = xr[64 * j]; }
#pragma unroll
    for (int t = 0; t < 8; ++t) { float s = 0.f;
#pragma unroll
        for (int j = 0; j < 4; ++j) s += (v[t][j].x * v[t][j].x + v[t][j].y * v[t][j].y) + (v[t][j].z * v[t][j].z + v[t][j].w * v[t][j].w);
        ss[t] = s; }
#pragma unroll
    for (int o = 1; o < 64; o <<= 1) {
#pragma unroll
        for (int t = 0; t < 8; ++t) ss[t] += shx(ss[t], o, lane); }
#pragma unroll
    for (int t = 0; t < 4; ++t) { const float ra = rsqrtf(ss[t] * (1.f / DM) + EPS), rb = rsqrtf(ss[4 + t] * (1.f / DM) + EPS); const bool single = lone && t == 0;
        unsigned long long* oa = (unsigned long long*)hrow[t] + lane; unsigned long long* ob = (unsigned long long*)hrow[4 + t] + lane;
        unsigned long long* op = (unsigned long long*)hp[t] + lane; unsigned long long* om = (unsigned long long*)hm[t] + lane;
#pragma unroll
        for (int j = 0; j < 4; ++j) { const f32x4 ya = v[t][j] * ra * gm[j] + sh[j], yb = v[4 + t][j] * rb * gm[j] + sh[j];
            const f32x4 yp = single ? ya : ya + yb, ym = single ? (f32x4){0.f, 0.f, 0.f, 0.f} : ya - yb;
            oa[64 * j] = (unsigned long long)pk2(ya.x, ya.y) | ((unsigned long long)pk2(ya.z, ya.w) << 32);
            ob[64 * j] = (unsigned long long)pk2(yb.x, yb.y) | ((unsigned long long)pk2(yb.z, yb.w) << 32);
            op[64 * j] = (unsigned long long)pk2(yp.x, yp.y) | ((unsigned long long)pk2(yp.z, yp.w) << 32);
            om[64 * j] = (unsigned long long)pk2(ym.x, ym.y) | ((unsigned long long)pk2(ym.z, ym.w) << 32); } }
}
template <bool ADDP>
__device__ __forceinline__ void norm_rows(Frame& F, const Args& a, int layer, bf16_t* H, int wsub = 8, bool fold = false) {
    PHASE_IDS();
    const float* xl = layer == 0 ? a.in[0] : a.out; const float* xc = (layer == 0 || (ADDP && layer == 1)) ? a.in[2] : (const float*)(ws + WS_XCTX);
    const float* ng = a.in[4] + layer * DM; const float* ADA = (const float*)(ws + WS_ADA) + layer * 9 * 3072;
    const int gw = F.vcu * wsub + wave, NGW = F.G * wsub;
    const int wpb = NGW >> 3;
    if (wpb > 0 && (NGW & 7) == 0) {
        const int b = gw / wpb, wi = gw - b * wpb; const float* adar = ADA + b * 3072;
        f32x4 gm[4], sh[4];
#pragma unroll
        for (int j = 0; j < 4; ++j) { const int col = 4 * lane + 256 * j; gm[j] = *(const f32x4*)(ng + col) * (*(const f32x4*)(adar + 1024 + col) + 1.0f); sh[j] = *(const f32x4*)(adar + col); }
        if (fold) {
            bf16_t* HP = (bf16_t*)(ws + WS_HP) + (size_t)b * 1024 * 1024; bf16_t* HM = (bf16_t*)hm_rows(ws, b);
            for (int l0 = wi; l0 < SEQ / 2; l0 += 4 * wpb) {
                const float* xr[8]; bf16_t* hr[8]; bf16_t* hp[4]; bf16_t* hm[4];
#pragma unroll
                for (int t = 0; t < 4; ++t) { const int la = l0 + t * wpb, lb = la == 0 ? SEQ / 2 : SEQ - la;
                    xr[t] = xl + (size_t)(b * SEQ + la) * DM; hr[t] = H + (size_t)(b * SEQ + la) * DM; xr[4 + t] = xl + (size_t)(b * SEQ + lb) * DM; hr[4 + t] = H + (size_t)(b * SEQ + lb) * DM;
                    hp[t] = HP + (size_t)la * DM; hm[t] = HM + (size_t)la * DM; }
                norm_batch_fold(xr, hr, hp, hm, l0 == 0, gm, sh, lane);
            }
        } else
        for (int l0 = wi; l0 < SEQ; l0 += 8 * wpb) {
            const float* xr[8]; bf16_t* hr[8]; int n = 0;
#pragma unroll
            for (int t = 0; t < 8; ++t) { const int l = l0 + t * wpb; const int ll = l < SEQ ? l : wi; if (l < SEQ) n = t + 1; xr[t] = xl + (size_t)(b * SEQ + ll) * DM; hr[t] = H + (size_t)(b * SEQ + ll) * DM; }
            norm_batch<8>(xr, hr, n, gm, sh, lane);
        }
        const float* adac = ADA + 8 * 3072;
#pragma unroll
        for (int j = 0; j < 4; ++j) { const int col = 4 * lane + 256 * j; gm[j] = *(const f32x4*)(ng + col) * (*(const f32x4*)(adac + 1024 + col) + 1.0f); sh[j] = *(const f32x4*)(adac + col); }
        for (int m = gw; m < NCTX; m += NGW) {
            f32x4 xv[4];
#pragma unroll
            for (int j = 0; j < 4; ++j) xv[j] = *((const f32x4*)(xc + (size_t)m * DM) + lane + 64 * j);
            if (ADDP && layer >= 1) {
                const float* part = (const float*)(ws + WS_PART); const float* gprev = (const float*)(ws + WS_ADA) + (layer - 1) * 9 * 3072 + 8 * 3072 + 2048;
                float* xw = (float*)(ws + WS_XCTX) + (size_t)m * DM;
#pragma unroll
                for (int j = 0; j < 4; ++j) { const f32x4* pr = (const f32x4*)(part + (size_t)m * DM) + lane + 64 * j;
                    const f32x4 ps = (pr[0] + pr[(size_t)NCTX * DM / 4]) + (pr[(size_t)2 * NCTX * DM / 4] + pr[(size_t)3 * NCTX * DM / 4]);
                    xv[j] = xv[j] + *(const f32x4*)(gprev + 4 * lane + 256 * j) * ps;
                    *((f32x4*)xw + lane + 64 * j) = xv[j]; }
            }
            float s_ = 0.f;
#pragma unroll
            for (int j = 0; j < 4; ++j) s_ += (xv[j].x * xv[j].x + xv[j].y * xv[j].y) + (xv[j].z * xv[j].z + xv[j].w * xv[j].w);
            const float rinv = rsqrtf(wave_sum(s_, lane) * (1.f / DM) + EPS);
            unsigned long long* o8 = (unsigned long long*)(H + (size_t)(NLAT + m) * DM) + lane;
#pragma unroll
            for (int j = 0; j < 4; ++j) { const f32x4 y = xv[j] * rinv * gm[j] + sh[j];
                o8[64 * j] = (unsigned long long)pk2(y.x, y.y) | ((unsigned long long)pk2(y.z, y.w) << 32); }
        }
        return;
    }
    for (int m = gw; m < NTOK; m += NGW) {
        const bool lat = m < NLAT; const int r = lat ? (m >> 11) : 8; const float* adar = ADA + r * 3072;
        f32x4 gm[4], sh[4];
#pragma unroll
        for (int j = 0; j < 4; ++j) { const int col = 4 * lane + 256 * j; gm[j] = *(const f32x4*)(ng + col) * (*(const f32x4*)(adar + 1024 + col) + 1.0f); sh[j] = *(const f32x4*)(adar + col); }
        const float* xr[1] = {lat ? xl + (size_t)m * DM : xc + (size_t)(m - NLAT) * DM}; bf16_t* hr[1] = {H + (size_t)m * DM};
        norm_batch<1>(xr, hr, 1, gm, sh, lane);
    }
}
__device__ __forceinline__ void cf_prep(Frame& F, int wave, int lane) {
    LAS float* ctab = (LAS float*)(F.lds + 139264);
    { const int tt = wave * 64 + lane; if (tt < 256) ctab[tt] = cospif((float)tt * (1.f / 128.f)) * 0.0625f; }
    __syncthreads();
}
__device__ __forceinline__ void cf_main(Frame& F, const Args& a, int j, int gw, int NGW, unsigned char* ws, int wave, int lane, size_t dst = WS_WF, int gwt = -1) {
    if (gwt < 0) gwt = gw;
    LAS float* scr = (LAS float*)(F.lds + wave * 17408); const LAS float* ctab = (const LAS float*)(F.lds + 139264);
    bf16_t* W1 = (bf16_t*)(ws + dst);
    const float* win = a.in[7] + (size_t)j * 1024 * 4096; const float* wout = a.in[8] + (size_t)j * 2048 * 1024;
    bf16_t* WfoT = W1 + (size_t)4096 * 1024;
    for (int t = gw; t < 2048; t += NGW) fold_task(win, ctab, W1, t, lane);
    for (int it = gwt; it < 1024; it += NGW) {
        if (it < 512) transpose_item<2>(win, 1024, 4096, 2048, W1 + (size_t)2048 * 1024, scr, it, 32, lane);
        else transpose_item<3>(wout, 2048, 1024, 0, WfoT, scr, it - 512, 16, lane); }
}
__device__ __forceinline__ void cf_cs(Frame& F, int gt, int NT, unsigned char* ws, int wave, int lane) {
    bf16_t* CS = (bf16_t*)(ws + WS_CS);
    __syncthreads();
    LAS float* ctab2 = (LAS float*)F.lds;
    for (int n = wave * 64 + lane; n < 2048; n += 512) ctab2[n] = cospif((float)n * (1.f / 1024.f)) * 0.022097087f;
    __syncthreads();
    for (int ch = gt; ch < 2048 * 128; ch += NT) { const int row = ch >> 7, l0 = (ch & 127) * 8, kt = row >> 8, hf = (row >> 7) & 1, k = kt * 128 + (row & 127);
        const int off = hf ? -512 : 0;
        unsigned w[4];
#pragma unroll
        for (int e = 0; e < 4; ++e) { float v[2];
#pragma unroll
            for (int q = 0; q < 2; ++q) { const int l = l0 + 2 * e + q; v[q] = ctab2[(k * l + off) & 2047]; }
            w[e] = pk2(v[0], v[1]); }
        *(u32x4*)(CS + (size_t)row * 1024 + l0) = (u32x4){w[0], w[1], w[2], w[3]}; }
    __syncthreads();
}
__device__ __forceinline__ void conv_fourier(Frame& F, const Args& a, int j, int gw, int NGW, int gt, int NT, unsigned char* ws, int wave, int lane) {
    cf_prep(F, wave, lane); cf_main(F, a, j, gw, NGW, ws, wave, lane); cf_cs(F, gt, NT, ws, wave, lane);
}
__device__ __forceinline__ void conv_ret(Frame& F, const Args& a, int j, int gw, int NGW, unsigned char* ws, int wave, int lane, int lo = 0, int hi = 2048) {
    LAS float* scr = (LAS float*)(F.lds + wave * 17408);
    bf16_t* W1 = (bf16_t*)(ws + WS_W);
    const float* win = a.in[9] + (size_t)j * 1024 * 6144; const float* wout = a.in[10] + (size_t)j * 2048 * 1024;
    bf16_t* WroT = W1 + (size_t)6144 * 1024;
    for (int it = lo + gw; it < hi; it += NGW) {
        if (it < 1536) transpose_item<1>(win, 1024, 6144, 0, W1, scr, it, 96, lane);
        else transpose_item<0>(wout, 2048, 1024, 0, WroT, scr, it - 1536, 16, lane);
    }
}
__device__ __forceinline__ void bg_conv_ret(Frame& F, const Args& a, int layer, int cu_lo, int lo, int hi) {
    PHASE_IDS();
    const int cu = (int)blockIdx.x - cu_lo;
    if (layer + 1 >= NLAYER || F.G != 256 || cu < 0 || cu >= 128) return;
    conv_ret(F, a, (layer + 1) >> 1, cu * 8 + wave, 1024, ws, wave, lane, lo, hi);
}
__device__ __forceinline__ void p0_conv(Frame& F, const Args& a) {
    PHASE_IDS();
    __syncthreads();
    if (F.G == 256) { cf_prep(F, wave, lane); cf_main(F, a, 0, F.vcu * 8 + wave, F.G * 8, ws, wave, lane); }
    else conv_fourier(F, a, 0, F.vcu * 8 + wave, F.G * 8, F.vcu * 512 + tid, F.G * 512, ws, wave, lane);
}
__device__ __forceinline__ void n_phase(Frame& F, const Args& a, int layer) {
    PHASE_IDS();
    const bool fourier = (layer & 1) == 0;
    if (fourier && layer >= 1 && F.G == 256) {
        norm_rows<true>(F, a, layer, (bf16_t*)(ws + WS_H), 8, true);
        return;
    }
    if (fourier && layer >= 1) {
        cf_prep(F, wave, lane);
        if (wave < 4) norm_rows<true>(F, a, layer, (bf16_t*)(ws + WS_H), 4, F.G == 256); else cf_main(F, a, layer >> 1, F.vcu * 4 + wave - 4, F.G * 4, ws, wave, lane);
        cf_cs(F, F.vcu * 512 + tid, F.G * 512, ws, wave, lane);
        return;
    }
    norm_rows<true>(F, a, layer, (bf16_t*)(ws + (fourier ? WS_H : WS_OF)), 8, fourier && F.G == 256);
    if (layer >= 1) {
        if (fourier) conv_fourier(F, a, layer >> 1, F.vcu * 8 + wave, F.G * 8, F.vcu * 512 + tid, F.G * 512, ws, wave, lane);
        else if (F.G != 256) conv_ret(F, a, layer >> 1, F.vcu * 8 + wave, F.G * 8, ws, wave, lane);
    }
}
__device__ __forceinline__ void ufold_jobs(Frame& F, int cu_lo) {
    PHASE_IDS();
    const int cu = (int)blockIdx.x - cu_lo;
    if (cu < 0 || cu >= 128) return;
    const bf16_t* W1 = (const bf16_t*)(ws + WS_WF); const bf16_t* H = (const bf16_t*)(ws + WS_H); const bf16_t* HP = (const bf16_t*)(ws + WS_HP);
    bf16_t* UTF = (bf16_t*)(ws + WS_UTL); float* AH = (float*)(ws + WS_RINV);
    const int t = cu * 8 + wave, col = lane & 15, q = lane >> 4;
    if (t < 512) {
        const int b = t >> 6, l0 = (t & 63) * 16;
        const f32x4 d = skinny16x8(HP + ((size_t)b * 1024 + l0) * 1024, W1 + (size_t)128 * 1024, (size_t)256 * 1024, lane);
        if (col < 8) { u32x2 o; o.x = pk2(d[0], d[1]); o.y = pk2(d[2], d[3]); *(u32x2*)(UTF + ((size_t)b * 2048 + col * 256 + 128) * 1024 + l0 + 4 * q) = o; }
    } else if (t < 640) {
        const int R0 = (t - 512) * 16;
        const f32x4 d = skinny16x8(W1 + (size_t)R0 * 1024, H + (size_t)1024 * 1024, (size_t)2048 * 1024, lane);
        if (col < 8) *(f32x4*)(AH + (size_t)col * 2048 + R0 + 4 * q) = d;
    }
}
__device__ __forceinline__ void bg_conv_fourier(Frame& F, const Args& a, int layer, int cu_lo) {
    PHASE_IDS();
    const int cu = (int)blockIdx.x - cu_lo;
    if (layer + 1 >= NLAYER || F.G != 256 || cu < 0) return;
    cf_prep(F, wave, lane);
    { const int gw = cu * 8 + wave, NGW = (256 - cu_lo) * 8;
      cf_main(F, a, (layer + 1) >> 1, gw, NGW, ws, wave, lane, WS_K, (gw + NGW - 512) % NGW); }
}
__device__ __forceinline__ void bg_place_fourier(Frame& F, const Args& a, int layer, int cu_lo) {
    PHASE_IDS();
    const int cu = (int)blockIdx.x - cu_lo;
    if (layer + 1 >= NLAYER || F.G != 256 || cu < 0) return;
    const int gt = cu * 512 + tid, NT = (256 - cu_lo) * 512;
    { const GAS u32x4* src = (const GAS u32x4*)(ws + WS_K); GAS u32x4* dst = (GAS u32x4*)(ws + WS_WF);
      for (int i = gt; i < (int)(12 * MiB / 16); i += NT) dst[i] = src[i]; }
    cf_cs(F, gt, NT, ws, wave, lane);
}
__device__ __forceinline__ void bg_cs_fourier(Frame& F, int cu_lo) {
    PHASE_IDS();
    const int cu = (int)blockIdx.x - cu_lo;
    if (cu < 0 || cu >= 128) return;
    cf_cs(F, cu * 512 + tid, 128 * 512, ws, wave, lane);
}
__device__ __forceinline__ void nyq_row_phase(Frame& F) {
    PHASE_IDS();
    const bf16_t* UTF = (const bf16_t*)(ws + WS_UTL); const float* AH = (const float*)(ws + WS_RINV); bf16_t* Z = (bf16_t*)(ws + WS_Z);
    int gw = F.vcu * 8 + wave, NGW = F.G * 8;
    if (F.G == 256) { if ((int)blockIdx.x < 128) return; gw = ((int)blockIdx.x - 128) * 8 + wave; NGW = 1024; }
    for (int t0 = gw; t0 < 64 * 129; t0 += 4 * NGW) {
        u32x4 v[4][2]; float ah[4]; unsigned short zv[4]; bf16_t* zp[4]; bool act[4];
#pragma unroll
        for (int i = 0; i < 4; ++i) { const int t = t0 + i * NGW; const bool ok = t < 64 * 129; const int tt = ok ? t : gw;
            const int bg = tt / 129, mt = tt - bg * 129, b = bg >> 3, g = bg & 7; const int row = b * 2048 + g * 256 + mt;
            const GAS u32x4* src = (const GAS u32x4*)(UTF + (size_t)row * 1024);
            v[i][0] = src[lane]; v[i][1] = src[lane + 64]; ah[i] = AH[row];
            bf16_t* zrow = Z + (size_t)(b * 2048 + 1024) * 2048 + g * 256;
            act[i] = ok && (lane == 0 || (lane == 1 && mt >= 1 && mt <= 127)); zp[i] = zrow + (lane == 0 ? mt : 128 + mt);
            zv[i] = act[i] ? *(const GAS unsigned short*)zp[i] : (unsigned short)0; }
#pragma unroll
        for (int i = 0; i < 4; ++i) { float s_ = 0.f;
#pragma unroll
            for (int h2 = 0; h2 < 2; ++h2) { const u32x4 x = v[i][h2]; s_ += (bflo(x.x) - bfhi(x.x)) + (bflo(x.y) - bfhi(x.y)) + (bflo(x.z) - bfhi(x.z)) + (bflo(x.w) - bfhi(x.w)); }
            s_ = wave_sum(s_, lane);
            const float y = (s_ + ah[i]) * 0.022097087f;
            if (act[i]) *zp[i] = (bf16_t)f2bf(y * bf1((bf16_t)zv[i])); }
    }
}
__device__ __forceinline__ bf16_t* s_chunk(unsigned char* ws, int h, int rc) {
    return rc < 56 ? (bf16_t*)(ws + WS_SA) + ((size_t)(h * 56 + rc) << 14) : (bf16_t*)(ws + WS_SB) + ((size_t)(h * 88 + rc - 56) << 14);
}
struct DiagOrder {
    int G, c;
    __device__ bool next(int i, pg8::Unit& u) const { const int L = i * G + c; if (L >= 288) return false; u.aux = L / 72; u.pm = L - 72 * u.aux; u.pn = u.pm; return true; }
    __device__ __forceinline__ const char* a_ptr(const pg8::Gemm& g, const pg8::Unit& u) const { return (const char*)(g.A + ((size_t)(2 * u.pm) * 4 + u.aux) * 32768); }
    __device__ __forceinline__ const char* b_ptr(const pg8::Gemm& g, const pg8::Unit& u, int half) const { return (const char*)(g.Bt + ((size_t)(2 * u.pm + half) * 4 + u.aux) * 32768); }
    __device__ __forceinline__ bool b_mirror(const pg8::Unit&) const { return false; }
    __device__ __forceinline__ bool b_fix(const pg8::Unit&) const { return false; }
    __device__ __forceinline__ int ktiles(const pg8::Gemm& g, const pg8::Unit&) const { return g.K / pg8::BK; }
    __device__ __forceinline__ int a_half_rows() const { return pg8::HALF; }
};
struct EpiS {
    static constexpr bool PERM = true;
    unsigned char* ws;
    __device__ __forceinline__ void operator()(AccRef acc, const pg8::Unit& u, int wr, int wc, int fr, int fq) const {
#pragma unroll
        for (int ai = 0; ai < 2; ++ai) { bf16_t* sp = s_chunk(ws, u.aux, 2 * u.pm + ai);
#pragma unroll
            for (int m = 0; m < 4; ++m) { const f32x4 v0 = acc[ai][ai][m][0], v1 = acc[ai][ai][m][1]; u32x4 w;
                w.x = cvt_pk_bf16(v0[0], v0[1]); w.y = cvt_pk_bf16(v0[2], v0[3]); w.z = cvt_pk_bf16(v1[0], v1[1]); w.w = cvt_pk_bf16(v1[2], v1[3]);
                *(u32x4*)(sp + ((((wr * 4 + m) * 4 + wc) * 64 + fq * 16 + fr) << 3)) = w; } }
    }
};
struct QKVOrder : pg8::TileOrder {
    int i0, i1;
    __device__ void init2(int G_, int c_, int i0_, int i1_) { nM = 72; nN = 16; nwg = 1152; G = G_; c = c_; i0 = i0_; i1 = i1_; }
    __device__ bool next(int i, pg8::Unit& u) const {
        const int ii = i + i0; if (ii >= i1) return false;
        const int L = ii * G + c; if (L >= 1152) return false;
        if (L < 576) { map(L, 72, 8, u); } else if (L < 1008) { map(L - 576, 72, 6, u); u.pn += 8; } else { map(L - 1008, 72, 2, u); u.pn += 14; }
        return true;
    }
    __device__ __forceinline__ const char* a_ptr(const pg8::Gemm& g, const pg8::Unit& u) const {
        return u.pn >= 8 ? (const char*)(g.Bt + (size_t)u.pn * 256 * g.ldb) : (const char*)(g.A + (size_t)u.pm * 256 * g.lda); }
    __device__ __forceinline__ const char* b_ptr(const pg8::Gemm& g, const pg8::Unit& u, int half) const {
        return u.pn >= 8 ? (const char*)(g.A + (size_t)(u.pm * 256 + 128 * half) * g.lda) : (const char*)(g.Bt + (size_t)(u.pn * 256 + 128 * half) * g.ldb); }
};
#define XQ_SUB(l, j) (3584 + 64 * ((l) * 16 + (j)))
#define XQ_TOP(l)    (8768 + 64 * (l))
__device__ __forceinline__ void xq_arrive(const XcdBarrier& b, int layer) {
    asm volatile("s_waitcnt vmcnt(0)" ::: "memory");
    __syncthreads();
    if (threadIdx.x == 0) {
        const unsigned old = xb_add(&b.bar[XQ_SUB(layer, b.x)], 1u);
        if (old + 1u == b.nloc) { __builtin_amdgcn_fence(__ATOMIC_RELEASE, "agent"); asm volatile("s_waitcnt vmcnt(0)" ::: "memory"); xb_add(&b.bar[XQ_TOP(layer)], 1u); }
    }
}
__device__ __forceinline__ void xq_wait(const XcdBarrier& b, int layer) {
    if (threadIdx.x == 0) {
        const unsigned nx = b.nx;
        XB_SPIN(xb_ld(&b.bar[XQ_TOP(layer)]) < nx, b.bar);
        __builtin_amdgcn_fence(__ATOMIC_ACQUIRE, "agent");
        asm volatile("s_waitcnt vmcnt(0)" ::: "memory");
    }
    __syncthreads();
}
typedef short bf16x4 __attribute__((ext_vector_type(4)));
typedef short v4i16_t __attribute__((ext_vector_type(4)));
__device__ __forceinline__ bf16x8 ldtr2(const LAS unsigned char* p0, const LAS unsigned char* p1) {
    const bf16x4 lo = __builtin_bit_cast(bf16x4, __builtin_amdgcn_ds_read_tr16_b64_v4i16((LAS v4i16_t*)p0));
    const bf16x4 hi = __builtin_bit_cast(bf16x4, __builtin_amdgcn_ds_read_tr16_b64_v4i16((LAS v4i16_t*)p1));
    return __builtin_shufflevector(lo, hi, 0, 1, 2, 3, 4, 5, 6, 7);
}
__device__ __forceinline__ int blk_perm(int rb) { return (rb & ~3) | ((rb >> 1) & 1) | ((rb & 1) << 1); }
__device__ __forceinline__ int scan_t0(int dir, int b, int s) {
    return dir == 0 ? ((s < 2) ? (NLAT + b * CTXL + s * 128) : (b * SEQ + (s - 2) * 128)) : ((s < 2) ? (NLAT + b * CTXL + (1 - s) * 128) : (b * SEQ + (17 - s) * 128));
}
__device__ __forceinline__ int scan_rc(int dir, int b, int s) {
    return dir == 0 ? ((s < 2) ? (128 + b * 2 + s) : (b * 16 + (s - 2))) : ((s < 2) ? (128 + b * 2 + (1 - s)) : (b * 16 + (17 - s)));
}
__device__ __forceinline__ u32x4 ldg16(const void* ub, unsigned voff) { return *(const GAS u32x4*)((const GAS unsigned char*)ub + voff); }
template <int DIR>
__device__ __forceinline__ void scan_load_s(u32x4 (&sf)[4], unsigned char* ws, int h, int rc, int w, int r, int q) {
    const bf16_t* ub = s_chunk(ws, h, rc) + w * 2048; const unsigned vo = (unsigned)(16 * q + r) * 16u;
#pragma unroll
    for (int ks = 0; ks < 4; ++ks) if (DIR == 0 ? (ks <= (w >> 1)) : (ks >= (w >> 1))) sf[ks] = ldg16(ub, vo + 1024u * ks);
}
__device__ __forceinline__ void scan_load_q(u32x4 (&qf)[8], const bf16_t* Qg, int h, int t0, int w, int r, int q) {
    const bf16_t* ub = Qg + (((size_t)(t0 >> 7) * 4 + h) * 8 + w) * 4096; const unsigned vo = (unsigned)(16 * q + r) * 16u;
#pragma unroll
    for (int ks = 0; ks < 8; ++ks) qf[ks] = ldg16(ub, vo + 1024u * ks);
}
__device__ __forceinline__ void scan_load_kv(u32x4 (&kr)[8], u32x4 (&vr)[2], const bf16_t* Kg, const bf16_t* Vg, int h, int sl, int t0, int w, int lane, int tid) {
    const bf16_t* kb = Kg + (((size_t)(t0 >> 7) * 4 + h) * 8 + w) * 4096; const unsigned ko = (unsigned)lane * 16u;
#pragma unroll
    for (int it = 0; it < 8; ++it) kr[it] = ldg16(kb, ko + 1024u * it);
    const bf16_t* vb = Vg + ((size_t)((((t0 >> 7) * 4 + h) * 8 + sl)) << 13); const unsigned vo = (unsigned)tid * 16u;
#pragma unroll
    for (int i = 0; i < 2; ++i) vr[i] = ldg16(vb, vo + 8192u * i);
}
#ifndef DBG_SEG
#define DBG_SEG -1
#endif
#define SEG_MARK(k) do { if (DBG_SEG >= 0) { __builtin_amdgcn_sched_barrier(0); const unsigned long long t_ = __builtin_amdgcn_s_memtime(); if (DBG_SEG == (k)) segacc += t_ - segt; segt = t_; __builtin_amdgcn_sched_barrier(0); } } while (0)
template <int DIR>
__device__ __forceinline__ void scan_step(unsigned long long& segacc, unsigned long long& segt, LAS unsigned char* lds, u32x4 (&sf)[4], u32x4 (&qf)[8], u32x4 (&kr)[8], u32x4 (&vr)[2], f32x4 (&Rb)[2][4], const float (&wm)[2], float rsc, float g128,
                                          int t0, int t0n, int rcn, int sb, unsigned char* ws, int h, int sl, int w, int lane_in, int tid_in, const bf16_t* Qg, const bf16_t* Kg, const bf16_t* Vg, bf16_t* OF, float* SSP) {
    int lane = lane_in; asm volatile("" : "+v"(lane));
    const int tid = (tid_in & ~63) | lane;
    const int r = lane & 15, q = lane >> 4;
    LAS unsigned char* VI = lds + SC_V_OFF + sb * 16384; LAS unsigned char* RT = lds + SC_RT_OFF + sb * 32768; LAS unsigned char* RTN = lds + SC_RT_OFF + (sb ^ 1) * 32768; LAS unsigned char* KI = lds + SC_K_OFF + w * 8192;
    SEG_MARK(5);
    { float wj[8]; wj[0] = wm[0];
#pragma unroll
      for (int j = 1; j < 8; ++j) wj[j] = wj[j - 1] * wm[1];
      const int ev = tid >> 4, mg = tid & 15; LAS unsigned char* vw = VI + ev * 256 + ((mg ^ (ev & 15)) << 4);
#pragma unroll
      for (int i = 0; i < 2; ++i) { const u32x4 v = vr[i]; u32x4 o;
        o.x = cvt_pk_bf16(bflo(v.x) * wj[0], bfhi(v.x) * wj[1]); o.y = cvt_pk_bf16(bflo(v.y) * wj[2], bfhi(v.y) * wj[3]); o.z = cvt_pk_bf16(bflo(v.z) * wj[4], bfhi(v.z) * wj[5]); o.w = cvt_pk_bf16(bflo(v.w) * wj[6], bfhi(v.w) * wj[7]);
        *(LAS u32x4*)(vw + 8192 * i) = o; } }
#pragma unroll
    for (int it = 0; it < 8; ++it) { const int m = it * 16 + (lane >> 2), dc = lane & 3;
        *(LAS u32x4*)(KI + 128 * ((dc >> 1) * 32 + blk_perm(m >> 2)) + (m & 3) * 32 + (dc & 1) * 16) = kr[it]; }
    SEG_MARK(0);
    asm volatile("s_waitcnt lgkmcnt(0)" ::: "memory"); __builtin_amdgcn_s_barrier(); asm volatile("" ::: "memory");
    SEG_MARK(1);
    const int jl = 16 * w + r;
    { const bf16_t* vb = Vg + ((size_t)((((t0n >> 7) * 4 + h) * 8 + sl)) << 13); const unsigned vo = (unsigned)tid * 16u;
#pragma unroll
      for (int i = 0; i < 2; ++i) vr[i] = ldg16(vb, vo + 8192u * i); }
    GAS unsigned char* ob = (GAS unsigned char*)(OF + ((size_t)((((t0 >> 7) * 4 + h) * 8 + sl) * 8 + w) << 10)); const unsigned oo = (unsigned)lane * 8u;
    f32x4 O[4];
#pragma unroll
    for (int eb = 0; eb < 4; ++eb) O[eb] = (f32x4){0.f, 0.f, 0.f, 0.f};
    const LAS unsigned char* rtb = RT + r * 512;
    const bf16_t* qub = Qg + (((size_t)(t0n >> 7) * 4 + h) * 8 + w) * 4096; const unsigned qvo = (unsigned)(16 * q + r) * 16u;
    const bf16_t* kub = Kg + (((size_t)(t0n >> 7) * 4 + h) * 8 + w) * 4096; const unsigned kvo = (unsigned)lane * 16u;
    bf16x8 avp[2][4];
#pragma unroll
    for (int eb = 0; eb < 4; ++eb) avp[0][eb] = *(const LAS bf16x8*)(rtb + (16 * eb * 512) + ((q ^ r) << 4));
#pragma unroll
    for (int ks = 0; ks < 8; ++ks) { const bf16x8 qv = __builtin_bit_cast(bf16x8, qf[ks]);
        if (ks < 7) {
#pragma unroll
            for (int eb = 0; eb < 4; ++eb) avp[(ks + 1) & 1][eb] = *(const LAS bf16x8*)(rtb + (16 * eb * 512) + (((4 * (ks + 1) + q) ^ r) << 4));
            asm volatile("s_waitcnt lgkmcnt(4)" ::: "memory"); }
        else asm volatile("s_waitcnt lgkmcnt(0)" ::: "memory");
        __builtin_amdgcn_sched_barrier(0);
#pragma unroll
        for (int eb = 0; eb < 4; ++eb) O[eb] = __builtin_amdgcn_mfma_f32_16x16x32_bf16(avp[ks & 1][eb], qv, O[eb], 0, 0, 0);
        if (w < 4) { qf[ks] = ldg16(qub, qvo + 1024u * ks); kr[ks] = ldg16(kub, kvo + 1024u * ks); }
        __builtin_amdgcn_sched_barrier(0); }
    u32x2 pvf[4];
    if (DIR == 1) {
#pragma unroll
        for (int eb = 0; eb < 4; ++eb) pvf[eb] = *(const GAS u32x2*)(ob + oo + 512 * eb); }
    SEG_MARK(2);
    const int lofs = 128 * (4 * (q >> 1) + (q & 1)) + 8 * r;
    const LAS unsigned char* vtb = VI + r * 256; const LAS unsigned char* ktb = KI + lofs;
#pragma unroll
    for (int ks = 0; ks < 4; ++ks) {
        bf16x8 vb[4], ka[2];
#pragma unroll
        for (int eb = 0; eb < 4; ++eb) vb[eb] = *(const LAS bf16x8*)(vtb + eb * 4096 + (((4 * ks + q) ^ r) << 4));
#pragma unroll
        for (int db = 0; db < 2; ++db) ka[db] = ldtr2(ktb + 128 * (db * 32 + 8 * ks), ktb + 128 * (db * 32 + 8 * ks + 2));
        __builtin_amdgcn_sched_barrier(0);
        const int rel = DIR == 0 ? (ks - (w >> 1)) : ((w >> 1) - ks);
        if (rel <= 0) {
            bf16x8 sfm;
            if (rel < 0) sfm = __builtin_bit_cast(bf16x8, sf[ks]);
            else { unsigned wd[4] = {sf[ks].x, sf[ks].y, sf[ks].z, sf[ks].w};
#pragma unroll
              for (int i = 0; i < 4; ++i) { const int m0 = 32 * ks + 8 * q + 2 * i; const bool k0 = DIR == 0 ? (m0 <= jl) : (m0 >= jl), k1 = DIR == 0 ? (m0 + 1 <= jl) : (m0 + 1 >= jl);
                  wd[i] &= (k0 ? 0xffffu : 0u) | (k1 ? 0xffff0000u : 0u); }
              sfm = __builtin_bit_cast(bf16x8, (u32x4){wd[0], wd[1], wd[2], wd[3]}); }
#pragma unroll
            for (int eb = 0; eb < 4; ++eb) O[eb] = __builtin_amdgcn_mfma_f32_16x16x32_bf16(vb[eb], sfm, O[eb], 0, 0, 0);
        }
#pragma unroll
        for (int db = 0; db < 2; ++db)
#pragma unroll
            for (int eb = 0; eb < 4; ++eb) Rb[db][eb] = __builtin_amdgcn_mfma_f32_16x16x32_bf16(ka[db], vb[eb], Rb[db][eb], 0, 0, 0);
        if (w >= 4) {
            qf[2 * ks] = ldg16(qub, qvo + 1024u * (2 * ks)); qf[2 * ks + 1] = ldg16(qub, qvo + 1024u * (2 * ks + 1));
            kr[2 * ks] = ldg16(kub, kvo + 1024u * (2 * ks)); kr[2 * ks + 1] = ldg16(kub, kvo + 1024u * (2 * ks + 1)); }
    }
    SEG_MARK(3);
    scan_load_s<DIR>(sf, ws, h, rcn, w, r, q);
    {
        float ss = 0.f;
#pragma unroll
        for (int eb = 0; eb < 4; ++eb) { f32x4 v = O[eb] * rsc;
            if (DIR == 1) { const u32x2 pv = pvf[eb]; v[0] += bflo(pv.x); v[1] += bfhi(pv.x); v[2] += bflo(pv.y); v[3] += bfhi(pv.y);
                ss += (v[0] * v[0] + v[1] * v[1]) + (v[2] * v[2] + v[3] * v[3]); }
            u32x2 o; o.x = cvt_pk_bf16(v[0], v[1]); o.y = cvt_pk_bf16(v[2], v[3]); *(GAS u32x2*)(ob + oo + 512 * eb) = o; }
        if (DIR == 1) { ss += shx(ss, 16, lane); ss += shx(ss, 32, lane); if (q == 0) *(GAS float*)((GAS unsigned char*)(SSP + (size_t)(t0 + 16 * w) * 32 + h * 8 + sl) + (unsigned)r * 128u) = ss; }
    }
#pragma unroll
    for (int db = 0; db < 2; ++db)
#pragma unroll
        for (int eb = 0; eb < 4; ++eb) Rb[db][eb] = Rb[db][eb] * g128;
    SEG_MARK(4);
#pragma unroll
    for (int db = 0; db < 2; ++db)
#pragma unroll
        for (int eb = 0; eb < 4; ++eb) { u32x2 o; o.x = cvt_pk_bf16(Rb[db][eb][0], Rb[db][eb][1]); o.y = cvt_pk_bf16(Rb[db][eb][2], Rb[db][eb][3]);
            *(LAS u32x2*)(RTN + (16 * eb + r) * 512 + ((((4 * w + 2 * db + (q >> 1)) ^ r) << 4) | ((q & 1) << 3))) = o; }
}
template <int DIR>
__device__ __forceinline__ void scan_unit(Frame& F, int tid, unsigned char* ws, int b, int h, int sl, float lg, const bf16_t* Qg, const bf16_t* Kg, const bf16_t* Vg, bf16_t* OF, float* SSP) {
    const int lane = tid & 63, w = __builtin_amdgcn_readfirstlane(tid >> 6), r = lane & 15, q = lane >> 4;
    const float g128 = __expf(128.f * lg);
    float wm[2];
    { const int m0 = 8 * (tid & 15); wm[0] = __expf(lg * (float)(DIR == 0 ? 127 - m0 : m0)); wm[1] = __expf(DIR == 0 ? -lg : lg); }
    const int jl = 16 * w + r; const float rsc = __expf(lg * (float)(DIR == 0 ? jl - 127 : -jl));
    f32x4 Rb[2][4];
#pragma unroll
    for (int db = 0; db < 2; ++db)
#pragma unroll
        for (int eb = 0; eb < 4; ++eb) Rb[db][eb] = (f32x4){0.f, 0.f, 0.f, 0.f};
    {
        LAS unsigned char* RT = F.lds + SC_RT_OFF;
#pragma unroll
        for (int db = 0; db < 2; ++db)
#pragma unroll
            for (int eb = 0; eb < 4; ++eb) *(LAS u32x2*)(RT + (16 * eb + r) * 512 + ((((4 * w + 2 * db + (q >> 1)) ^ r) << 4) | ((q & 1) << 3))) = (u32x2){0u, 0u};
    }
    u32x4 sf[4], qf[8], kr[8], vr[2];
    unsigned long long segacc = 0ull, segt = (DBG_SEG >= 0) ? __builtin_amdgcn_s_memtime() : 0ull;
#pragma unroll
    for (int ks = 0; ks < 4; ++ks) sf[ks] = (u32x4){0u, 0u, 0u, 0u};
    scan_load_s<DIR>(sf, ws, h, scan_rc(DIR, b, 0), w, r, q);
    scan_load_q(qf, Qg, h, scan_t0(DIR, b, 0), w, r, q);
    scan_load_kv(kr, vr, Kg, Vg, h, sl, scan_t0(DIR, b, 0), w, lane, tid);
    for (int s = 0; s < 18; ++s) {
        const int sn = (s + 1 < 18) ? s + 1 : 17;
        scan_step<DIR>(segacc, segt, F.lds, sf, qf, kr, vr, Rb, wm, rsc, g128, scan_t0(DIR, b, s), scan_t0(DIR, b, sn), scan_rc(DIR, b, sn), s & 1, ws, h, sl, w, lane, tid, Qg, Kg, Vg, OF, SSP);
    }
    if (DBG_SEG >= 0) { const unsigned long long te_ = __builtin_amdgcn_s_memtime() + segacc; while (__builtin_amdgcn_s_memtime() < te_) __builtin_amdgcn_s_sleep(4); }
    __syncthreads();
}
__device__ __forceinline__ void scan_phase(Frame& F, const Args& a, int layer, int dir) {
    PHASE_IDS();
    const int j = layer >> 1; const float* dec = a.in[11] + j * 8 + dir * 4;
    for (int u = F.vcu; u < 256; u += F.G) {
        const int b = u >> 5, h = (u >> 3) & 3, sl = u & 7;
        const float lg = log1pf(-exp2f(dec[h]));
        if (dir == 0) scan_unit<0>(F, tid, ws, b, h, sl, lg, (const bf16_t*)(ws + WS_Q), (const bf16_t*)(ws + WS_K), (const bf16_t*)(ws + WS_V), (bf16_t*)(ws + WS_OF), (float*)(ws + WS_SSP));
        else scan_unit<1>(F, tid, ws, b, h, sl, lg, (const bf16_t*)(ws + WS_Q), (const bf16_t*)(ws + WS_K), (const bf16_t*)(ws + WS_V), (bf16_t*)(ws + WS_OF), (float*)(ws + WS_SSP));
    }
}
__device__ __forceinline__ void n2_phase(Frame& F, const Args& a, int layer) {
    PHASE_IDS();
    norm_rows<false>(F, a, layer, (bf16_t*)(ws + WS_Q));
    const float* SSP = (const float*)(ws + WS_SSP); float* RINV = (float*)(ws + WS_RINV);
    const int gt = F.vcu * 512 + tid, NT = F.G * 512;
    for (int idx = gt; idx < NTOK * 4; idx += NT) { const f32x4 p0 = *(const f32x4*)(SSP + (size_t)idx * 8), p1 = *(const f32x4*)(SSP + (size_t)idx * 8 + 4);
        const float ss = ((p0.x + p0.y) + (p0.z + p0.w)) + ((p1.x + p1.y) + (p1.z + p1.w)); RINV[idx] = rsqrtf(ss * (1.f / 512.f) + EPS); }
}
__device__ __forceinline__ void final_phase(Frame& F, const Args& a) {
    PHASE_IDS();
    const float* fg = a.in[12]; const int gw = F.vcu * 8 + wave, NGW = F.G * 8;
    f32x4 g[4];
#pragma unroll
    for (int jj = 0; jj < 4; ++jj) g[jj] = *(const f32x4*)(fg + 4 * lane + 256 * jj);
    for (int m0 = gw; m0 < NLAT; m0 += 4 * NGW) {
        f32x4 v[4][4]; float ss[4];
#pragma unroll
        for (int t = 0; t < 4; ++t) { const int m = (m0 + t * NGW) < NLAT ? (m0 + t * NGW) : gw; const f32x4* xr = (const f32x4*)(a.out + (size_t)m * DM) + lane;
#pragma unroll
            for (int jj = 0; jj < 4; ++jj) v[t][jj] = xr[64 * jj]; }
#pragma unroll
        for (int t = 0; t < 4; ++t) { float s = 0.f;
#pragma unroll
            for (int jj = 0; jj < 4; ++jj) s += (v[t][jj].x * v[t][jj].x + v[t][jj].y * v[t][jj].y) + (v[t][jj].z * v[t][jj].z + v[t][jj].w * v[t][jj].w);
            ss[t] = s; }
#pragma unroll
        for (int o = 1; o < 64; o <<= 1) {
#pragma unroll
            for (int t = 0; t < 4; ++t) ss[t] += shx(ss[t], o, lane); }
#pragma unroll
        for (int t = 0; t < 4; ++t) { const int m = m0 + t * NGW; if (m < NLAT) { const float rinv = rsqrtf(ss[t] * (1.f / DM) + EPS); f32x4* xw = (f32x4*)(a.out + (size_t)m * DM) + lane;
#pragma unroll
            for (int jj = 0; jj < 4; ++jj) xw[64 * jj] = v[t][jj] * rinv * g[jj]; } }
    }
}

constexpr int N_PHASES = 34;
__global__ void __launch_bounds__(512, 2) trunk_fwd(Args args) {
    extern __shared__ __attribute__((aligned(16))) unsigned char lds_raw[];
    Frame F;
    F.lds = (LAS unsigned char*)lds_raw;
    F.G = gridDim.x; F.wv = __builtin_amdgcn_readfirstlane((int)threadIdx.x >> 6); { const int bx = blockIdx.x; F.vcu = (F.G % 8 == 0) ? (bx % 8) * (F.G / 8) + bx / 8 : bx; }
    F.ws = args.ws;
    const int lo = args.ph_lo, hi = args.ph_hi;
    XcdBarrier bar; bar.bar = (unsigned*)(args.ws + WS_CTL) + 4096; bar.x = 0; bar.nloc = 1u; bar.nx = 1u;
    const bool multi = (hi - lo) > 1;
    if (multi) { bar = xcd_barrier_post((unsigned*)(args.ws + WS_CTL) + 4096); xcd_census(bar, (volatile LAS unsigned*)F.lds); }
#ifndef KINDS
#define KINDS 0xFFFF
#endif
#define KON(b) (((KINDS) >> (b)) & 1)
#define IN(k) (lo <= (k) && (k) < hi)
#ifndef DBG_PROBE
#define DBG_PROBE -1
#endif
    unsigned long long tph0 = (DBG_PROBE >= 0) ? __builtin_amdgcn_s_memrealtime() : 0ull; int cur_layer = -1;
#ifndef DBG_PLAYER
#define DBG_PLAYER -1
#endif
#define PROBE(kind) do { if (DBG_PROBE == (kind) && (DBG_PLAYER < 0 || DBG_PLAYER == cur_layer)) { const unsigned long long t1_ = __builtin_amdgcn_s_memrealtime(); const unsigned long long te_ = t1_ + (t1_ - tph0); while (__builtin_amdgcn_s_memrealtime() < te_) __builtin_amdgcn_s_sleep(8); } } while (0)
#define SEAM(k) do { if (multi && (k) + 1 < hi) xcd_barrier(bar); if (DBG_PROBE >= 0) tph0 = __builtin_amdgcn_s_memrealtime(); } while (0)
    const int bx = (int)blockIdx.x, G = F.G;
    const bool mergeS = multi && G == 256 && lo == 0;
    const bool mergeP0 = mergeS && hi > 1 && KON(0) && KON(1);
    if (KON(0) && IN(0)) { p0_phase(F, args); if (mergeP0) xq_arrive(bar, 4); p0_conv(F, args); if (mergeP0) xq_wait(bar, 4); PROBE(0); if (!mergeP0) SEAM(0); }
    for (int layer = 0; layer < NLAYER; ++layer) {
        const int pb = 1 + 8 * layer; const bool fourier = (layer & 1) == 0; cur_layer = layer;
        unsigned char* ws = launder_ptr(args.ws);
#define MAKE_ER() const EpiResid ER{layer == 0 ? args.in[0] : args.out, args.out, (const float*)(ws + WS_ADA) + layer * 9 * 3072 + 2048, (float*)(ws + WS_PART)}
        if (KON(1) && IN(pb)) { n_phase(F, args, layer); PROBE(1); SEAM(pb); }
        if (fourier) {
            bf16_t* W1 = (bf16_t*)(ws + WS_WF);
            if (KON(2) && IN(pb + 1)) {
                { pg8::Gemm g{(const bf16_t*)(ws + WS_H), W1 + (size_t)2048 * 1024, 1024, 1024, 1024}; pg8::TileOrder S; S.init(72, 8, G, bx);
                  EpiSilu E{(bf16_t*)(ws + WS_Z), 2048}; pg8::gemm_phase(F.lds, F.wv, g, S, E); }
                if (G == 256) {
                  { pg8::Gemm g{W1, (const bf16_t*)(ws + WS_H), 1024, 1024, 1024}; UFoldOrder S; S.init(4, 80, G, (bx + 64) % G); S.ws = ws;
                    EpiUTF2 E{(bf16_t*)(ws + WS_UTL), (bf16_t*)(ws + WS_UTC)}; pg8::gemm_phase(F.lds, F.wv, g, S, E); }
                  ufold_jobs(F, 64);
                  if (layer == 0) bg_cs_fourier(F, 64);
                } else
                { pg8::Gemm g{W1, (const bf16_t*)(ws + WS_H), 1024, 1024, 1024}; UOrder S; S.init(8, 72, G, (bx + 64) % G);
                  EpiUTF E{(bf16_t*)(ws + WS_UTL), (bf16_t*)(ws + WS_UTC), (float*)(ws + WS_RINV)}; pg8::gemm_phase<EpiUTF, UOrder, true>(F.lds, F.wv, g, S, E); }
                bg_conv_ret(F, args, layer, 64, 0, 1024);
                PROBE(2); SEAM(pb + 1);
            }
            if (KON(3) && IN(pb + 2)) {
                { pg8::Gemm g{(const bf16_t*)(ws + WS_CS), (const bf16_t*)(ws + WS_UTL), 1024, 1024, 1024}; pg8::TileOrder S; S.init(8, 64, G, bx);
                  EpiDft<true> E{(bf16_t*)(ws + WS_Z), 2048, 0, (const float*)(ws + WS_RINV)}; pg8::gemm_phase(F.lds, F.wv, g, S, E); }
                { pg8::Gemm g{(const bf16_t*)(ws + WS_CS256), (const bf16_t*)(ws + WS_UTC), 256, 256, 256}; pg8::TileOrder S; S.init(2, 64, G, bx);
                  EpiDft<false> E{(bf16_t*)(ws + WS_Z), 256, NLAT, nullptr}; pg8::gemm_phase(F.lds, F.wv, g, S, E); }
                nyq_row_phase(F);
                bg_conv_ret(F, args, layer, 128, 1024, 1536);
                PROBE(3); SEAM(pb + 2);
            }
            if (KON(4) && IN(pb + 3)) {
                pg8::Gemm g{(const bf16_t*)(ws + WS_Z), W1 + (size_t)4096 * 1024, 2048, 2048, 2048}; OutOrder S; S.init(G, bx, true); MAKE_ER();
                pg8::gemm_phase(F.lds, F.wv, g, S, ER);
                bg_conv_ret(F, args, layer, 128, 1536, 2048);
                PROBE(4); SEAM(pb + 3);
            }
        } else {
            bf16_t* W1 = (bf16_t*)(ws + WS_W);
            if (KON(5) && IN(pb + 1)) {
                pg8::Gemm g{(const bf16_t*)(ws + WS_OF), W1, 1024, 1024, 1024};
                EpiQKV E{(bf16_t*)(ws + WS_Q), (bf16_t*)(ws + WS_K), (bf16_t*)(ws + WS_V), (const float*)(ws + WS_ROPE), (const float*)(ws + WS_ROPE) + 4096};
                if (mergeS) {
                    { QKVOrder S; S.init2(G, bx, 0, 4); pg8::gemm_phase(F.lds, F.wv, g, S, E); }
                    xq_arrive(bar, layer);
                    if (bx < 128) { QKVOrder S; S.init2(G, bx, 4, 5); pg8::gemm_phase(F.lds, F.wv, g, S, E); }
                    else { xq_wait(bar, layer);
                        pg8::Gemm gs{(const bf16_t*)(ws + WS_Q), (const bf16_t*)(ws + WS_K), 1024, 1024, 256}; DiagOrder S{128, bx - 128};
                        EpiS ES{ws}; pg8::gemm_phase<EpiS, DiagOrder, false, true>(F.lds, F.wv, gs, S, ES); }
                } else { QKVOrder S; S.init2(G, bx, 0, 1 << 20); pg8::gemm_phase(F.lds, F.wv, g, S, E); }
                PROBE(5); SEAM(pb + 1);
            }
            if (KON(6) && IN(pb + 2)) {
                if (!mergeS) {
                    { pg8::Gemm g{(const bf16_t*)(ws + WS_Q), (const bf16_t*)(ws + WS_K), 1024, 1024, 256}; DiagOrder S{G, bx};
                      EpiS E{ws}; pg8::gemm_phase<EpiS, DiagOrder, false, true>(F.lds, F.wv, g, S, E); }
                    PROBE(11); if (multi) xcd_barrier(bar); if (DBG_PROBE >= 0) tph0 = __builtin_amdgcn_s_memrealtime(); }
                scan_phase(F, args, layer, 0); PROBE(6);
            }
            if (KON(6) && IN(pb + 3)) {
                if (multi) { asm volatile("s_waitcnt vmcnt(0)" ::: "memory"); __syncthreads();
                    if (threadIdx.x == 0) { __builtin_amdgcn_fence(__ATOMIC_ACQUIRE, "agent"); asm volatile("s_waitcnt vmcnt(0)" ::: "memory"); }
                    __syncthreads(); if (DBG_PROBE >= 0) tph0 = __builtin_amdgcn_s_memrealtime(); }
                scan_phase(F, args, layer, 1); PROBE(12); SEAM(pb + 3); }
            if (KON(7) && IN(pb + 4)) { n2_phase(F, args, layer); PROBE(7); SEAM(pb + 4); }
            if (KON(8) && IN(pb + 5)) {
                pg8::Gemm g{(const bf16_t*)(ws + WS_Q), W1 + (size_t)4096 * 1024, 1024, 1024, 1024}; pg8::TileOrder S; S.init(layer == NLAYER - 1 ? 64 : 72, 8, G, bx);
                EpiZGate E{(const bf16_t*)(ws + WS_OF), (const float*)(ws + WS_RINV), (bf16_t*)(ws + WS_V)};
                pg8::gemm_phase(F.lds, F.wv, g, S, E);
                bg_conv_fourier(F, args, layer, 64);
                PROBE(8); SEAM(pb + 5);
            }
            if (KON(9) && IN(pb + 6)) {
                pg8::Gemm g{(const bf16_t*)(ws + WS_V), W1 + (size_t)6144 * 1024, 2048, 2048, 2048}; OutOrder S; S.init(G, bx, layer != NLAYER - 1); MAKE_ER();
                pg8::gemm_phase(F.lds, F.wv, g, S, ER);
                bg_place_fourier(F, args, layer, 128);
                PROBE(9); SEAM(pb + 6);
            }
        }
    }
    if (KON(10) && IN(33)) { final_phase(F, args); PROBE(10); }
#undef IN
#undef SEAM
}

extern "C" void kernel_launch(void* const* d_in, const int* in_sizes, int n_in, void* d_out, int out_size, void* d_ws, size_t ws_size, hipStream_t stream) {
    static int grid = 0;
    if (grid == 0) {
        if (n_in != 13 || out_size != NLAT * DM || ws_size < WS_END) { fprintf(stderr, "kernel_launch: unexpected problem (n_in %d, out %d, ws %zu)\n", n_in, out_size, ws_size); grid = -1; return; }
        int dev = 0, cus = 0;
        if (hipGetDevice(&dev) != hipSuccess || hipDeviceGetAttribute(&cus, hipDeviceAttributeMultiprocessorCount, dev) != hipSuccess) { grid = -1; return; }
        if (hipFuncSetAttribute((const void*)trunk_fwd, hipFuncAttributeMaxDynamicSharedMemorySize, LDS_BYTES) != hipSuccess) { fprintf(stderr, "kernel_launch: hipFuncSetAttribute failed\n"); grid = -1; return; }
        (void)hipGetLastError();
        grid = cus;
    }
    if (grid < 0) return;
    if (hipMemsetAsync((char*)d_ws + WS_CTL, 0, CTL_ZERO_BYTES, stream) != hipSuccess) return;
    Args a{};
    for (int i = 0; i < 13; ++i) a.in[i] = (const float*)d_in[i];
    a.out = (float*)d_out; a.ws = (unsigned char*)d_ws;
    a.ph_lo = 0; a.ph_hi = N_PHASES;
    hipLaunchKernelGGL(trunk_fwd, dim3(grid), dim3(512), LDS_BYTES, stream, a);
}
```
